# Optimizing an MI355X kernel written in HIP

```python
import jax
import jax.numpy as jnp
from jax import lax
import numpy as np

D_MODEL = 2048
BATCH = 1
SEQ = 8192
DEPTH = 4

D_MIX = D_MODEL
HEAD_DIM = 128
HG_HEADS = D_MIX // (4 * HEAD_DIM)
HG_DK = 128
HG_DV = HEAD_DIM
HG_WIDTH = HG_HEADS * HG_DV
HG_CHUNK = 64
HG_MIN_FORGET = 1e-20
NSA_HEADS = D_MIX // (2 * HEAD_DIM)
NSA_KV_HEADS = 2
NSA_GROUP = NSA_HEADS // NSA_KV_HEADS
NSA_WIDTH = NSA_HEADS * HEAD_DIM
NSA_KV_WIDTH = NSA_KV_HEADS * HEAD_DIM
CMP_LEN = 32
CMP_STRIDE = 16
SEL_BLOCK = 64
N_SELECT = 16
WINDOW = 512
WIN_BLOCK = 128
SEL_Q_BLOCK = 64
ML_HEADS = D_MIX // (4 * HEAD_DIM)
ML_DK = HEAD_DIM
ML_DV = HEAD_DIM
ML_WIDTH = ML_HEADS * ML_DV
ML_CHUNK = 64
ML_CONV = 4
MEM_TOKENS = 256
XA_HEADS = 4
XA_HEAD_DIM = D_MODEL // XA_HEADS
D_FF = 4 * D_MODEL
ROPE_THETA = 10000.0
EPS = 1e-6
NEG_INF = -1e30
FORCE_BONUS = 1e4
IN_SIZES = ((HG_HEADS * HG_DK,) * 2 + (HG_WIDTH,) * 2
            + (NSA_WIDTH,) + (NSA_KV_WIDTH,) * 6 + (3 * NSA_HEADS,)
            + (ML_HEADS * ML_DK,) * 2 + (ML_WIDTH,) * 2 + (ML_HEADS, ML_HEADS))
D_IN = sum(IN_SIZES)

kernel_name = 'hymba_style_hgrn2_nsa_mlstm_trunk'


def rms_norm(x, gain):
    xf = x.astype(jnp.float32)
    y = xf * lax.rsqrt(jnp.mean(xf * xf, axis=-1, keepdims=True) + EPS)
    return (y * gain.astype(jnp.float32)).astype(x.dtype)


def rope(x, pos):
    half = x.shape[-1] // 2
    inv_freq = ROPE_THETA ** (-jnp.arange(half, dtype=jnp.float32) / half)
    ang = pos[:, None] * inv_freq[None, :]
    cos = jnp.cos(ang)[:, None, :]
    sin = jnp.sin(ang)[:, None, :]
    xf = x.astype(jnp.float32)
    x1, x2 = xf[..., :half], xf[..., half:]
    return jnp.concatenate([x1 * cos - x2 * sin, x2 * cos + x1 * sin], axis=-1).astype(x.dtype)


def masked_softmax(s, mask):
    p = jax.nn.softmax(jnp.where(mask, s, NEG_INF), axis=-1)
    return jnp.where(mask, p, 0.0)


def causal_conv(x, w):
    c = x.shape[-1]
    return lax.conv_general_dilated(x, w[:, None, :].astype(x.dtype), window_strides=(1,),
                                    padding=[(w.shape[0] - 1, 0)],
                                    dimension_numbers=('NWC', 'WIO', 'NWC'),
                                    feature_group_count=c)


def split_cols(z, sizes):
    parts, start = [], 0
    for s in sizes:
        parts.append(z[..., start:start + s])
        start += s
    return parts


def hgrn2_mixer(q, f_pre, i_in, g, lb, norm_gain):
    b_sz, t_len, _ = q.shape
    lbf = lb.astype(jnp.float32)
    zf = f_pre.astype(jnp.float32)
    forget = lbf + (1.0 - lbf) * jax.nn.sigmoid(zf)
    log_f = jnp.log(jnp.maximum(forget, HG_MIN_FORGET))
    key = (1.0 - lbf) * jax.nn.sigmoid(-zf)
    n_chunks = t_len // HG_CHUNK

    def chunked(a, d):
        return a.astype(jnp.float32).reshape(b_sz, n_chunks, HG_CHUNK, HG_HEADS, d).transpose(1, 0, 3, 2, 4)

    xs = (chunked(q, HG_DK), chunked(log_f, HG_DK), chunked(key, HG_DK), chunked(i_in, HG_DV))
    causal = jnp.tril(jnp.ones((HG_CHUNK, HG_CHUNK), dtype=bool))[:, :, None]

    def step(state, inp):
        qc, lfc, kc, vc = inp
        b = jnp.cumsum(lfc, axis=2)
        diff = b[:, :, :, None, :] - b[:, :, None, :, :]
        decay = jnp.where(causal, jnp.exp(jnp.where(causal, diff, 0.0)), 0.0)
        scores = jnp.einsum('bhtd,bhsd,bhtsd->bhts', qc, kc, decay)
        out = (jnp.einsum('bhtd,bhde->bhte', qc * jnp.exp(b), state)
               + jnp.einsum('bhts,bhse->bhte', scores, vc))
        b_end = b[:, :, -1:, :]
        new_state = (jnp.exp(b_end[:, :, 0, :])[..., None] * state
                     + jnp.einsum('bhsd,bhse->bhde', kc * jnp.exp(b_end - b), vc))
        return new_state, out

    s0 = jnp.zeros((b_sz, HG_HEADS, HG_DK, HG_DV), jnp.float32)
    _, o = lax.scan(step, s0, xs)
    o = o.transpose(1, 0, 3, 2, 4).reshape(b_sz, t_len, HG_HEADS, HG_DV)
    o = rms_norm(o, norm_gain.reshape(HG_HEADS, HG_DV)).reshape(b_sz, t_len, HG_WIDTH)
    return (o * jax.nn.silu(g.astype(jnp.float32))).astype(g.dtype)


def nsa_mixer(q, k_c, v_c, k_s, v_s, k_w, v_w, gate_pre, q_gain, k_gains, cmp_pos, cmp_w):
    dt = q.dtype
    b_sz, t_len, _ = q.shape
    hk, grp, d = NSA_KV_HEADS, NSA_GROUP, HEAD_DIM
    scale = d ** -0.5
    pos = jnp.arange(t_len, dtype=jnp.float32)
    qh = rope(rms_norm(q.reshape(b_sz, t_len, NSA_HEADS, d), q_gain), pos)
    qh = qh.reshape(b_sz, t_len, hk, grp, d).transpose(0, 2, 3, 1, 4)

    def kv_heads(a):
        return a.reshape(b_sz, t_len, hk, d)

    n_cmp = t_len // CMP_STRIDE - 1
    cmp_idx = np.arange(n_cmp)[:, None] * CMP_STRIDE + np.arange(CMP_LEN)[None, :]

    def compress(a, pe, w):
        blocks = kv_heads(a)[:, cmp_idx] + pe[None, None, :, None, :]
        return jnp.einsum('bclgd,lde->bcge', blocks, w)

    cmp_end = jnp.arange(n_cmp, dtype=jnp.float32) * CMP_STRIDE + (CMP_LEN - 1)
    kc = rope(rms_norm(compress(k_c, cmp_pos[0], cmp_w[0]), k_gains[0]), cmp_end).transpose(0, 2, 1, 3)
    vc = compress(v_c, cmp_pos[1], cmp_w[1]).transpose(0, 2, 1, 3)
    cmp_visible = cmp_end[None, :] <= pos[:, None]
    s_cmp = jnp.einsum('bgjtd,bgcd->bgjtc', qh, kc, preferred_element_type=jnp.float32) * scale
    p_cmp = masked_softmax(s_cmp, cmp_visible)
    o_cmp = jnp.einsum('bgjtc,bgcd->bgjtd', p_cmp.astype(dt), vc)

    n_sel = t_len // SEL_BLOCK
    k_top = min(N_SELECT, n_sel)
    c_start = np.arange(n_cmp) * CMP_STRIDE
    s_start = np.arange(n_sel) * SEL_BLOCK
    overlap = ((c_start[:, None] < s_start[None, :] + SEL_BLOCK)
               & (c_start[:, None] + CMP_LEN > s_start[None, :])).astype(np.float32)
    importance = jnp.einsum('bgjtc,cs->bgts', p_cmp, jnp.asarray(overlap))
    cur_blk = np.arange(t_len)[:, None] // SEL_BLOCK
    blk = np.arange(n_sel)[None, :]
    eligible = blk <= cur_blk
    forced = (blk == 0) | (blk == cur_blk) | (blk == cur_blk - 1)
    sel_score = jnp.where(eligible, importance + jnp.where(forced, FORCE_BONUS, 0.0), NEG_INF)
    top_val, top_idx = lax.top_k(sel_score, k_top)
    top_ok = top_val > 0.5 * NEG_INF

    k_sel = rope(rms_norm(kv_heads(k_s), k_gains[1]), pos).transpose(0, 2, 1, 3).reshape(b_sz, hk, n_sel, SEL_BLOCK, d)
    v_sel = kv_heads(v_s).transpose(0, 2, 1, 3).reshape(b_sz, hk, n_sel, SEL_BLOCK, d)
    n_qb = t_len // SEL_Q_BLOCK
    q_blocks = qh.reshape(b_sz, hk, grp, n_qb, SEL_Q_BLOCK, d).transpose(3, 0, 1, 2, 4, 5)
    idx_blocks = top_idx.reshape(b_sz, hk, n_qb, SEL_Q_BLOCK, k_top).transpose(2, 0, 1, 3, 4)
    ok_blocks = top_ok.reshape(b_sz, hk, n_qb, SEL_Q_BLOCK, k_top).transpose(2, 0, 1, 3, 4)
    t_blocks = jnp.arange(t_len).reshape(n_qb, SEL_Q_BLOCK)
    bi = jnp.arange(b_sz)[:, None, None, None]
    gi = jnp.arange(hk)[None, :, None, None]
    offs = jnp.arange(SEL_BLOCK)

    def select_block(args):
        qb, ib, okb, tb = args
        kg = k_sel[bi, gi, ib].reshape(b_sz, hk, SEL_Q_BLOCK, k_top * SEL_BLOCK, d)
        vg = v_sel[bi, gi, ib].reshape(b_sz, hk, SEL_Q_BLOCK, k_top * SEL_BLOCK, d)
        kpos = ib[..., None] * SEL_BLOCK + offs
        mask = (okb[..., None] & (kpos <= tb[None, None, :, None, None])).reshape(
            b_sz, hk, SEL_Q_BLOCK, k_top * SEL_BLOCK)
        s = jnp.einsum('bgjqd,bgqkd->bgjqk', qb, kg, preferred_element_type=jnp.float32) * scale
        p = masked_softmax(s, mask[:, :, None])
        return jnp.einsum('bgjqk,bgqkd->bgjqd', p.astype(dt), vg)

    o_sel = lax.map(select_block, (q_blocks, idx_blocks, ok_blocks, t_blocks))
    o_sel = o_sel.transpose(1, 2, 3, 0, 4, 5).reshape(b_sz, hk, grp, t_len, d)

    n_wb = t_len // WIN_BLOCK
    n_back = WINDOW // WIN_BLOCK
    band = np.arange(n_wb)[:, None] + np.arange(n_back + 1)[None, :]

    def banded(a):
        blocks = a.transpose(0, 2, 1, 3).reshape(b_sz, hk, n_wb, WIN_BLOCK, d)
        padded = jnp.pad(blocks, ((0, 0), (0, 0), (n_back, 0), (0, 0), (0, 0)))
        return padded[:, :, band].reshape(b_sz, hk, n_wb, (n_back + 1) * WIN_BLOCK, d)

    k_band = banded(rope(rms_norm(kv_heads(k_w), k_gains[2]), pos))
    v_band = banded(kv_heads(v_w))
    q_pos = np.arange(t_len).reshape(n_wb, WIN_BLOCK)
    k_pos = (np.arange(n_wb)[:, None] - n_back) * WIN_BLOCK + np.arange((n_back + 1) * WIN_BLOCK)[None, :]
    rel = q_pos[:, :, None] - k_pos[:, None, :]
    win_mask = (rel >= 0) & (rel < WINDOW) & (k_pos[:, None, :] >= 0)
    q_win = qh.reshape(b_sz, hk, grp, n_wb, WIN_BLOCK, d)
    s_win = jnp.einsum('bgjnqd,bgnkd->bgjnqk', q_win, k_band, preferred_element_type=jnp.float32) * scale
    p_win = masked_softmax(s_win, win_mask)
    o_win = jnp.einsum('bgjnqk,bgnkd->bgjnqd', p_win.astype(dt), v_band).reshape(b_sz, hk, grp, t_len, d)

    gates = jax.nn.sigmoid(gate_pre.astype(jnp.float32)).reshape(b_sz, t_len, hk, grp, 3).transpose(0, 2, 3, 1, 4)
    o = gates[..., 0:1] * o_cmp + gates[..., 1:2] * o_sel + gates[..., 2:3] * o_win
    return o.transpose(0, 3, 1, 2, 4).reshape(b_sz, t_len, NSA_WIDTH).astype(dt)


def mlstm_mixer(q, k, v, o_pre, i_pre, f_pre, conv_w, norm_gain):
    b_sz, t_len, _ = q.shape
    qk = jax.nn.silu(causal_conv(jnp.concatenate([q, k], axis=-1), conv_w))
    q, k = qk[..., :ML_HEADS * ML_DK], qk[..., ML_HEADS * ML_DK:]
    n_chunks = t_len // ML_CHUNK

    def chunked(a, d):
        return a.astype(jnp.float32).reshape(b_sz, n_chunks, ML_CHUNK, ML_HEADS, d).transpose(1, 0, 3, 2, 4)

    def chunked_gate(a):
        return a.astype(jnp.float32).reshape(b_sz, n_chunks, ML_CHUNK, ML_HEADS).transpose(1, 0, 3, 2)

    xs = (chunked(q, ML_DK) * ML_DK ** -0.5, chunked(k, ML_DK), chunked(v, ML_DV),
          chunked_gate(jax.nn.log_sigmoid(f_pre.astype(jnp.float32))),
          chunked_gate(i_pre))
    causal = jnp.tril(jnp.ones((ML_CHUNK, ML_CHUNK), dtype=bool))

    def step(carry, inp):
        c_mem, n_mem, m_prev = carry
        qc, kc, vc, lfc, lic = inp
        b = jnp.cumsum(lfc, axis=-1)
        d_log = jnp.where(causal, b[..., :, None] - b[..., None, :] + lic[..., None, :], NEG_INF)
        inter_log = b + m_prev[..., None]
        m_t = jnp.maximum(inter_log, jnp.max(d_log, axis=-1))
        w_intra = jnp.exp(d_log - m_t[..., None])
        w_inter = jnp.exp(inter_log - m_t)
        s = jnp.einsum('bhtd,bhsd->bhts', qc, kc) * w_intra
        num = (w_inter[..., None] * jnp.einsum('bhtd,bhde->bhte', qc, c_mem)
               + jnp.einsum('bhts,bhse->bhte', s, vc))
        qn = w_inter * jnp.einsum('bhtd,bhd->bht', qc, n_mem) + jnp.sum(s, axis=-1)
        h = num / jnp.maximum(jnp.abs(qn), jnp.exp(-m_t))[..., None]
        b_end = b[..., -1]
        w_state = b_end[..., None] - b + lic
        m_new = jnp.maximum(b_end + m_prev, jnp.max(w_state, axis=-1))
        carry_decay = jnp.exp(b_end + m_prev - m_new)
        k_w = kc * jnp.exp(w_state - m_new[..., None])[..., None]
        c_new = carry_decay[..., None, None] * c_mem + jnp.einsum('bhsd,bhse->bhde', k_w, vc)
        n_new = carry_decay[..., None] * n_mem + jnp.sum(k_w, axis=-2)
        return (c_new, n_new, m_new), h

    init = (jnp.zeros((b_sz, ML_HEADS, ML_DK, ML_DV), jnp.float32),
            jnp.zeros((b_sz, ML_HEADS, ML_DK), jnp.float32),
            jnp.zeros((b_sz, ML_HEADS), jnp.float32))
    _, h = lax.scan(step, init, xs)
    h = h.transpose(1, 0, 3, 2, 4).reshape(b_sz, t_len, ML_HEADS, ML_DV)
    h = rms_norm(h, norm_gain.reshape(ML_HEADS, ML_DV)).reshape(b_sz, t_len, ML_WIDTH)
    return (h * jax.nn.sigmoid(o_pre.astype(jnp.float32))).astype(o_pre.dtype)


def memory_cross_attention(h, mem_n, wq, wk, wv, wo, q_gain, k_gain):
    b_sz, t_len, _ = h.shape
    m_len = mem_n.shape[1]
    q = rms_norm((h @ wq).reshape(b_sz, t_len, XA_HEADS, XA_HEAD_DIM), q_gain)
    k = rms_norm((mem_n @ wk).reshape(b_sz, m_len, XA_HEADS, XA_HEAD_DIM), k_gain)
    v = (mem_n @ wv).reshape(b_sz, m_len, XA_HEADS, XA_HEAD_DIM)
    s = jnp.einsum('bthd,bmhd->bhtm', q, k, preferred_element_type=jnp.float32) * XA_HEAD_DIM ** -0.5
    p = jax.nn.softmax(s, axis=-1)
    o = jnp.einsum('bhtm,bmhd->bthd', p.astype(v.dtype), v).reshape(b_sz, t_len, D_MODEL)
    return o @ wo


def setup_inputs(seed: int = 0) -> dict:
    key = jax.random.key(seed)
    ks = jax.random.split(key, 26)
    f32 = jnp.float32

    def normal(k, shape, scale):
        return jax.random.normal(k, shape, f32) * scale

    def gain(k, shape):
        return 1.0 + 0.02 * jax.random.normal(k, shape, f32)

    b_in = normal(ks[3], (DEPTH, D_IN), 0.02)
    b_in = b_in.at[:, D_IN - ML_HEADS:].add(jnp.linspace(3.0, 6.0, ML_HEADS, dtype=f32))
    return {
        'x': normal(ks[0], (BATCH, SEQ, D_MODEL), 1.0),
        'mem': normal(ks[1], (BATCH, MEM_TOKENS, D_MODEL), 1.0),
        'norm_mix': gain(ks[2], (DEPTH, D_MODEL)),
        'w_in': normal(ks[4], (DEPTH, D_MODEL, D_IN), D_MODEL ** -0.5),
        'b_in': b_in,
        'hgrn_lb_logits': normal(ks[5], (DEPTH, HG_HEADS * HG_DK), 0.1),
        'hgrn_norm': gain(ks[6], (DEPTH, HG_WIDTH)),
        'nsa_q_norm': gain(ks[7], (DEPTH, HEAD_DIM)),
        'nsa_k_norm': gain(ks[8], (DEPTH, 3, HEAD_DIM)),
        'nsa_cmp_pos': normal(ks[9], (DEPTH, 2, CMP_LEN, HEAD_DIM), 0.02),
        'nsa_cmp_w': normal(ks[10], (DEPTH, 2, CMP_LEN, HEAD_DIM, HEAD_DIM), (CMP_LEN * HEAD_DIM) ** -0.5),
        'mlstm_conv': normal(ks[11], (DEPTH, ML_CONV, 2 * ML_HEADS * ML_DK), ML_CONV ** -0.5),
        'mlstm_norm': gain(ks[12], (DEPTH, ML_WIDTH)),
        'w_out': normal(ks[13], (DEPTH, D_MIX, D_MODEL), 0.5 * D_MIX ** -0.5),
        'norm_xattn': gain(ks[14], (DEPTH, D_MODEL)),
        'norm_mem': gain(ks[15], (DEPTH, D_MODEL)),
        'xa_wq': normal(ks[16], (DEPTH, D_MODEL, D_MODEL), D_MODEL ** -0.5),
        'xa_wk': normal(ks[17], (DEPTH, D_MODEL, D_MODEL), D_MODEL ** -0.5),
        'xa_wv': normal(ks[18], (DEPTH, D_MODEL, D_MODEL), D_MODEL ** -0.5),
        'xa_wo': normal(ks[19], (DEPTH, D_MODEL, D_MODEL), 0.5 * D_MODEL ** -0.5),
        'xa_q_norm': gain(ks[20], (DEPTH, XA_HEAD_DIM)),
        'xa_k_norm': gain(ks[21], (DEPTH, XA_HEAD_DIM)),
        'norm_mlp': gain(ks[22], (DEPTH, D_MODEL)),
        'mlp_w1': normal(ks[23], (DEPTH, D_MODEL, D_FF), D_MODEL ** -0.5),
        'mlp_w2': normal(ks[24], (DEPTH, D_FF, D_MODEL), 0.5 * D_FF ** -0.5),
    }


def reference(x, mem, norm_mix, w_in, b_in, hgrn_lb_logits, hgrn_norm, nsa_q_norm, nsa_k_norm,
              nsa_cmp_pos, nsa_cmp_w, mlstm_conv, mlstm_norm, w_out, norm_xattn, norm_mem,
              xa_wq, xa_wk, xa_wv, xa_wo, xa_q_norm, xa_k_norm, norm_mlp, mlp_w1, mlp_w2):
    probs = jax.nn.softmax(hgrn_lb_logits.astype(jnp.float32), axis=0)
    lower_bounds = jnp.cumsum(probs, axis=0) - probs[0:1]
    for layer in range(DEPTH):
        h = rms_norm(x, norm_mix[layer])
        z = h @ w_in[layer] + b_in[layer]
        (hg_q, hg_f, hg_i, hg_g,
         ns_q, ns_kc, ns_vc, ns_ks, ns_vs, ns_kw, ns_vw, ns_gate,
         ml_q, ml_k, ml_v, ml_o, ml_i, ml_f) = split_cols(z, IN_SIZES)
        y_hg = hgrn2_mixer(hg_q, hg_f, hg_i, hg_g, lower_bounds[layer], hgrn_norm[layer])
        y_ns = nsa_mixer(ns_q, ns_kc, ns_vc, ns_ks, ns_vs, ns_kw, ns_vw, ns_gate,
                         nsa_q_norm[layer], nsa_k_norm[layer], nsa_cmp_pos[layer], nsa_cmp_w[layer])
        y_ml = mlstm_mixer(ml_q, ml_k, ml_v, ml_o, ml_i, ml_f, mlstm_conv[layer], mlstm_norm[layer])
        y = jnp.concatenate([y_hg, y_ns, y_ml], axis=-1)
        x = x + y @ w_out[layer]
        x = x + memory_cross_attention(rms_norm(x, norm_xattn[layer]), rms_norm(mem, norm_mem[layer]),
                                       xa_wq[layer], xa_wk[layer], xa_wv[layer], xa_wo[layer],
                                       xa_q_norm[layer], xa_k_norm[layer])
        hm = rms_norm(x, norm_mlp[layer])
        x = x + jnp.square(jax.nn.relu(hm @ mlp_w1[layer])) @ mlp_w2[layer]
    return x
```

```cpp
#include <hip/hip_runtime.h>
#include <cstdio>
#include <cstdint>
#define MK_PER_PHASE 0
#ifndef ORACLE_MIX
#define ORACLE_MIX 0
#endif
#ifndef ORACLE_ATTN
#define ORACLE_ATTN 0
#endif
#ifndef NSA_V2
#define NSA_V2 1
#endif
#ifndef KS
#define KS 1
#endif
__device__ __forceinline__ void swap32(unsigned& a, unsigned& b) { asm volatile("s_nop 1\n\tv_permlane32_swap_b32 %0, %1\n\ts_nop 1" : "+v"(a), "+v"(b)); }
template <int M> __device__ __forceinline__ float sxor(float v) { static_assert(M < 32, "use half_sum / half_max for the two lane halves");
    return __builtin_bit_cast(float, __builtin_amdgcn_ds_swizzle(__builtin_bit_cast(int, v), (M << 10) | 0x1f)); }
template <int M> __device__ __forceinline__ int sxori(int v) { static_assert(M < 32, "");
    return __builtin_amdgcn_ds_swizzle(v, (M << 10) | 0x1f); }
__device__ __forceinline__ float half_sum(float v) { unsigned a = __builtin_bit_cast(unsigned, v), b = a; swap32(a, b); return __builtin_bit_cast(float, a) + __builtin_bit_cast(float, b); }
__device__ __forceinline__ float half_max(float v) { unsigned a = __builtin_bit_cast(unsigned, v), b = a; swap32(a, b); return fmaxf(__builtin_bit_cast(float, a), __builtin_bit_cast(float, b)); }
namespace pg8 {
#define PG8_LAS __attribute__((address_space(3)))
typedef unsigned short bf16_t;
typedef short bf16x8 __attribute__((ext_vector_type(8)));
typedef float f32x4 __attribute__((ext_vector_type(4)));
typedef unsigned u32x4 __attribute__((ext_vector_type(4)));
constexpr int BM = 256, BK = 64, HALF = 128, HTB = HALF * BK * 2  , STAGE_BYTES = 8 * HTB, NXCD = 8, WGM = 8;

__host__ __device__ __forceinline__ int lds_byte(int r, int c) { const int st = (r >> 4) * 2 + (c >> 5), rr = r & 15, cc = c & 31, ob = rr * 64 + cc * 2; return st * 1024 + (ob ^ (((ob >> 9) & 1) << 5)); }
__host__ __device__ __forceinline__ void stage_rc(int b, int& R, int& C) { const int st = b / 1024, sb = b % 1024, swz = sb ^ (((sb >> 9) & 1) << 5); R = (st >> 1) * 16 + swz / 64; C = (st & 1) * 32 + (swz % 64) / 2; }
__host__ __device__ __forceinline__ int perm32(int rho) { const int n = rho >> 4, i = rho & 15; return 8 * (i >> 2) + 4 * n + (i & 3); }

struct Unit { int pm, pn; };
struct Gemm { const bf16_t* A; const bf16_t* Bt; int M, N, K; };

struct StaticOrder {
    int nM, nN, nwg, G, c;
    __host__ __device__ void init(int M, int N, int G_, int c_) { nM = M / BM; nN = N / BM; nwg = nM * nN; G = G_; c = c_; }
    __host__ __device__ bool next(int i, Unit& u) const {
        const long L = (long)i * G + c; if (L >= nwg) return false;
        int wgid = (int)L; { const int q = nwg / NXCD, r = nwg % NXCD, xcd = wgid % NXCD, off = wgid / NXCD; wgid = (xcd < r ? xcd * (q + 1) : r * (q + 1) + (xcd - r) * q) + off; }
        const int nig = WGM * nN, gid = wgid / nig, fm = gid * WGM, gsz = (nM - fm) < WGM ? (nM - fm) : WGM;
        u.pm = fm + ((wgid % nig) % gsz); u.pn = (wgid % nig) / gsz; return true;
    }
    __device__ __forceinline__ void a_ready(const Unit&) const {}
    __device__ __forceinline__ void done(const Unit&) const {}
};

__device__ __forceinline__ unsigned cvt_pk_bf16(float lo, float hi) { unsigned r; asm volatile("v_cvt_pk_bf16_f32 %0, %1, %2" : "=v"(r) : "v"(lo), "v"(hi)); return r; }
__device__ __forceinline__ float bf_hi_f(unsigned pk) { return __builtin_bit_cast(float, pk << 16); }
__device__ __forceinline__ float bf_lo_of(float v) { unsigned h; { unsigned u = __builtin_bit_cast(unsigned, v); h = (u + 0x7fffu + ((u >> 16) & 1u)) & 0xffff0000u; } return v - __builtin_bit_cast(float, h); }
__device__ __forceinline__ void store_a8(bf16_t* rowp, int Kreal, int col, const f32x4& v0, const f32x4& v1) {
    u32x4 w; w.x = cvt_pk_bf16(v0[0], v0[1]); w.y = cvt_pk_bf16(v0[2], v0[3]); w.z = cvt_pk_bf16(v1[0], v1[1]); w.w = cvt_pk_bf16(v1[2], v1[3]);
    *(u32x4*)(rowp + col) = w;
#if KS == 3
    *(u32x4*)(rowp + Kreal + col) = w;
    u32x4 l; l.x = cvt_pk_bf16(bf_lo_of(v0[0]), bf_lo_of(v0[1])); l.y = cvt_pk_bf16(bf_lo_of(v0[2]), bf_lo_of(v0[3])); l.z = cvt_pk_bf16(bf_lo_of(v1[0]), bf_lo_of(v1[1])); l.w = cvt_pk_bf16(bf_lo_of(v1[2]), bf_lo_of(v1[3]));
    *(u32x4*)(rowp + 2 * Kreal + col) = l;
#endif
}

constexpr int RS_OFF = 131072, RS_TAG_OFF = RS_OFF + 4 * 256 * 4;
template <class Sched>
__device__ __forceinline__ void rs_table_fill(PG8_LAS unsigned char* lds, const Sched& S, const float* ssq, int ldp, float inv_n, float eps, int wid_, int p0 = 0, int npart = 32, bool recip = false) {
    int tid = 0;
    PG8_LAS float* rs = (PG8_LAS float*)(lds + RS_OFF); PG8_LAS int* tag = (PG8_LAS int*)(lds + RS_TAG_OFF);
    { int z_ = 0; asm volatile("" : "+s"(z_)); tid = (tid >> 6) * 0 + (int)__builtin_amdgcn_mbcnt_hi(~0u, __builtin_amdgcn_mbcnt_lo(~0u, (unsigned)z_)) + 64 * wid_; }
#pragma unroll 1
    for (int pass = 0; pass < 2; ++pass) { const int i = 2 * pass + (tid >> 8); Unit u; const bool ok = S.next(i, u);
        if (ok) { const int r = u.pm * BM + (tid & 255); float s = 0.f;
#pragma unroll 8
            for (int p = 0; p < npart; ++p) s += ssq[(size_t)(p0 + p) * ldp + r];
            rs[i * 256 + (tid & 255)] = recip ? ((s > 0.f) ? 1.0f / s : 0.f) : 1.0f / sqrtf(s * inv_n + eps); }
        if ((tid & 255) == 0) tag[i] = ok ? u.pm : -1; }
    __syncthreads();
}
__device__ __forceinline__ int rs_slot(PG8_LAS unsigned char* lds, const Unit& u) { const PG8_LAS int* tag = (const PG8_LAS int*)(lds + RS_TAG_OFF);
    const int t0 = __builtin_amdgcn_readfirstlane(tag[0]), t1 = __builtin_amdgcn_readfirstlane(tag[1]), t2 = __builtin_amdgcn_readfirstlane(tag[2]);
    return (t0 == u.pm) ? 0 : (t1 == u.pm) ? 1 : (t2 == u.pm) ? 2 : 3; }
__device__ __forceinline__ float row_rs(const float* ssq, int np, PG8_LAS unsigned char* lds, int slot, int r, float inv_n, float eps) {
    if (np == 1) return 1.0f / sqrtf(ssq[r] * inv_n + eps);
    return ((const PG8_LAS float*)(lds + RS_OFF))[slot * 256 + (r & 255)];
}

struct EpiScaleF32 {
    static constexpr bool PERM = false, AFTER_DRAIN = false;
    float* C; int ldc; const float* bias; const float* ssq; int np; PG8_LAS unsigned char* lds; float inv_n, eps;
    __device__ __forceinline__ void operator()(const f32x4 (&acc)[2][2][4][2], const Unit& u, int wr, int wc, int fr, int fq) const {
        const int row0 = u.pm * BM + wr * 64 + fr, col0 = u.pn * BM + wc * 32 + 4 * fq;
        const int slot = (np == 1) ? 0 : rs_slot(lds, u);
        f32x4 bv[2][2];
#pragma unroll
        for (int bj = 0; bj < 2; ++bj)
#pragma unroll
            for (int n = 0; n < 2; ++n) bv[bj][n] = bias ? *(const f32x4*)(bias + col0 + bj * HALF + n * 16) : (f32x4){0.f, 0.f, 0.f, 0.f};
#pragma unroll
        for (int ai = 0; ai < 2; ++ai)
#pragma unroll
            for (int m = 0; m < 4; ++m) { const int r = row0 + ai * HALF + m * 16; float* rowp = C + (size_t)r * ldc + col0;
                const float rs = row_rs(ssq, np, lds, slot, r, inv_n, eps);
#pragma unroll
                for (int bj = 0; bj < 2; ++bj)
#pragma unroll
                    for (int n = 0; n < 2; ++n) *(f32x4*)(rowp + bj * HALF + n * 16) = acc[ai][bj][m][n] * rs + bv[bj][n]; }
    }
};

struct EpiResid {
    static constexpr bool PERM = true, AFTER_DRAIN = false;
    const float* xres; float* xout; bf16_t* xb; float* ssq; int ld, ldp;
    __device__ __forceinline__ void operator()(const f32x4 (&acc)[2][2][4][2], const Unit& u, int wr, int wc, int fr, int fq) const {
        const int row0 = u.pm * BM + wr * 64 + fr, col0 = u.pn * BM + wc * 32 + 8 * fq;
#pragma unroll
        for (int ai = 0; ai < 2; ++ai)
#pragma unroll
            for (int m = 0; m < 4; ++m) { const int r = row0 + ai * HALF + m * 16; float s = 0.f;
#pragma unroll
                for (int bj = 0; bj < 2; ++bj) { const int c = col0 + bj * HALF; const float* xr = xres + (size_t)r * ld + c; float* xo = xout + (size_t)r * ld + c;
                    const f32x4 v0 = acc[ai][bj][m][0] + *(const f32x4*)xr, v1 = acc[ai][bj][m][1] + *(const f32x4*)(xr + 4);
                    *(f32x4*)xo = v0; *(f32x4*)(xo + 4) = v1;
                    s += (v0[0] * v0[0] + v0[1] * v0[1]) + (v0[2] * v0[2] + v0[3] * v0[3]) + (v1[0] * v1[0] + v1[1] * v1[1]) + (v1[2] * v1[2] + v1[3] * v1[3]);
                    store_a8(xb + (size_t)r * (KS * ld), ld, c, v0, v1); }
                s += sxor<16>(s); s = half_sum(s);
                if (fq == 0) ssq[(size_t)(u.pn * 4 + wc) * ldp + r] = s;
                if (m & 1) asm volatile("" ::: "memory"); }
    }
};

struct EpiRelu2 {
    static constexpr bool PERM = true, AFTER_DRAIN = false;
    bf16_t* H; int ld; const float* ssq; int np; PG8_LAS unsigned char* lds; float inv_n, eps;
    __device__ __forceinline__ void operator()(const f32x4 (&acc)[2][2][4][2], const Unit& u, int wr, int wc, int fr, int fq) const {
        const int row0 = u.pm * BM + wr * 64 + fr, col0 = u.pn * BM + wc * 32 + 8 * fq; const int slot = (np == 1) ? 0 : rs_slot(lds, u);
#pragma unroll
        for (int ai = 0; ai < 2; ++ai)
#pragma unroll
            for (int m = 0; m < 4; ++m) { const int r = row0 + ai * HALF + m * 16; const float rs = row_rs(ssq, np, lds, slot, r, inv_n, eps);
#pragma unroll
                for (int bj = 0; bj < 2; ++bj) { f32x4 v0 = acc[ai][bj][m][0] * rs, v1 = acc[ai][bj][m][1] * rs;
#pragma unroll
                    for (int j = 0; j < 4; ++j) { const float a = fmaxf(v0[j], 0.f), b = fmaxf(v1[j], 0.f); v0[j] = a * a; v1[j] = b * b; }
                    store_a8(H + (size_t)r * (KS * ld), ld, col0 + bj * HALF, v0, v1); } }
    }
};

struct EpiScaleBf16 {
    static constexpr bool PERM = true, AFTER_DRAIN = false;
    bf16_t* O; int M_; const float* ssq; int np; PG8_LAS unsigned char* lds; float inv_n, eps; float* qss;
    __device__ __forceinline__ void operator()(const f32x4 (&acc)[2][2][4][2], const Unit& u, int wr, int wc, int fr, int fq) const {
        const int row0 = u.pm * BM + wr * 64 + fr, col0 = (u.pn & 1) * BM + wc * 32 + 8 * fq; const int slot = (np == 1) ? 0 : rs_slot(lds, u);
        bf16_t* Oh = O + (size_t)(u.pn >> 1) * M_ * 512;
#pragma unroll
        for (int ai = 0; ai < 2; ++ai)
#pragma unroll
            for (int m = 0; m < 4; ++m) { const int r = row0 + ai * HALF + m * 16; const float rs = row_rs(ssq, np, lds, slot, r, inv_n, eps); float s = 0.f;
#pragma unroll
                for (int bj = 0; bj < 2; ++bj) { const f32x4 v0 = acc[ai][bj][m][0] * rs, v1 = acc[ai][bj][m][1] * rs;
                    s += (v0[0] * v0[0] + v0[1] * v0[1]) + (v0[2] * v0[2] + v0[3] * v0[3]) + (v1[0] * v1[0] + v1[1] * v1[1]) + (v1[2] * v1[2] + v1[3] * v1[3]);
                    u32x4 w; w.x = cvt_pk_bf16(v0[0], v0[1]); w.y = cvt_pk_bf16(v0[2], v0[3]); w.z = cvt_pk_bf16(v1[0], v1[1]); w.w = cvt_pk_bf16(v1[2], v1[3]);
                    *(u32x4*)(Oh + (size_t)r * 512 + col0 + bj * HALF) = w; }
                s += sxor<16>(s); s = half_sum(s);
                if (fq == 0) qss[(size_t)(u.pn * 4 + wc) * M_ + r] = s;
                asm volatile("" ::: "memory"); }
    }
};
#define EPI_FRESH_LANE() { int z_ = 0; asm volatile("" : "+s"(z_)); const int l_ = (int)__builtin_amdgcn_mbcnt_hi(~0u, __builtin_amdgcn_mbcnt_lo(~0u, (unsigned)z_)); fr = l_ & 15; fq = l_ >> 4; }
struct EpiExpP {
    static constexpr bool PERM = true, AFTER_DRAIN = false;
    bf16_t* P; float* lp; int M_; PG8_LAS unsigned char* lds; float bound;
    __device__ __forceinline__ void operator()(const f32x4 (&acc)[2][2][4][2], const Unit& u, int wr, int wc, int fr, int fq) const {
        EPI_FRESH_LANE();
        const int row0 = u.pm * BM + wr * 64 + fr, col0 = wc * 32 + 8 * fq; const int slot = rs_slot(lds, u);
#pragma unroll
        for (int ai = 0; ai < 2; ++ai)
#pragma unroll
            for (int m = 0; m < 4; ++m) { const int r = row0 + ai * HALF + m * 16; const float rs = ((const PG8_LAS float*)(lds + RS_OFF))[slot * 256 + (r & 255)]; float s = 0.f;
#pragma unroll
                for (int bj = 0; bj < 2; ++bj) { f32x4 v0, v1;
#pragma unroll
                    for (int j = 0; j < 4; ++j) { v0[j] = __builtin_amdgcn_exp2f(acc[ai][bj][m][0][j] * rs - bound); v1[j] = __builtin_amdgcn_exp2f(acc[ai][bj][m][1][j] * rs - bound); }
                    s += ((v0[0] + v0[1]) + (v0[2] + v0[3])) + ((v1[0] + v1[1]) + (v1[2] + v1[3]));
                    u32x4 w; w.x = cvt_pk_bf16(v0[0], v0[1]); w.y = cvt_pk_bf16(v0[2], v0[3]); w.z = cvt_pk_bf16(v1[0], v1[1]); w.w = cvt_pk_bf16(v1[2], v1[3]);
                    *(u32x4*)(P + (size_t)r * 256 + col0 + bj * HALF) = w; }
                s += sxor<16>(s); s = half_sum(s);
                if (fq == 0) lp[(size_t)wc * M_ + r] = s;
                asm volatile("" ::: "memory"); }
    }
};
struct EpiRowScaleA {
    static constexpr bool PERM = true, AFTER_DRAIN = false;
    bf16_t* Y; int ld, colbase; PG8_LAS unsigned char* lds;
    __device__ __forceinline__ void operator()(const f32x4 (&acc)[2][2][4][2], const Unit& u, int wr, int wc, int fr, int fq) const {
        EPI_FRESH_LANE();
        const int row0 = u.pm * BM + wr * 64 + fr, col0 = colbase + u.pn * BM + wc * 32 + 8 * fq; const int slot = rs_slot(lds, u);
#pragma unroll
        for (int ai = 0; ai < 2; ++ai)
#pragma unroll
            for (int m = 0; m < 4; ++m) { const int r = row0 + ai * HALF + m * 16; const float il = ((const PG8_LAS float*)(lds + RS_OFF))[slot * 256 + (r & 255)];
#pragma unroll
                for (int bj = 0; bj < 2; ++bj) store_a8(Y + (size_t)r * (KS * ld), ld, col0 + bj * HALF, acc[ai][bj][m][0] * il, acc[ai][bj][m][1] * il);
                asm volatile("" ::: "memory"); }
    }
};

struct EpiExpPN {
    static constexpr bool PERM = true, AFTER_DRAIN = false;
    bf16_t* P; int ldc, colbase; PG8_LAS unsigned char* lds; float bound;
    __device__ __forceinline__ void operator()(const f32x4 (&acc)[2][2][4][2], const Unit& u, int wr, int wc, int fr, int fq) const {
        EPI_FRESH_LANE();
        const int rin0 = wr * 64 + fr, col0 = colbase + wc * 32 + 8 * fq; const int slot = rs_slot(lds, u);
        const PG8_LAS float* rst = (const PG8_LAS float*)(lds + RS_OFF) + slot * 256; PG8_LAS float* part = (PG8_LAS float*)(lds + RS_OFF + 8192);
#pragma unroll
        for (int ai = 0; ai < 2; ++ai)
#pragma unroll
            for (int m = 0; m < 4; ++m) { const int rin = rin0 + ai * HALF + m * 16; const float rs = rst[rin]; float s = 0.f;
#pragma unroll
                for (int bj = 0; bj < 2; ++bj)
#pragma unroll
                    for (int j = 0; j < 4; ++j) s += __builtin_amdgcn_exp2f(acc[ai][bj][m][0][j] * rs - bound) + __builtin_amdgcn_exp2f(acc[ai][bj][m][1][j] * rs - bound);
                s += sxor<16>(s); s = half_sum(s);
                if (fq == 0) part[rin * 4 + wc] = s; }
        asm volatile("s_waitcnt lgkmcnt(0)" ::: "memory"); __builtin_amdgcn_s_barrier(); asm volatile("" ::: "memory");
#pragma unroll
        for (int ai = 0; ai < 2; ++ai)
#pragma unroll
            for (int m = 0; m < 4; ++m) { const int rin = rin0 + ai * HALF + m * 16; const float rs = rst[rin]; const f32x4 p4 = *(const PG8_LAS f32x4*)(part + rin * 4);
                const float inv = 1.0f / ((p4[0] + p4[1]) + (p4[2] + p4[3])); bf16_t* prow = P + (size_t)(u.pm * BM + rin) * ldc + col0;
#pragma unroll
                for (int bj = 0; bj < 2; ++bj) { f32x4 v0, v1;
#pragma unroll
                    for (int j = 0; j < 4; ++j) { v0[j] = __builtin_amdgcn_exp2f(acc[ai][bj][m][0][j] * rs - bound) * inv; v1[j] = __builtin_amdgcn_exp2f(acc[ai][bj][m][1][j] * rs - bound) * inv; }
                    u32x4 w; w.x = cvt_pk_bf16(v0[0], v0[1]); w.y = cvt_pk_bf16(v0[2], v0[3]); w.z = cvt_pk_bf16(v1[0], v1[1]); w.w = cvt_pk_bf16(v1[2], v1[3]);
                    *(u32x4*)(prow + bj * HALF) = w; }
                asm volatile("" ::: "memory"); }
    }
};
struct EpiPlainBf16 {
    static constexpr bool PERM = true, AFTER_DRAIN = false;
    bf16_t* O; int ldc, colbase;
    __device__ __forceinline__ void operator()(const f32x4 (&acc)[2][2][4][2], const Unit& u, int wr, int wc, int fr, int fq) const {
        EPI_FRESH_LANE();
        const int row0 = u.pm * BM + wr * 64 + fr, col0 = colbase + u.pn * BM + wc * 32 + 8 * fq;
#pragma unroll
        for (int ai = 0; ai < 2; ++ai)
#pragma unroll
            for (int m = 0; m < 4; ++m) { bf16_t* orow = O + (size_t)(row0 + ai * HALF + m * 16) * ldc + col0;
#pragma unroll
                for (int bj = 0; bj < 2; ++bj) { const f32x4 v0 = acc[ai][bj][m][0], v1 = acc[ai][bj][m][1];
                    u32x4 w; w.x = cvt_pk_bf16(v0[0], v0[1]); w.y = cvt_pk_bf16(v0[2], v0[3]); w.z = cvt_pk_bf16(v1[0], v1[1]); w.w = cvt_pk_bf16(v1[2], v1[3]);
                    *(u32x4*)(orow + bj * HALF) = w; }
                asm volatile("" ::: "memory"); }
    }
};
template <class Epi, class Sched, bool ALIGN_EPI = false, bool SP2 = false>
__device__ __forceinline__ void gemm_phase(PG8_LAS unsigned char* lds, const Gemm g, const Sched& S, const Epi& E, int wid_in) {
    int zero_ = 0; asm volatile("" : "+s"(zero_));
    const int lane = (int)__builtin_amdgcn_mbcnt_hi(~0u, __builtin_amdgcn_mbcnt_lo(~0u, (unsigned)zero_));
    const int wid = wid_in, tid = wid * 64 + lane, wr = wid >> 2, wc = wid & 3, fr = lane & 15, fq = lane >> 4;
    const int K = g.K, nt = K / BK;
    unsigned voffA[2], voffB[2];
#pragma unroll
    for (int i = 0; i < 2; ++i) { int R, C; stage_rc(tid * 16 + i * 8192, R, C); const int Rb = Epi::PERM ? ((R & ~31) + perm32(R & 31)) : R;
        voffA[i] = (unsigned)(R * K + C) * 2u; voffB[i] = (unsigned)(Rb * K + C) * 2u; }
    const size_t kstep = (size_t)(BK * 2);
    const size_t hstep = (size_t)HALF * K * 2;
    const size_t tstep = 2 * hstep;
    const unsigned ldsw = (unsigned)wid * 1024u;
    const int aoff = lds_byte(wr * 64 + fr, fq * 8), boff = lds_byte(wc * 32 + fr, fq * 8);
#define PG8_SA(b, h) (((b) * 2 + (h)) * HTB)
#define PG8_SB(b, h) ((4 + (b) * 2 + (h)) * HTB)
#define PG8_STAGE(bufoff, gbase, voff) do { _Pragma("unroll") for (int _i = 0; _i < 2; ++_i) \
        __builtin_amdgcn_global_load_lds((const unsigned*)((const char*)(gbase) + (voff)[_i]), (PG8_LAS unsigned*)(lds + (bufoff) + ldsw + _i * 8192), 16, 0, 0); } while (0)
#define PG8_LDA(dst, b, h) do { _Pragma("unroll") for (int m = 0; m < 4; ++m) _Pragma("unroll") for (int k = 0; k < 2; ++k) dst[m][k] = *(const PG8_LAS bf16x8*)(lds + PG8_SA(b, h) + aoff + m * 2048 + k * 1024); } while (0)
#define PG8_LDB(dst, b, h) do { _Pragma("unroll") for (int n = 0; n < 2; ++n) _Pragma("unroll") for (int k = 0; k < 2; ++k) dst[n][k] = *(const PG8_LAS bf16x8*)(lds + PG8_SB(b, h) + boff + n * 2048 + k * 1024); } while (0)
#define PG8_MMA(ai, bj, At, Bt) do { __builtin_amdgcn_s_setprio(1); _Pragma("unroll") for (int m = 0; m < 4; ++m) _Pragma("unroll") for (int n = 0; n < 2; ++n) _Pragma("unroll") for (int k = 0; k < 2; ++k) \
        acc[ai][bj][m][n] = __builtin_amdgcn_mfma_f32_16x16x32_bf16(Bt[n][k], At[m][k], acc[ai][bj][m][n], 0, 0, 0); __builtin_amdgcn_s_setprio(0); } while (0)
#define PG8_WAIT_V(n) asm volatile("s_waitcnt vmcnt(" #n ")" ::: "memory")
#define PG8_WAIT_L(n) asm volatile("s_waitcnt lgkmcnt(" #n ")" ::: "memory")
#define PG8_BAR __builtin_amdgcn_s_barrier()
#define PG8_SCHED __builtin_amdgcn_sched_barrier(0)
    Unit cur, nxt; int ui = 0;
    if (!S.next(0, cur)) return;
    f32x4 acc[2][2][4][2];
#pragma unroll
    for (int a = 0; a < 2; ++a)
#pragma unroll
        for (int b = 0; b < 2; ++b)
#pragma unroll
            for (int m = 0; m < 4; ++m)
#pragma unroll
                for (int n = 0; n < 2; ++n) acc[a][b][m][n] = (f32x4){0.f, 0.f, 0.f, 0.f};
    bf16x8 At[4][2], B0[2][2], B1[2][2];
    const char* cA = (const char*)g.A + (size_t)cur.pm * tstep; const char* cB = (const char*)g.Bt + (size_t)cur.pn * tstep;
    S.a_ready(cur);
    if constexpr (SP2) {
        PG8_STAGE(PG8_SB(0, 0), cB, voffB); PG8_STAGE(PG8_SB(0, 1), cB + hstep, voffB); PG8_STAGE(PG8_SA(0, 0), cA, voffA); PG8_STAGE(PG8_SA(0, 1), cA + hstep, voffA);
        if (wr == 1) PG8_BAR;
        PG8_WAIT_V(2); PG8_BAR;
        PG8_STAGE(PG8_SB(1, 0), cB + kstep, voffB); PG8_STAGE(PG8_SA(1, 0), cA + kstep, voffA); PG8_STAGE(PG8_SB(1, 1), cB + hstep + kstep, voffB);
        PG8_WAIT_V(6); PG8_BAR;
    } else {
        PG8_STAGE(PG8_SB(0, 0), cB, voffB); PG8_STAGE(PG8_SA(0, 0), cA, voffA); PG8_STAGE(PG8_SB(0, 1), cB + hstep, voffB); PG8_STAGE(PG8_SA(0, 1), cA + hstep, voffA);
        if (wr == 1) PG8_BAR;
        PG8_WAIT_V(4); PG8_BAR;
        PG8_STAGE(PG8_SB(1, 0), cB + kstep, voffB); PG8_STAGE(PG8_SA(1, 0), cA + kstep, voffA); PG8_STAGE(PG8_SB(1, 1), cB + hstep + kstep, voffB);
        PG8_WAIT_V(6); PG8_BAR;
    }
    for (;;) {
        const bool has_next = S.next(ui + 1, nxt);
        const char* nA = has_next ? (const char*)g.A + (size_t)nxt.pm * tstep : cA; const char* nB = has_next ? (const char*)g.Bt + (size_t)nxt.pn * tstep : cB;
        for (int t = 0; t < nt; t += 2) {
            const bool last = (t == nt - 2);
            const char* a1 = cA + (size_t)(t + 1) * kstep;
            const char* a2 = last ? nA : cA + (size_t)(t + 2) * kstep; const char* b2 = last ? nB : cB + (size_t)(t + 2) * kstep;
            const char* a3 = a2 + kstep; const char* b3 = b2 + kstep;
            if (last && has_next) S.a_ready(nxt);
            if constexpr (SP2) {
            PG8_LDB(B0, 0, 0); PG8_LDB(B1, 0, 1); PG8_SCHED; PG8_LDA(At, 0, 0); PG8_STAGE(PG8_SA(1, 1), a1 + hstep, voffA);
            PG8_WAIT_V(8); PG8_WAIT_L(0); PG8_BAR; PG8_MMA(0, 0, At, B0); PG8_MMA(0, 1, At, B1); PG8_BAR; PG8_SCHED;
            PG8_LDA(At, 0, 1); PG8_STAGE(PG8_SB(0, 0), b2, voffB); PG8_STAGE(PG8_SB(0, 1), b2 + hstep, voffB); PG8_STAGE(PG8_SA(0, 0), a2, voffA);
            PG8_WAIT_V(8); PG8_WAIT_L(0); PG8_BAR; PG8_MMA(1, 0, At, B0); PG8_MMA(1, 1, At, B1); PG8_BAR; PG8_SCHED;
            PG8_LDB(B0, 1, 0); PG8_LDB(B1, 1, 1); PG8_SCHED; PG8_LDA(At, 1, 0); PG8_STAGE(PG8_SA(0, 1), a2 + hstep, voffA);
            PG8_WAIT_V(8); PG8_WAIT_L(0); PG8_BAR; PG8_MMA(0, 0, At, B0); PG8_MMA(0, 1, At, B1); PG8_BAR; PG8_SCHED;
            PG8_LDA(At, 1, 1); PG8_STAGE(PG8_SB(1, 0), b3, voffB); PG8_STAGE(PG8_SB(1, 1), b3 + hstep, voffB); PG8_STAGE(PG8_SA(1, 0), a3, voffA);
            PG8_WAIT_V(8); PG8_WAIT_L(0); PG8_BAR; PG8_MMA(1, 0, At, B0); PG8_MMA(1, 1, At, B1); PG8_BAR; PG8_SCHED;
            } else {
            PG8_LDB(B0, 0, 0); PG8_SCHED; PG8_LDA(At, 0, 0); PG8_STAGE(PG8_SA(1, 1), a1 + hstep, voffA);
            PG8_WAIT_L(8); PG8_BAR; PG8_WAIT_L(0); PG8_MMA(0, 0, At, B0); PG8_BAR; PG8_SCHED;
            PG8_LDB(B1, 0, 1); PG8_STAGE(PG8_SB(0, 0), b2, voffB);
            PG8_BAR; PG8_WAIT_L(0); PG8_MMA(0, 1, At, B1); PG8_BAR;
            PG8_LDA(At, 0, 1); PG8_STAGE(PG8_SA(0, 0), a2, voffA);
            PG8_BAR; PG8_WAIT_L(0); PG8_MMA(1, 0, At, B0); PG8_BAR; PG8_SCHED;
            PG8_STAGE(PG8_SB(0, 1), b2 + hstep, voffB);
            PG8_WAIT_V(6); PG8_BAR; PG8_MMA(1, 1, At, B1); PG8_BAR;
            PG8_LDB(B0, 1, 0); PG8_SCHED; PG8_LDA(At, 1, 0); PG8_STAGE(PG8_SA(0, 1), a2 + hstep, voffA);
            PG8_WAIT_L(8); PG8_BAR; PG8_WAIT_L(0); PG8_MMA(0, 0, At, B0); PG8_BAR; PG8_SCHED;
            PG8_LDB(B1, 1, 1); PG8_STAGE(PG8_SB(1, 0), b3, voffB);
            PG8_BAR; PG8_WAIT_L(0); PG8_MMA(0, 1, At, B1); PG8_BAR;
            PG8_LDA(At, 1, 1); PG8_STAGE(PG8_SA(1, 0), a3, voffA);
            PG8_BAR; PG8_WAIT_L(0); PG8_MMA(1, 0, At, B0); PG8_BAR; PG8_SCHED;
            PG8_STAGE(PG8_SB(1, 1), b3 + hstep, voffB);
            PG8_WAIT_V(6); PG8_BAR; PG8_MMA(1, 1, At, B1); PG8_BAR;
            }
        }
        if constexpr (ALIGN_EPI) { if (wr == 0) PG8_BAR; }
        if constexpr (!Epi::AFTER_DRAIN) { E(acc, cur, wr, wc, fr, fq); S.done(cur); }
        if (!has_next) break;
#pragma unroll
        for (int a = 0; a < 2; ++a)
#pragma unroll
            for (int b = 0; b < 2; ++b)
#pragma unroll
                for (int m = 0; m < 4; ++m)
#pragma unroll
                    for (int n = 0; n < 2; ++n) acc[a][b][m][n] = (f32x4){0.f, 0.f, 0.f, 0.f};
        cur = nxt; cA = nA; cB = nB; ++ui;
        if constexpr (ALIGN_EPI) { if (wr == 1) PG8_BAR; }
    }
    PG8_WAIT_V(0);
    if constexpr (!ALIGN_EPI) { if (wr == 0) PG8_BAR; }
    PG8_BAR;
    if constexpr (Epi::AFTER_DRAIN) { E.fused(acc, cur, wr, wc, fr, fq, lds, wid, lane); S.done(cur); }
#undef PG8_SA
#undef PG8_SB
#undef PG8_STAGE
#undef PG8_LDA
#undef PG8_LDB
#undef PG8_MMA
#undef PG8_WAIT_V
#undef PG8_WAIT_L
#undef PG8_BAR
#undef PG8_SCHED
}
}
#define PG8_SP2 true
#define PG8_ALIGN true
constexpr int T = 8192, D = 2048, DIN = 6688, NIN = 6912, DFF = 8192, MEM = 256, DEPTH = 4;
constexpr int NCMP = 511, NCH = 128;
constexpr float EPS = 1e-6f;
constexpr int ZC_HGQ = 0, ZC_HGF = 512, ZC_HGI = 1024, ZC_HGG = 1536, ZC_NSQ = 2048, ZC_NKC = 3072, ZC_NVC = 3328, ZC_NKS = 3584, ZC_NVS = 3840, ZC_NKW = 4096, ZC_NVW = 4352,
              ZC_MLQ = 4608, ZC_MLK = 5120, ZC_MLV = 5632, ZC_MLO = 6144, ZC_GATE = 6656, ZC_MLI = 6680, ZC_MLF = 6684;
__host__ __device__ __forceinline__ int zcol_src(int j) {
    if (j < 4608) return j; if (j < 6656) return j + 24; if (j < 6680) return j - 6656 + 4608; if (j < 6688) return j; return -1; }
#ifndef K4PER_
#define K4PER_ 24
#endif
constexpr int NPH = 12;
constexpr int NPHASES = 1 + DEPTH * NPH;

constexpr size_t MiB = 1u << 20;
constexpr size_t al256(size_t x) { return (x + 255) & ~(size_t)255; }
constexpr size_t WS_CTL = 0, CTL_ZERO_BYTES = 1 * MiB;
constexpr size_t SZ_DD = (size_t)D * D * KS * 2;
constexpr size_t WS_WIN = CTL_ZERO_BYTES;
constexpr size_t WS_WOUT = WS_WIN + (size_t)NIN * D * KS * 2;
constexpr size_t WS_WQ = WS_WOUT + SZ_DD, WS_WO = WS_WQ + SZ_DD, WS_WKV = WS_WO + SZ_DD;
constexpr size_t WS_W1 = WS_WKV + 2 * SZ_DD;
constexpr size_t WS_W2 = WS_W1 + (size_t)DFF * D * KS * 2;
constexpr size_t WS_WCF = WS_W2 + (size_t)DFF * D * KS * 2;
constexpr size_t WS_BPERM = WS_WCF + (size_t)2 * 4 * 256 * 512 * 2;
constexpr size_t WS_WSET = al256(WS_BPERM + NIN * 4) - WS_WIN;
#ifndef XFUSE
#define XFUSE (KS == 1)
#endif
#ifndef WOVL
#define WOVL (KS == 1)
#endif
constexpr size_t WS_A0 = WS_WIN + (WOVL ? 2 : 1) * WS_WSET;
constexpr size_t WS_A1 = WS_A0 + (size_t)T * D * KS * 2;
constexpr size_t WS_MEMB = WS_A1 + (size_t)T * D * KS * 2;
constexpr size_t WS_SSQA = WS_MEMB + (size_t)MEM * D * KS * 2;
constexpr size_t WS_SSQB = WS_SSQA + 32 * T * 4, WS_SSQC = WS_SSQB + 32 * T * 4, WS_SSQM = WS_SSQC + 32 * T * 4;
constexpr size_t WS_LB = WS_SSQM + MEM * 4;
constexpr size_t WS_COS = WS_LB + DEPTH * 512 * 4, WS_SIN = WS_COS + (size_t)T * 64 * 4;
constexpr size_t WS_KVX = WS_SIN + (size_t)T * 64 * 4;
constexpr size_t WS_KXN = WS_KVX + (size_t)MEM * 2 * D * 4;
constexpr size_t WS_KCN = WS_KXN + (size_t)MEM * D * 4;
constexpr size_t WS_VCN = WS_KCN + 2 * 512 * 128 * 4;
constexpr size_t WS_HGDEC = WS_VCN + 2 * 512 * 128 * 4;
constexpr size_t WS_MLNL = WS_HGDEC + NCH * 512 * 4, WS_MLN = WS_MLNL + NCH * 512 * 4;
constexpr size_t WS_MLSC = WS_MLN + NCH * 512 * 4;
constexpr size_t WS_KXF = al256(WS_MLSC + 3 * NCH * 4 * 4);
constexpr size_t WS_VXF = WS_KXF + (size_t)MEM * D * 2;
constexpr size_t WS_QSS = WS_VXF + (size_t)MEM * D * 2;
constexpr size_t WS_LPX = WS_QSS + (size_t)32 * T * 4;
constexpr size_t WS_BTC = WS_LPX + (size_t)16 * T * 4;
constexpr size_t WS_R = al256(WS_BTC + (size_t)D * 1024 * 2);
constexpr size_t WS_Z = WS_R;
constexpr size_t WS_XQ = WS_R;
constexpr size_t WS_XQB = WS_R;
constexpr size_t WS_PH = WS_R + (size_t)T * D * 2;
constexpr size_t WS_NSQ = WS_Z + (size_t)T * NIN * 4;
constexpr size_t SZ_ORA = ORACLE_ATTN ? (size_t)T * 256 * 4 : 0;
constexpr size_t WS_NKS = WS_NSQ + 4 * SZ_ORA, WS_NKW = WS_NKS + SZ_ORA;
constexpr size_t WS_MLQ = WS_NKW + SZ_ORA, WS_MLK = WS_MLQ + (size_t)T * 512 * 4;
constexpr size_t SZ_ST = (size_t)NCH * 4 * 128 * 128 * 4;
constexpr size_t SZ_STO = ORACLE_MIX ? SZ_ST : 0;
constexpr size_t WS_HGU = WS_MLK + (size_t)T * 512 * 4, WS_HGS = WS_HGU + SZ_ST, WS_MLU = WS_HGS + SZ_STO, WS_MLS = WS_MLU + SZ_ST;
constexpr size_t WS_QN = WS_MLS + SZ_STO;
constexpr size_t SZ_KF = (size_t)2 * T * 128 * 2;
constexpr size_t WS_KSF = WS_QN + (size_t)T * 1024 * 2, WS_KWF = WS_KSF + SZ_KF, WS_VSF = WS_KWF + SZ_KF, WS_VWF = WS_VSF + SZ_KF;
constexpr size_t WS_KCF = WS_VWF + SZ_KF, WS_VCF = WS_KCF + 2 * 16 * 4096 * 2;
constexpr size_t WS_OC = WS_VCF + 2 * 16 * 4096 * 2;
constexpr size_t WS_SELG = WS_OC + (size_t)T * 1024 * 4;
constexpr size_t WS_HGST = WS_SELG + (size_t)T * 2 * 16 * 4;
constexpr size_t WS_MLST = WS_HGST + SZ_ST / 2;
constexpr size_t WS_MIX_END = WS_MLST + SZ_ST / 2;
constexpr size_t WS_HM = WS_R;
constexpr size_t WS_R_END1 = WS_MIX_END, WS_R_END2 = WS_HM + (size_t)T * DFF * KS * 2;
constexpr size_t WS_END = WS_R_END1 > WS_R_END2 ? WS_R_END1 : WS_R_END2;

constexpr int CW_TMO = 0;
constexpr int CW_BAR = 4096;
constexpr int LDS_SCR = 155648;
constexpr int MISC_OFF = LDS_SCR;
constexpr int LDS_BYTES = LDS_SCR + 1024;
constexpr int WAVE_SCR = LDS_SCR / 8;

#define GAS __attribute__((address_space(1)))
#define LAS __attribute__((address_space(3)))
typedef unsigned short bf16;
typedef unsigned v4u __attribute__((ext_vector_type(4)));
typedef unsigned v2u __attribute__((ext_vector_type(2)));
typedef float f32x4 __attribute__((ext_vector_type(4)));
typedef float f32x2 __attribute__((ext_vector_type(2)));
typedef GAS unsigned gu32;
#define RLX_AGENT __ATOMIC_RELAXED, __HIP_MEMORY_SCOPE_AGENT
#define LDS_WAIT() asm volatile("s_waitcnt lgkmcnt(0)" ::: "memory")
__device__ __forceinline__ unsigned f2bf(float f) { unsigned u = __builtin_bit_cast(unsigned, f); return (u + 0x7fffu + ((u >> 16) & 1u)) >> 16; }
__device__ __forceinline__ float bf2f(unsigned b) { return __builtin_bit_cast(float, b << 16); }
__device__ __forceinline__ unsigned pk2(float lo, float hi) { return f2bf(lo) | (f2bf(hi) << 16); }
__device__ __forceinline__ float lo_of(float v) { return v - bf2f(f2bf(v)); }
__device__ __forceinline__ void storeA1(bf16* rowp, int Kreal, int col, float v) { const unsigned h = f2bf(v); rowp[col] = (bf16)h;
#if KS == 3
    rowp[Kreal + col] = (bf16)h; rowp[2 * Kreal + col] = (bf16)f2bf(v - bf2f(h));
#endif
}
__device__ __forceinline__ void storeA2(bf16* rowp, int Kreal, int col, float a, float b) { *(unsigned*)(rowp + col) = pk2(a, b);
#if KS == 3
    *(unsigned*)(rowp + Kreal + col) = pk2(a, b); *(unsigned*)(rowp + 2 * Kreal + col) = pk2(lo_of(a), lo_of(b));
#endif
}
__device__ __forceinline__ void storeA4(bf16* rowp, int Kreal, int col, f32x4 v) { v2u w; w.x = pk2(v[0], v[1]); w.y = pk2(v[2], v[3]); *(v2u*)(rowp + col) = w;
#if KS == 3
    *(v2u*)(rowp + Kreal + col) = w; v2u l; l.x = pk2(lo_of(v[0]), lo_of(v[1])); l.y = pk2(lo_of(v[2]), lo_of(v[3])); *(v2u*)(rowp + 2 * Kreal + col) = l;
#endif
}
__device__ __forceinline__ float wave_sum(float v) { v += sxor<1>(v); v += sxor<2>(v); v += sxor<4>(v); v += sxor<8>(v); v += sxor<16>(v); return half_sum(v); }
__device__ __forceinline__ float wave_max(float v) { v = fmaxf(v, sxor<1>(v)); v = fmaxf(v, sxor<2>(v)); v = fmaxf(v, sxor<4>(v)); v = fmaxf(v, sxor<8>(v)); v = fmaxf(v, sxor<16>(v)); return half_max(v); }
#define ARGMAX_STEP(M) do { const float ov_ = sxor<M>(bv); const int oi_ = sxori<M>(bi); if (ov_ > bv || (ov_ == bv && oi_ < bi)) { bv = ov_; bi = oi_; } } while (0)
__device__ __forceinline__ void wave_argmax(float& bv, int& bi) { ARGMAX_STEP(1); ARGMAX_STEP(2); ARGMAX_STEP(4); ARGMAX_STEP(8); ARGMAX_STEP(16);
    unsigned va = __builtin_bit_cast(unsigned, bv), vb = va, ia = (unsigned)bi, ib = ia; swap32(va, vb); swap32(ia, ib);
    const float v0 = __builtin_bit_cast(float, va), v1 = __builtin_bit_cast(float, vb); const int i0 = (int)ia, i1 = (int)ib;
    if (v0 > v1 || (v0 == v1 && i0 < i1)) { bv = v0; bi = i0; } else { bv = v1; bi = i1; } }
__device__ __forceinline__ float sigmoidf_(float x) { return 1.0f / (1.0f + __expf(-x)); }
#define XB_TMO      128
#define XB_XCNT(j)  (256  + 64 * (j))
#define XB_XSUB(j)  (1280 + 64 * (j))
#define XB_XGEN(j)  (2304 + 64 * (j))
#define XB_TOP      3328
#define XB_TOPGEN   3392
#define XCD_BAR_WORDS 3456
#define XB_SPIN_CAP (1u << 18)

__device__ __forceinline__ unsigned xb_ld(unsigned* p)              { return __hip_atomic_load(p, __ATOMIC_RELAXED, __HIP_MEMORY_SCOPE_AGENT); }
__device__ __forceinline__ unsigned xb_add(unsigned* p, unsigned v) { return __hip_atomic_fetch_add(p, v, __ATOMIC_RELAXED, __HIP_MEMORY_SCOPE_AGENT); }
__device__ __forceinline__ unsigned xb_xcc_id() { return (unsigned)__builtin_amdgcn_s_getreg((3 << 11) | 20) & 0xFu; }
#define XB_SPIN(cond, bar) do { unsigned _sp = 0; while (cond) { __builtin_amdgcn_s_sleep(1); \
    if ((++_sp & 255u) == 0u) { if (xb_ld(&(bar)[XB_TMO])) break; if (_sp > XB_SPIN_CAP) { atomicAdd(&(bar)[XB_TMO], 1u); break; } } } } while (0)

struct XcdBarrier {
    unsigned* bar; unsigned x;
    volatile LAS unsigned* st;
};

__device__ __forceinline__ XcdBarrier xcd_barrier_post(unsigned* bar, volatile LAS unsigned* st) {
    XcdBarrier b; b.bar = bar; b.x = xb_xcc_id(); b.st = st;
    if (threadIdx.x == 0) (void)xb_add(&bar[XB_XCNT(b.x)], 1u);
    return b;
}
__device__ __forceinline__ void xcd_barrier_complete(unsigned* bar, unsigned x, unsigned& nloc, unsigned& nx) {
    const unsigned G = gridDim.x * gridDim.y * gridDim.z;
    unsigned sum, cnt, mine, sp = 0u;
    for (;;) {
        sum = 0u; cnt = 0u; mine = 0u;
#pragma unroll
        for (unsigned j = 0; j < 16; ++j) { const unsigned c = xb_ld(&bar[XB_XCNT(j)]); sum += c; cnt += (c > 0u) ? 1u : 0u; mine = (j == x) ? c : mine; }
        if (sum == G) break;
        __builtin_amdgcn_s_sleep(1);
        if ((++sp & 255u) == 0u) { if (xb_ld(&bar[XB_TMO])) break; if (sp > XB_SPIN_CAP) { atomicAdd(&bar[XB_TMO], 1u); break; } }
    }
    nloc = mine > 0u ? mine : 1u; nx = cnt > 0u ? cnt : 1u;
}

__device__ __forceinline__ void xcd_barrier(const XcdBarrier& b) {
    asm volatile("s_waitcnt vmcnt(0)" ::: "memory");
    __syncthreads();
    if (threadIdx.x == 0) {
        unsigned* bar = b.bar;
        __builtin_amdgcn_s_waitcnt(0);
        unsigned nloc = b.st[0], nx = b.st[1];
        if (nloc == 0u) { xcd_barrier_complete(bar, b.x, nloc, nx); b.st[0] = nloc; b.st[1] = nx; }
        const unsigned old = xb_add(&bar[XB_XSUB(b.x)], 1u);
        const unsigned gen = old / nloc;
        if (old + 1u == (gen + 1u) * nloc) {
            __builtin_amdgcn_fence(__ATOMIC_RELEASE, "agent");
            asm volatile("s_waitcnt vmcnt(0)" ::: "memory");
            const unsigned og = xb_add(&bar[XB_TOP], 1u);
            const unsigned tg = og / nx;
            if (og + 1u == (tg + 1u) * nx) xb_add(&bar[XB_TOPGEN], 1u);
            else XB_SPIN(xb_ld(&bar[XB_TOPGEN]) == tg, bar);
            __builtin_amdgcn_fence(__ATOMIC_ACQUIRE, "agent");
            xb_add(&bar[XB_XGEN(b.x)], 1u);
            asm volatile("s_waitcnt vmcnt(0)" ::: "memory");
        } else {
            XB_SPIN(xb_ld(&bar[XB_XGEN(b.x)]) == gen, bar);
            __builtin_amdgcn_fence(__ATOMIC_ACQUIRE, "agent");
            asm volatile("s_waitcnt vmcnt(0)" ::: "memory");
        }
    }
    __syncthreads();
}


__device__ __forceinline__ void xcd_barrier_arrive(const XcdBarrier& b) {
    asm volatile("s_waitcnt vmcnt(0)" ::: "memory");
    __syncthreads();
    if (threadIdx.x == 0) {
        unsigned* bar = b.bar;
        __builtin_amdgcn_s_waitcnt(0);
        unsigned nloc = b.st[0], nx = b.st[1];
        if (nloc == 0u) { xcd_barrier_complete(bar, b.x, nloc, nx); b.st[0] = nloc; b.st[1] = nx; }
        const unsigned old = xb_add(&bar[XB_XSUB(b.x)], 1u);
        const unsigned gen = old / nloc;
        if (old + 1u == (gen + 1u) * nloc) {
            __builtin_amdgcn_fence(__ATOMIC_RELEASE, "agent");
            asm volatile("s_waitcnt vmcnt(0)" ::: "memory");
            const unsigned og = xb_add(&bar[XB_TOP], 1u);
            const unsigned tg = og / nx;
            if (og + 1u == (tg + 1u) * nx) xb_add(&bar[XB_TOPGEN], 1u);
            else XB_SPIN(xb_ld(&bar[XB_TOPGEN]) == tg, bar);
            __builtin_amdgcn_fence(__ATOMIC_ACQUIRE, "agent");
            xb_add(&bar[XB_XGEN(b.x)], 1u);
            asm volatile("s_waitcnt vmcnt(0)" ::: "memory");
            b.st[2] = 0xFFFFFFFFu;
        } else b.st[2] = gen;
    }
}
__device__ __forceinline__ void xcd_barrier_wait(const XcdBarrier& b) {
    if (threadIdx.x == 0) {
        const unsigned gen = b.st[2];
        if (gen != 0xFFFFFFFFu) {
            XB_SPIN(xb_ld(&b.bar[XB_XGEN(b.x)]) == gen, b.bar);
            __builtin_amdgcn_fence(__ATOMIC_ACQUIRE, "agent");
            asm volatile("s_waitcnt vmcnt(0)" ::: "memory");
        }
    }
    __syncthreads();
}
struct KArgs { const float* in[25]; float* out; unsigned char* ws; int ph_lo, ph_hi, li, pad; };
struct Frame {
    LAS unsigned char* lds;
    volatile LAS unsigned* MISC;
    gu32* ctl;
    int tid, lane, wave, G, bid;
    size_t wofs;
    unsigned char* ws;
    const KArgs __attribute__((address_space(4)))* ap;
};
#define INP(i) ((const float*)F.ap->in[i])
#define OUTP   ((float*)F.ap->out)
#define LAUNDER() do { asm volatile("" : "+s"(F.ws)); asm volatile("" : "+s"(F.ap)); int z_ = 0; asm volatile("" : "+s"(z_)); F.lane = (int)__builtin_amdgcn_mbcnt_hi(~0u, __builtin_amdgcn_mbcnt_lo(~0u, (unsigned)z_)); F.tid = F.wave * 64 + F.lane; } while (0)
#define WSP(type, off) ((type*)(F.ws + (off)))
#define WSL(type, off) ((type*)(F.ws + (off) + F.wofs))
#define WSO(type, off, wo) ((type*)(F.ws + (off) + (wo)))
#define EXPF(x) __expf(x)
#define LOGF(x) __logf(x)
__device__ __forceinline__ float sigm(float x) { return __builtin_amdgcn_rcpf(1.0f + EXPF(-x)); }
__device__ __forceinline__ float siluf_(float x) { return x * __builtin_amdgcn_rcpf(1.0f + EXPF(-x)); }

__device__ const float c_invf[64] = {1.000000000e+00f, 8.659643531e-01f, 7.498942018e-01f, 6.493816376e-01f, 5.623413324e-01f, 4.869675338e-01f, 4.216965139e-01f, 3.651741147e-01f, 3.162277639e-01f, 2.738419771e-01f, 2.371373773e-01f, 2.053525001e-01f, 1.778279394e-01f, 1.539926529e-01f, 1.333521456e-01f, 1.154781953e-01f, 1.000000015e-01f, 8.659642935e-02f, 7.498942316e-02f, 6.493816525e-02f, 5.623413250e-02f, 4.869675264e-02f, 4.216964915e-02f, 3.651741147e-02f, 3.162277490e-02f, 2.738419548e-02f, 2.371373773e-02f, 2.053525113e-02f, 1.778279431e-02f, 1.539926510e-02f, 1.333521400e-02f, 1.154781971e-02f, 9.999999776e-03f, 8.659643121e-03f, 7.498942316e-03f, 6.493816152e-03f, 5.623413250e-03f, 4.869675264e-03f, 4.216964822e-03f, 3.651741194e-03f, 3.162277630e-03f, 2.738419687e-03f, 2.371373819e-03f, 2.053525066e-03f, 1.778279431e-03f, 1.539926510e-03f, 1.333521446e-03f, 1.154782018e-03f, 1.000000047e-03f, 8.659643354e-04f, 7.498941850e-04f, 6.493816036e-04f, 5.623413017e-04f, 4.869675322e-04f, 4.216965172e-04f, 3.651741135e-04f, 3.162277571e-04f, 2.738419571e-04f, 2.371373703e-04f, 2.053525095e-04f, 1.778279402e-04f, 1.539926598e-04f, 1.333521504e-04f, 1.154782003e-04f};

__device__ __forceinline__ void sincos_acc(float ang, float& s_out, float& c_out) {
    const double x = (double)ang;
    const double k = rint(x * 0.63661977236758134308);
    double r = fma(-k, 1.57079632679489655800e+00, x); r = fma(-k, 6.12323399573676603587e-17, r);
    const double r2 = r * r;
    double sp = -1.0 / 6227020800.0; sp = fma(sp, r2, 1.0 / 39916800.0); sp = fma(sp, r2, -1.0 / 362880.0); sp = fma(sp, r2, 1.0 / 5040.0); sp = fma(sp, r2, -1.0 / 120.0); sp = fma(sp, r2, 1.0 / 6.0);
    const double sn = fma(-sp * r2, r, r);
    double cp = -1.0 / 87178291200.0; cp = fma(cp, r2, 1.0 / 479001600.0); cp = fma(cp, r2, -1.0 / 3628800.0); cp = fma(cp, r2, 1.0 / 40320.0); cp = fma(cp, r2, -1.0 / 720.0); cp = fma(cp, r2, 1.0 / 24.0); cp = fma(cp, r2, -0.5);
    const double cs = fma(cp, r2, 1.0);
    const int q = ((int)k) & 3;
    const double s = (q == 0) ? sn : (q == 1) ? cs : (q == 2) ? -sn : -cs;
    const double c = (q == 0) ? cs : (q == 1) ? -sn : (q == 2) ? -cs : sn;
    s_out = (float)s; c_out = (float)c;
}

__device__ __forceinline__ void row_to_bf16_ssq(Frame& F, const float* xrow, bf16* orow, float* ssq_out, int np, int ldp) {
    const f32x4* xr = (const f32x4*)xrow + F.lane; float s = 0.f;
#pragma unroll
    for (int j = 0; j < D / 256; ++j) { const f32x4 v = xr[64 * j]; s += (v[0] * v[0] + v[1] * v[1]) + (v[2] * v[2] + v[3] * v[3]); storeA4(orow, D, 256 * j + 4 * F.lane, v); }
    s = wave_sum(s); if (F.lane < np) ssq_out[(size_t)F.lane * ldp] = (F.lane == 0) ? s : 0.f;
}

__device__ __forceinline__ void ph_prologue(Frame& F) {
    const int gw = F.bid * 8 + F.wave, NGW = F.G * 8, gt = F.bid * 512 + F.tid, NGT = F.G * 512;
    float* cosT = WSP(float, WS_COS); float* sinT = WSP(float, WS_SIN);
    for (int i = gt; i < T * 64; i += NGT) { const int pos = i >> 6, fi = i & 63; const float ang = (float)pos * c_invf[fi]; float s, c; sincos_acc(ang, s, c); cosT[i] = c; sinT[i] = s; }
    const float* lg = INP(5); float* lb = WSP(float, WS_LB);
    for (int j = gt; j < 512; j += NGT) { const float a0 = lg[j], a1 = lg[512 + j], a2 = lg[1024 + j], a3 = lg[1536 + j]; const float mx = fmaxf(fmaxf(a0, a1), fmaxf(a2, a3));
        const float e0 = EXPF(a0 - mx), e1 = EXPF(a1 - mx), e2 = EXPF(a2 - mx), e3 = EXPF(a3 - mx), inv = 1.0f / (((e0 + e1) + e2) + e3);
        const float p0 = e0 * inv, p1 = e1 * inv, p2 = e2 * inv, p3 = e3 * inv;
        lb[j] = p0 - p0; lb[512 + j] = (p0 + p1) - p0; lb[1024 + j] = ((p0 + p1) + p2) - p0; lb[1536 + j] = (((p0 + p1) + p2) + p3) - p0; }
    for (int m = gw; m < T; m += NGW) row_to_bf16_ssq(F, INP(0) + (size_t)m * D, WSP(bf16, WS_A0) + (size_t)m * (KS * D), WSP(float, WS_SSQA) + m, 32, T);
    for (int m = gw; m < MEM; m += NGW) row_to_bf16_ssq(F, INP(1) + (size_t)m * D, WSP(bf16, WS_MEMB) + (size_t)m * (KS * D), WSP(float, WS_SSQM) + m, 1, 0);
}

template <bool ZMAP, bool HSL = false>
__device__ __forceinline__ void wconv_item(const float* W, int K, int ldw, const float* gain, bf16* WT, LAS float* scr, int item, int nblk, int lane) {
    const int kb = item / nblk, nb = item % nblk, k0 = 64 * kb, n0 = 64 * nb;
    const int c4 = 4 * (lane & 15), rr = lane >> 4;
    const int nsrc = ZMAP ? zcol_src(n0 + c4) : (n0 + c4);
    f32x4 v[16];
#pragma unroll
    for (int i = 0; i < 16; ++i) v[i] = (nsrc >= 0) ? __builtin_nontemporal_load((const f32x4*)(W + (size_t)(k0 + 4 * i + rr) * ldw + nsrc)) : (f32x4){0.f, 0.f, 0.f, 0.f};
#pragma unroll
    for (int i = 0; i < 16; ++i) { const int kk = 4 * i + rr; const float gk = gain ? gain[k0 + kk] : 1.0f; LAS float* d = scr + kk * 65 + c4; d[0] = v[i][0] * gk; d[1] = v[i][1] * gk; d[2] = v[i][2] * gk; d[3] = v[i][3] * gk; }
    LDS_WAIT(); asm volatile("" ::: "memory");
    const int c = lane & 7;
#pragma unroll
    for (int j = 0; j < 8; ++j) { const int n = (lane >> 3) + 8 * j; const LAS float* s = scr + (8 * c) * 65 + n;
        float x[8];
#pragma unroll
        for (int q = 0; q < 8; ++q) x[q] = s[q * 65];
        v4u o; o.x = pk2(x[0], x[1]); o.y = pk2(x[2], x[3]); o.z = pk2(x[4], x[5]); o.w = pk2(x[6], x[7]);
        bf16* dst = HSL ? WT + ((size_t)(k0 >> 9) * (size_t)(nblk * 64) + (n0 + n)) * 512 + (k0 & 511) + 8 * c : WT + (size_t)(n0 + n) * (KS * K) + k0 + 8 * c;
        __builtin_nontemporal_store(o, (v4u*)dst);
#if KS == 3
        v4u l; l.x = pk2(lo_of(x[0]), lo_of(x[1])); l.y = pk2(lo_of(x[2]), lo_of(x[3])); l.z = pk2(lo_of(x[4]), lo_of(x[5])); l.w = pk2(lo_of(x[6]), lo_of(x[7]));
        *(v4u*)(dst + K) = l; *(v4u*)(dst + 2 * K) = o;
#endif
    }
    LDS_WAIT(); asm volatile("" ::: "memory");
}
constexpr int WC_I_IN = (D / 64) * (NIN / 64), WC_I_DD = (D / 64) * (D / 64), WC_I_1 = (D / 64) * (DFF / 64), WC_I_2 = (DFF / 64) * (D / 64);
constexpr int WC_NT = WC_I_IN + 5 * WC_I_DD + WC_I_1 + WC_I_2, WC_NALL = WC_NT + 2048 + NIN / 256;
constexpr int K4_PER = K4PER_, K4_CONV = 128 * K4_PER;
constexpr int K1_PER = 46, K1_CONV = 140 * K1_PER;
__device__ __forceinline__ void wcf_item(Frame& F, int L, size_t wo, int item);
constexpr int WC_DEF_LO = WC_I_IN + 5 * WC_I_DD, WC_DEF_N = WC_I_1 + WC_I_2;
__device__ __forceinline__ void ph_wconv(Frame& F, int L, size_t wo, int lo, int hi, int skip_lo = 1 << 30, int skip_len = 0, int w_lo = 0) {
    LAS float* scr = (LAS float*)(F.lds + F.wave * WAVE_SCR);
    const float* w_in = INP(3) + (size_t)L * D * DIN; const float* g_mix = INP(2) + L * D;
    const float* w_out = INP(13) + (size_t)L * D * D;
    const float* wq = INP(16) + (size_t)L * D * D; const float* wk = INP(17) + (size_t)L * D * D; const float* wv = INP(18) + (size_t)L * D * D; const float* wo_ = INP(19) + (size_t)L * D * D;
    const float* g_xa = INP(14) + L * D; const float* g_mem = INP(15) + L * D; const float* g_mlp = INP(22) + L * D;
    const float* w1 = INP(23) + (size_t)L * D * DFF; const float* w2 = INP(24) + (size_t)L * DFF * D;
    if (F.wave < w_lo) return;
    for (int it = lo + (F.wave - w_lo); it < hi; it += 8 - w_lo) {
        int r = it + (it >= skip_lo ? skip_len : 0);
        if (r < WC_I_IN) { wconv_item<true>(w_in, D, DIN, g_mix, WSO(bf16, WS_WIN, wo), scr, r, NIN / 64, F.lane); continue; } r -= WC_I_IN;
        if (r < WC_I_DD) { wconv_item<false>(w_out, D, D, nullptr, WSO(bf16, WS_WOUT, wo), scr, r, D / 64, F.lane); continue; } r -= WC_I_DD;
        if (r < WC_I_DD) { wconv_item<false>(wq, D, D, g_xa, WSO(bf16, WS_WQ, wo), scr, r, D / 64, F.lane); continue; } r -= WC_I_DD;
        if (r < WC_I_DD) { wconv_item<false, XFUSE != 0>(wo_, D, D, nullptr, WSO(bf16, WS_WO, wo), scr, r, D / 64, F.lane); continue; } r -= WC_I_DD;
        if (r < WC_I_DD) { wconv_item<false>(wk, D, D, g_mem, WSO(bf16, WS_WKV, wo), scr, r, D / 64, F.lane); continue; } r -= WC_I_DD;
        if (r < WC_I_DD) { wconv_item<false>(wv, D, D, g_mem, WSO(bf16, WS_WKV, wo) + (size_t)D * (KS * D), scr, r, D / 64, F.lane); continue; } r -= WC_I_DD;
        if (r < WC_I_1) { wconv_item<false>(w1, D, DFF, g_mlp, WSO(bf16, WS_W1, wo), scr, r, DFF / 64, F.lane); continue; } r -= WC_I_1;
        if (r < WC_I_2) { wconv_item<false>(w2, DFF, D, nullptr, WSO(bf16, WS_W2, wo), scr, r, D / 64, F.lane); continue; } r -= WC_I_2;
        if (r < 2048) { wcf_item(F, L, wo, r); continue; } r -= 2048;
        { float* bp = WSO(float, WS_BPERM, wo); const float* b_in = INP(4) + (size_t)L * DIN;
          for (int j = 256 * r + F.lane; j < 256 * r + 256; j += 64) { const int s = zcol_src(j); bp[j] = (s >= 0) ? b_in[s] : 0.f; } }
    }
}

__device__ __forceinline__ void normrope_head(const float* src, const float* gain, const float* cosr, const float* sinr, float& o1, float& o2, int lane) {
    const float x1 = src[lane], x2 = src[lane + 64];
    const float ss = wave_sum(x1 * x1 + x2 * x2);
    const float rs = 1.0f / sqrtf(ss * (1.0f / 128.0f) + EPS);
    const float y1 = x1 * rs * gain[lane], y2 = x2 * rs * gain[lane + 64];
    const float c = cosr[lane], s = sinr[lane];
    o1 = y1 * c - y2 * s; o2 = y2 * c + y1 * s;
}
__device__ __forceinline__ int swap23_(int r) { return (r & ~12) | ((r & 4) << 1) | ((r & 8) >> 1); }
__device__ __forceinline__ size_t kf_index_(int g, int t, int d) { return ((size_t)(g * 256 + (t >> 5)) * 4096) + (d >> 4) * 512 + (swap23_(t & 31) + 32 * ((d >> 3) & 1)) * 8 + (d & 7); }
__device__ __forceinline__ void ph_prep(Frame& F, int L, int w_lo) {
    if (F.wave < w_lo) return;
    const int gw = F.bid * (8 - w_lo) + (F.wave - w_lo), NGW = F.G * (8 - w_lo), lane = F.lane;
    const float* z = WSP(float, WS_Z);
    const float* qg = INP(7) + L * 128; const float* kg = INP(8) + L * 3 * 128; const float* cw = INP(11) + (size_t)L * 4 * 1024;
    const float* cosT = WSP(float, WS_COS); const float* sinT = WSP(float, WS_SIN);
#if ORACLE_ATTN
    float* nsq = WSP(float, WS_NSQ); float* nks = WSP(float, WS_NKS); float* nkw = WSP(float, WS_NKW);
#endif
    float* mlq = WSP(float, WS_MLQ); float* mlk = WSP(float, WS_MLK);
    const float qscale = 0.08838834764831845f;
    bf16* qn = WSP(bf16, WS_QN); bf16* ksf = WSP(bf16, WS_KSF); bf16* kwf = WSP(bf16, WS_KWF);
    for (int t = gw; t < T; t += NGW) {
        const float* zr = z + (size_t)t * NIN; const float c = cosT[t * 64 + lane], s = sinT[t * 64 + lane];
        float x1[12], x2[12], ss[12];
#pragma unroll
        for (int i = 0; i < 12; ++i) { const int col = (i < 8) ? ZC_NSQ + i * 128 : (i < 10) ? ZC_NKS + (i - 8) * 128 : ZC_NKW + (i - 10) * 128; x1[i] = zr[col + lane]; x2[i] = zr[col + lane + 64]; ss[i] = x1[i] * x1[i] + x2[i] * x2[i]; }
#pragma unroll
        for (int i = 0; i < 12; ++i) ss[i] += sxor<1>(ss[i]);
#pragma unroll
        for (int i = 0; i < 12; ++i) ss[i] += sxor<2>(ss[i]);
#pragma unroll
        for (int i = 0; i < 12; ++i) ss[i] += sxor<4>(ss[i]);
#pragma unroll
        for (int i = 0; i < 12; ++i) ss[i] += sxor<8>(ss[i]);
#pragma unroll
        for (int i = 0; i < 12; ++i) ss[i] += sxor<16>(ss[i]);
#pragma unroll
        for (int i = 0; i < 12; ++i) ss[i] = half_sum(ss[i]);
#pragma unroll
        for (int i = 0; i < 12; ++i) { const float* gn = (i < 8) ? qg : (i < 10) ? kg + 128 : kg + 256; const float rs = 1.0f / sqrtf(ss[i] * (1.0f / 128.0f) + EPS);
            const float y1 = x1[i] * rs * gn[lane], y2 = x2[i] * rs * gn[lane + 64]; const float o1 = y1 * c - y2 * s, o2 = y2 * c + y1 * s;
            if (i < 8) { qn[(size_t)t * 1024 + i * 128 + lane] = (bf16)f2bf(o1 * (qscale * 1.4426950408889634f)); qn[(size_t)t * 1024 + i * 128 + lane + 64] = (bf16)f2bf(o2 * (qscale * 1.4426950408889634f));
#if ORACLE_ATTN
                nsq[(size_t)t * 1024 + i * 128 + lane] = o1 * qscale; nsq[(size_t)t * 1024 + i * 128 + lane + 64] = o2 * qscale;
#endif
            } else { bf16* kf = (i < 10) ? ksf : kwf; const int hh = (i - 8) & 1; kf[kf_index_(hh, t, lane)] = (bf16)f2bf(o1); kf[kf_index_(hh, t, lane + 64)] = (bf16)f2bf(o2);
#if ORACLE_ATTN
                float* kn = (i < 10) ? nks : nkw; kn[(size_t)t * 256 + hh * 128 + lane] = o1; kn[(size_t)t * 256 + hh * 128 + lane + 64] = o2;
#endif
            } }
#if ORACLE_MIX
        for (int i = 0; i < 16; ++i) { const int ch = lane + 64 * i; const int zc = (ch < 512) ? (ZC_MLQ + ch) : (ZC_MLK + ch - 512); float a = 0.f;
#pragma unroll
            for (int j = 0; j < 4; ++j) { const int tt = t - 3 + j; if (tt >= 0) a += cw[j * 1024 + ch] * z[(size_t)tt * NIN + zc]; }
            a = siluf_(a); if (ch < 512) mlq[(size_t)t * 512 + ch] = a * qscale; else mlk[(size_t)t * 512 + ch - 512] = a; }
#endif
    }
    { bf16* vsf = WSP(bf16, WS_VSF); bf16* vwf = WSP(bf16, WS_VWF);
      for (int tg8 = gw; tg8 < T / 8; tg8 += NGW) { const int t0 = 8 * tg8;
#pragma unroll
          for (int which = 0; which < 2; ++which)
#pragma unroll
              for (int g = 0; g < 2; ++g)
#pragma unroll
                  for (int dd = 0; dd < 2; ++dd) { const int d = lane + 64 * dd; const float* src = z + (size_t)t0 * NIN + (which ? ZC_NVW : ZC_NVS) + g * 128 + d; float v[8];
#pragma unroll
                      for (int j = 0; j < 8; ++j) v[j] = src[(size_t)j * NIN];
                      v4u o; o.x = pk2(v[0], v[1]); o.y = pk2(v[2], v[3]); o.z = pk2(v[4], v[5]); o.w = pk2(v[6], v[7]);
                      const size_t idx = ((size_t)(g * 256 + (t0 >> 5)) * 4096) + ((d >> 5) * 2 + ((t0 & 31) >> 4)) * 512 + ((d & 31) + 32 * ((t0 >> 3) & 1)) * 8;
                      *(v4u*)((which ? vwf : vsf) + idx) = o; } } }
    const float* kvx = WSP(float, WS_KVX); const float* xkg = INP(21) + L * 512; const float* xqg = INP(20) + L * 512; bf16* kxf = WSP(bf16, WS_KXF);
#if ORACLE_ATTN
    float* kxn = WSP(float, WS_KXN);
#endif
    for (int it = gw; it < MEM * 4; it += NGW) { const int m = it >> 2, h = it & 3; const float* src = kvx + (size_t)m * (2 * D) + h * 512; float v[8]; float ss = 0.f;
#pragma unroll
        for (int j = 0; j < 8; ++j) { v[j] = src[lane + 64 * j]; ss += v[j] * v[j]; }
        ss = wave_sum(ss); const float rs = 1.0f / sqrtf(ss * (1.0f / 512.0f) + EPS);
#pragma unroll
        for (int j = 0; j < 8; ++j) { const int d = lane + 64 * j; const float y = v[j] * rs * xkg[d]; const float yq = y * xqg[d] * (0.04419417382415922f * 1.4426950408889634f);
#if ORACLE_ATTN
            kxn[((size_t)h * MEM + m) * 512 + d] = y;
#endif
            kxf[((size_t)h * MEM + m) * 512 + d] = (bf16)f2bf(yq); } }
#if XFUSE
    { bf16* vxr = WSP(bf16, WS_VXF);
      for (int it = gw; it < MEM * 4; it += NGW) { const int m = it >> 2, h = it & 3; const float* src = kvx + (size_t)m * (2 * D) + D + h * 512 + 8 * lane;
          const f32x4 a = *(const f32x4*)src, b2 = *(const f32x4*)(src + 4);
          v4u o; o.x = pk2(a[0], a[1]); o.y = pk2(a[2], a[3]); o.z = pk2(b2[0], b2[1]); o.w = pk2(b2[2], b2[3]);
          *(v4u*)(vxr + ((size_t)h * MEM + m) * 512 + 8 * lane) = o; } }
#else
    { bf16* vxf = WSP(bf16, WS_VXF);
      for (int it = gw; it < (MEM / 8) * 4; it += NGW) { const int m0 = 8 * (it >> 2), h = it & 3;
#pragma unroll
          for (int dd = 0; dd < 8; ++dd) { const int d = lane + 64 * dd; const float* src = kvx + (size_t)m0 * (2 * D) + D + h * 512 + d; float v[8];
#pragma unroll
              for (int j = 0; j < 8; ++j) v[j] = src[(size_t)j * (2 * D)];
              v4u o; o.x = pk2(v[0], v[1]); o.y = pk2(v[2], v[3]); o.z = pk2(v[4], v[5]); o.w = pk2(v[6], v[7]);
              *(v4u*)(vxf + ((size_t)h * 512 + d) * MEM + m0) = o; } } }
#endif
}
constexpr int HP = 129;
__device__ __forceinline__ void hg_gates(Frame& F, int L, int c, int h, LAS float* B, LAS float* KY) {
    const float* z = WSP(float, WS_Z); const float* lb = WSP(float, WS_LB) + L * 512 + h * 128;
    for (int i = F.tid; i < 64 * 128; i += 512) { const int s = i >> 7, d = i & 127; const float zf = z[(size_t)(64 * c + s) * NIN + ZC_HGF + h * 128 + d]; const float l = lb[d];
        const float e = EXPF(-fabsf(zf)); const float sp = (zf >= 0.f) ? 1.0f / (1.0f + e) : e / (1.0f + e);
        const float sn = (zf >= 0.f) ? e / (1.0f + e) : 1.0f / (1.0f + e);
        const float forget = l + (1.0f - l) * sp;
        B[s * HP + d] = LOGF(fmaxf(forget, 1e-20f)); KY[s * HP + d] = (1.0f - l) * sn; }
    __syncthreads();
    float offs[2];
    for (int k = 0; k < 2; ++k) { const int i = F.tid + 512 * k, d = i & 127, s0 = (i >> 7) * 8; float a = 0.f;
#pragma unroll
        for (int j = 0; j < 8; ++j) { a += B[(s0 + j) * HP + d]; B[(s0 + j) * HP + d] = a; } }
    __syncthreads();
    for (int k = 0; k < 2; ++k) { const int i = F.tid + 512 * k, d = i & 127, ch = i >> 7; float off = 0.f;
        for (int c2 = 0; c2 < ch; ++c2) off += B[(8 * c2 + 7) * HP + d];
        offs[k] = off; }
    __syncthreads();
    for (int k = 0; k < 2; ++k) { const int i = F.tid + 512 * k, d = i & 127, s0 = (i >> 7) * 8;
#pragma unroll
        for (int j = 0; j < 8; ++j) B[(s0 + j) * HP + d] += offs[k]; }
    __syncthreads();
}
__device__ __forceinline__ void hg_summary_item(Frame& F, int L, int c, int h) {
    LAS float* B = (LAS float*)F.lds; LAS float* KY = B + 64 * HP; LAS float* V = KY + 64 * HP;
    const float* z = WSP(float, WS_Z);
    hg_gates(F, L, c, h, B, KY);
    for (int i = F.tid; i < 64 * 128; i += 512) { const int s = i >> 7, d = i & 127; KY[s * HP + d] *= EXPF(B[63 * HP + d] - B[s * HP + d]); V[s * HP + d] = z[(size_t)(64 * c + s) * NIN + ZC_HGI + h * 128 + d]; }
    if (F.tid < 128) WSP(float, WS_HGDEC)[(c * 4 + h) * 128 + F.tid] = EXPF(B[63 * HP + F.tid]);
    __syncthreads();
    const int e = F.tid & 127, dg = F.tid >> 7; float acc[32];
#pragma unroll
    for (int j = 0; j < 32; ++j) acc[j] = 0.f;
    for (int s = 0; s < 64; ++s) { const float v = V[s * HP + e];
#pragma unroll
        for (int j = 0; j < 32; ++j) acc[j] += KY[s * HP + dg * 32 + j] * v; }
    float* U = WSP(float, WS_HGU) + (size_t)(c * 4 + h) * 16384;
#pragma unroll
    for (int j = 0; j < 32; ++j) U[(dg * 32 + j) * 128 + e] = acc[j];
    __syncthreads();
}
template <bool SILU>
__device__ __forceinline__ void finish_rows(Frame& F, LAS float* O, const float* gain, const float* gate_src, int gate_col, int ycol, int c) {
    bf16* y = WSP(bf16, WS_A1);
    for (int rr = 0; rr < 8; ++rr) { const int t = F.wave * 8 + rr; const float o1 = O[t * HP + F.lane], o2 = O[t * HP + F.lane + 64];
        const float ss = wave_sum(o1 * o1 + o2 * o2); const float rs = 1.0f / sqrtf(ss * (1.0f / 128.0f) + EPS);
        const float* gr = gate_src + (size_t)(64 * c + t) * NIN + gate_col; const float g1 = gr[F.lane], g2 = gr[F.lane + 64];
        const float a1 = SILU ? siluf_(g1) : sigm(g1), a2 = SILU ? siluf_(g2) : sigm(g2);
        bf16* yr = y + (size_t)(64 * c + t) * (KS * D);
        storeA1(yr, D, ycol + F.lane, o1 * rs * gain[F.lane] * a1); storeA1(yr, D, ycol + F.lane + 64, o2 * rs * gain[F.lane + 64] * a2); }
}
__device__ __forceinline__ void hg_output_item(Frame& F, int L, int c, int h) {
    LAS float* B = (LAS float*)F.lds; LAS float* KY = B + 64 * HP; LAS float* Q = KY + 64 * HP; LAS float* SC = Q + 64 * HP;
    const float* z = WSP(float, WS_Z);
    hg_gates(F, L, c, h, B, KY);
    for (int i = F.tid; i < 64 * 128; i += 512) { const int s = i >> 7, d = i & 127; Q[s * HP + d] = z[(size_t)(64 * c + s) * NIN + ZC_HGQ + h * 128 + d]; }
    __syncthreads();
    for (int p = F.tid; p < 4096; p += 512) { const int t = p >> 6, s = p & 63; float a = 0.f;
        if (s <= t) { for (int d = 0; d < 128; ++d) a += Q[t * HP + d] * KY[s * HP + d] * EXPF(B[t * HP + d] - B[s * HP + d]); }
        SC[t * 65 + s] = a; }
    __syncthreads();
    for (int i = F.tid; i < 64 * 128; i += 512) { const int s = i >> 7, d = i & 127; Q[s * HP + d] *= EXPF(B[s * HP + d]); }
    __syncthreads();
    const int e = F.tid & 127, tg = F.tid >> 7; float acc[16];
#pragma unroll
    for (int j = 0; j < 16; ++j) acc[j] = 0.f;
    for (int s = 0; s < 64; ++s) { const float v = z[(size_t)(64 * c + s) * NIN + ZC_HGI + h * 128 + e];
#pragma unroll
        for (int j = 0; j < 16; ++j) acc[j] += SC[(tg * 16 + j) * 65 + s] * v; }
    const float* S = WSP(float, WS_HGS) + (size_t)(c * 4 + h) * 16384;
    for (int d = 0; d < 128; ++d) { const float sv = S[d * 128 + e];
#pragma unroll
        for (int j = 0; j < 16; ++j) acc[j] += Q[(tg * 16 + j) * HP + d] * sv; }
    __syncthreads();
#pragma unroll
    for (int j = 0; j < 16; ++j) KY[(tg * 16 + j) * HP + e] = acc[j];
    __syncthreads();
    finish_rows<true>(F, KY, INP(6) + L * 512 + h * 128, z, ZC_HGG + h * 128, h * 128, c);
    __syncthreads();
}

__device__ __forceinline__ void ml_gates(Frame& F, int c, int h, LAS float* BL, LAS float* LI) {
    const float* z = WSP(float, WS_Z);
    if (F.tid < 64) { const float f = z[(size_t)(64 * c + F.tid) * NIN + ZC_MLF + h]; BL[F.tid] = fminf(f, 0.f) - log1pf(EXPF(-fabsf(f))); LI[F.tid] = z[(size_t)(64 * c + F.tid) * NIN + ZC_MLI + h]; }
    __syncthreads();
    if (F.tid < 64) { float a = 0.f; for (int s = 0; s < 64; ++s) { const float v = BL[s]; a += (s <= F.tid) ? v : 0.f; } LDS_WAIT(); asm volatile("" ::: "memory"); BL[F.tid] = a; }
    __syncthreads();
}
__device__ __forceinline__ void ml_summary_item(Frame& F, int c, int h) {
    LAS float* KW = (LAS float*)F.lds; LAS float* V = KW + 64 * HP; LAS float* BL = V + 64 * HP; LAS float* LI = BL + 64; LAS float* WS_ = LI + 64;
    const float* z = WSP(float, WS_Z); const float* mlk = WSP(float, WS_MLK);
    ml_gates(F, c, h, BL, LI);
    float mloc = -3.0e38f; for (int s = 0; s < 64; ++s) mloc = fmaxf(mloc, BL[63] - BL[s] + LI[s]);
    if (F.tid < 64) WS_[F.tid] = EXPF(BL[63] - BL[F.tid] + LI[F.tid] - mloc);
    __syncthreads();
    for (int i = F.tid; i < 64 * 128; i += 512) { const int s = i >> 7, d = i & 127; KW[s * HP + d] = mlk[(size_t)(64 * c + s) * 512 + h * 128 + d] * WS_[s]; V[s * HP + d] = z[(size_t)(64 * c + s) * NIN + ZC_MLV + h * 128 + d]; }
    float* msc = WSP(float, WS_MLSC);
    if (F.tid == 0) { msc[c * 4 + h] = mloc; msc[NCH * 4 + c * 4 + h] = BL[63]; }
    __syncthreads();
    const int e = F.tid & 127, dg = F.tid >> 7; float acc[32];
#pragma unroll
    for (int j = 0; j < 32; ++j) acc[j] = 0.f;
    for (int s = 0; s < 64; ++s) { const float v = V[s * HP + e];
#pragma unroll
        for (int j = 0; j < 32; ++j) acc[j] += KW[s * HP + dg * 32 + j] * v; }
    float* U = WSP(float, WS_MLU) + (size_t)(c * 4 + h) * 16384;
#pragma unroll
    for (int j = 0; j < 32; ++j) U[(dg * 32 + j) * 128 + e] = acc[j];
    if (F.tid < 128) { float a = 0.f; for (int s = 0; s < 64; ++s) a += KW[s * HP + F.tid]; WSP(float, WS_MLNL)[(c * 4 + h) * 128 + F.tid] = a; }
    __syncthreads();
}
__device__ __forceinline__ void ml_output_item(Frame& F, int L, int c, int h) {
    LAS float* Q = (LAS float*)F.lds; LAS float* KK = Q + 64 * HP; LAS float* SC = KK + 64 * HP; LAS float* BL = SC + 64 * 65; LAS float* LI = BL + 64; LAS float* MT = LI + 64; LAS float* WI = MT + 64; LAS float* QN = WI + 64;
    const float* z = WSP(float, WS_Z); const float* mlq = WSP(float, WS_MLQ); const float* mlk = WSP(float, WS_MLK);
    ml_gates(F, c, h, BL, LI);
    const float mprev = WSP(float, WS_MLSC)[2 * NCH * 4 + c * 4 + h];
    for (int i = F.tid; i < 64 * 128; i += 512) { const int s = i >> 7, d = i & 127; Q[s * HP + d] = mlq[(size_t)(64 * c + s) * 512 + h * 128 + d]; KK[s * HP + d] = mlk[(size_t)(64 * c + s) * 512 + h * 128 + d]; }
    if (F.tid < 64) { const int t = F.tid; const float inter = BL[t] + mprev; float mt = inter; for (int s = 0; s <= t; ++s) mt = fmaxf(mt, BL[t] - BL[s] + LI[s]); MT[t] = mt; WI[t] = EXPF(inter - mt); }
    __syncthreads();
    for (int p = F.tid; p < 4096; p += 512) { const int t = p >> 6, s = p & 63; float a = 0.f;
        if (s <= t) { for (int d = 0; d < 128; ++d) a += Q[t * HP + d] * KK[s * HP + d]; a *= EXPF(BL[t] - BL[s] + LI[s] - MT[t]); }
        SC[t * 65 + s] = a; }
    __syncthreads();
    if (F.tid < 64) { const int t = F.tid; const float* nst = WSP(float, WS_MLN) + (c * 4 + h) * 128; float a = 0.f; for (int d = 0; d < 128; ++d) a += Q[t * HP + d] * nst[d]; a *= WI[t];
        float r = 0.f; for (int s = 0; s < 64; ++s) r += SC[t * 65 + s]; QN[t] = a + r; }
    const int e = F.tid & 127, tg = F.tid >> 7; float acc[16];
#pragma unroll
    for (int j = 0; j < 16; ++j) acc[j] = 0.f;
    const float* Cst = WSP(float, WS_MLS) + (size_t)(c * 4 + h) * 16384;
    for (int d = 0; d < 128; ++d) { const float sv = Cst[d * 128 + e];
#pragma unroll
        for (int j = 0; j < 16; ++j) acc[j] += Q[(tg * 16 + j) * HP + d] * sv; }
#pragma unroll
    for (int j = 0; j < 16; ++j) acc[j] *= WI[tg * 16 + j];
    for (int s = 0; s < 64; ++s) { const float v = z[(size_t)(64 * c + s) * NIN + ZC_MLV + h * 128 + e];
#pragma unroll
        for (int j = 0; j < 16; ++j) acc[j] += SC[(tg * 16 + j) * 65 + s] * v; }
    __syncthreads();
#pragma unroll
    for (int j = 0; j < 16; ++j) { const int t = tg * 16 + j; KK[t * HP + e] = acc[j] / fmaxf(fabsf(QN[t]), EXPF(-MT[t])); }
    __syncthreads();
    finish_rows<false>(F, KK, INP(12) + L * 512 + h * 128, z, ZC_MLO + h * 128, 1536 + h * 128, c);
    __syncthreads();
}

__device__ __forceinline__ void cmp_item(Frame& F, int L, int item) {
    const int which = item & 1, g = (item >> 1) & 1, c0 = (item >> 2) * 8;
    LAS float* A = (LAS float*)F.lds;
    LAS float* PE = A + 144 * HP;
    LAS float* O = PE + 32 * 128;
    const float* z = WSP(float, WS_Z); const int zc = (which ? ZC_NVC : ZC_NKC) + g * 128;
    const float* pe = INP(9) + ((size_t)(L * 2 + which) * 32) * 128; const float* w = INP(10) + ((size_t)(L * 2 + which) * 32) * 128 * 128;
    for (int i = F.tid; i < 144 * 128; i += 512) { const int r = i >> 7, d = i & 127; const int tok = 16 * c0 + r; A[r * HP + d] = (tok < T) ? z[(size_t)tok * NIN + zc + d] : 0.f; }
    for (int i = F.tid; i < 32 * 128; i += 512) PE[i] = pe[i];
    __syncthreads();
    const int e = F.tid & 127, rg = F.tid >> 7;
    float a0 = 0.f, a1 = 0.f;
    for (int l = 0; l < 32; ++l) { const LAS float* r0 = A + (16 * (2 * rg) + l) * HP; const LAS float* r1 = A + (16 * (2 * rg + 1) + l) * HP; const LAS float* pr = PE + l * 128; const float* wl = w + (size_t)l * 16384 + e;
        for (int d = 0; d < 128; ++d) { const float wv = wl[d * 128], p = pr[d]; a0 += (r0[d] + p) * wv; a1 += (r1[d] + p) * wv; } }
    O[(2 * rg) * HP + e] = a0; O[(2 * rg + 1) * HP + e] = a1;
    __syncthreads();
    if (!which) { const int c = c0 + F.wave; const float o1 = O[F.wave * HP + F.lane], o2 = O[F.wave * HP + F.lane + 64];
        const float* kg = INP(8) + L * 384; const float ss = wave_sum(o1 * o1 + o2 * o2); const float rs = 1.0f / sqrtf(ss * (1.0f / 128.0f) + EPS);
        const float y1 = o1 * rs * kg[F.lane], y2 = o2 * rs * kg[F.lane + 64]; const int pos = (c < NCMP) ? 16 * c + 31 : 0; const float cs = WSP(float, WS_COS)[pos * 64 + F.lane], sn = WSP(float, WS_SIN)[pos * 64 + F.lane];
        const float r1 = y1 * cs - y2 * sn, r2 = y2 * cs + y1 * sn;
        bf16* kcf = WSP(bf16, WS_KCF) + (size_t)g * 16 * 4096 + (size_t)(c >> 5) * 4096;
        { const int d = F.lane; kcf[(d >> 4) * 512 + (swap23_(c & 31) + 32 * ((d >> 3) & 1)) * 8 + (d & 7)] = (bf16)f2bf(r1); }
        { const int d = F.lane + 64; kcf[(d >> 4) * 512 + (swap23_(c & 31) + 32 * ((d >> 3) & 1)) * 8 + (d & 7)] = (bf16)f2bf(r2); }
#if ORACLE_ATTN
        if (c < NCMP) { float* dst = WSP(float, WS_KCN) + (size_t)g * 512 * 128; dst[c * 128 + F.lane] = r1; dst[c * 128 + F.lane + 64] = r2; }
#endif
    } else {
        if (F.tid < 128) { const int d = F.tid; float v[8];
#pragma unroll
            for (int j = 0; j < 8; ++j) v[j] = O[j * HP + d];
            v4u o; o.x = pk2(v[0], v[1]); o.y = pk2(v[2], v[3]); o.z = pk2(v[4], v[5]); o.w = pk2(v[6], v[7]);
            *(v4u*)(WSP(bf16, WS_VCF) + (size_t)g * 16 * 4096 + (size_t)(c0 >> 5) * 4096 + ((d >> 5) * 2 + ((c0 & 31) >> 4)) * 512 + ((d & 31) + 32 * ((c0 >> 3) & 1)) * 8) = o; }
#if ORACLE_ATTN
        { const int c = c0 + F.wave; if (c < NCMP) { float* dst = WSP(float, WS_VCN) + (size_t)g * 512 * 128; dst[c * 128 + F.lane] = O[F.wave * HP + F.lane]; dst[c * 128 + F.lane + 64] = O[F.wave * HP + F.lane + 64]; } }
#endif
    }
    __syncthreads();
}

__device__ __forceinline__ void ph_scan(Frame& F) {
    const int gt = F.bid * 512 + F.tid, NGT = F.G * 512;
    const float* msc = WSP(float, WS_MLSC);
    for (int id = gt; id < 131072; id += NGT) { const int i = id & 65535; const int h = i >> 14, de = i & 16383, d = de >> 7;
        if (id < 65536) { const float* U = WSP(float, WS_HGU); float* S = WSP(float, WS_HGS); const float* dec = WSP(float, WS_HGDEC); float st = 0.f;
            for (int c = 0; c < NCH; ++c) { const size_t o = (size_t)(c * 4 + h) * 16384 + de; S[o] = st; st = dec[(c * 4 + h) * 128 + d] * st + U[o]; } }
        else { const float* U = WSP(float, WS_MLU); float* S = WSP(float, WS_MLS); float st = 0.f, m = 0.f;
            for (int c = 0; c < NCH; ++c) { const size_t o = (size_t)(c * 4 + h) * 16384 + de; S[o] = st; const float mloc = msc[c * 4 + h], bend = msc[NCH * 4 + c * 4 + h]; const float mn = fmaxf(bend + m, mloc);
                st = EXPF(bend + m - mn) * st + EXPF(mloc - mn) * U[o]; m = mn; } } }
    for (int i = gt; i < 512; i += NGT) { const int h = i >> 7, d = i & 127; const float* nl = WSP(float, WS_MLNL); float* ns = WSP(float, WS_MLN); float st = 0.f, m = 0.f;
        for (int c = 0; c < NCH; ++c) { const int o = (c * 4 + h) * 128 + d; ns[o] = st; const float mloc = msc[c * 4 + h], bend = msc[NCH * 4 + c * 4 + h]; const float mn = fmaxf(bend + m, mloc);
            st = EXPF(bend + m - mn) * st + EXPF(mloc - mn) * nl[o]; m = mn; } }
    for (int i = gt; i < 4; i += NGT) { float* mp = WSP(float, WS_MLSC) + 2 * NCH * 4; float m = 0.f;
        for (int c = 0; c < NCH; ++c) { mp[c * 4 + i] = m; m = fmaxf(msc[NCH * 4 + c * 4 + i] + m, msc[c * 4 + i]); } }
}
#if ORACLE_ATTN
__device__ __forceinline__ void nsa_scores(const float* kbase, int kstride, int kfirst, int nk, LAS float* QV, LAS float* SCW, int off, int lane) {
    const int sub = lane & 3, slot = lane >> 2;
    for (int p = 0; p < nk; p += 16) { const int i = p + slot; const bool ok = i < nk; const float* row = kbase + (size_t)(kfirst + (ok ? i : 0)) * kstride + 4 * sub;
        float a0 = 0.f, a1 = 0.f, a2 = 0.f, a3 = 0.f;
#pragma unroll 2
        for (int j = 0; j < 8; ++j) { const f32x4 kv = *(const f32x4*)(row + 16 * j); const LAS float* q = QV + 16 * j + 4 * sub;
            const f32x4 q0 = *(const LAS f32x4*)q, q1 = *(const LAS f32x4*)(q + 128), q2 = *(const LAS f32x4*)(q + 256), q3 = *(const LAS f32x4*)(q + 384);
            a0 += kv[0] * q0[0] + kv[1] * q0[1] + kv[2] * q0[2] + kv[3] * q0[3]; a1 += kv[0] * q1[0] + kv[1] * q1[1] + kv[2] * q1[2] + kv[3] * q1[3];
            a2 += kv[0] * q2[0] + kv[1] * q2[1] + kv[2] * q2[2] + kv[3] * q2[3]; a3 += kv[0] * q3[0] + kv[1] * q3[1] + kv[2] * q3[2] + kv[3] * q3[3]; }
        a0 += sxor<1>(a0); a1 += sxor<1>(a1); a2 += sxor<1>(a2); a3 += sxor<1>(a3);
        a0 += sxor<2>(a0); a1 += sxor<2>(a1); a2 += sxor<2>(a2); a3 += sxor<2>(a3);
        if (ok && sub == 0) *(LAS f32x4*)(SCW + (size_t)(off + i) * 4) = (f32x4){a0, a1, a2, a3}; }
}
__device__ __forceinline__ f32x4 nsa_softmax(LAS float* SCW, int n, int lane) {
    f32x4 mx = {-3.0e38f, -3.0e38f, -3.0e38f, -3.0e38f};
    for (int i = lane; i < n; i += 64) { const f32x4 s = *(const LAS f32x4*)(SCW + i * 4); mx[0] = fmaxf(mx[0], s[0]); mx[1] = fmaxf(mx[1], s[1]); mx[2] = fmaxf(mx[2], s[2]); mx[3] = fmaxf(mx[3], s[3]); }
#pragma unroll
    for (int h = 0; h < 4; ++h) mx[h] = wave_max(mx[h]);
    f32x4 sm = {0.f, 0.f, 0.f, 0.f};
    for (int i = lane; i < n; i += 64) { f32x4 s = *(const LAS f32x4*)(SCW + i * 4);
#pragma unroll
        for (int h = 0; h < 4; ++h) { s[h] = EXPF(s[h] - mx[h]); sm[h] += s[h]; }
        *(LAS f32x4*)(SCW + i * 4) = s; }
#pragma unroll
    for (int h = 0; h < 4; ++h) { sm[h] = wave_sum(sm[h]); sm[h] = (n > 0) ? 1.0f / sm[h] : 0.f; }
    LDS_WAIT();
    return sm;
}
__device__ __forceinline__ void nsa_pv(const float* vbase, int vstride, int vfirst, int nk, const LAS float* SCW, int off, f32x2 (&acc)[4], int lane) {
    const float* vp = vbase + (size_t)vfirst * vstride + 2 * lane;
    for (int i = 0; i < nk; ++i) { const f32x4 p = *(const LAS f32x4*)(SCW + (size_t)(off + i) * 4); const f32x2 v = *(const f32x2*)(vp + (size_t)i * vstride);
#pragma unroll
        for (int h = 0; h < 4; ++h) { acc[h][0] += p[h] * v[0]; acc[h][1] += p[h] * v[1]; } }
}
__device__ __forceinline__ void ph_nsa(Frame& F, int L) {
    const int lane = F.lane; LAS float* SCW = (LAS float*)(F.lds + F.wave * WAVE_SCR);
    LAS float* QV = SCW + 4096; LAS float* IMP = QV + 512; LAS int* SEL = (LAS int*)(IMP + 128);
    const float* z = WSP(float, WS_Z); const float* nsq = WSP(float, WS_NSQ); const float* nks = WSP(float, WS_NKS); const float* nkw = WSP(float, WS_NKW);
    bf16* y = WSP(bf16, WS_A1);
    for (int it = F.bid * 8 + F.wave; it < 2 * T; it += F.G * 8) {
        const int t = it >> 1, g = it & 1, cur = t >> 6;
        { const f32x4* qs = (const f32x4*)(nsq + (size_t)t * 1024 + g * 512); *(LAS f32x4*)(QV + 4 * lane) = qs[lane]; *(LAS f32x4*)(QV + 256 + 4 * lane) = qs[64 + lane]; }
        LDS_WAIT();
        f32x4 gate[3];
#pragma unroll
        for (int h = 0; h < 4; ++h)
#pragma unroll
            for (int b = 0; b < 3; ++b) gate[b][h] = sigm(z[(size_t)t * NIN + ZC_GATE + (g * 4 + h) * 3 + b]);
        f32x2 tot[4], acc[4];
#pragma unroll
        for (int h = 0; h < 4; ++h) tot[h] = (f32x2){0.f, 0.f};
        const int ncv = (t >= 31) ? ((t - 31) >> 4) + 1 : 0;
        const float* kcn = WSP(float, WS_KCN) + (size_t)g * 512 * 128; const float* vcn = WSP(float, WS_VCN) + (size_t)g * 512 * 128;
        nsa_scores(kcn, 128, 0, ncv, QV, SCW, 0, lane); LDS_WAIT();
        f32x4 inv = nsa_softmax(SCW, ncv, lane);
#pragma unroll
        for (int h = 0; h < 4; ++h) acc[h] = (f32x2){0.f, 0.f};
        nsa_pv(vcn, 128, 0, ncv, SCW, 0, acc, lane);
#pragma unroll
        for (int h = 0; h < 4; ++h) { tot[h][0] += acc[h][0] * inv[h] * gate[0][h]; tot[h][1] += acc[h][1] * inv[h] * gate[0][h]; }
        float v0, v1;
        { float im[2];
#pragma unroll
          for (int k = 0; k < 2; ++k) { const int s = lane + 64 * k; float a = 0.f;
              for (int c = 4 * s - 1; c <= 4 * s + 3; ++c) if (c >= 0 && c < ncv) { const f32x4 p = *(const LAS f32x4*)(SCW + c * 4); a += ((p[0] * inv[0] + p[1] * inv[1]) + p[2] * inv[2]) + p[3] * inv[3]; }
              im[k] = a; }
          v0 = im[0]; v1 = im[1]; }
        int nsel;
        if (cur < 16) { nsel = cur + 1; if (lane < 16) SEL[lane] = lane; }
        else { nsel = 16;
            { const int s0 = lane, s1 = lane + 64;
              v0 = (s0 > cur) ? -3.0e38f : ((s0 == 0 || s0 == cur || s0 == cur - 1) ? 3.0e38f : v0);
              v1 = (s1 > cur) ? -3.0e38f : ((s1 == cur || s1 == cur - 1) ? 3.0e38f : v1); }
            for (int k = 0; k < 16; ++k) { float bv; int bi; if (v0 >= v1) { bv = v0; bi = lane; } else { bv = v1; bi = lane + 64; }
                wave_argmax(bv, bi);
                if (bi == lane) v0 = -3.0e38f; if (bi == lane + 64) v1 = -3.0e38f;
                if (lane == 0) SEL[k] = bi; } }
        LDS_WAIT();
        int n = 0;
        for (int k = 0; k < nsel; ++k) { const int b = SEL[k]; const int nk = (b == cur) ? (t - 64 * cur + 1) : 64; nsa_scores(nks + g * 128, 256, 64 * b, nk, QV, SCW, n, lane); n += nk; }
        LDS_WAIT();
        inv = nsa_softmax(SCW, n, lane);
#pragma unroll
        for (int h = 0; h < 4; ++h) acc[h] = (f32x2){0.f, 0.f};
        n = 0;
        for (int k = 0; k < nsel; ++k) { const int b = SEL[k]; const int nk = (b == cur) ? (t - 64 * cur + 1) : 64; nsa_pv(z + ZC_NVS + g * 128, NIN, 64 * b, nk, SCW, n, acc, lane); n += nk; }
#pragma unroll
        for (int h = 0; h < 4; ++h) { tot[h][0] += acc[h][0] * inv[h] * gate[1][h]; tot[h][1] += acc[h][1] * inv[h] * gate[1][h]; }
        const int lo = (t >= 511) ? t - 511 : 0; n = t - lo + 1;
        nsa_scores(nkw + g * 128, 256, lo, n, QV, SCW, 0, lane); LDS_WAIT();
        inv = nsa_softmax(SCW, n, lane);
#pragma unroll
        for (int h = 0; h < 4; ++h) acc[h] = (f32x2){0.f, 0.f};
        nsa_pv(z + ZC_NVW + g * 128, NIN, lo, n, SCW, 0, acc, lane);
        bf16* yr = y + (size_t)t * (KS * D);
#pragma unroll
        for (int h = 0; h < 4; ++h) { const float o0 = tot[h][0] + acc[h][0] * inv[h] * gate[2][h], o1 = tot[h][1] + acc[h][1] * inv[h] * gate[2][h];
            storeA2(yr, D, 512 + (g * 4 + h) * 128 + 2 * lane, o0, o1); }
    }
}

__device__ __forceinline__ void ph_xattn(Frame& F, int L) {
    const int lane = F.lane; LAS float* QV = (LAS float*)(F.lds + F.wave * WAVE_SCR); LAS float* SC = QV + 512;
    const float* xq = WSP(float, WS_XQ); const float* kxn = WSP(float, WS_KXN); const float* kvx = WSP(float, WS_KVX); const float* qg = INP(20) + L * 512;
    bf16* y = WSP(bf16, WS_A1); const int sub = lane & 3, slot = lane >> 2;
    for (int it = F.bid * 8 + F.wave; it < 4 * T; it += F.G * 8) {
        const int t = it >> 2, h = it & 3;
        { const float* src = xq + (size_t)t * D + h * 512; const f32x4 a = *(const f32x4*)(src + 4 * lane), b = *(const f32x4*)(src + 256 + 4 * lane);
          float ss = (a[0] * a[0] + a[1] * a[1]) + (a[2] * a[2] + a[3] * a[3]) + (b[0] * b[0] + b[1] * b[1]) + (b[2] * b[2] + b[3] * b[3]); ss = wave_sum(ss);
          const float rs = (1.0f / sqrtf(ss * (1.0f / 512.0f) + EPS)) * 0.04419417382415922f;
          const f32x4 g0 = *(const f32x4*)(qg + 4 * lane), g1 = *(const f32x4*)(qg + 256 + 4 * lane);
          *(LAS f32x4*)(QV + 4 * lane) = a * rs * g0; *(LAS f32x4*)(QV + 256 + 4 * lane) = b * rs * g1; }
        LDS_WAIT();
        const float* kb = kxn + (size_t)h * MEM * 512;
        for (int p = 0; p < MEM; p += 16) { const int i = p + slot; const float* row = kb + (size_t)i * 512 + 4 * sub; float a = 0.f;
#pragma unroll 8
            for (int j = 0; j < 32; ++j) { const f32x4 kv = *(const f32x4*)(row + 16 * j); const f32x4 q = *(const LAS f32x4*)(QV + 16 * j + 4 * sub); a += (kv[0] * q[0] + kv[1] * q[1]) + (kv[2] * q[2] + kv[3] * q[3]); }
            a += sxor<1>(a); a += sxor<2>(a);
            if (sub == 0) SC[i] = a; }
        LDS_WAIT();
        float s4[4], mx = -3.0e38f;
#pragma unroll
        for (int k = 0; k < 4; ++k) { s4[k] = SC[lane + 64 * k]; mx = fmaxf(mx, s4[k]); }
        mx = wave_max(mx); float sm = 0.f;
#pragma unroll
        for (int k = 0; k < 4; ++k) { s4[k] = EXPF(s4[k] - mx); sm += s4[k]; }
        sm = wave_sum(sm); const float inv = 1.0f / sm;
#pragma unroll
        for (int k = 0; k < 4; ++k) SC[lane + 64 * k] = s4[k] * inv;
        LDS_WAIT();
        f32x4 o0 = {0.f, 0.f, 0.f, 0.f}, o1 = {0.f, 0.f, 0.f, 0.f};
        const float* vb = kvx + D + h * 512 + 4 * lane;
        for (int m = 0; m < MEM; ++m) { const float p = SC[m]; const f32x4 a = *(const f32x4*)(vb + (size_t)m * (2 * D)), b = *(const f32x4*)(vb + (size_t)m * (2 * D) + 256); o0 += a * p; o1 += b * p; }
        bf16* yr = y + (size_t)t * (KS * D);
        storeA4(yr, D, h * 512 + 4 * lane, o0); storeA4(yr, D, h * 512 + 256 + 4 * lane, o1);
        LDS_WAIT();
    }
}
#endif
typedef short bf16x8 __attribute__((ext_vector_type(8)));
typedef float f32x16 __attribute__((ext_vector_type(16)));
typedef __bf16 bf16x2_t __attribute__((ext_vector_type(2)));
#define MFMA32(a, b, c) __builtin_amdgcn_mfma_f32_32x32x16_bf16((a), (b), (c), 0, 0, 0)
__device__ __forceinline__ unsigned cvtpk(float lo, float hi) { const f32x2 v = {lo, hi}; const bf16x2_t b = __builtin_convertvector(v, bf16x2_t); return __builtin_bit_cast(unsigned, b); }
__device__ __forceinline__ bf16x8 pack8(const f32x16& x, int s) { v4u w; w.x = cvtpk(x[8 * s], x[8 * s + 1]); w.y = cvtpk(x[8 * s + 2], x[8 * s + 3]); w.z = cvtpk(x[8 * s + 4], x[8 * s + 5]); w.w = cvtpk(x[8 * s + 6], x[8 * s + 7]); return __builtin_bit_cast(bf16x8, w); }
__device__ __forceinline__ int swap23(int r) { return (r & ~12) | ((r & 4) << 1) | ((r & 8) >> 1); }
__device__ __forceinline__ size_t kf_index(int g, int t, int d) { return ((size_t)(g * 256 + (t >> 5)) * 4096) + (d >> 4) * 512 + (swap23(t & 31) + 32 * ((d >> 3) & 1)) * 8 + (d & 7); }
__device__ __forceinline__ size_t vf_chunk(int g, int t0, int d) { return ((size_t)(g * 256 + (t0 >> 5)) * 4096) + ((d >> 5) * 2 + ((t0 & 31) >> 4)) * 512 + ((d & 31) + 32 * ((t0 >> 3) & 1)) * 8; }
__device__ __forceinline__ f32x16 zero16() { f32x16 z; for (int i = 0; i < 16; ++i) z[i] = 0.f; return z; }
__device__ __forceinline__ float gain_absmax128(const float* g, int lane) { return wave_max(fmaxf(fabsf(g[lane]), fabsf(g[lane + 64]))); }
constexpr float LOG2E = 1.4426950408889634f;

__device__ __forceinline__ f32x16 st_tile128(const bf16* ktile, const bf16x8 (&qf)[8], int lane) {
    f32x16 s = zero16(); const bf16x8* kp = (const bf16x8*)ktile + lane;
#pragma unroll
    for (int sp = 0; sp < 8; ++sp) s = MFMA32(kp[sp * 64], qf[sp], s);
    return s;
}
__device__ __forceinline__ void pv_tile128(const bf16* vtile, const bf16x8 (&pb)[2], f32x16 (&o)[4], int lane) {
    const bf16x8* vp = (const bf16x8*)vtile + lane;
#pragma unroll
    for (int dt = 0; dt < 4; ++dt)
#pragma unroll
        for (int s = 0; s < 2; ++s) o[dt] = MFMA32(vp[(dt * 2 + s) * 64], pb[s], o[dt]);
}
__device__ __forceinline__ void load_qf128(const bf16* qrow, int h, bf16x8 (&qf)[8]) {
#pragma unroll
    for (int sp = 0; sp < 8; ++sp) qf[sp] = *(const bf16x8*)(qrow + 16 * sp + 8 * h);
}

__device__ __forceinline__ void nsa_wave_item(Frame& F, int L, int tg, int g, LAS float* IMPW) {
    const int lane = F.lane, r = lane & 31, h = lane >> 5, slot = r >> 2, jh = r & 3;
    const int tq = 8 * tg + slot, head = 4 * g + jh, cur = tg >> 3;
    const float gq = gain_absmax128(INP(7) + L * 128, lane); const float* kgn = INP(8) + L * 384;
    const float bc = 11.313708498984761f * LOG2E * 1.02f;
    const float bound_c = bc * gq * gain_absmax128(kgn, lane), bound_s = bc * gq * gain_absmax128(kgn + 128, lane), bound_w = bc * gq * gain_absmax128(kgn + 256, lane);
    bf16x8 qf[8]; load_qf128(WSP(bf16, WS_QN) + (size_t)tq * 1024 + head * 128, h, qf);
    const float* zg = WSP(float, WS_Z) + (size_t)tq * NIN + ZC_GATE + head * 3;
    const float g0 = sigm(zg[0]), g1 = sigm(zg[1]), g2 = sigm(zg[2]);
    f32x16 o[4];
    float* ocr = WSP(float, WS_OC) + (size_t)tq * 1024 + head * 128;
    for (int i = lane; i < 2 * 8 * 129; i += 64) IMPW[i] = 0.f;
    LDS_WAIT();
    { const bf16* kc = WSP(bf16, WS_KCF) + (size_t)g * 16 * 4096; const bf16* vc = WSP(bf16, WS_VCF) + (size_t)g * 16 * 4096;
      const int cmaxq = (tq >= 31) ? ((tq - 31) >> 4) : -1;
      const int tmax = 8 * tg + 7; const int ntile = (tmax >= 31) ? (((tmax - 31) >> 4) >> 5) + 1 : 0;
      float lsum = 0.f;
      for (int kt = 0; kt < ntile; ++kt) { const f32x16 s = st_tile128(kc + (size_t)kt * 4096, qf, lane);
#pragma unroll
          for (int R = 0; R < 16; ++R) { const int c = 32 * kt + 16 * (R >> 3) + 8 * h + (R & 7); lsum += (c <= cmaxq) ? __builtin_amdgcn_exp2f(s[R] - bound_c) : 0.f; } }
      lsum = half_sum(lsum);
      const float inv = (lsum > 0.f) ? 1.0f / lsum : 0.f;
      o[0] = zero16(); o[1] = zero16(); o[2] = zero16(); o[3] = zero16();
      LAS float* imrow = IMPW + (h * 8 + slot) * 129;
      for (int kt = 0; kt < ntile; ++kt) { f32x16 s = st_tile128(kc + (size_t)kt * 4096, qf, lane);
#pragma unroll
          for (int R = 0; R < 16; ++R) { const int c = 32 * kt + 16 * (R >> 3) + 8 * h + (R & 7); s[R] = (c <= cmaxq) ? __builtin_amdgcn_exp2f(s[R] - bound_c) * inv : 0.f; }
#pragma unroll
          for (int s2 = 0; s2 < 2; ++s2) { const int sb = 8 * kt + 4 * s2 + 2 * h;
              float a = (s[8 * s2] + s[8 * s2 + 1]) + (s[8 * s2 + 2] + s[8 * s2 + 3]), b = ((s[8 * s2 + 4] + s[8 * s2 + 5]) + (s[8 * s2 + 6] + s[8 * s2 + 7])) + s[8 * s2 + 3], c7 = s[8 * s2 + 7];
              a += sxor<1>(a); b += sxor<1>(b); c7 += sxor<1>(c7); a += sxor<2>(a); b += sxor<2>(b); c7 += sxor<2>(c7);
              if (jh == 0) { imrow[sb] = a; imrow[sb + 1] = b; imrow[sb + 2] = c7; } }
          bf16x8 pb[2]; pb[0] = pack8(s, 0); pb[1] = pack8(s, 1);
          pv_tile128(vc + (size_t)kt * 4096, pb, o, lane); }
#pragma unroll
      for (int dt = 0; dt < 4; ++dt)
#pragma unroll
          for (int rg = 0; rg < 4; ++rg) { f32x4 v = {o[dt][4 * rg], o[dt][4 * rg + 1], o[dt][4 * rg + 2], o[dt][4 * rg + 3]}; *(f32x4*)(ocr + 32 * dt + 8 * rg + 4 * h) = v * g0; } }
    LDS_WAIT();
    unsigned my[4] = {0u, 0u, 0u, 0u}, un[4] = {0u, 0u, 0u, 0u};
    if (cur < 16) { my[0] = un[0] = (cur == 31) ? 0xffffffffu : ((1u << (cur + 1)) - 1u); }
    else {
        for (int ts = 0; ts < 8; ++ts) { const int s0 = lane, s1 = lane + 64;
            float v0 = IMPW[ts * 129 + s0] + IMPW[(8 + ts) * 129 + s0], v1 = IMPW[ts * 129 + s1] + IMPW[(8 + ts) * 129 + s1];
            v0 = (s0 > cur) ? -3.0e38f : ((s0 == 0 || s0 == cur || s0 == cur - 1) ? 3.0e38f : v0);
            v1 = (s1 > cur) ? -3.0e38f : ((s1 == cur || s1 == cur - 1) ? 3.0e38f : v1);
            for (int k = 0; k < 16; ++k) { float bv; int bi; if (v0 >= v1) { bv = v0; bi = lane; } else { bv = v1; bi = lane + 64; }
                wave_argmax(bv, bi);
                if (bi == lane) v0 = -3.0e38f; if (bi == lane + 64) v1 = -3.0e38f;
                bi = __builtin_amdgcn_readfirstlane(bi);
                const unsigned bit = 1u << (bi & 31); const int wi = bi >> 5; const bool mine = (slot == ts);
#pragma unroll
                for (int q4 = 0; q4 < 4; ++q4) { if (wi == q4) { un[q4] |= bit; if (mine) my[q4] |= bit; } } } } }
    { const bf16* ksf = WSP(bf16, WS_KSF) + (size_t)g * 256 * 4096; const bf16* vsf = WSP(bf16, WS_VSF) + (size_t)g * 256 * 4096;
      o[0] = zero16(); o[1] = zero16(); o[2] = zero16(); o[3] = zero16(); float lsum = 0.f;
#pragma unroll
      for (int q4 = 0; q4 < 4; ++q4) { unsigned um = __builtin_amdgcn_readfirstlane(un[q4]);
          while (um) { const int jb = __builtin_ctz(um); um &= um - 1; const int j = 32 * q4 + jb; const bool sel = (my[q4] >> jb) & 1u;
#pragma unroll 1
              for (int half = 0; half < 2; ++half) { const int kt = 2 * j + half; f32x16 s = st_tile128(ksf + (size_t)kt * 4096, qf, lane);
#pragma unroll
                  for (int R = 0; R < 16; ++R) { const int key = 32 * kt + 16 * (R >> 3) + 8 * h + (R & 7); const float p = (sel && key <= tq) ? __builtin_amdgcn_exp2f(s[R] - bound_s) : 0.f; s[R] = p; lsum += p; }
                  bf16x8 pb[2]; pb[0] = pack8(s, 0); pb[1] = pack8(s, 1);
                  pv_tile128(vsf + (size_t)kt * 4096, pb, o, lane); } } }
      lsum = half_sum(lsum); const float cs = (lsum > 0.f) ? g1 / lsum : 0.f;
#pragma unroll
      for (int dt = 0; dt < 4; ++dt)
#pragma unroll
          for (int rg = 0; rg < 4; ++rg) { f32x4 v = {o[dt][4 * rg], o[dt][4 * rg + 1], o[dt][4 * rg + 2], o[dt][4 * rg + 3]}; f32x4* p = (f32x4*)(ocr + 32 * dt + 8 * rg + 4 * h); *p = *p + v * cs; } }
    { const bf16* kwf = WSP(bf16, WS_KWF) + (size_t)g * 256 * 4096; const bf16* vwf = WSP(bf16, WS_VWF) + (size_t)g * 256 * 4096;
      o[0] = zero16(); o[1] = zero16(); o[2] = zero16(); o[3] = zero16(); float lsum = 0.f;
      const int tmin = 8 * tg, tmax = 8 * tg + 7; const int kt0 = (tmin >= 511) ? ((tmin - 511) >> 5) : 0, ktl = tmax >> 5;
      for (int kt = kt0; kt <= ktl; ++kt) { f32x16 s = st_tile128(kwf + (size_t)kt * 4096, qf, lane);
#pragma unroll
          for (int R = 0; R < 16; ++R) { const int key = 32 * kt + 16 * (R >> 3) + 8 * h + (R & 7); const float p = (key <= tq && tq - key < 512) ? __builtin_amdgcn_exp2f(s[R] - bound_w) : 0.f; s[R] = p; lsum += p; }
          bf16x8 pb[2]; pb[0] = pack8(s, 0); pb[1] = pack8(s, 1);
          pv_tile128(vwf + (size_t)kt * 4096, pb, o, lane); }
      lsum = half_sum(lsum); const float cw = g2 / lsum;
      bf16* yr = WSP(bf16, WS_A1) + (size_t)tq * (KS * D);
#pragma unroll
      for (int dt = 0; dt < 4; ++dt)
#pragma unroll
          for (int rg = 0; rg < 4; ++rg) { const f32x4 c4 = *(const f32x4*)(ocr + 32 * dt + 8 * rg + 4 * h); f32x4 v;
#pragma unroll
              for (int e = 0; e < 4; ++e) v[e] = c4[e] + cw * o[dt][4 * rg + e];
              storeA4(yr, D, 512 + head * 128 + 32 * dt + 8 * rg + 4 * h, v); } }
}
__device__ __forceinline__ void ph_nsa_mfma(Frame& F, int L) {
    LAS float* IMPW = (LAS float*)(F.lds + F.wave * WAVE_SCR);
    for (int v = F.bid * 8 + F.wave; v < 2048; v += F.G * 8) { const int b = v >> 3, w = v & 7, s = b * 4 + (w & 3);
        const int tg = (w < 4) ? s : 1023 - s, g = (w < 4) ? 0 : 1;
        nsa_wave_item(F, L, tg, g, IMPW); }
}

constexpr int NS_KB = 0, NS_VB = 16384, NS_IMP = 32768, NS_TL = 131072, NS_UNI = NS_TL + 4 * 640, NS_MYM = NS_UNI + 64, NS_S2K = 0, NS_S2V = 65536, NS_NT = 4;
__device__ __forceinline__ f32x16 st_tile_lds(const LAS unsigned char* kslot, const bf16x8 (&qf)[8], int lane) {
    f32x16 s = zero16(); const LAS bf16x8* kp = (const LAS bf16x8*)kslot + lane;
    const unsigned ka = (unsigned)(size_t)kp;
#pragma unroll
    for (int hf = 0; hf < 2; ++hf) { bf16x8 k0, k1, k2, k3;
        if (hf == 0) asm volatile("ds_read_b128 %0, %4\n\tds_read_b128 %1, %4 offset:1024\n\tds_read_b128 %2, %4 offset:2048\n\tds_read_b128 %3, %4 offset:3072\n\ts_waitcnt lgkmcnt(0)" : "=&v"(k0), "=&v"(k1), "=&v"(k2), "=&v"(k3) : "v"(ka) : "memory");
        else         asm volatile("ds_read_b128 %0, %4 offset:4096\n\tds_read_b128 %1, %4 offset:5120\n\tds_read_b128 %2, %4 offset:6144\n\tds_read_b128 %3, %4 offset:7168\n\ts_waitcnt lgkmcnt(0)" : "=&v"(k0), "=&v"(k1), "=&v"(k2), "=&v"(k3) : "v"(ka) : "memory");
        s = MFMA32(k0, qf[4 * hf], s); s = MFMA32(k1, qf[4 * hf + 1], s); s = MFMA32(k2, qf[4 * hf + 2], s); s = MFMA32(k3, qf[4 * hf + 3], s); }
    return s;
}
__device__ __forceinline__ void pv_tile_lds(const LAS unsigned char* vslot, const bf16x8 (&pb)[2], f32x16 (&o)[4], int lane) {
    const LAS bf16x8* vp = (const LAS bf16x8*)vslot + lane;
#pragma unroll
    for (int dt = 0; dt < 4; dt += 2) { bf16x8 v0, v1, v2, v3; const unsigned va = (unsigned)(size_t)vp;
        if (dt == 0) asm volatile("ds_read_b128 %0, %4\n\tds_read_b128 %1, %4 offset:1024\n\tds_read_b128 %2, %4 offset:2048\n\tds_read_b128 %3, %4 offset:3072\n\ts_waitcnt lgkmcnt(0)" : "=&v"(v0), "=&v"(v1), "=&v"(v2), "=&v"(v3) : "v"(va) : "memory");
        else         asm volatile("ds_read_b128 %0, %4 offset:4096\n\tds_read_b128 %1, %4 offset:5120\n\tds_read_b128 %2, %4 offset:6144\n\tds_read_b128 %3, %4 offset:7168\n\ts_waitcnt lgkmcnt(0)" : "=&v"(v0), "=&v"(v1), "=&v"(v2), "=&v"(v3) : "v"(va) : "memory");
        o[dt] = MFMA32(v0, pb[0], o[dt]); o[dt] = MFMA32(v1, pb[1], o[dt]); o[dt + 1] = MFMA32(v2, pb[0], o[dt + 1]); o[dt + 1] = MFMA32(v3, pb[1], o[dt + 1]); }
}
__device__ __forceinline__ void nsa_block_unit(Frame& F, int L, int qb, int g) {
    const int lane = F.lane, w = F.wave, r = lane & 31, h = lane >> 5, slot = r >> 2, jh = r & 3;
    const int tg = 8 * qb + w, tq = 8 * tg + slot, head = 4 * g + jh, cur = qb;
    LAS unsigned char* lds = F.lds; LAS int* TL = (LAS int*)(lds + NS_TL); LAS unsigned* UNI = (LAS unsigned*)(lds + NS_UNI); LAS float* IMPW = (LAS float*)(lds + NS_IMP) + w * (2 * 8 * 129);
    const float* kgn = INP(8) + L * 384;
    const float bc = 11.313708498984761f * LOG2E * 1.02f * gain_absmax128(INP(7) + L * 128, lane);
#define UNIF(x) __builtin_bit_cast(float, __builtin_amdgcn_readfirstlane(__builtin_bit_cast(int, (x))))
    const float bound_c = UNIF(bc * gain_absmax128(kgn, lane)), bound_s = UNIF(bc * gain_absmax128(kgn + 128, lane)), bound_w = UNIF(bc * gain_absmax128(kgn + 256, lane));
    bf16x8 qf[8]; load_qf128(WSP(bf16, WS_QN) + (size_t)tq * 1024 + head * 128, h, qf);
#define NS_GATE(b) sigm(WSP(float, WS_Z)[(size_t)tq * NIN + ZC_GATE + head * 3 + (b)])
#define NS_OCR (WSP(float, WS_OC) + (size_t)tq * 1024 + head * 128)
    const unsigned char* wsb = F.ws;
#define NS_KT(src, kt) ((const v4u*)(wsb + ((src) == 0 ? WS_KCF + (size_t)g * 16 * 8192 : (src) == 1 ? WS_KSF + (size_t)g * 256 * 8192 : WS_KWF + (size_t)g * 256 * 8192) + (size_t)(kt) * 8192) + F.tid)
#define NS_VT(src, kt) ((const v4u*)(wsb + ((src) == 0 ? WS_VCF + (size_t)g * 16 * 8192 : (src) == 1 ? WS_VSF + (size_t)g * 256 * 8192 : WS_VWF + (size_t)g * 256 * 8192) + (size_t)(kt) * 8192) + F.tid)
#define NS_COPY(src, kt, sl) do { __builtin_amdgcn_global_load_lds((const unsigned*)NS_KT(src, kt), (LAS unsigned*)(lds + NS_KB + (sl) * 8192 + w * 1024), 16, 0, 0); \
                                  __builtin_amdgcn_global_load_lds((const unsigned*)NS_VT(src, kt), (LAS unsigned*)(lds + NS_VB + (sl) * 8192 + w * 1024), 16, 0, 0); } while (0)
#define NS_COPYK(src, kt, sl) __builtin_amdgcn_global_load_lds((const unsigned*)NS_KT(src, kt), (LAS unsigned*)(lds + NS_KB + (sl) * 8192 + w * 1024), 16, 0, 0)
#define NS_LAND() asm volatile("s_waitcnt vmcnt(0)" ::: "memory")
    f32x16 o[4]; o[0] = zero16(); o[1] = zero16(); o[2] = zero16(); o[3] = zero16();
    for (int i = lane; i < 2 * 8 * 129; i += 64) IMPW[i] = 0.f;
    if (F.tid < 4) UNI[F.tid] = 0u;
    const int ntb = (((64 * qb + 63 - 31) >> 4) >> 5) + 1;
    const int cmaxq = (tq >= 31) ? ((tq - 31) >> 4) : -1;
    const int ntw = (8 * tg + 7 >= 31) ? (((8 * tg + 7 - 31) >> 4) >> 5) + 1 : 0;
    float lsum = 0.f, inv = 0.f;
    { const int n = 2 * ntb;
      NS_COPYK(0, 0, 0); NS_LAND();
      __syncthreads();
      LAS float* imrow = IMPW + (h * 8 + slot) * 129;
#pragma unroll 1
      for (int i = 0; i < n; ++i) { const int kt = (i < ntb) ? i : i - ntb; const bool pass2 = i >= ntb;
          if (i + 1 < n) { if (i + 1 < ntb) NS_COPYK(0, i + 1, (i + 1) & 1); else NS_COPY(0, i + 1 - ntb, (i + 1) & 1); }
          if (i == ntb) { lsum = half_sum(lsum); inv = (lsum > 0.f) ? 1.0f / lsum : 0.f; }
          if (kt < ntw) { const LAS unsigned char* ks = lds + NS_KB + (i & 1) * 8192; f32x16 s = st_tile_lds(ks, qf, lane);
              if (!pass2) {
#pragma unroll
                  for (int R = 0; R < 16; ++R) { const int c = 32 * kt + 16 * (R >> 3) + 8 * h + (R & 7); lsum += (c <= cmaxq) ? __builtin_amdgcn_exp2f(s[R] - bound_c) : 0.f; } }
              else {
#pragma unroll
                  for (int R = 0; R < 16; ++R) { const int c = 32 * kt + 16 * (R >> 3) + 8 * h + (R & 7); s[R] = (c <= cmaxq) ? __builtin_amdgcn_exp2f(s[R] - bound_c) * inv : 0.f; }
#pragma unroll
                  for (int s2 = 0; s2 < 2; ++s2) { const int sb = 8 * kt + 4 * s2 + 2 * h;
                      float a = (s[8 * s2] + s[8 * s2 + 1]) + (s[8 * s2 + 2] + s[8 * s2 + 3]), b = ((s[8 * s2 + 4] + s[8 * s2 + 5]) + (s[8 * s2 + 6] + s[8 * s2 + 7])) + s[8 * s2 + 3], c7 = s[8 * s2 + 7];
                      a += sxor<1>(a); b += sxor<1>(b); c7 += sxor<1>(c7); a += sxor<2>(a); b += sxor<2>(b); c7 += sxor<2>(c7);
                      if (jh == 0) { imrow[sb] = a; imrow[sb + 1] = b; imrow[sb + 2] = c7; } }
                  bf16x8 pb[2]; pb[0] = pack8(s, 0); pb[1] = pack8(s, 1);
                  pv_tile_lds(lds + NS_VB + (i & 1) * 8192, pb, o, lane); } }
          NS_LAND();
          __syncthreads(); } }
    { const float g0 = NS_GATE(0); float* ocr = NS_OCR;
#pragma unroll
    for (int dt = 0; dt < 4; ++dt)
#pragma unroll
        for (int rg = 0; rg < 4; ++rg) { f32x4 v = {o[dt][4 * rg], o[dt][4 * rg + 1], o[dt][4 * rg + 2], o[dt][4 * rg + 3]}; *(f32x4*)(ocr + 32 * dt + 8 * rg + 4 * h) = v * g0; } }
    LDS_WAIT();
    unsigned my[4] = {0u, 0u, 0u, 0u}, un[4] = {0u, 0u, 0u, 0u};
    if (cur < 16) { my[0] = un[0] = (1u << (cur + 1)) - 1u; }
    else {
        float v0[8], v1[8];
#pragma unroll
        for (int ts = 0; ts < 8; ++ts) { const int s0 = lane, s1 = lane + 64;
            const float a0 = IMPW[ts * 129 + s0] + IMPW[(8 + ts) * 129 + s0], a1 = IMPW[ts * 129 + s1] + IMPW[(8 + ts) * 129 + s1];
            v0[ts] = (s0 > cur) ? -3.0e38f : ((s0 == 0 || s0 == cur || s0 == cur - 1) ? 3.0e38f : a0);
            v1[ts] = (s1 > cur) ? -3.0e38f : ((s1 == cur || s1 == cur - 1) ? 3.0e38f : a1); }
#pragma unroll 1
        for (int k = 0; k < 16; ++k) { float bv[8]; int bi[8];
#pragma unroll
            for (int ts = 0; ts < 8; ++ts) { if (v0[ts] >= v1[ts]) { bv[ts] = v0[ts]; bi[ts] = lane; } else { bv[ts] = v1[ts]; bi[ts] = lane + 64; } }
#define AMX(M) _Pragma("unroll") for (int ts = 0; ts < 8; ++ts) { const float ov_ = sxor<M>(bv[ts]); const int oi_ = sxori<M>(bi[ts]); if (ov_ > bv[ts] || (ov_ == bv[ts] && oi_ < bi[ts])) { bv[ts] = ov_; bi[ts] = oi_; } }
            AMX(1) AMX(2) AMX(4) AMX(8) AMX(16)
#undef AMX
#pragma unroll
            for (int ts = 0; ts < 8; ++ts) { unsigned va = __builtin_bit_cast(unsigned, bv[ts]), vb = va, ia = (unsigned)bi[ts], ib = ia; swap32(va, vb); swap32(ia, ib);
                const float x0 = __builtin_bit_cast(float, va), x1 = __builtin_bit_cast(float, vb); const int i0 = (int)ia, i1 = (int)ib;
                int win = (x0 > x1 || (x0 == x1 && i0 < i1)) ? i0 : i1;
                if (win == lane) v0[ts] = -3.0e38f; if (win == lane + 64) v1[ts] = -3.0e38f;
                win = __builtin_amdgcn_readfirstlane(win);
                const unsigned bit = 1u << (win & 31); const int wi = win >> 5; const bool mine = (slot == ts);
#pragma unroll
                for (int q4 = 0; q4 < 4; ++q4) { if (wi == q4) { un[q4] |= bit; if (mine) my[q4] |= bit; } } } } }
    LAS unsigned* MYM = (LAS unsigned*)(lds + NS_MYM) + (w * 64 + lane) * 4;
    *(LAS v4u*)MYM = (v4u){my[0], my[1], my[2], my[3]};
    if (lane == 0) {
#pragma unroll
        for (int q4 = 0; q4 < 4; ++q4) (void)__hip_atomic_fetch_or(UNI + q4, un[q4], __ATOMIC_RELAXED, __HIP_MEMORY_SCOPE_WORKGROUP); }
    __syncthreads();
    unsigned u0 = UNI[0], u1 = UNI[1], u2 = UNI[2], u3 = UNI[3];
    const int nsel = 2 * (__builtin_popcount(u0) + __builtin_popcount(u1) + __builtin_popcount(u2) + __builtin_popcount(u3));
    const int ktl = 2 * qb + 1, kt0 = (ktl >= 17) ? ktl - 17 : 0, nwin = ktl - kt0 + 1, ntl = nsel + nwin;
    int jt_ = F.tid; asm volatile("" : "+v"(jt_));
    if (jt_ < 128) { const int j = jt_; const unsigned wsel = (j < 32) ? u0 : (j < 64) ? u1 : (j < 96) ? u2 : u3;
        if ((wsel >> (j & 31)) & 1u) { int pos = __builtin_popcount(wsel & ((1u << (j & 31)) - 1u)); if (j >= 32) pos += __builtin_popcount(u0); if (j >= 64) pos += __builtin_popcount(u1); if (j >= 96) pos += __builtin_popcount(u2);
            TL[2 * pos] = (2 * j) | (1 << 16); TL[2 * pos + 1] = (2 * j + 1) | (1 << 16); } }
    else if (jt_ < 128 + 32) { const int i = jt_ - 128; if (i < nwin) TL[nsel + i] = (kt0 + i) | (2 << 16); }
    __syncthreads();
    o[0] = zero16(); o[1] = zero16(); o[2] = zero16(); o[3] = zero16(); lsum = 0.f;
    {
#define NS_COPY2(src, kt, sl) do { __builtin_amdgcn_global_load_lds((const unsigned*)NS_KT(src, kt), (LAS unsigned*)(lds + NS_S2K + (sl) * 8192 + w * 1024), 16, 0, 0); \
                                   __builtin_amdgcn_global_load_lds((const unsigned*)NS_VT(src, kt), (LAS unsigned*)(lds + NS_S2V + (sl) * 8192 + w * 1024), 16, 0, 0); } while (0)
#pragma unroll 1
      for (int u2 = 0; u2 < NS_NT; ++u2) if (u2 < ntl) { const int e0 = TL[u2]; NS_COPY2(e0 >> 16, e0 & 0xffff, u2); }
      NS_LAND();
      __syncthreads();
      const int wkt0 = (8 * tg >= 511) ? ((8 * tg - 511) >> 5) : 0, wktl = (8 * tg + 7) >> 5;
      const int nst = (ntl + NS_NT - 1) / NS_NT, nss = nsel / NS_NT;
#pragma unroll 1
      for (int st = 0; st < nst; ++st) {
          if (st + 1 < nst) {
#pragma unroll 1
              for (int u2 = 0; u2 < NS_NT; ++u2) { const int ix = NS_NT * (st + 1) + u2; if (ix < ntl) { const int ea = TL[ix]; NS_COPY2(ea >> 16, ea & 0xffff, ((st + 1) & 1) * NS_NT + u2); } } }
#pragma unroll 1
          for (int u2 = 0; u2 < NS_NT; ++u2) { const int i = NS_NT * st + u2; if (i >= ntl) break;
          if (i == nsel) {
              lsum = half_sum(lsum); const float cs = (lsum > 0.f) ? NS_GATE(1) / lsum : 0.f; float* ocr = NS_OCR;
#pragma unroll
              for (int dt = 0; dt < 4; ++dt)
#pragma unroll
                  for (int rg = 0; rg < 4; ++rg) { f32x4 v = {o[dt][4 * rg], o[dt][4 * rg + 1], o[dt][4 * rg + 2], o[dt][4 * rg + 3]}; f32x4* p = (f32x4*)(ocr + 32 * dt + 8 * rg + 4 * h); *p = *p + v * cs; }
              o[0] = zero16(); o[1] = zero16(); o[2] = zero16(); o[3] = zero16(); lsum = 0.f; }
          const int en = TL[i], src = en >> 16, kt = en & 0xffff; const int sl = (st & 1) * NS_NT + u2;
          bool need, full; int lo, hi; float bnd;
          if (src == 1) { const int j = kt >> 1; const unsigned wu = (j < 32) ? un[0] : (j < 64) ? un[1] : (j < 96) ? un[2] : un[3]; const unsigned wm = MYM[j >> 5];
              need = (__builtin_amdgcn_readfirstlane(wu) >> (j & 31)) & 1u; const bool sel = (wm >> (j & 31)) & 1u; lo = 0; hi = tq; bnd = sel ? bound_s : 3.0e38f; full = (j < cur); }
          else { need = (kt >= wkt0 && kt <= wktl); lo = tq - 511; hi = tq; bnd = bound_w; full = (32 * kt + 31 <= 8 * tg) && (32 * kt >= 8 * tg + 7 - 511); }
          if (need) { f32x16 s = st_tile_lds(lds + NS_S2K + sl * 8192, qf, lane);
              if (full) {
#pragma unroll
                  for (int R = 0; R < 16; ++R) { const float p = __builtin_amdgcn_exp2f(s[R] - bnd); s[R] = p; lsum += p; } }
              else {
#pragma unroll
              for (int R = 0; R < 16; ++R) { const int key = 32 * kt + 16 * (R >> 3) + 8 * h + (R & 7); const float p = (key >= lo && key <= hi) ? __builtin_amdgcn_exp2f(s[R] - bnd) : 0.f; s[R] = p; lsum += p; } }
              bf16x8 pb[2]; pb[0] = pack8(s, 0); pb[1] = pack8(s, 1);
              pv_tile_lds(lds + NS_S2V + sl * 8192, pb, o, lane); } }
          NS_LAND();
          __syncthreads(); } }
    { lsum = half_sum(lsum); const float cw = NS_GATE(2) / lsum; const float* ocr = NS_OCR;
      bf16* yr = WSP(bf16, WS_A1) + (size_t)tq * (KS * D);
#pragma unroll
      for (int dt = 0; dt < 4; ++dt)
#pragma unroll
          for (int rg = 0; rg < 4; ++rg) { const f32x4 c4 = *(const f32x4*)(ocr + 32 * dt + 8 * rg + 4 * h); f32x4 v;
#pragma unroll
              for (int e = 0; e < 4; ++e) v[e] = c4[e] + cw * o[dt][4 * rg + e];
              storeA4(yr, D, 512 + head * 128 + 32 * dt + 8 * rg + 4 * h, v); } }
    __syncthreads();
#undef NS_KT
#undef NS_VT
#undef NS_COPY
#undef NS_LAND
#undef NS_COPY2
#undef NS_GATE
#undef NS_OCR
#undef UNIF
}
__device__ __forceinline__ void ph_nsa_block(Frame& F, int L) {
    for (int u = F.bid; u < 256; u += F.G) { const int g = u & 1, qb = u >> 1; nsa_block_unit(F, L, qb, g); }
}

__device__ __forceinline__ f32x16 st_tile_lds_q(const LAS unsigned char* kslot, const LAS unsigned char* qlds, const bf16x8 (&qh)[4], int lane) {
    f32x16 s = zero16(); const unsigned ka = (unsigned)(size_t)((const LAS bf16x8*)kslot + lane), qa = (unsigned)(size_t)((const LAS bf16x8*)qlds + lane);
    { bf16x8 k0, k1, k2, k3, q0, q1, q2, q3;
      asm volatile("ds_read_b128 %0, %8\n\tds_read_b128 %1, %8 offset:1024\n\tds_read_b128 %2, %8 offset:2048\n\tds_read_b128 %3, %8 offset:3072\n\t"
                   "ds_read_b128 %4, %9\n\tds_read_b128 %5, %9 offset:1024\n\tds_read_b128 %6, %9 offset:2048\n\tds_read_b128 %7, %9 offset:3072\n\ts_waitcnt lgkmcnt(0)"
                   : "=&v"(k0), "=&v"(k1), "=&v"(k2), "=&v"(k3), "=&v"(q0), "=&v"(q1), "=&v"(q2), "=&v"(q3) : "v"(ka), "v"(qa) : "memory");
      s = MFMA32(k0, q0, s); s = MFMA32(k1, q1, s); s = MFMA32(k2, q2, s); s = MFMA32(k3, q3, s); }
    { bf16x8 k0, k1, k2, k3;
      asm volatile("ds_read_b128 %0, %4 offset:4096\n\tds_read_b128 %1, %4 offset:5120\n\tds_read_b128 %2, %4 offset:6144\n\tds_read_b128 %3, %4 offset:7168\n\ts_waitcnt lgkmcnt(0)" : "=&v"(k0), "=&v"(k1), "=&v"(k2), "=&v"(k3) : "v"(ka) : "memory");
      s = MFMA32(k0, qh[0], s); s = MFMA32(k1, qh[1], s); s = MFMA32(k2, qh[2], s); s = MFMA32(k3, qh[3], s); }
    return s;
}
constexpr int N3_QL = 119616;
constexpr int N3_KB = 0, N3_VB = 32768, N3_TL = 65536, N3_UNI = N3_TL + 2560, N3_LX = N3_UNI + 64, N3_IMP = N3_LX + 2048, N3_MYM = N3_IMP + 4 * 2 * 8 * 129 * 4;
__device__ __forceinline__ void n3_tile(const LAS unsigned char* ks, const LAS unsigned char* vs, const LAS unsigned char* ql, const bf16x8 (&qf)[4], f32x16 (&o)[4], float& lsum, float bnd, bool full, int lo, int hi, int kt, int h, bool do_pv, int lane) {
    f32x16 s = st_tile_lds_q(ks, ql, qf, lane);
    if (full) {
#pragma unroll
        for (int R = 0; R < 16; ++R) { const float p = __builtin_amdgcn_exp2f(s[R] - bnd); s[R] = p; lsum += p; } }
    else {
#pragma unroll
        for (int R = 0; R < 16; ++R) { const int key = 32 * kt + 16 * (R >> 3) + 8 * h + (R & 7); const float p = (key >= lo && key <= hi) ? __builtin_amdgcn_exp2f(s[R] - bnd) : 0.f; s[R] = p; lsum += p; } }
    if (do_pv) { bf16x8 pb[2]; pb[0] = pack8(s, 0); pb[1] = pack8(s, 1); pv_tile_lds(vs, pb, o, lane); }
}
__device__ __forceinline__ void nsa_unit3(Frame& F, int L, int qbh, int g) {
#define OPQL() ({ int l_ = F.lane; asm volatile("" : "+v"(l_)); l_; })
    const int lane = OPQL(), w = F.wave, r = lane & 31, h = lane >> 5, slot = r >> 2, jh = r & 3, tgw = w & 3, par = w >> 2;
    const int tg = 4 * qbh + tgw, tq = 8 * tg + slot, head = 4 * g + jh, cur = qbh >> 1;
    LAS unsigned char* lds = F.lds; LAS int* TL = (LAS int*)(lds + N3_TL); LAS unsigned* UNI = (LAS unsigned*)(lds + N3_UNI); LAS float* LX = (LAS float*)(lds + N3_LX);
    LAS float* IMPG = (LAS float*)(lds + N3_IMP) + tgw * (2 * 8 * 129);
    const float* kgn = INP(8) + L * 384;
    const float bc = 11.313708498984761f * LOG2E * 1.02f * gain_absmax128(INP(7) + L * 128, lane);
#define UNIF(x) __builtin_bit_cast(float, __builtin_amdgcn_readfirstlane(__builtin_bit_cast(int, (x))))
    const float bound_c = UNIF(bc * gain_absmax128(kgn, lane)), bound_s = UNIF(bc * gain_absmax128(kgn + 128, lane)), bound_w = UNIF(bc * gain_absmax128(kgn + 256, lane));
    bf16x8 qf[4]; LAS unsigned char* ql = lds + N3_QL + w * 4096;
    { const bf16* qrow = WSP(bf16, WS_QN) + (size_t)tq * 1024 + head * 128 + 8 * h;
#pragma unroll
      for (int sp = 0; sp < 4; ++sp) { *((LAS bf16x8*)ql + sp * 64 + lane) = *(const bf16x8*)(qrow + 16 * sp); qf[sp] = *(const bf16x8*)(qrow + 16 * (sp + 4)); } }
#define N3_GATE(b) sigm(*(const float*)(F.ws + WS_Z + (size_t)(32 * qbh) * NIN * 4 + (unsigned)((((tq - 32 * qbh) * NIN) + ZC_GATE + head * 3 + (b)) * 4)))
#define N3_OCR ({ const int l2_ = OPQL(); const int r2_ = l2_ & 31; (float*)(F.ws + WS_OC + (unsigned)((((8 * tg + (r2_ >> 2)) * 1024 + (4 * g + (r2_ & 3)) * 128) + 4 * (l2_ >> 5)) * 4)); })
    const unsigned char* wsb = F.ws;
    const unsigned dmaoff = (unsigned)(w * 1024 + lane * 16);
#define N3_KT(src, kt) ((const unsigned*)((wsb + ((src) == 0 ? WS_KCF + (size_t)g * 16 * 8192 : (src) == 1 ? WS_KSF + (size_t)g * 256 * 8192 : WS_KWF + (size_t)g * 256 * 8192) + (size_t)(kt) * 8192) + dmaoff))
#define N3_VT(src, kt) ((const unsigned*)((wsb + ((src) == 0 ? WS_VCF + (size_t)g * 16 * 8192 : (src) == 1 ? WS_VSF + (size_t)g * 256 * 8192 : WS_VWF + (size_t)g * 256 * 8192) + (size_t)(kt) * 8192) + dmaoff))
#define N3_COPY(src, kt, sl) do { __builtin_amdgcn_global_load_lds(N3_KT(src, kt), (LAS unsigned*)(lds + N3_KB + (sl) * 8192 + w * 1024), 16, 0, 0); \
                                  __builtin_amdgcn_global_load_lds(N3_VT(src, kt), (LAS unsigned*)(lds + N3_VB + (sl) * 8192 + w * 1024), 16, 0, 0); } while (0)
#define N3_LAND() asm volatile("s_waitcnt vmcnt(0)" ::: "memory")
#define N3_FOLD(COEF, FIRST) do { const float cf_ = (COEF); float* ocr_ = N3_OCR; \
        for (int pp_ = 0; pp_ < 2; ++pp_) { if (pp_ == par) { _Pragma("unroll") for (int dt = 0; dt < 4; ++dt) _Pragma("unroll") for (int rg = 0; rg < 4; ++rg) { \
            f32x4 v_ = {o[dt][4 * rg], o[dt][4 * rg + 1], o[dt][4 * rg + 2], o[dt][4 * rg + 3]}; f32x4* p_ = (f32x4*)(ocr_ + 32 * dt + 8 * rg); if ((FIRST) && pp_ == 0) *p_ = v_ * cf_; else *p_ = *p_ + v_ * cf_; } \
            asm volatile("s_waitcnt vmcnt(0)" ::: "memory"); } __syncthreads(); } } while (0)
#define N3_LTOT(dst) do { const int l3_ = OPQL(); lsum = half_sum(lsum); LX[w * 64 + l3_] = lsum; __syncthreads(); dst = LX[tgw * 64 + l3_] + LX[(tgw + 4) * 64 + l3_]; __syncthreads(); } while (0)
    f32x16 o[4]; o[0] = zero16(); o[1] = zero16(); o[2] = zero16(); o[3] = zero16();
    for (int i = OPQL() + 64 * par; i < 2 * 8 * 129; i += 128) IMPG[i] = 0.f;
    if (F.tid < 4) UNI[F.tid] = 0u;
    const int tlast = 32 * qbh + 31; const int ntb = (tlast >= 31) ? (((tlast - 31) >> 4) >> 5) + 1 : 0;
    const int cmaxq = (tq >= 31) ? ((tq - 31) >> 4) : -1;
    const int cmin_w = (8 * tg >= 31) ? ((8 * tg - 31) >> 4) : -1;
    const int ntw = (8 * tg + 7 >= 31) ? (((8 * tg + 7 - 31) >> 4) >> 5) + 1 : 0;
    float lsum = 0.f; float bnd2 = 3.0e38f;
    { const int s1 = (ntb + 1) >> 1, n = 2 * s1;
      if (n > 0) { if (0 < ntb) N3_COPY(0, 0, 0); if (1 < ntb) N3_COPY(0, 1, 1); }
      N3_LAND(); __syncthreads();
      LAS float* imrow = IMPG + (h * 8 + slot) * 129;
#pragma unroll 1
      for (int i = 0; i < n; ++i) { const int ii = (i < s1) ? i : i - s1, kt = 2 * ii + par; const bool pass2 = i >= s1;
          if (i + 1 < n) { const int in = (i + 1 < s1) ? i + 1 : i + 1 - s1; if (2 * in < ntb) N3_COPY(0, 2 * in, ((i + 1) & 1) * 2); if (2 * in + 1 < ntb) N3_COPY(0, 2 * in + 1, ((i + 1) & 1) * 2 + 1); }
          if (i == s1) { float lt; N3_LTOT(lt); bnd2 = (lt > 0.f) ? bound_c + __builtin_amdgcn_logf(lt) : 3.0e38f; lsum = 0.f; }
          if (kt < ntb && kt < ntw) { const LAS unsigned char* ks = lds + N3_KB + ((i & 1) * 2 + par) * 8192; const LAS unsigned char* vs = lds + N3_VB + ((i & 1) * 2 + par) * 8192;
              const bool full = (32 * kt + 31 <= cmin_w);
              if (!pass2) n3_tile(ks, vs, ql, qf, o, lsum, bound_c, full, 0, cmaxq, kt, h, false, lane);
              else { f32x16 s = st_tile_lds_q(ks, ql, qf, lane);
#pragma unroll
                  for (int R = 0; R < 16; ++R) { const int c = 32 * kt + 16 * (R >> 3) + 8 * h + (R & 7); s[R] = (full || c <= cmaxq) ? __builtin_amdgcn_exp2f(s[R] - bnd2) : 0.f; }
#pragma unroll
                  for (int s2 = 0; s2 < 2; ++s2) { const int sb = 8 * kt + 4 * s2 + 2 * h;
                      float a = (s[8 * s2] + s[8 * s2 + 1]) + (s[8 * s2 + 2] + s[8 * s2 + 3]), b = ((s[8 * s2 + 4] + s[8 * s2 + 5]) + (s[8 * s2 + 6] + s[8 * s2 + 7])) + s[8 * s2 + 3], c7 = s[8 * s2 + 7];
                      a += sxor<1>(a); b += sxor<1>(b); c7 += sxor<1>(c7); a += sxor<2>(a); b += sxor<2>(b); c7 += sxor<2>(c7);
                      if (jh == 0) { imrow[sb] = a; imrow[sb + 1] = b; imrow[sb + 2] = c7; } }
                  bf16x8 pb[2]; pb[0] = pack8(s, 0); pb[1] = pack8(s, 1);
                  pv_tile_lds(vs, pb, o, lane); } }
          N3_LAND(); __syncthreads(); } }
    N3_FOLD(N3_GATE(0), true);
    unsigned my[4] = {0u, 0u, 0u, 0u}, un[4] = {0u, 0u, 0u, 0u};
    if (cur < 16) { my[0] = un[0] = (1u << (cur + 1)) - 1u; }
    else {
        const int lk_ = OPQL();
#pragma unroll 1
        for (int ts = 0; ts < 8; ++ts) { const int s0 = lk_, s1 = lk_ + 64;
            float v0 = IMPG[ts * 129 + s0] + IMPG[(8 + ts) * 129 + s0], v1 = IMPG[ts * 129 + s1] + IMPG[(8 + ts) * 129 + s1];
            v0 = (s0 > cur) ? -3.0e38f : ((s0 == 0 || s0 == cur || s0 == cur - 1) ? 3.0e38f : v0);
            v1 = (s1 > cur) ? -3.0e38f : ((s1 == cur || s1 == cur - 1) ? 3.0e38f : v1);
#pragma unroll 1
            for (int k = 0; k < 16; ++k) { float bv; int bi; if (v0 >= v1) { bv = v0; bi = lk_; } else { bv = v1; bi = lk_ + 64; }
                wave_argmax(bv, bi);
                if (bi == lk_) v0 = -3.0e38f; if (bi == lk_ + 64) v1 = -3.0e38f;
                bi = __builtin_amdgcn_readfirstlane(bi);
                const unsigned bit = 1u << (bi & 31); const int wi = bi >> 5; const bool mine = (slot == ts);
#pragma unroll
                for (int q4 = 0; q4 < 4; ++q4) { if (wi == q4) { un[q4] |= bit; if (mine) my[q4] |= bit; } } } } }
    LAS unsigned* MYM = (LAS unsigned*)(lds + N3_MYM) + (w * 64 + OPQL()) * 4;
    *(LAS v4u*)MYM = (v4u){my[0], my[1], my[2], my[3]};
    if (lane == 0) {
#pragma unroll
        for (int q4 = 0; q4 < 4; ++q4) (void)__hip_atomic_fetch_or(UNI + q4, un[q4], __ATOMIC_RELAXED, __HIP_MEMORY_SCOPE_WORKGROUP); }
    __syncthreads();
    const unsigned u0 = UNI[0], u1 = UNI[1], u2 = UNI[2], u3 = UNI[3];
    const int nsel = 2 * (__builtin_popcount(u0) + __builtin_popcount(u1) + __builtin_popcount(u2) + __builtin_popcount(u3));
    const int ktl = qbh, kt0 = (ktl >= 16) ? ktl - 16 : 0, nwin = ktl - kt0 + 1, ntl = nsel + nwin;
    { int jt_ = F.tid; asm volatile("" : "+v"(jt_));
      if (jt_ < 128) { const int j = jt_; const unsigned wsel = (j < 32) ? u0 : (j < 64) ? u1 : (j < 96) ? u2 : u3;
          if ((wsel >> (j & 31)) & 1u) { int pos = __builtin_popcount(wsel & ((1u << (j & 31)) - 1u)); if (j >= 32) pos += __builtin_popcount(u0); if (j >= 64) pos += __builtin_popcount(u1); if (j >= 96) pos += __builtin_popcount(u2);
              TL[2 * pos] = (2 * j) | (1 << 16); TL[2 * pos + 1] = (2 * j + 1) | (1 << 16); } }
      else if (jt_ < 128 + 32) { const int i = jt_ - 128; if (i < nwin) TL[nsel + i] = (kt0 + i) | (2 << 16); } }
    __syncthreads();
    o[0] = zero16(); o[1] = zero16(); o[2] = zero16(); o[3] = zero16(); lsum = 0.f;
    { const int nst = (ntl + 1) >> 1, nss = nsel >> 1;
      { const int e0 = TL[0]; N3_COPY(e0 >> 16, e0 & 0xffff, 0); if (1 < ntl) { const int e1 = TL[1]; N3_COPY(e1 >> 16, e1 & 0xffff, 1); } }
      N3_LAND(); __syncthreads();
      const int wkt0 = (8 * tg >= 511) ? ((8 * tg - 511) >> 5) : 0, wktl = (8 * tg + 7) >> 5;
#pragma unroll 1
      for (int i = 0; i < nst; ++i) {
          if (i + 1 < nst) { const int ea = TL[2 * i + 2]; N3_COPY(ea >> 16, ea & 0xffff, ((i + 1) & 1) * 2); if (2 * i + 3 < ntl) { const int eb = TL[2 * i + 3]; N3_COPY(eb >> 16, eb & 0xffff, ((i + 1) & 1) * 2 + 1); } }
          if (i == nss) { float lt; N3_LTOT(lt); N3_FOLD((lt > 0.f) ? N3_GATE(1) / lt : 0.f, false); o[0] = zero16(); o[1] = zero16(); o[2] = zero16(); o[3] = zero16(); lsum = 0.f; }
          const int ei = 2 * i + par;
          if (ei < ntl) { const int en = TL[ei], src = en >> 16, kt = en & 0xffff; bool need, full; int lo, hi; float bnd;
              if (src == 1) { const int j = kt >> 1; const unsigned wu = (j < 32) ? un[0] : (j < 64) ? un[1] : (j < 96) ? un[2] : un[3];
                  need = (__builtin_amdgcn_readfirstlane(wu) >> (j & 31)) & 1u; const bool sel = (MYM[j >> 5] >> (j & 31)) & 1u; bnd = sel ? bound_s : 3.0e38f; lo = 0; hi = tq; full = (j < cur); }
              else { need = (kt >= wkt0 && kt <= wktl); lo = tq - 511; hi = tq; bnd = bound_w; full = (32 * kt + 31 <= 8 * tg) && (32 * kt >= 8 * tg + 7 - 511); }
              if (need) n3_tile(lds + N3_KB + ((i & 1) * 2 + par) * 8192, lds + N3_VB + ((i & 1) * 2 + par) * 8192, ql, qf, o, lsum, bnd, full, lo, hi, kt, h, true, lane); }
          N3_LAND(); __syncthreads(); } }
    { float lt; N3_LTOT(lt); const float cw = N3_GATE(2) / lt; float* ocr = N3_OCR;
      if (par == 0) {
#pragma unroll
          for (int dt = 0; dt < 4; ++dt)
#pragma unroll
              for (int rg = 0; rg < 4; ++rg) { f32x4 v = {o[dt][4 * rg], o[dt][4 * rg + 1], o[dt][4 * rg + 2], o[dt][4 * rg + 3]}; f32x4* p = (f32x4*)(ocr + 32 * dt + 8 * rg); *p = *p + v * cw; }
          asm volatile("s_waitcnt vmcnt(0)" ::: "memory"); }
      __syncthreads();
      if (par == 1) { const int l4_ = OPQL(); const int hh_ = l4_ >> 5; bf16* yr = (bf16*)(F.ws + WS_A1 + (size_t)(32 * qbh) * (KS * D) * 2 + (unsigned)(((8 * tgw + ((l4_ & 31) >> 2)) * (KS * D)) * 2));
#pragma unroll
          for (int dt = 0; dt < 4; ++dt)
#pragma unroll
              for (int rg = 0; rg < 4; ++rg) { const f32x4 c4 = *(const f32x4*)(ocr + 32 * dt + 8 * rg); f32x4 v;
#pragma unroll
                  for (int e = 0; e < 4; ++e) v[e] = c4[e] + cw * o[dt][4 * rg + e];
                  storeA4(yr, D, 512 + head * 128 + 32 * dt + 8 * rg + 4 * hh_, v); } } }
    __syncthreads();
#undef OPQL
#undef UNIF
#undef N3_GATE
#undef N3_OCR
#undef N3_KT
#undef N3_VT
#undef N3_COPY
#undef N3_LAND
#undef N3_FOLD
#undef N3_LTOT
}
__device__ __forceinline__ void ph_nsa3(Frame& F, int L) {
    for (int b = F.bid; b < 256; b += F.G) {
#pragma unroll 1
        for (int k = 0; k < 2; ++k) { const int u = k ? 511 - b : b; nsa_unit3(F, L, u >> 1, u & 1); } }
}

__device__ __forceinline__ void ph_xattn_mfma(Frame& F, int L) {
    const int lane = F.lane, q = lane & 31, h = lane >> 5;
    const float* qg = INP(20) + L * 512; const float* kg = INP(21) + L * 512;
    float gm_q = 0.f, gm_k = 0.f;
#pragma unroll
    for (int i = 0; i < 8; ++i) { gm_q = fmaxf(gm_q, fabsf(qg[lane + 64 * i])); gm_k = fmaxf(gm_k, fabsf(kg[lane + 64 * i])); }
    const float bound = 22.627416997969522f * LOG2E * 1.02f * wave_max(gm_q) * wave_max(gm_k);
    const bf16* xqb = WSP(bf16, WS_XQB);
    for (int it = F.bid * 8 + F.wave; it < (T / 32) * 4; it += F.G * 8) {
        const int tg = it >> 2, hd = it & 3, t = 32 * tg + q;
        const bf16x8* qp = (const bf16x8*)(xqb + (size_t)t * D + hd * 512 + 8 * h);
        float ss = 0.f;
#pragma unroll 8
        for (int sp = 0; sp < 32; ++sp) { const v4u wv = __builtin_bit_cast(v4u, qp[2 * sp]);
#pragma unroll
            for (int e = 0; e < 4; ++e) { const float lo = bf2f(wv[e] & 0xffffu), hi = bf2f(wv[e] >> 16); ss += lo * lo + hi * hi; } }
        ss = half_sum(ss);
        const float rs = 1.0f / sqrtf(ss * (1.0f / 512.0f) + EPS);
        const bf16x8* kx = (const bf16x8*)(WSP(bf16, WS_KXF) + (size_t)hd * 8 * 16384) + lane;
        bf16x8 pb[16]; float lsum = 0.f;
#pragma unroll
        for (int kt = 0; kt < 8; ++kt) { f32x16 s = zero16();
#pragma unroll 4
            for (int sp = 0; sp < 32; ++sp) s = MFMA32(kx[(kt * 32 + sp) * 64], qp[2 * sp], s);
#pragma unroll
            for (int R = 0; R < 16; ++R) { const float p = __builtin_amdgcn_exp2f(s[R] * rs - bound); s[R] = p; lsum += p; }
            pb[2 * kt] = pack8(s, 0); pb[2 * kt + 1] = pack8(s, 1); }
        lsum = half_sum(lsum); const float inv = 1.0f / lsum;
        const bf16x8* vx = (const bf16x8*)(WSP(bf16, WS_VXF) + (size_t)hd * 8 * 16384) + lane;
        bf16* yr = WSP(bf16, WS_A1) + (size_t)t * (KS * D);
#pragma unroll 1
        for (int dt = 0; dt < 16; ++dt) { f32x16 o = zero16();
#pragma unroll
            for (int kt = 0; kt < 8; ++kt)
#pragma unroll
                for (int s = 0; s < 2; ++s) o = MFMA32(vx[((kt * 16 + dt) * 2 + s) * 64], pb[2 * kt + s], o);
#pragma unroll
            for (int rg = 0; rg < 4; ++rg) { f32x4 v = {o[4 * rg] * inv, o[4 * rg + 1] * inv, o[4 * rg + 2] * inv, o[4 * rg + 3] * inv}; storeA4(yr, D, hd * 512 + 32 * dt + 8 * rg + 4 * h, v); } }
    }
}
__device__ __forceinline__ bf16x8 ldsfrag(const LAS bf16* p) { return *(const LAS bf16x8*)p; }
__device__ __forceinline__ v4u pack8f(const float (&v)[8]) { v4u o; o.x = cvtpk(v[0], v[1]); o.y = cvtpk(v[2], v[3]); o.z = cvtpk(v[4], v[5]); o.w = cvtpk(v[6], v[7]); return o; }
constexpr int PQ = 136, PV = 72;
__device__ __forceinline__ size_t st_chunk(int c, int h, int e, int doct) { return ((((size_t)(c * 4 + h) * 4 + (e >> 5)) * 8 + (doct >> 1)) * 512) + ((e & 31) + 32 * (doct & 1)) * 8; }

__device__ __forceinline__ void summary_mma(Frame& F, const LAS bf16* AT, const LAS bf16* VT, float* U) {
    const int lane = F.lane, r = lane & 31, h = lane >> 5;
#pragma unroll
    for (int i = 0; i < 2; ++i) { const int tile = F.wave * 2 + i, dt = tile >> 2, et = tile & 3; f32x16 c = zero16();
#pragma unroll
        for (int ks = 0; ks < 4; ++ks) c = MFMA32(ldsfrag(AT + (32 * dt + r) * PV + 16 * ks + 8 * h), ldsfrag(VT + (32 * et + r) * PV + 16 * ks + 8 * h), c);
#pragma unroll
        for (int R = 0; R < 16; ++R) U[(size_t)(32 * dt + (R & 3) + 8 * (R >> 2) + 4 * h) * 128 + 32 * et + r] = c[R]; }
}
__device__ __forceinline__ void fill_vt(Frame& F, const float* vsrc  , LAS bf16* VT) {
    for (int i = F.tid; i < 1024; i += 512) { const int e = i & 127, s0 = (i >> 7) * 8; float v[8];
#pragma unroll
        for (int j = 0; j < 8; ++j) v[j] = vsrc[(size_t)(s0 + j) * NIN + e];
        *(LAS v4u*)(VT + e * PV + s0) = pack8f(v); }
}
__device__ __forceinline__ void hg_summary_mfma(Frame& F, int L, int c, int h) {
    LAS float* B = (LAS float*)F.lds; LAS float* KY = B + 64 * HP; LAS bf16* AT = (LAS bf16*)(KY + 64 * HP); LAS bf16* VT = AT + 128 * PV;
    const float* z = WSP(float, WS_Z);
    hg_gates(F, L, c, h, B, KY);
    for (int i = F.tid; i < 1024; i += 512) { const int d = i & 127, s0 = (i >> 7) * 8; const float be = B[63 * HP + d]; float v[8];
#pragma unroll
        for (int j = 0; j < 8; ++j) v[j] = KY[(s0 + j) * HP + d] * EXPF(be - B[(s0 + j) * HP + d]);
        *(LAS v4u*)(AT + d * PV + s0) = pack8f(v); }
    fill_vt(F, z + (size_t)(64 * c) * NIN + ZC_HGI + h * 128, VT);
    if (F.tid < 128) WSP(float, WS_HGDEC)[(c * 4 + h) * 128 + F.tid] = EXPF(B[63 * HP + F.tid]);
    __syncthreads();
    summary_mma(F, AT, VT, WSP(float, WS_HGU) + (size_t)(c * 4 + h) * 16384);
    __syncthreads();
}
__device__ __forceinline__ void ml_summary_mfma(Frame& F, int L, int c, int h) {
    LAS float* BL = (LAS float*)F.lds; LAS float* LI = BL + 64; LAS float* WS_ = LI + 64; LAS bf16* AT = (LAS bf16*)(WS_ + 64); LAS bf16* VT = AT + 128 * PV; LAS float* KC = (LAS float*)(VT + 128 * PV);
    const float* z = WSP(float, WS_Z); float* mlq = WSP(float, WS_MLQ); float* mlk = WSP(float, WS_MLK); const float* cw = INP(11) + (size_t)L * 4 * 1024;
    ml_gates(F, c, h, BL, LI);
    if (F.tid < 64) { const float a = BL[63] - BL[F.tid] + LI[F.tid]; const float mloc = wave_max(a); WS_[F.tid] = EXPF(a - mloc); if (F.tid == 0) { float* msc = WSP(float, WS_MLSC); msc[c * 4 + h] = mloc; msc[NCH * 4 + c * 4 + h] = BL[63]; } }
    { const int d = F.tid & 127; const float wq0 = cw[h * 128 + d], wq1 = cw[1024 + h * 128 + d], wq2 = cw[2048 + h * 128 + d], wq3 = cw[3072 + h * 128 + d];
      const float wk0 = cw[512 + h * 128 + d], wk1 = cw[1536 + h * 128 + d], wk2 = cw[2560 + h * 128 + d], wk3 = cw[3584 + h * 128 + d];
#pragma unroll 1
      for (int s = F.tid >> 7; s < 64; s += 4) { const int t = 64 * c + s; const float* zq = z + (size_t)t * NIN + ZC_MLQ + h * 128 + d; const float* zk = z + (size_t)t * NIN + ZC_MLK + h * 128 + d;
          const long b1 = (t >= 1) ? -(long)NIN : 0, b2 = (t >= 2) ? -2L * NIN : 0, b3 = (t >= 3) ? -3L * NIN : 0;
          const float f1 = (t >= 1) ? 1.f : 0.f, f2 = (t >= 2) ? 1.f : 0.f, f3 = (t >= 3) ? 1.f : 0.f;
          const float q0 = zq[0], q1 = zq[b1], q2 = zq[b2], q3 = zq[b3], k0_ = zk[0], k1_ = zk[b1], k2_ = zk[b2], k3_ = zk[b3];
          float aq = wq3 * q0 + f1 * wq2 * q1 + f2 * wq1 * q2 + f3 * wq0 * q3, ak = wk3 * k0_ + f1 * wk2 * k1_ + f2 * wk1 * k2_ + f3 * wk0 * k3_;
          aq = siluf_(aq) * 0.08838834764831845f; ak = siluf_(ak);
          mlq[(size_t)t * 512 + h * 128 + d] = aq; mlk[(size_t)t * 512 + h * 128 + d] = ak; KC[s * HP + d] = ak; } }
    __syncthreads();
    for (int i = F.tid; i < 1024; i += 512) { const int d = i & 127, s0 = (i >> 7) * 8; float v[8];
#pragma unroll
        for (int j = 0; j < 8; ++j) v[j] = KC[(s0 + j) * HP + d] * WS_[s0 + j];
        *(LAS v4u*)(AT + d * PV + s0) = pack8f(v); }
    fill_vt(F, z + (size_t)(64 * c) * NIN + ZC_MLV + h * 128, VT);
    if (F.tid < 128) { float a = 0.f; for (int s = 0; s < 64; ++s) a += KC[s * HP + F.tid] * WS_[s]; WSP(float, WS_MLNL)[(c * 4 + h) * 128 + F.tid] = a; }
    __syncthreads();
    summary_mma(F, AT, VT, WSP(float, WS_MLU) + (size_t)(c * 4 + h) * 16384);
    __syncthreads();
}


__device__ __forceinline__ void ph_scan_v2(Frame& F, int nblk, int nw) {
    const float* msc = WSP(float, WS_MLSC);
    const bool main_ = F.bid < nblk;
    const bool nst_ = (nw < 8) ? (main_ && F.wave == nw) : (F.bid >= nblk && F.bid < nblk + 8 && F.wave == 0); const int nsb_ = (nw < 8) ? F.bid : F.bid - nblk;
    if (main_ && F.wave < nw) for (int id = (F.bid * nw + F.wave) * 64 + F.lane; id < 32768; id += nblk * nw * 64) { const bool ml = id >= 16384; const int i = id & 16383, h = i >> 12, dq = (i >> 7) & 31, e = i & 127;
        const float* U = WSP(float, ml ? WS_MLU : WS_HGU) + (size_t)h * 16384 + (size_t)(4 * dq) * 128 + e; bf16* ST = WSP(bf16, ml ? WS_MLST : WS_HGST);
        const float* dec = WSP(float, WS_HGDEC) + h * 128 + 4 * dq;
        float st[4] = {0.f, 0.f, 0.f, 0.f}; float m = 0.f;
#pragma unroll 1
        for (int c0 = 0; c0 < NCH; c0 += 8) { float u[8][4], dk[8][4];
#pragma unroll
            for (int cc = 0; cc < 8; ++cc)
#pragma unroll
                for (int j = 0; j < 4; ++j) { u[cc][j] = U[(size_t)(c0 + cc) * 65536 + j * 128]; dk[cc][j] = ml ? 0.f : dec[(c0 + cc) * 512 + j]; }
#pragma unroll
            for (int cc = 0; cc < 8; ++cc) { const int c = c0 + cc;
                { v2u pk; pk.x = cvtpk(st[0], st[1]); pk.y = cvtpk(st[2], st[3]); *(v2u*)(ST + st_chunk(c, h, e, dq >> 1) + 4 * (dq & 1)) = pk; }
                if (ml) { const float mloc = msc[c * 4 + h], bend = msc[NCH * 4 + c * 4 + h]; const float mn = fmaxf(bend + m, mloc); const float fa = EXPF(bend + m - mn), fb = EXPF(mloc - mn); m = mn;
#pragma unroll
                    for (int j = 0; j < 4; ++j) st[j] = fa * st[j] + fb * u[cc][j]; }
                else {
#pragma unroll
                    for (int j = 0; j < 4; ++j) st[j] = dk[cc][j] * st[j] + u[cc][j]; } } } }
    const int gt = F.bid * 512 + F.tid, NGT = nblk * 512;
    if (nst_) for (int i = nsb_ * 64 + F.lane; i < 512; i += 512) { const int h = i >> 7, d = i & 127; const float* nl = WSP(float, WS_MLNL); float* ns = WSP(float, WS_MLN); float st = 0.f, m = 0.f;
        for (int c = 0; c < NCH; ++c) { const int o = (c * 4 + h) * 128 + d; ns[o] = st; const float mloc = msc[c * 4 + h], bend = msc[NCH * 4 + c * 4 + h]; const float mn = fmaxf(bend + m, mloc);
            st = EXPF(bend + m - mn) * st + EXPF(mloc - mn) * nl[o]; m = mn; } }
    if (main_) for (int i = gt; i < 4; i += NGT) { float* mp = WSP(float, WS_MLSC) + 2 * NCH * 4; float m = 0.f;
        for (int c = 0; c < NCH; ++c) { mp[c * 4 + i] = m; m = fmaxf(msc[NCH * 4 + c * 4 + i] + m, msc[c * 4 + i]); } }
}

template <bool SILU>
__device__ __forceinline__ void finish_tile(Frame& F, const f32x16& o, LAS float* PART, const float* gain, const float* gate_base  , int ycol, int c) {
    const int lane = F.lane, r = lane & 31, h = lane >> 5, et = F.wave & 3, tt = F.wave >> 2, t = 32 * tt + r;
    float ss = 0.f;
#pragma unroll
    for (int R = 0; R < 16; ++R) ss += o[R] * o[R];
    ss = half_sum(ss);
    if (h == 0) PART[t * 4 + et] = ss;
    __syncthreads();
    const f32x4 p4 = *(const LAS f32x4*)(PART + t * 4); const float rs = 1.0f / sqrtf(((p4[0] + p4[1]) + (p4[2] + p4[3])) * (1.0f / 128.0f) + EPS);
    bf16* yr = WSP(bf16, WS_A1) + (size_t)(64 * c + t) * (KS * D); const float* gr = gate_base + (size_t)t * NIN;
#pragma unroll
    for (int rg = 0; rg < 4; ++rg) { const int e = 32 * et + 8 * rg + 4 * h; const f32x4 gv = *(const f32x4*)(gr + e), gn = *(const f32x4*)(gain + e); f32x4 v;
#pragma unroll
        for (int q = 0; q < 4; ++q) v[q] = o[4 * rg + q] * rs * gn[q] * (SILU ? siluf_(gv[q]) : sigm(gv[q]));
        storeA4(yr, D, ycol + e, v); }
}
__device__ __forceinline__ void hg_output_mfma(Frame& F, int L, int c, int h) {
    LAS float* B = (LAS float*)F.lds; LAS float* KY = B + 64 * HP; LAS bf16* QA = (LAS bf16*)(KY + 64 * HP); LAS bf16* KA = QA + 64 * PQ; LAS bf16* QE = KA + 64 * PQ; LAS bf16* VT = QE + 64 * PQ; LAS float* PART = (LAS float*)(VT + 128 * PV);
    const float* z = WSP(float, WS_Z);
    hg_gates(F, L, c, h, B, KY);
    for (int i = F.tid; i < 1024; i += 512) { const int t = i >> 4, d0 = (i & 15) * 8; const float* qs = z + (size_t)(64 * c + t) * NIN + ZC_HGQ + h * 128 + d0; const f32x4 qa = *(const f32x4*)qs, qb = *(const f32x4*)(qs + 4);
        float vq[8], vk[8], ve[8];
#pragma unroll
        for (int j = 0; j < 8; ++j) { const float b = B[t * HP + d0 + j], br = B[31 * HP + d0 + j], qv = (j < 4) ? qa[j & 3] : qb[j & 3];
            vq[j] = qv * EXPF(fminf(fmaxf(b - br, -80.f), 80.f)); vk[j] = KY[t * HP + d0 + j] * EXPF(fminf(fmaxf(br - b, -80.f), 80.f)); ve[j] = qv * EXPF(b); }
        *(LAS v4u*)(QA + t * PQ + d0) = pack8f(vq); *(LAS v4u*)(KA + t * PQ + d0) = pack8f(vk); *(LAS v4u*)(QE + t * PQ + d0) = pack8f(ve); }
    fill_vt(F, z + (size_t)(64 * c) * NIN + ZC_HGI + h * 128, VT);
    __syncthreads();
    const int lane = F.lane, r = lane & 31, hh = lane >> 5, et = F.wave & 3, tt = F.wave >> 2, t = 32 * tt + r;
    f32x16 o = zero16();
#pragma unroll
    for (int st = 0; st <= 1; ++st) { if (st <= tt) { f32x16 sc = zero16();
#pragma unroll
        for (int kd = 0; kd < 8; ++kd) sc = MFMA32(ldsfrag(KA + (32 * st + swap23(r)) * PQ + 16 * kd + 8 * hh), ldsfrag(QA + t * PQ + 16 * kd + 8 * hh), sc);
#pragma unroll
        for (int R = 0; R < 16; ++R) { const int s = 32 * st + 16 * (R >> 3) + 8 * hh + (R & 7); sc[R] = (s <= t) ? sc[R] : 0.f; }
        bf16x8 pb[2]; pb[0] = pack8(sc, 0); pb[1] = pack8(sc, 1);
#pragma unroll
        for (int ks = 0; ks < 2; ++ks) o = MFMA32(ldsfrag(VT + (32 * et + r) * PV + 32 * st + 16 * ks + 8 * hh), pb[ks], o); } }
    { const bf16x8* sp = (const bf16x8*)(WSP(bf16, WS_HGST) + (((size_t)(c * 4 + h) * 4 + et) * 8) * 512) + lane;
#pragma unroll
      for (int kd = 0; kd < 8; ++kd) o = MFMA32(sp[kd * 64], ldsfrag(QE + t * PQ + 16 * kd + 8 * hh), o); }
    finish_tile<true>(F, o, PART, INP(6) + L * 512 + h * 128, z + (size_t)(64 * c) * NIN + ZC_HGG + h * 128, h * 128, c);
    __syncthreads();
}
__device__ __forceinline__ void ml_output_mfma(Frame& F, int L, int c, int h) {
    LAS float* BL = (LAS float*)F.lds; LAS float* LI = BL + 64; LAS float* MT = LI + 64; LAS float* WI = MT + 64; LAS float* QNN = WI + 64; LAS float* PART = QNN + 64;
    LAS bf16* QA = (LAS bf16*)(PART + 256); LAS bf16* KA = QA + 64 * PQ; LAS bf16* VT = KA + 64 * PQ;
    const float* z = WSP(float, WS_Z); const float* mlq = WSP(float, WS_MLQ); const float* mlk = WSP(float, WS_MLK);
    ml_gates(F, c, h, BL, LI);
    const float mprev = WSP(float, WS_MLSC)[2 * NCH * 4 + c * 4 + h];
    for (int i = F.tid; i < 1024; i += 512) { const int t = i >> 4, d0 = (i & 15) * 8; const float* qs = mlq + (size_t)(64 * c + t) * 512 + h * 128 + d0; const float* ks = mlk + (size_t)(64 * c + t) * 512 + h * 128 + d0;
        const f32x4 qa = *(const f32x4*)qs, qb = *(const f32x4*)(qs + 4), ka = *(const f32x4*)ks, kb = *(const f32x4*)(ks + 4);
        float vq[8] = {qa[0], qa[1], qa[2], qa[3], qb[0], qb[1], qb[2], qb[3]}, vk[8] = {ka[0], ka[1], ka[2], ka[3], kb[0], kb[1], kb[2], kb[3]};
        *(LAS v4u*)(QA + t * PQ + d0) = pack8f(vq); *(LAS v4u*)(KA + t * PQ + d0) = pack8f(vk); }
    fill_vt(F, z + (size_t)(64 * c) * NIN + ZC_MLV + h * 128, VT);
    if (F.tid < 64) { const int t = F.tid; const float inter = BL[t] + mprev; float mt = inter; for (int s = 0; s <= t; ++s) mt = fmaxf(mt, BL[t] - BL[s] + LI[s]); MT[t] = mt; WI[t] = EXPF(inter - mt);
    }
    { const int t = F.tid >> 3, p = F.tid & 7; const float* nst = WSP(float, WS_MLN) + (c * 4 + h) * 128 + 16 * p; const float* qs = mlq + (size_t)(64 * c + t) * 512 + h * 128 + 16 * p; float a = 0.f;
#pragma unroll
      for (int d = 0; d < 16; ++d) a += qs[d] * nst[d];
      a += sxor<1>(a); a += sxor<2>(a); a += sxor<4>(a); if (p == 0) QNN[t] = a; }
    __syncthreads();
    const int lane = F.lane, r = lane & 31, hh = lane >> 5, et = F.wave & 3, tt = F.wave >> 2, t = 32 * tt + r;
    const float mt = MT[t], wi = WI[t], blt = BL[t];
    f32x16 o = zero16(); float rsum = 0.f;
#pragma unroll
    for (int st = 0; st <= 1; ++st) { if (st <= tt) { f32x16 sc = zero16();
#pragma unroll
        for (int kd = 0; kd < 8; ++kd) sc = MFMA32(ldsfrag(KA + (32 * st + swap23(r)) * PQ + 16 * kd + 8 * hh), ldsfrag(QA + t * PQ + 16 * kd + 8 * hh), sc);
#pragma unroll
        for (int R = 0; R < 16; ++R) { const int s = 32 * st + 16 * (R >> 3) + 8 * hh + (R & 7); const float wgt = (s <= t) ? EXPF(blt - BL[s] + LI[s] - mt) : 0.f; sc[R] = sc[R] * wgt; rsum += sc[R]; }
        bf16x8 pb[2]; pb[0] = pack8(sc, 0); pb[1] = pack8(sc, 1);
#pragma unroll
        for (int ks = 0; ks < 2; ++ks) o = MFMA32(ldsfrag(VT + (32 * et + r) * PV + 32 * st + 16 * ks + 8 * hh), pb[ks], o); } }
    rsum = half_sum(rsum);
    f32x16 oi = zero16();
    { const bf16x8* sp = (const bf16x8*)(WSP(bf16, WS_MLST) + (((size_t)(c * 4 + h) * 4 + et) * 8) * 512) + lane;
#pragma unroll
      for (int kd = 0; kd < 8; ++kd) oi = MFMA32(sp[kd * 64], ldsfrag(QA + t * PQ + 16 * kd + 8 * hh), oi); }
    const float qn = wi * QNN[t] + rsum; const float den = 1.0f / fmaxf(fabsf(qn), EXPF(-mt));
#pragma unroll
    for (int R = 0; R < 16; ++R) o[R] = (o[R] + wi * oi[R]) * den;
    finish_tile<false>(F, o, PART, INP(12) + L * 512 + h * 128, z + (size_t)(64 * c) * NIN + ZC_MLO + h * 128, 1536 + h * 128, c);
    __syncthreads();
}

__device__ __forceinline__ void cmp_item_mfma(Frame& F, int L, int item) {
    const int which = item & 1, g = (item >> 1) & 1, rt = item >> 2, c0 = 32 * rt;
    const int lane = F.lane, r = lane & 31, hh = lane >> 5, ct = F.wave & 3, kh = F.wave >> 2;
    LAS float* PARTC = (LAS float*)F.lds;
    LAS float* O = PARTC + 4096;
    const float* z = WSP(float, WS_Z); const int zc = (which ? ZC_NVC : ZC_NKC) + g * 128;
    const float* pe = INP(9) + ((size_t)(L * 2 + which) * 32) * 128;
    const bf16x8* wf = (const bf16x8*)(WSL(bf16, WS_WCF) + ((size_t)(which * 4 + ct) * 256) * 512) + lane;
    f32x16 acc = zero16();
    for (int l = 16 * kh; l < 16 * kh + 16; ++l) { int tok = 16 * (c0 + r) + l; const bool ok = tok < T; if (!ok) tok = T - 1; const float* zr = z + (size_t)tok * NIN + zc + 8 * hh; const float* pr = pe + l * 128 + 8 * hh;
#pragma unroll
        for (int sp = 0; sp < 8; ++sp) { const f32x4 a = *(const f32x4*)(zr + 16 * sp), b = *(const f32x4*)(zr + 16 * sp + 4), pa = *(const f32x4*)(pr + 16 * sp), pb = *(const f32x4*)(pr + 16 * sp + 4);
            float v[8];
#pragma unroll
            for (int j = 0; j < 4; ++j) { v[j] = ok ? a[j] + pa[j] : 0.f; v[4 + j] = ok ? b[j] + pb[j] : 0.f; }
            acc = MFMA32(__builtin_bit_cast(bf16x8, pack8f(v)), wf[(8 * l + sp) * 64], acc); } }
    if (kh == 1) {
#pragma unroll
        for (int R = 0; R < 16; ++R) PARTC[(ct * 16 + R) * 64 + lane] = acc[R]; }
    __syncthreads();
    if (kh == 0) {
#pragma unroll
        for (int R = 0; R < 16; ++R) O[((R & 3) + 8 * (R >> 2) + 4 * hh) * HP + 32 * ct + r] = acc[R] + PARTC[(ct * 16 + R) * 64 + lane]; }
    __syncthreads();
    if (!which) { const float* kg = INP(8) + L * 384;
        for (int rr = 0; rr < 4; ++rr) { const int cl = 4 * F.wave + rr, c = c0 + cl; const float o1 = O[cl * HP + lane], o2 = O[cl * HP + lane + 64];
            const float ss = wave_sum(o1 * o1 + o2 * o2); const float rs = 1.0f / sqrtf(ss * (1.0f / 128.0f) + EPS);
            const float y1 = o1 * rs * kg[lane], y2 = o2 * rs * kg[lane + 64]; const int pos = (c < NCMP) ? 16 * c + 31 : 0; const float cs = WSP(float, WS_COS)[pos * 64 + lane], sn = WSP(float, WS_SIN)[pos * 64 + lane];
            const float r1 = y1 * cs - y2 * sn, r2 = y2 * cs + y1 * sn;
            bf16* kcf = WSP(bf16, WS_KCF) + (size_t)g * 16 * 4096 + (size_t)rt * 4096;
            { const int d = lane; kcf[(d >> 4) * 512 + (swap23(cl) + 32 * ((d >> 3) & 1)) * 8 + (d & 7)] = (bf16)f2bf(r1); }
            { const int d = lane + 64; kcf[(d >> 4) * 512 + (swap23(cl) + 32 * ((d >> 3) & 1)) * 8 + (d & 7)] = (bf16)f2bf(r2); } } }
    else { const int d = F.tid & 127, cg = F.tid >> 7; float v[8];
#pragma unroll
        for (int j = 0; j < 8; ++j) v[j] = O[(8 * cg + j) * HP + d];
        *(v4u*)(WSP(bf16, WS_VCF) + (size_t)g * 16 * 4096 + (size_t)rt * 4096 + ((d >> 5) * 2 + (cg >> 1)) * 512 + ((d & 31) + 32 * (cg & 1)) * 8) = pack8f(v); }
    __syncthreads();
}
__device__ __forceinline__ void wcf_item(Frame& F, int L, size_t wo, int item) {
    const int which = item >> 10, ct = (item >> 8) & 3, ks = item & 255, l = ks >> 3, sp = ks & 7, lane = F.lane, r = lane & 31, hh = lane >> 5;
    const float* w = INP(10) + (((size_t)(L * 2 + which) * 32 + l) * 128 + 16 * sp + 8 * hh) * 128 + 32 * ct + r; float v[8];
#pragma unroll
    for (int j = 0; j < 8; ++j) v[j] = w[j * 128];
    *(v4u*)(WSO(bf16, WS_WCF, wo) + ((size_t)((which * 4 + ct) * 256 + ks)) * 512 + lane * 8) = pack8f(v);
}
#ifndef SPLITB
#define SPLITB 1
#endif
#ifndef K5SQ
#define K5SQ 64
#endif
#ifndef K5A
#define K5A 265
#endif
#ifndef K5CUT
#define K5CUT 120
#endif
#ifndef K5S
#define K5S 100
#endif
#ifndef K5TO
#define K5TO 19
#endif
#ifndef K5TAB
#define K5TAB 1
#endif
#ifndef K5A0T
#define K5A0T 288
#endif
#ifndef K5CUT0
#define K5CUT0 128
#endif
struct K5Deal { unsigned short o[2][257]; unsigned cf[2][257]; };
constexpr K5Deal make_k5deal() {
    K5Deal d{};
    for (int cls = 0; cls < 2; ++cls) {
        long s[256] = {}; long tot = 0;
        for (int j = 0; j < 256; ++j) { const int q = j >> 1; long w = (cls ? K5A : K5A0T) - 2 * q - ((q < K5SQ) ? K5S : 0); if (q >= (cls ? K5CUT : K5CUT0) || w < 0) w = 0; s[j] = w; tot += w; }
        long cw = 0;
        for (int j = 0; j < 256; ++j) { d.o[cls][j] = (unsigned short)(1024 * cw / tot); cw += s[j]; }
        d.o[cls][256] = 1024;
        const long NC = (WC_NALL - K1_CONV - K4_CONV) + (cls == 0 ? WC_DEF_N : 0), W = 1024L * K5TO + NC;
        long r[256] = {}; long rtot = 0;
        for (int j = 0; j < 256; ++j) { const long outs = d.o[cls][j + 1] - d.o[cls][j]; long v = (s[j] * W * 16) / tot - outs * K5TO * 16; if (v < 0) v = 0; r[j] = v; rtot += v; }
        long cum = 0;
        for (int j = 0; j < 256; ++j) { d.cf[cls][j] = (unsigned)((cum << 20) / rtot); cum += r[j]; }
        d.cf[cls][256] = 1u << 20;
    }
    return d;
}
__device__ const K5Deal K5DEAL = make_k5deal();

typedef KArgs Args;
__global__ void __launch_bounds__(512, 2) fwd(Args args) {
    extern __shared__ __attribute__((aligned(16))) unsigned char lds[];
    Frame F;
    F.lds = (LAS unsigned char*)lds; F.MISC = (volatile LAS unsigned*)(F.lds + MISC_OFF);
    F.tid = threadIdx.x; F.lane = F.tid & 63; F.wave = __builtin_amdgcn_readfirstlane(F.tid >> 6); F.G = gridDim.x; F.bid = blockIdx.x;
    F.ap = (const KArgs __attribute__((address_space(4)))*)__builtin_amdgcn_kernarg_segment_ptr();
    F.ws = args.ws; F.ctl = (gu32*)(args.ws + WS_CTL);
    for (int u = F.tid; u < (LDS_BYTES - MISC_OFF) / 4; u += 512) ((LAS unsigned*)(F.lds + MISC_OFF))[u] = 0u;
    __syncthreads();
    const int lo = args.ph_lo, hi = args.ph_hi;
    XcdBarrier bar; bar.bar = (unsigned*)(F.ctl + CW_BAR) + args.li * XCD_BAR_WORDS; bar.x = 0; bar.st = nullptr;
    if (hi - lo > 1) bar = xcd_barrier_post((unsigned*)(F.ctl + CW_BAR) + args.li * XCD_BAR_WORDS, F.MISC + 8);
#if 1
#define IN(k) (lo <= (k) && (k) < hi)
#define SEAM(k) do { if (IN((k) + 1)) xcd_barrier(bar); } while (0)
#else
#define IN(k) 1
#define SEAM(k) do { if ((k) + 1 < NPHASES) xcd_barrier(bar); } while (0)
#endif
    LAS unsigned char* glds = F.lds;

#ifndef PHMASK
#define PHMASK 0x1fff
#endif
#define PHON(kk) (((PHMASK) >> (kk)) & 1)
#ifndef SPLITB
#define SPLITB 1
#endif
#ifndef K5SQ
#define K5SQ 64
#endif
#ifndef DEFER0
#define DEFER0 1
#endif
#ifndef DBLMASK
#define DBLMASK 0
#endif
#define NREP(kk) (1 + (((DBLMASK) >> (kk)) & 1))
    if (PHON(12) && IN(0)) { LAUNDER(); ph_prologue(F); SEAM(0); }
    for (int L = 0; L < DEPTH; ++L) {
        const int pb = 1 + L * NPH;
        F.wofs = WOVL ? (size_t)(L & 1) * WS_WSET : 0;
        if (PHON(0) && IN(pb + 0) && (!WOVL || L == 0)) for (int rep = 0; rep < NREP(0); ++rep) { LAUNDER(); if (rep) xcd_barrier(bar);
            { const bool df_ = WOVL && DEFER0 && F.G == 256 && NSA_V2 == 1; const int n0_ = df_ ? WC_NALL - WC_DEF_N : WC_NALL;
              const int per = (n0_ + F.G - 1) / F.G, lo_ = F.bid * per, hi_ = (lo_ + per < n0_) ? lo_ + per : n0_; ph_wconv(F, L, F.wofs, lo_, hi_, df_ ? WC_DEF_LO : (1 << 30), WC_DEF_N); }
            __syncthreads(); SEAM(pb + 0); }
        if (PHON(1) && IN(pb + 1)) for (int rep = 0; rep < NREP(1); ++rep) { LAUNDER(); if (rep) xcd_barrier(bar);
            { pg8::Gemm g{WSP(pg8::bf16_t, WS_A0), WSL(pg8::bf16_t, WS_WIN), T, NIN, KS * D}; pg8::StaticOrder S; S.init(T, NIN, F.G, F.bid);
              pg8::rs_table_fill(glds, S, WSP(float, WS_SSQA), T, 1.0f / D, EPS, F.wave);
              pg8::EpiScaleF32 E{WSP(float, WS_Z), NIN, WSL(float, WS_BPERM), WSP(float, WS_SSQA), 32, glds, 1.0f / D, EPS};
              pg8::gemm_phase<pg8::EpiScaleF32, pg8::StaticOrder, PG8_ALIGN, PG8_SP2>(glds, g, S, E, F.wave); }
            { pg8::Gemm g{WSP(pg8::bf16_t, WS_MEMB), WSL(pg8::bf16_t, WS_WKV), MEM, 2 * D, KS * D}; pg8::StaticOrder S; S.init(MEM, 2 * D, F.G, (F.bid + F.G - (F.G > 116 ? 100 : 0)) % F.G);
              pg8::EpiScaleF32 E{WSP(float, WS_KVX), 2 * D, nullptr, WSP(float, WS_SSQM), 1, glds, 1.0f / D, EPS};
              pg8::gemm_phase<pg8::EpiScaleF32, pg8::StaticOrder, PG8_ALIGN, PG8_SP2>(glds, g, S, E, F.wave); }
#if WOVL
            if (L + 1 < DEPTH && F.G == 256 && F.bid >= 116) { LAUNDER(); const int lo_ = (F.bid - 116) * K1_PER, hi_ = lo_ + K1_PER; ph_wconv(F, L + 1, (size_t)((L + 1) & 1) * WS_WSET, lo_, hi_); __syncthreads(); }
#endif
            SEAM(pb + 1); }
#if ORACLE_MIX
        if (PHON(2) && IN(pb + 2)) { LAUNDER(); ph_prep(F, L, 0); __syncthreads(); SEAM(pb + 2); }
#endif
        if (PHON(3) && IN(pb + 3)) for (int rep = 0; rep < NREP(3); ++rep) { LAUNDER(); if (rep) xcd_barrier(bar);
#if ORACLE_MIX
            for (int it = F.bid; it < 512; it += F.G) hg_summary_item(F, L, it >> 2, it & 3);
            for (int it = F.bid; it < 512; it += F.G) ml_summary_item(F, it >> 2, it & 3);
            for (int it = F.bid; it < 256; it += F.G) cmp_item(F, L, it);
#else
            { const bool g256 = (F.G == 256), cmpwg = g256 && F.bid >= 192;
              const int c_lo = g256 ? (cmpwg ? F.bid - 192 : 64) : F.G - 1 - F.bid, c_st = g256 ? 64 : F.G;
              const int s_lo = g256 ? (cmpwg ? 960 + F.bid - 192 : 5 * F.bid) : F.bid, s_hi = g256 ? s_lo + (cmpwg ? 1 : 5) : 1024, s_st = g256 ? 1 : F.G;
#pragma unroll 1
              for (int it = c_lo; it < 64; it += c_st) cmp_item_mfma(F, L, it);
              LAUNDER();
#pragma unroll 1
              for (int it = s_lo; it < s_hi; it += s_st) { if (it < 512) hg_summary_mfma(F, L, it >> 2, it & 3); else ml_summary_mfma(F, L, (it - 512) >> 2, it & 3); } }
#if SPLITB
            __syncthreads(); LAUNDER(); ph_prep(F, L, 0); __syncthreads();
#endif
#endif
            SEAM(pb + 3); }
        if (PHON(4) && IN(pb + 4)) for (int rep = 0; rep < NREP(4); ++rep) { LAUNDER(); if (rep) xcd_barrier(bar);
#if ORACLE_MIX
            ph_scan(F);
#else
#if SPLITB
            if (F.G == 256) { ph_scan_v2(F, 2 * K5SQ, (K5SQ == 32) ? 8 : 4);
#if WOVL
                if (K4_PER > 0 && L + 1 < DEPTH && F.bid < 128) { LAUNDER(); const int lo_ = K1_CONV + F.bid * K4_PER; ph_wconv(F, L + 1, (size_t)((L + 1) & 1) * WS_WSET, lo_, lo_ + K4_PER, 1 << 30, 0, 5); }
#endif
                xcd_barrier_arrive(bar); }
            else { ph_scan_v2(F, F.G, 2); __syncthreads(); xcd_barrier(bar); }
#else
            ph_scan_v2(F, F.G, 2); LAUNDER(); ph_prep(F, L, 3);
#endif
#endif
#if !SPLITB
            __syncthreads(); SEAM(pb + 4);
#endif
            }
        if (PHON(5) && IN(pb + 5)) for (int rep = 0; rep < NREP(5); ++rep) { LAUNDER(); if (rep) xcd_barrier(bar);
#if ORACLE_MIX
#define HG_OUT hg_output_item
#define ML_OUT ml_output_item
#else
#define HG_OUT hg_output_mfma
#define ML_OUT ml_output_mfma
#endif
#ifndef P5MASK
#define P5MASK 7
#endif
#ifndef P5DBL
#define P5DBL 0
#endif
            const bool g256_ = (F.G == 256) && (NSA_V2 == 1); const int q5_ = F.bid >> 1, r5_ = F.bid & 1;
#ifndef K5A
#define K5A 265
#endif
#ifndef K5A0
#define K5A0 265
#endif
#ifndef K5CUT
#define K5CUT 120
#endif
#ifndef K5S
#define K5S 100
#endif
            long cwa_ = 0, K5TOT = 0;
            const int k5a_ = (DEFER0 && L == 0) ? K5A0 : K5A;
#pragma unroll 1
            for (int qq = 0; qq < 128; ++qq) { const int wr_ = k5a_ - 2 * qq - ((SPLITB && qq < K5SQ) ? K5S : 0), wq_ = (qq >= K5CUT || wr_ < 0) ? 0 : wr_; if (qq < q5_) cwa_ += 2 * wq_; else if (qq == q5_) cwa_ += r5_ * wq_; K5TOT += 2 * wq_; }
            const int wm_ = k5a_ - 2 * q5_ - ((SPLITB && q5_ < K5SQ) ? K5S : 0); const long cwb_ = cwa_ + ((q5_ >= K5CUT || wm_ < 0) ? 0 : wm_);
#if !SPLITB
            { const int o_lo = g256_ ? ((SPLITB && K5TAB) ? (int)K5DEAL.o[(DEFER0 && L == 0) ? 0 : 1][F.bid] : (int)(1024L * cwa_ / K5TOT)) : F.bid, o_hi = g256_ ? ((SPLITB && K5TAB) ? (int)K5DEAL.o[(DEFER0 && L == 0) ? 0 : 1][F.bid + 1] : (int)(1024L * cwb_ / K5TOT)) : 1024, o_st = g256_ ? 1 : F.G;
#pragma unroll 1
              for (int r5 = 0; r5 < 1 + (P5DBL & 1); ++r5)
#pragma unroll 1
                for (int it = o_lo; it < o_hi; it += o_st) { LAUNDER(); if (it < 512) { if (P5MASK & 1) HG_OUT(F, L, it >> 2, it & 3); } else { if (P5MASK & 2) ML_OUT(F, L, (it - 512) >> 2, it & 3); } } }
#endif
#if ORACLE_ATTN
            if (P5MASK & 4) { ph_nsa(F, L); __syncthreads(); }
#else
            LAUNDER();
            if (P5MASK & 4) for (int r5 = 0; r5 < 1 + ((P5DBL >> 2) & 1); ++r5) {
#if NSA_V2 == 2
                ph_nsa3(F, L);
#elif NSA_V2
                ph_nsa_block(F, L);
#else
                ph_nsa_mfma(F, L);
#endif
                __syncthreads(); }
#if SPLITB
            LAUNDER(); if (F.G == 256) xcd_barrier_wait(bar);
            LAUNDER();
            { const int o_lo = g256_ ? ((SPLITB && K5TAB) ? (int)K5DEAL.o[(DEFER0 && L == 0) ? 0 : 1][F.bid] : (int)(1024L * cwa_ / K5TOT)) : F.bid, o_hi = g256_ ? ((SPLITB && K5TAB) ? (int)K5DEAL.o[(DEFER0 && L == 0) ? 0 : 1][F.bid + 1] : (int)(1024L * cwb_ / K5TOT)) : 1024, o_st = g256_ ? 1 : F.G;
#pragma unroll 1
              for (int r5 = 0; r5 < 1 + (P5DBL & 1); ++r5)
#pragma unroll 1
                for (int it = o_lo; it < o_hi; it += o_st) { LAUNDER(); if (it < 512) { if (P5MASK & 1) HG_OUT(F, L, it >> 2, it & 3); } else { if (P5MASK & 2) ML_OUT(F, L, (it - 512) >> 2, it & 3); } } }
            __syncthreads();
#endif
#if WOVL
            if (g256_) {
#pragma unroll 1
                for (int s5 = (DEFER0 && L == 0) ? 0 : 1; s5 < 2 && L + s5 < DEPTH; ++s5) { LAUNDER();
                    const int c0_ = s5 ? K1_CONV + (SPLITB ? K4_CONV : 0) : WC_DEF_LO, n5_ = s5 ? WC_NALL - K1_CONV - (SPLITB ? K4_CONV : 0) : WC_DEF_N; const int cl_ = (DEFER0 && L == 0) ? 0 : 1; const int lo_ = c0_ + ((SPLITB && K5TAB) ? (int)(((long)n5_ * K5DEAL.cf[cl_][F.bid]) >> 20) : (int)((long)n5_ * cwa_ / K5TOT)), hi_ = c0_ + ((SPLITB && K5TAB) ? (int)(((long)n5_ * K5DEAL.cf[cl_][F.bid + 1]) >> 20) : (int)((long)n5_ * cwb_ / K5TOT));
                    ph_wconv(F, L + s5, (size_t)((L + s5) & 1) * WS_WSET, lo_, hi_); __syncthreads(); } }
            else if (L + 1 < DEPTH) { LAUNDER(); const int per = (WC_NALL + F.G - 1) / F.G, lo_ = F.bid * per, hi_ = (lo_ + per < WC_NALL) ? lo_ + per : WC_NALL; ph_wconv(F, L + 1, (size_t)((L + 1) & 1) * WS_WSET, lo_, hi_); __syncthreads(); }
#endif
#endif
            SEAM(pb + 5); }
        if (PHON(6) && IN(pb + 6)) { LAUNDER(); pg8::Gemm g{WSP(pg8::bf16_t, WS_A1), WSL(pg8::bf16_t, WS_WOUT), T, D, KS * D}; pg8::StaticOrder S; S.init(T, D, F.G, F.bid);
            pg8::EpiResid E{L == 0 ? INP(0) : OUTP, OUTP, WSP(pg8::bf16_t, WS_A0), WSP(float, WS_SSQB), D, T};
            pg8::gemm_phase<pg8::EpiResid, pg8::StaticOrder, PG8_ALIGN, PG8_SP2>(glds, g, S, E, F.wave); SEAM(pb + 6); }
        if (PHON(7) && IN(pb + 7)) for (int rep = 0; rep < NREP(7); ++rep) { LAUNDER(); if (rep) xcd_barrier(bar); pg8::Gemm g{WSP(pg8::bf16_t, WS_A0), WSL(pg8::bf16_t, WS_WQ), T, D, KS * D}; pg8::StaticOrder S; S.init(T, D, F.G, F.bid);
#if ORACLE_ATTN
            pg8::rs_table_fill(glds, S, WSP(float, WS_SSQB), T, 1.0f / D, EPS, F.wave);
            pg8::EpiScaleF32 E{WSP(float, WS_XQ), D, nullptr, WSP(float, WS_SSQB), 32, glds, 1.0f / D, EPS};
            pg8::gemm_phase<pg8::EpiScaleF32, pg8::StaticOrder, PG8_ALIGN, PG8_SP2>(glds, g, S, E, F.wave);
#else
            pg8::rs_table_fill(glds, S, WSP(float, WS_SSQB), T, 1.0f / D, EPS, F.wave);
            pg8::EpiScaleBf16 E{WSP(pg8::bf16_t, WS_XQB), T, WSP(float, WS_SSQB), 32, glds, 1.0f / D, EPS, WSP(float, WS_QSS)};
            pg8::gemm_phase<pg8::EpiScaleBf16, pg8::StaticOrder, PG8_ALIGN, PG8_SP2>(glds, g, S, E, F.wave);
#endif
            SEAM(pb + 7); }
        if (PHON(8) && IN(pb + 8)) for (int rep = 0; rep < NREP(8); ++rep) { LAUNDER(); if (rep) xcd_barrier(bar);
#if ORACLE_ATTN
            ph_xattn(F, L);
            __syncthreads(); SEAM(pb + 8);
#else
#if XFUSE
            { const float* qg_ = INP(20) + L * 512; const float* kg_ = INP(21) + L * 512; float gq_ = 0.f, gk_ = 0.f;
#pragma unroll
              for (int i = 0; i < 8; ++i) { gq_ = fmaxf(gq_, fabsf(qg_[F.lane + 64 * i])); gk_ = fmaxf(gk_, fabsf(kg_[F.lane + 64 * i])); }
              const float bound_ = 22.627416997969522f * 1.4426950408889634f * 1.02f * wave_max(gq_) * wave_max(gk_);
#pragma unroll 1
              for (int h = 0; h < 4; ++h) { pg8::Gemm g{WSP(pg8::bf16_t, WS_XQB) + (size_t)h * T * 512, WSP(pg8::bf16_t, WS_KXF) + (size_t)h * MEM * 512, T, MEM, 512};
                  pg8::StaticOrder S; S.init(T, MEM, F.G, (F.bid + 64 * h) % F.G);
                  pg8::rs_table_fill(glds, S, WSP(float, WS_QSS), T, 1.0f / 512.0f, EPS, F.wave, 8 * h, 8, false);
                  pg8::EpiExpPN E{WSP(pg8::bf16_t, WS_PH), 1024, 256 * h, glds, bound_};
                  pg8::gemm_phase<pg8::EpiExpPN, pg8::StaticOrder, true, PG8_SP2>(glds, g, S, E, F.wave); __syncthreads(); }
#pragma unroll 1
              for (int h = 0; h < 4; ++h) { pg8::Gemm g{WSL(pg8::bf16_t, WS_WO) + (size_t)h * D * 512, WSP(pg8::bf16_t, WS_VXF) + (size_t)h * MEM * 512, D, MEM, 512};
                  pg8::StaticOrder S; S.init(D, MEM, F.G, (F.bid + 64 * h + 224) % F.G);
                  pg8::EpiPlainBf16 E{WSP(pg8::bf16_t, WS_BTC), 1024, 256 * h};
                  pg8::gemm_phase<pg8::EpiPlainBf16, pg8::StaticOrder, PG8_ALIGN, PG8_SP2>(glds, g, S, E, F.wave); __syncthreads(); } }
#else
            { const float* qg_ = INP(20) + L * 512; const float* kg_ = INP(21) + L * 512; float gq_ = 0.f, gk_ = 0.f;
#pragma unroll
              for (int i = 0; i < 8; ++i) { gq_ = fmaxf(gq_, fabsf(qg_[F.lane + 64 * i])); gk_ = fmaxf(gk_, fabsf(kg_[F.lane + 64 * i])); }
              const float bound_ = 22.627416997969522f * 1.4426950408889634f * 1.02f * wave_max(gq_) * wave_max(gk_);
#pragma unroll 1
              for (int h = 0; h < 4; ++h) { pg8::Gemm g{WSP(pg8::bf16_t, WS_XQB) + (size_t)h * T * 512, WSP(pg8::bf16_t, WS_KXF) + (size_t)h * MEM * 512, T, MEM, 512};
                  pg8::StaticOrder S; S.init(T, MEM, F.G, (F.bid + 64 * h) % F.G);
                  pg8::rs_table_fill(glds, S, WSP(float, WS_QSS), T, 1.0f / 512.0f, EPS, F.wave, 8 * h, 8, false);
                  pg8::EpiExpP E{WSP(pg8::bf16_t, WS_PH) + (size_t)h * T * MEM, WSP(float, WS_LPX) + (size_t)h * 4 * T, T, glds, bound_};
                  pg8::gemm_phase<pg8::EpiExpP, pg8::StaticOrder, PG8_ALIGN, PG8_SP2>(glds, g, S, E, F.wave); __syncthreads(); } }
            xcd_barrier(bar); LAUNDER();
#pragma unroll 1
            for (int h = 0; h < 4; ++h) { pg8::Gemm g{WSP(pg8::bf16_t, WS_PH) + (size_t)h * T * MEM, WSP(pg8::bf16_t, WS_VXF) + (size_t)h * 512 * MEM, T, 512, MEM};
                pg8::StaticOrder S; S.init(T, 512, F.G, (F.bid + 64 * h) % F.G);
                pg8::rs_table_fill(glds, S, WSP(float, WS_LPX) + (size_t)h * 4 * T, T, 1.0f, 0.f, F.wave, 0, 4, true);
                pg8::EpiRowScaleA E{WSP(pg8::bf16_t, WS_A1), D, 512 * h, glds};
                pg8::gemm_phase<pg8::EpiRowScaleA, pg8::StaticOrder, PG8_ALIGN, PG8_SP2>(glds, g, S, E, F.wave); __syncthreads(); }
#endif
            SEAM(pb + 8);
#endif
            }
        if (PHON(9) && IN(pb + 9)) { LAUNDER();
#if XFUSE
            pg8::Gemm g{WSP(pg8::bf16_t, WS_PH), WSP(pg8::bf16_t, WS_BTC), T, D, 1024};
#else
            pg8::Gemm g{WSP(pg8::bf16_t, WS_A1), WSL(pg8::bf16_t, WS_WO), T, D, KS * D};
#endif
            pg8::StaticOrder S; S.init(T, D, F.G, F.bid);
            pg8::EpiResid E{OUTP, OUTP, WSP(pg8::bf16_t, WS_A0), WSP(float, WS_SSQC), D, T};
            pg8::gemm_phase<pg8::EpiResid, pg8::StaticOrder, PG8_ALIGN, PG8_SP2>(glds, g, S, E, F.wave); SEAM(pb + 9); }
        if (PHON(10) && IN(pb + 10)) for (int rep = 0; rep < NREP(10); ++rep) { LAUNDER(); if (rep) xcd_barrier(bar); pg8::Gemm g{WSP(pg8::bf16_t, WS_A0), WSL(pg8::bf16_t, WS_W1), T, DFF, KS * D}; pg8::StaticOrder S; S.init(T, DFF, F.G, F.bid);
            pg8::rs_table_fill(glds, S, WSP(float, WS_SSQC), T, 1.0f / D, EPS, F.wave);
            pg8::EpiRelu2 E{WSP(pg8::bf16_t, WS_HM), DFF, WSP(float, WS_SSQC), 32, glds, 1.0f / D, EPS};
            pg8::gemm_phase<pg8::EpiRelu2, pg8::StaticOrder, PG8_ALIGN, PG8_SP2>(glds, g, S, E, F.wave); SEAM(pb + 10); }
        if (PHON(11) && IN(pb + 11)) { LAUNDER(); pg8::Gemm g{WSP(pg8::bf16_t, WS_HM), WSL(pg8::bf16_t, WS_W2), T, D, KS * DFF}; pg8::StaticOrder S; S.init(T, D, F.G, F.bid);
            pg8::EpiResid E{OUTP, OUTP, WSP(pg8::bf16_t, WS_A0), WSP(float, WS_SSQA), D, T};
            pg8::gemm_phase<pg8::EpiResid, pg8::StaticOrder, PG8_ALIGN, PG8_SP2>(glds, g, S, E, F.wave); SEAM(pb + 11); }
    }
    LAUNDER();
    if (hi - lo > 1 && hi == NPHASES) { __syncthreads(); if (xb_ld(&bar.bar[XB_TMO]) != 0u) { const float q = __builtin_nanf(""); for (int i = F.bid * 512 + F.tid; i < T * D; i += F.G * 512 * 64) OUTP[i] = q; } }
#undef IN
#undef SEAM
}

#ifndef MK_PER_PHASE
#define MK_PER_PHASE 0
#endif
extern "C" void kernel_launch(void* const* d_in, const int* in_sizes, int n_in, void* d_out, int out_size, void* d_ws, size_t ws_size, hipStream_t stream) {
    static int grid = 0;
    if (grid == 0) {
        if (n_in != 25 || out_size != T * D || ws_size < WS_END) { fprintf(stderr, "kernel_launch: unexpected sizes (n_in %d, out %d, ws %zu, need %zu); nothing launched\n", n_in, out_size, ws_size, (size_t)WS_END); grid = -1; return; }
        int dev = 0, cus = 0, per_cu = 0;
        if (hipGetDevice(&dev) != hipSuccess || hipDeviceGetAttribute(&cus, hipDeviceAttributeMultiprocessorCount, dev) != hipSuccess) { grid = -1; return; }
        if (hipFuncSetAttribute((const void*)fwd, hipFuncAttributeMaxDynamicSharedMemorySize, LDS_BYTES) != hipSuccess) { fprintf(stderr, "kernel_launch: hipFuncSetAttribute failed\n"); grid = -1; return; }
        if (hipOccupancyMaxActiveBlocksPerMultiprocessor(&per_cu, (const void*)fwd, 512, LDS_BYTES) != hipSuccess || per_cu < 1) { fprintf(stderr, "kernel_launch: occupancy query says %d\n", per_cu); }
        (void)hipGetLastError();
        grid = cus;
    }
    if (grid < 0) return;
    if (hipMemsetAsync((char*)d_ws + WS_CTL, 0, CTL_ZERO_BYTES, stream) != hipSuccess) return;
    Args a{};
    for (int i = 0; i < 25; ++i) a.in[i] = (const float*)d_in[i];
    a.out = (float*)d_out; a.ws = (unsigned char*)d_ws; a.pad = 0;
#if MK_PER_PHASE
    for (int p = 0; p < NPHASES; ++p) { a.ph_lo = p; a.ph_hi = p + 1; a.li = 0; hipLaunchKernelGGL(fwd, dim3(grid), dim3(512), LDS_BYTES, stream, a); }
#else
    a.ph_lo = 0; a.ph_hi = NPHASES; a.li = 0;
    hipLaunchKernelGGL(fwd, dim3(grid), dim3(512), LDS_BYTES, stream, a);
#endif
}
```

```cpp
#include <hip/hip_runtime.h>
#include <cstdio>
#include <cstdint>
#define MK_PER_PHASE 0
#ifndef ORACLE_MIX
#define ORACLE_MIX 0
#endif
#ifndef ORACLE_ATTN
#define ORACLE_ATTN 0
#endif
#ifndef NSA_V2
#define NSA_V2 1
#endif
#ifndef KS
#define KS 1
#endif
__device__ __forceinline__ void swap32(unsigned& a, unsigned& b) { asm volatile("s_nop 1\n\tv_permlane32_swap_b32 %0, %1\n\ts_nop 1" : "+v"(a), "+v"(b)); }
template <int M> __device__ __forceinline__ float sxor(float v) { static_assert(M < 32, "use half_sum / half_max for the two lane halves");
    return __builtin_bit_cast(float, __builtin_amdgcn_ds_swizzle(__builtin_bit_cast(int, v), (M << 10) | 0x1f)); }
template <int M> __device__ __forceinline__ int sxori(int v) { static_assert(M < 32, "");
    return __builtin_amdgcn_ds_swizzle(v, (M << 10) | 0x1f); }
__device__ __forceinline__ float half_sum(float v) { unsigned a = __builtin_bit_cast(unsigned, v), b = a; swap32(a, b); return __builtin_bit_cast(float, a) + __builtin_bit_cast(float, b); }
__device__ __forceinline__ float half_max(float v) { unsigned a = __builtin_bit_cast(unsigned, v), b = a; swap32(a, b); return fmaxf(__builtin_bit_cast(float, a), __builtin_bit_cast(float, b)); }
namespace pg8 {
#define PG8_LAS __attribute__((address_space(3)))
typedef unsigned short bf16_t;
typedef short bf16x8 __attribute__((ext_vector_type(8)));
typedef float f32x4 __attribute__((ext_vector_type(4)));
typedef unsigned u32x4 __attribute__((ext_vector_type(4)));
constexpr int BM = 256, BK = 64, HALF = 128, HTB = HALF * BK * 2  , STAGE_BYTES = 8 * HTB, NXCD = 8, WGM = 8;

__host__ __device__ __forceinline__ int lds_byte(int r, int c) { const int st = (r >> 4) * 2 + (c >> 5), rr = r & 15, cc = c & 31, ob = rr * 64 + cc * 2; return st * 1024 + (ob ^ (((ob >> 9) & 1) << 5)); }
__host__ __device__ __forceinline__ void stage_rc(int b, int& R, int& C) { const int st = b / 1024, sb = b % 1024, swz = sb ^ (((sb >> 9) & 1) << 5); R = (st >> 1) * 16 + swz / 64; C = (st & 1) * 32 + (swz % 64) / 2; }
__host__ __device__ __forceinline__ int perm32(int rho) { const int n = rho >> 4, i = rho & 15; return 8 * (i >> 2) + 4 * n + (i & 3); }

struct Unit { int pm, pn; };
struct Gemm { const bf16_t* A; const bf16_t* Bt; int M, N, K; };

struct StaticOrder {
    int nM, nN, nwg, G, c;
    __host__ __device__ void init(int M, int N, int G_, int c_) { nM = M / BM; nN = N / BM; nwg = nM * nN; G = G_; c = c_; }
    __host__ __device__ bool next(int i, Unit& u) const {
        const long L = (long)i * G + c; if (L >= nwg) return false;
        int wgid = (int)L; { const int q = nwg / NXCD, r = nwg % NXCD, xcd = wgid % NXCD, off = wgid / NXCD; wgid = (xcd < r ? xcd * (q + 1) : r * (q + 1) + (xcd - r) * q) + off; }
        const int nig = WGM * nN, gid = wgid / nig, fm = gid * WGM, gsz = (nM - fm) < WGM ? (nM - fm) : WGM;
        u.pm = fm + ((wgid % nig) % gsz); u.pn = (wgid % nig) / gsz; return true;
    }
    __device__ __forceinline__ void a_ready(const Unit&) const {}
    __device__ __forceinline__ void done(const Unit&) const {}
};

__device__ __forceinline__ unsigned cvt_pk_bf16(float lo, float hi) { unsigned r; asm volatile("v_cvt_pk_bf16_f32 %0, %1, %2" : "=v"(r) : "v"(lo), "v"(hi)); return r; }
__device__ __forceinline__ float bf_hi_f(unsigned pk) { return __builtin_bit_cast(float, pk << 16); }
__device__ __forceinline__ float bf_lo_of(float v) { unsigned h; { unsigned u = __builtin_bit_cast(unsigned, v); h = (u + 0x7fffu + ((u >> 16) & 1u)) & 0xffff0000u; } return v - __builtin_bit_cast(float, h); }
__device__ __forceinline__ void store_a8(bf16_t* rowp, int Kreal, int col, const f32x4& v0, const f32x4& v1) {
    u32x4 w; w.x = cvt_pk_bf16(v0[0], v0[1]); w.y = cvt_pk_bf16(v0[2], v0[3]); w.z = cvt_pk_bf16(v1[0], v1[1]); w.w = cvt_pk_bf16(v1[2], v1[3]);
    *(u32x4*)(rowp + col) = w;
#if KS == 3
    *(u32x4*)(rowp + Kreal + col) = w;
    u32x4 l; l.x = cvt_pk_bf16(bf_lo_of(v0[0]), bf_lo_of(v0[1])); l.y = cvt_pk_bf16(bf_lo_of(v0[2]), bf_lo_of(v0[3])); l.z = cvt_pk_bf16(bf_lo_of(v1[0]), bf_lo_of(v1[1])); l.w = cvt_pk_bf16(bf_lo_of(v1[2]), bf_lo_of(v1[3]));
    *(u32x4*)(rowp + 2 * Kreal + col) = l;
#endif
}

constexpr int RS_OFF = 131072, RS_TAG_OFF = RS_OFF + 4 * 256 * 4;
template <class Sched>
__device__ __forceinline__ void rs_table_fill(PG8_LAS unsigned char* lds, const Sched& S, const float* ssq, int ldp, float inv_n, float eps, int wid_, int p0 = 0, int npart = 32, bool recip = false) {
    int tid = 0;
    PG8_LAS float* rs = (PG8_LAS float*)(lds + RS_OFF); PG8_LAS int* tag = (PG8_LAS int*)(lds + RS_TAG_OFF);
    { int z_ = 0; asm volatile("" : "+s"(z_)); tid = (tid >> 6) * 0 + (int)__builtin_amdgcn_mbcnt_hi(~0u, __builtin_amdgcn_mbcnt_lo(~0u, (unsigned)z_)) + 64 * wid_; }
#pragma unroll 1
    for (int pass = 0; pass < 2; ++pass) { const int i = 2 * pass + (tid >> 8); Unit u; const bool ok = S.next(i, u);
        if (ok) { const int r = u.pm * BM + (tid & 255); float s = 0.f;
#pragma unroll 8
            for (int p = 0; p < npart; ++p) s += ssq[(size_t)(p0 + p) * ldp + r];
            rs[i * 256 + (tid & 255)] = recip ? ((s > 0.f) ? 1.0f / s : 0.f) : 1.0f / sqrtf(s * inv_n + eps); }
        if ((tid & 255) == 0) tag[i] = ok ? u.pm : -1; }
    __syncthreads();
}
__device__ __forceinline__ int rs_slot(PG8_LAS unsigned char* lds, const Unit& u) { const PG8_LAS int* tag = (const PG8_LAS int*)(lds + RS_TAG_OFF);
    const int t0 = __builtin_amdgcn_readfirstlane(tag[0]), t1 = __builtin_amdgcn_readfirstlane(tag[1]), t2 = __builtin_amdgcn_readfirstlane(tag[2]);
    return (t0 == u.pm) ? 0 : (t1 == u.pm) ? 1 : (t2 == u.pm) ? 2 : 3; }
__device__ __forceinline__ float row_rs(const float* ssq, int np, PG8_LAS unsigned char* lds, int slot, int r, float inv_n, float eps) {
    if (np == 1) return 1.0f / sqrtf(ssq[r] * inv_n + eps);
    return ((const PG8_LAS float*)(lds + RS_OFF))[slot * 256 + (r & 255)];
}

struct EpiScaleF32 {
    static constexpr bool PERM = false, AFTER_DRAIN = false;
    float* C; int ldc; const float* bias; const float* ssq; int np; PG8_LAS unsigned char* lds; float inv_n, eps;
    __device__ __forceinline__ void operator()(const f32x4 (&acc)[2][2][4][2], const Unit& u, int wr, int wc, int fr, int fq) const {
        const int row0 = u.pm * BM + wr * 64 + fr, col0 = u.pn * BM + wc * 32 + 4 * fq;
        const int slot = (np == 1) ? 0 : rs_slot(lds, u);
        f32x4 bv[2][2];
#pragma unroll
        for (int bj = 0; bj < 2; ++bj)
#pragma unroll
            for (int n = 0; n < 2; ++n) bv[bj][n] = bias ? *(const f32x4*)(bias + col0 + bj * HALF + n * 16) : (f32x4){0.f, 0.f, 0.f, 0.f};
#pragma unroll
        for (int ai = 0; ai < 2; ++ai)
#pragma unroll
            for (int m = 0; m < 4; ++m) { const int r = row0 + ai * HALF + m * 16; float* rowp = C + (size_t)r * ldc + col0;
                const float rs = row_rs(ssq, np, lds, slot, r, inv_n, eps);
#pragma unroll
                for (int bj = 0; bj < 2; ++bj)
#pragma unroll
                    for (int n = 0; n < 2; ++n) *(f32x4*)(rowp + bj * HALF + n * 16) = acc[ai][bj][m][n] * rs + bv[bj][n]; }
    }
};

struct EpiResid {
    static constexpr bool PERM = true, AFTER_DRAIN = false;
    const float* xres; float* xout; bf16_t* xb; float* ssq; int ld, ldp;
    __device__ __forceinline__ void operator()(const f32x4 (&acc)[2][2][4][2], const Unit& u, int wr, int wc, int fr, int fq) const {
        const int row0 = u.pm * BM + wr * 64 + fr, col0 = u.pn * BM + wc * 32 + 8 * fq;
#pragma unroll
        for (int ai = 0; ai < 2; ++ai)
#pragma unroll
            for (int m = 0; m < 4; ++m) { const int r = row0 + ai * HALF + m * 16; float s = 0.f;
#pragma unroll
                for (int bj = 0; bj < 2; ++bj) { const int c = col0 + bj * HALF; const float* xr = xres + (size_t)r * ld + c; float* xo = xout + (size_t)r * ld + c;
                    const f32x4 v0 = acc[ai][bj][m][0] + *(const f32x4*)xr, v1 = acc[ai][bj][m][1] + *(const f32x4*)(xr + 4);
                    *(f32x4*)xo = v0; *(f32x4*)(xo + 4) = v1;
                    s += (v0[0] * v0[0] + v0[1] * v0[1]) + (v0[2] * v0[2] + v0[3] * v0[3]) + (v1[0] * v1[0] + v1[1] * v1[1]) + (v1[2] * v1[2] + v1[3] * v1[3]);
                    store_a8(xb + (size_t)r * (KS * ld), ld, c, v0, v1); }
                s += sxor<16>(s); s = half_sum(s);
                if (fq == 0) ssq[(size_t)(u.pn * 4 + wc) * ldp + r] = s;
                if (m & 1) asm volatile("" ::: "memory"); }
    }
};

struct EpiRelu2 {
    static constexpr bool PERM = true, AFTER_DRAIN = false;
    bf16_t* H; int ld; const float* ssq; int np; PG8_LAS unsigned char* lds; float inv_n, eps;
    __device__ __forceinline__ void operator()(const f32x4 (&acc)[2][2][4][2], const Unit& u, int wr, int wc, int fr, int fq) const {
        const int row0 = u.pm * BM + wr * 64 + fr, col0 = u.pn * BM + wc * 32 + 8 * fq; const int slot = (np == 1) ? 0 : rs_slot(lds, u);
#pragma unroll
        for (int ai = 0; ai < 2; ++ai)
#pragma unroll
            for (int m = 0; m < 4; ++m) { const int r = row0 + ai * HALF + m * 16; const float rs = row_rs(ssq, np, lds, slot, r, inv_n, eps);
#pragma unroll
                for (int bj = 0; bj < 2; ++bj) { f32x4 v0 = acc[ai][bj][m][0] * rs, v1 = acc[ai][bj][m][1] * rs;
#pragma unroll
                    for (int j = 0; j < 4; ++j) { const float a = fmaxf(v0[j], 0.f), b = fmaxf(v1[j], 0.f); v0[j] = a * a; v1[j] = b * b; }
                    store_a8(H + (size_t)r * (KS * ld), ld, col0 + bj * HALF, v0, v1); } }
    }
};

struct EpiScaleBf16 {
    static constexpr bool PERM = true, AFTER_DRAIN = false;
    bf16_t* O; int M_; const float* ssq; int np; PG8_LAS unsigned char* lds; float inv_n, eps; float* qss;
    __device__ __forceinline__ void operator()(const f32x4 (&acc)[2][2][4][2], const Unit& u, int wr, int wc, int fr, int fq) const {
        const int row0 = u.pm * BM + wr * 64 + fr, col0 = (u.pn & 1) * BM + wc * 32 + 8 * fq; const int slot = (np == 1) ? 0 : rs_slot(lds, u);
        bf16_t* Oh = O + (size_t)(u.pn >> 1) * M_ * 512;
#pragma unroll
        for (int ai = 0; ai < 2; ++ai)
#pragma unroll
            for (int m = 0; m < 4; ++m) { const int r = row0 + ai * HALF + m * 16; const float rs = row_rs(ssq, np, lds, slot, r, inv_n, eps); float s = 0.f;
#pragma unroll
                for (int bj = 0; bj < 2; ++bj) { const f32x4 v0 = acc[ai][bj][m][0] * rs, v1 = acc[ai][bj][m][1] * rs;
                    s += (v0[0] * v0[0] + v0[1] * v0[1]) + (v0[2] * v0[2] + v0[3] * v0[3]) + (v1[0] * v1[0] + v1[1] * v1[1]) + (v1[2] * v1[2] + v1[3] * v1[3]);
                    u32x4 w; w.x = cvt_pk_bf16(v0[0], v0[1]); w.y = cvt_pk_bf16(v0[2], v0[3]); w.z = cvt_pk_bf16(v1[0], v1[1]); w.w = cvt_pk_bf16(v1[2], v1[3]);
                    *(u32x4*)(Oh + (size_t)r * 512 + col0 + bj * HALF) = w; }
                s += sxor<16>(s); s = half_sum(s);
                if (fq == 0) qss[(size_t)(u.pn * 4 + wc) * M_ + r] = s;
                asm volatile("" ::: "memory"); }
    }
};
#define EPI_FRESH_LANE() { int z_ = 0; asm volatile("" : "+s"(z_)); const int l_ = (int)__builtin_amdgcn_mbcnt_hi(~0u, __builtin_amdgcn_mbcnt_lo(~0u, (unsigned)z_)); fr = l_ & 15; fq = l_ >> 4; }
struct EpiExpP {
    static constexpr bool PERM = true, AFTER_DRAIN = false;
    bf16_t* P; float* lp; int M_; PG8_LAS unsigned char* lds; float bound;
    __device__ __forceinline__ void operator()(const f32x4 (&acc)[2][2][4][2], const Unit& u, int wr, int wc, int fr, int fq) const {
        EPI_FRESH_LANE();
        const int row0 = u.pm * BM + wr * 64 + fr, col0 = wc * 32 + 8 * fq; const int slot = rs_slot(lds, u);
#pragma unroll
        for (int ai = 0; ai < 2; ++ai)
#pragma unroll
            for (int m = 0; m < 4; ++m) { const int r = row0 + ai * HALF + m * 16; const float rs = ((const PG8_LAS float*)(lds + RS_OFF))[slot * 256 + (r & 255)]; float s = 0.f;
#pragma unroll
                for (int bj = 0; bj < 2; ++bj) { f32x4 v0, v1;
#pragma unroll
                    for (int j = 0; j < 4; ++j) { v0[j] = __builtin_amdgcn_exp2f(acc[ai][bj][m][0][j] * rs - bound); v1[j] = __builtin_amdgcn_exp2f(acc[ai][bj][m][1][j] * rs - bound); }
                    s += ((v0[0] + v0[1]) + (v0[2] + v0[3])) + ((v1[0] + v1[1]) + (v1[2] + v1[3]));
                    u32x4 w; w.x = cvt_pk_bf16(v0[0], v0[1]); w.y = cvt_pk_bf16(v0[2], v0[3]); w.z = cvt_pk_bf16(v1[0], v1[1]); w.w = cvt_pk_bf16(v1[2], v1[3]);
                    *(u32x4*)(P + (size_t)r * 256 + col0 + bj * HALF) = w; }
                s += sxor<16>(s); s = half_sum(s);
                if (fq == 0) lp[(size_t)wc * M_ + r] = s;
                asm volatile("" ::: "memory"); }
    }
};
struct EpiRowScaleA {
    static constexpr bool PERM = true, AFTER_DRAIN = false;
    bf16_t* Y; int ld, colbase; PG8_LAS unsigned char* lds;
    __device__ __forceinline__ void operator()(const f32x4 (&acc)[2][2][4][2], const Unit& u, int wr, int wc, int fr, int fq) const {
        EPI_FRESH_LANE();
        const int row0 = u.pm * BM + wr * 64 + fr, col0 = colbase + u.pn * BM + wc * 32 + 8 * fq; const int slot = rs_slot(lds, u);
#pragma unroll
        for (int ai = 0; ai < 2; ++ai)
#pragma unroll
            for (int m = 0; m < 4; ++m) { const int r = row0 + ai * HALF + m * 16; const float il = ((const PG8_LAS float*)(lds + RS_OFF))[slot * 256 + (r & 255)];
#pragma unroll
                for (int bj = 0; bj < 2; ++bj) store_a8(Y + (size_t)r * (KS * ld), ld, col0 + bj * HALF, acc[ai][bj][m][0] * il, acc[ai][bj][m][1] * il);
                asm volatile("" ::: "memory"); }
    }
};

struct EpiExpPN {
    static constexpr bool PERM = true, AFTER_DRAIN = false;
    bf16_t* P; int ldc, colbase; PG8_LAS unsigned char* lds; float bound;
    __device__ __forceinline__ void operator()(const f32x4 (&acc)[2][2][4][2], const Unit& u, int wr, int wc, int fr, int fq) const {
        EPI_FRESH_LANE();
        const int rin0 = wr * 64 + fr, col0 = colbase + wc * 32 + 8 * fq; const int slot = rs_slot(lds, u);
        const PG8_LAS float* rst = (const PG8_LAS float*)(lds + RS_OFF) + slot * 256; PG8_LAS float* part = (PG8_LAS float*)(lds + RS_OFF + 8192);
#pragma unroll
        for (int ai = 0; ai < 2; ++ai)
#pragma unroll
            for (int m = 0; m < 4; ++m) { const int rin = rin0 + ai * HALF + m * 16; const float rs = rst[rin]; float s = 0.f;
#pragma unroll
                for (int bj = 0; bj < 2; ++bj)
#pragma unroll
                    for (int j = 0; j < 4; ++j) s += __builtin_amdgcn_exp2f(acc[ai][bj][m][0][j] * rs - bound) + __builtin_amdgcn_exp2f(acc[ai][bj][m][1][j] * rs - bound);
                s += sxor<16>(s); s = half_sum(s);
                if (fq == 0) part[rin * 4 + wc] = s; }
        asm volatile("s_waitcnt lgkmcnt(0)" ::: "memory"); __builtin_amdgcn_s_barrier(); asm volatile("" ::: "memory");
#pragma unroll
        for (int ai = 0; ai < 2; ++ai)
#pragma unroll
            for (int m = 0; m < 4; ++m) { const int rin = rin0 + ai * HALF + m * 16; const float rs = rst[rin]; const f32x4 p4 = *(const PG8_LAS f32x4*)(part + rin * 4);
                const float inv = 1.0f / ((p4[0] + p4[1]) + (p4[2] + p4[3])); bf16_t* prow = P + (size_t)(u.pm * BM + rin) * ldc + col0;
#pragma unroll
                for (int bj = 0; bj < 2; ++bj) { f32x4 v0, v1;
#pragma unroll
                    for (int j = 0; j < 4; ++j) { v0[j] = __builtin_amdgcn_exp2f(acc[ai][bj][m][0][j] * rs - bound) * inv; v1[j] = __builtin_amdgcn_exp2f(acc[ai][bj][m][1][j] * rs - bound) * inv; }
                    u32x4 w; w.x = cvt_pk_bf16(v0[0], v0[1]); w.y = cvt_pk_bf16(v0[2], v0[3]); w.z = cvt_pk_bf16(v1[0], v1[1]); w.w = cvt_pk_bf16(v1[2], v1[3]);
                    *(u32x4*)(prow + bj * HALF) = w; }
                asm volatile("" ::: "memory"); }
    }
};
struct EpiPlainBf16 {
    static constexpr bool PERM = true, AFTER_DRAIN = false;
    bf16_t* O; int ldc, colbase;
    __device__ __forceinline__ void operator()(const f32x4 (&acc)[2][2][4][2], const Unit& u, int wr, int wc, int fr, int fq) const {
        EPI_FRESH_LANE();
        const int row0 = u.pm * BM + wr * 64 + fr, col0 = colbase + u.pn * BM + wc * 32 + 8 * fq;
#pragma unroll
        for (int ai = 0; ai < 2; ++ai)
#pragma unroll
            for (int m = 0; m < 4; ++m) { bf16_t* orow = O + (size_t)(row0 + ai * HALF + m * 16) * ldc + col0;
#pragma unroll
                for (int bj = 0; bj < 2; ++bj) { const f32x4 v0 = acc[ai][bj][m][0], v1 = acc[ai][bj][m][1];
                    u32x4 w; w.x = cvt_pk_bf16(v0[0], v0[1]); w.y = cvt_pk_bf16(v0[2], v0[3]); w.z = cvt_pk_bf16(v1[0], v1[1]); w.w = cvt_pk_bf16(v1[2], v1[3]);
                    *(u32x4*)(orow + bj * HALF) = w; }
                asm volatile("" ::: "memory"); }
    }
};
template <class Epi, class Sched, bool ALIGN_EPI = false, bool SP2 = false>
__device__ __forceinline__ void gemm_phase(PG8_LAS unsigned char* lds, const Gemm g, const Sched& S, const Epi& E, int wid_in) {
    int zero_ = 0; asm volatile("" : "+s"(zero_));
    const int lane = (int)__builtin_amdgcn_mbcnt_hi(~0u, __builtin_amdgcn_mbcnt_lo(~0u, (unsigned)zero_));
    const int wid = wid_in, tid = wid * 64 + lane, wr = wid >> 2, wc = wid & 3, fr = lane & 15, fq = lane >> 4;
    const int K = g.K, nt = K / BK;
    unsigned voffA[2], voffB[2];
#pragma unroll
    for (int i = 0; i < 2; ++i) { int R, C; stage_rc(tid * 16 + i * 8192, R, C); const int Rb = Epi::PERM ? ((R & ~31) + perm32(R & 31)) : R;
        voffA[i] = (unsigned)(R * K + C) * 2u; voffB[i] = (unsigned)(Rb * K + C) * 2u; }
    const size_t kstep = (size_t)(BK * 2);
    const size_t hstep = (size_t)HALF * K * 2;
    const size_t tstep = 2 * hstep;
    const unsigned ldsw = (unsigned)wid * 1024u;
    const int aoff = lds_byte(wr * 64 + fr, fq * 8), boff = lds_byte(wc * 32 + fr, fq * 8);
#define PG8_SA(b, h) (((b) * 2 + (h)) * HTB)
#define PG8_SB(b, h) ((4 + (b) * 2 + (h)) * HTB)
#define PG8_STAGE(bufoff, gbase, voff) do { _Pragma("unroll") for (int _i = 0; _i < 2; ++_i) \
        __builtin_amdgcn_global_load_lds((const unsigned*)((const char*)(gbase) + (voff)[_i]), (PG8_LAS unsigned*)(lds + (bufoff) + ldsw + _i * 8192), 16, 0, 0); } while (0)
#define PG8_LDA(dst, b, h) do { _Pragma("unroll") for (int m = 0; m < 4; ++m) _Pragma("unroll") for (int k = 0; k < 2; ++k) dst[m][k] = *(const PG8_LAS bf16x8*)(lds + PG8_SA(b, h) + aoff + m * 2048 + k * 1024); } while (0)
#define PG8_LDB(dst, b, h) do { _Pragma("unroll") for (int n = 0; n < 2; ++n) _Pragma("unroll") for (int k = 0; k < 2; ++k) dst[n][k] = *(const PG8_LAS bf16x8*)(lds + PG8_SB(b, h) + boff + n * 2048 + k * 1024); } while (0)
#define PG8_MMA(ai, bj, At, Bt) do { __builtin_amdgcn_s_setprio(1); _Pragma("unroll") for (int m = 0; m < 4; ++m) _Pragma("unroll") for (int n = 0; n < 2; ++n) _Pragma("unroll") for (int k = 0; k < 2; ++k) \
        acc[ai][bj][m][n] = __builtin_amdgcn_mfma_f32_16x16x32_bf16(Bt[n][k], At[m][k], acc[ai][bj][m][n], 0, 0, 0); __builtin_amdgcn_s_setprio(0); } while (0)
#define PG8_WAIT_V(n) asm volatile("s_waitcnt vmcnt(" #n ")" ::: "memory")
#define PG8_WAIT_L(n) asm volatile("s_waitcnt lgkmcnt(" #n ")" ::: "memory")
#define PG8_BAR __builtin_amdgcn_s_barrier()
#define PG8_SCHED __builtin_amdgcn_sched_barrier(0)
    Unit cur, nxt; int ui = 0;
    if (!S.next(0, cur)) return;
    f32x4 acc[2][2][4][2];
#pragma unroll
    for (int a = 0; a < 2; ++a)
#pragma unroll
        for (int b = 0; b < 2; ++b)
#pragma unroll
            for (int m = 0; m < 4; ++m)
#pragma unroll
                for (int n = 0; n < 2; ++n) acc[a][b][m][n] = (f32x4){0.f, 0.f, 0.f, 0.f};
    bf16x8 At[4][2], B0[2][2], B1[2][2];
    const char* cA = (const char*)g.A + (size_t)cur.pm * tstep; const char* cB = (const char*)g.Bt + (size_t)cur.pn * tstep;
    S.a_ready(cur);
    if constexpr (SP2) {
        PG8_STAGE(PG8_SB(0, 0), cB, voffB); PG8_STAGE(PG8_SB(0, 1), cB + hstep, voffB); PG8_STAGE(PG8_SA(0, 0), cA, voffA); PG8_STAGE(PG8_SA(0, 1), cA + hstep, voffA);
        if (wr == 1) PG8_BAR;
        PG8_WAIT_V(2); PG8_BAR;
        PG8_STAGE(PG8_SB(1, 0), cB + kstep, voffB); PG8_STAGE(PG8_SA(1, 0), cA + kstep, voffA); PG8_STAGE(PG8_SB(1, 1), cB + hstep + kstep, voffB);
        PG8_WAIT_V(6); PG8_BAR;
    } else {
        PG8_STAGE(PG8_SB(0, 0), cB, voffB); PG8_STAGE(PG8_SA(0, 0), cA, voffA); PG8_STAGE(PG8_SB(0, 1), cB + hstep, voffB); PG8_STAGE(PG8_SA(0, 1), cA + hstep, voffA);
        if (wr == 1) PG8_BAR;
        PG8_WAIT_V(4); PG8_BAR;
        PG8_STAGE(PG8_SB(1, 0), cB + kstep, voffB); PG8_STAGE(PG8_SA(1, 0), cA + kstep, voffA); PG8_STAGE(PG8_SB(1, 1), cB + hstep + kstep, voffB);
        PG8_WAIT_V(6); PG8_BAR;
    }
    for (;;) {
        const bool has_next = S.next(ui + 1, nxt);
        const char* nA = has_next ? (const char*)g.A + (size_t)nxt.pm * tstep : cA; const char* nB = has_next ? (const char*)g.Bt + (size_t)nxt.pn * tstep : cB;
        for (int t = 0; t < nt; t += 2) {
            const bool last = (t == nt - 2);
            const char* a1 = cA + (size_t)(t + 1) * kstep;
            const char* a2 = last ? nA : cA + (size_t)(t + 2) * kstep; const char* b2 = last ? nB : cB + (size_t)(t + 2) * kstep;
            const char* a3 = a2 + kstep; const char* b3 = b2 + kstep;
            if (last && has_next) S.a_ready(nxt);
            if constexpr (SP2) {
            PG8_LDB(B0, 0, 0); PG8_LDB(B1, 0, 1); PG8_SCHED; PG8_LDA(At, 0, 0); PG8_STAGE(PG8_SA(1, 1), a1 + hstep, voffA);
            PG8_WAIT_V(8); PG8_WAIT_L(0); PG8_BAR; PG8_MMA(0, 0, At, B0); PG8_MMA(0, 1, At, B1); PG8_BAR; PG8_SCHED;
            PG8_LDA(At, 0, 1); PG8_STAGE(PG8_SB(0, 0), b2, voffB); PG8_STAGE(PG8_SB(0, 1), b2 + hstep, voffB); PG8_STAGE(PG8_SA(0, 0), a2, voffA);
            PG8_WAIT_V(8); PG8_WAIT_L(0); PG8_BAR; PG8_MMA(1, 0, At, B0); PG8_MMA(1, 1, At, B1); PG8_BAR; PG8_SCHED;
            PG8_LDB(B0, 1, 0); PG8_LDB(B1, 1, 1); PG8_SCHED; PG8_LDA(At, 1, 0); PG8_STAGE(PG8_SA(0, 1), a2 + hstep, voffA);
            PG8_WAIT_V(8); PG8_WAIT_L(0); PG8_BAR; PG8_MMA(0, 0, At, B0); PG8_MMA(0, 1, At, B1); PG8_BAR; PG8_SCHED;
            PG8_LDA(At, 1, 1); PG8_STAGE(PG8_SB(1, 0), b3, voffB); PG8_STAGE(PG8_SB(1, 1), b3 + hstep, voffB); PG8_STAGE(PG8_SA(1, 0), a3, voffA);
            PG8_WAIT_V(8); PG8_WAIT_L(0); PG8_BAR; PG8_MMA(1, 0, At, B0); PG8_MMA(1, 1, At, B1); PG8_BAR; PG8_SCHED;
            } else {
            PG8_LDB(B0, 0, 0); PG8_SCHED; PG8_LDA(At, 0, 0); PG8_STAGE(PG8_SA(1, 1), a1 + hstep, voffA);
            PG8_WAIT_L(8); PG8_BAR; PG8_WAIT_L(0); PG8_MMA(0, 0, At, B0); PG8_BAR; PG8_SCHED;
            PG8_LDB(B1, 0, 1); PG8_STAGE(PG8_SB(0, 0), b2, voffB);
            PG8_BAR; PG8_WAIT_L(0); PG8_MMA(0, 1, At, B1); PG8_BAR;
            PG8_LDA(At, 0, 1); PG8_STAGE(PG8_SA(0, 0), a2, voffA);
            PG8_BAR; PG8_WAIT_L(0); PG8_MMA(1, 0, At, B0); PG8_BAR; PG8_SCHED;
            PG8_STAGE(PG8_SB(0, 1), b2 + hstep, voffB);
            PG8_WAIT_V(6); PG8_BAR; PG8_MMA(1, 1, At, B1); PG8_BAR;
            PG8_LDB(B0, 1, 0); PG8_SCHED; PG8_LDA(At, 1, 0); PG8_STAGE(PG8_SA(0, 1), a2 + hstep, voffA);
            PG8_WAIT_L(8); PG8_BAR; PG8_WAIT_L(0); PG8_MMA(0, 0, At, B0); PG8_BAR; PG8_SCHED;
            PG8_LDB(B1, 1, 1); PG8_STAGE(PG8_SB(1, 0), b3, voffB);
            PG8_BAR; PG8_WAIT_L(0); PG8_MMA(0, 1, At, B1); PG8_BAR;
            PG8_LDA(At, 1, 1); PG8_STAGE(PG8_SA(1, 0), a3, voffA);
            PG8_BAR; PG8_WAIT_L(0); PG8_MMA(1, 0, At, B0); PG8_BAR; PG8_SCHED;
            PG8_STAGE(PG8_SB(1, 1), b3 + hstep, voffB);
            PG8_WAIT_V(6); PG8_BAR; PG8_MMA(1, 1, At, B1); PG8_BAR;
            }
        }
        if constexpr (ALIGN_EPI) { if (wr == 0) PG8_BAR; }
        if constexpr (!Epi::AFTER_DRAIN) { E(acc, cur, wr, wc, fr, fq); S.done(cur); }
        if (!has_next) break;
#pragma unroll
        for (int a = 0; a < 2; ++a)
#pragma unroll
            for (int b = 0; b < 2; ++b)
#pragma unroll
                for (int m = 0; m < 4; ++m)
#pragma unroll
                    for (int n = 0; n < 2; ++n) acc[a][b][m][n] = (f32x4){0.f, 0.f, 0.f, 0.f};
        cur = nxt; cA = nA; cB = nB; ++ui;
        if constexpr (ALIGN_EPI) { if (wr == 1) PG8_BAR; }
    }
    PG8_WAIT_V(0);
    if constexpr (!ALIGN_EPI) { if (wr == 0) PG8_BAR; }
    PG8_BAR;
    if constexpr (Epi::AFTER_DRAIN) { E.fused(acc, cur, wr, wc, fr, fq, lds, wid, lane); S.done(cur); }
#undef PG8_SA
#undef PG8_SB
#undef PG8_STAGE
#undef PG8_LDA
#undef PG8_LDB
#undef PG8_MMA
#undef PG8_WAIT_V
#undef PG8_WAIT_L
#undef PG8_BAR
#undef PG8_SCHED
}
}
#define PG8_SP2 true
#define PG8_ALIGN true
constexpr int T = 8192, D = 2048, DIN = 6688, NIN = 6912, DFF = 8192, MEM = 256, DEPTH = 4;
constexpr int NCMP = 511, NCH = 128;
constexpr float EPS = 1e-6f;
constexpr int ZC_HGQ = 0, ZC_HGF = 512, ZC_HGI = 1024, ZC_HGG = 1536, ZC_NSQ = 2048, ZC_NKC = 3072, ZC_NVC = 3328, ZC_NKS = 3584, ZC_NVS = 3840, ZC_NKW = 4096, ZC_NVW = 4352,
              ZC_MLQ = 4608, ZC_MLK = 5120, ZC_MLV = 5632, ZC_MLO = 6144, ZC_GATE = 6656, ZC_MLI = 6680, ZC_MLF = 6684;
__host__ __device__ __forceinline__ int zcol_src(int j) {
    if (j < 4608) return j; if (j < 6656) return j + 24; if (j < 6680) return j - 6656 + 4608; if (j < 6688) return j; return -1; }
#ifndef K4PER_
#define K4PER_ 24
#endif
constexpr int NPH = 12;
constexpr int NPHASES = 1 + DEPTH * NPH;

constexpr size_t MiB = 1u << 20;
constexpr size_t al256(size_t x) { return (x + 255) & ~(size_t)255; }
constexpr size_t WS_CTL = 0, CTL_ZERO_BYTES = 1 * MiB;
constexpr size_t SZ_DD = (size_t)D * D * KS * 2;
constexpr size_t WS_WIN = CTL_ZERO_BYTES;
constexpr size_t WS_WOUT = WS_WIN + (size_t)NIN * D * KS * 2;
constexpr size_t WS_WQ = WS_WOUT + SZ_DD, WS_WO = WS_WQ + SZ_DD, WS_WKV = WS_WO + SZ_DD;
constexpr size_t WS_W1 = WS_WKV + 2 * SZ_DD;
constexpr size_t WS_W2 = WS_W1 + (size_t)DFF * D * KS * 2;
constexpr size_t WS_WCF = WS_W2 + (size_t)DFF * D * KS * 2;
constexpr size_t WS_BPERM = WS_WCF + (size_t)2 * 4 * 256 * 512 * 2;
constexpr size_t WS_WSET = al256(WS_BPERM + NIN * 4) - WS_WIN;
#ifndef XFUSE
#define XFUSE (KS == 1)
#endif
#ifndef WOVL
#define WOVL (KS == 1)
#endif
constexpr size_t WS_A0 = WS_WIN + (WOVL ? 2 : 1) * WS_WSET;
constexpr size_t WS_A1 = WS_A0 + (size_t)T * D * KS * 2;
constexpr size_t WS_MEMB = WS_A1 + (size_t)T * D * KS * 2;
constexpr size_t WS_SSQA = WS_MEMB + (size_t)MEM * D * KS * 2;
constexpr size_t WS_SSQB = WS_SSQA + 32 * T * 4, WS_SSQC = WS_SSQB + 32 * T * 4, WS_SSQM = WS_SSQC + 32 * T * 4;
constexpr size_t WS_LB = WS_SSQM + MEM * 4;
constexpr size_t WS_COS = WS_LB + DEPTH * 512 * 4, WS_SIN = WS_COS + (size_t)T * 64 * 4;
constexpr size_t WS_KVX = WS_SIN + (size_t)T * 64 * 4;
constexpr size_t WS_KXN = WS_KVX + (size_t)MEM * 2 * D * 4;
constexpr size_t WS_KCN = WS_KXN + (size_t)MEM * D * 4;
constexpr size_t WS_VCN = WS_KCN + 2 * 512 * 128 * 4;
constexpr size_t WS_HGDEC = WS_VCN + 2 * 512 * 128 * 4;
constexpr size_t WS_MLNL = WS_HGDEC + NCH * 512 * 4, WS_MLN = WS_MLNL + NCH * 512 * 4;
constexpr size_t WS_MLSC = WS_MLN + NCH * 512 * 4;
constexpr size_t WS_KXF = al256(WS_MLSC + 3 * NCH * 4 * 4);
constexpr size_t WS_VXF = WS_KXF + (size_t)MEM * D * 2;
constexpr size_t WS_QSS = WS_VXF + (size_t)MEM * D * 2;
constexpr size_t WS_LPX = WS_QSS + (size_t)32 * T * 4;
constexpr size_t WS_BTC = WS_LPX + (size_t)16 * T * 4;
constexpr size_t WS_R = al256(WS_BTC + (size_t)D * 1024 * 2);
constexpr size_t WS_Z = WS_R;
constexpr size_t WS_XQ = WS_R;
constexpr size_t WS_XQB = WS_R;
constexpr size_t WS_PH = WS_R + (size_t)T * D * 2;
constexpr size_t WS_NSQ = WS_Z + (size_t)T * NIN * 4;
constexpr size_t SZ_ORA = ORACLE_ATTN ? (size_t)T * 256 * 4 : 0;
constexpr size_t WS_NKS = WS_NSQ + 4 * SZ_ORA, WS_NKW = WS_NKS + SZ_ORA;
constexpr size_t WS_MLQ = WS_NKW + SZ_ORA, WS_MLK = WS_MLQ + (size_t)T * 512 * 4;
constexpr size_t SZ_ST = (size_t)NCH * 4 * 128 * 128 * 4;
constexpr size_t SZ_STO = ORACLE_MIX ? SZ_ST : 0;
constexpr size_t WS_HGU = WS_MLK + (size_t)T * 512 * 4, WS_HGS = WS_HGU + SZ_ST, WS_MLU = WS_HGS + SZ_STO, WS_MLS = WS_MLU + SZ_ST;
constexpr size_t WS_QN = WS_MLS + SZ_STO;
constexpr size_t SZ_KF = (size_t)2 * T * 128 * 2;
constexpr size_t WS_KSF = WS_QN + (size_t)T * 1024 * 2, WS_KWF = WS_KSF + SZ_KF, WS_VSF = WS_KWF + SZ_KF, WS_VWF = WS_VSF + SZ_KF;
constexpr size_t WS_KCF = WS_VWF + SZ_KF, WS_VCF = WS_KCF + 2 * 16 * 4096 * 2;
constexpr size_t WS_OC = WS_VCF + 2 * 16 * 4096 * 2;
constexpr size_t WS_SELG = WS_OC + (size_t)T * 1024 * 4;
constexpr size_t WS_HGST = WS_SELG + (size_t)T * 2 * 16 * 4;
constexpr size_t WS_MLST = WS_HGST + SZ_ST / 2;
constexpr size_t WS_MIX_END = WS_MLST + SZ_ST / 2;
constexpr size_t WS_HM = WS_R;
constexpr size_t WS_R_END1 = WS_MIX_END, WS_R_END2 = WS_HM + (size_t)T * DFF * KS * 2;
constexpr size_t WS_END = WS_R_END1 > WS_R_END2 ? WS_R_END1 : WS_R_END2;

constexpr int CW_TMO = 0;
constexpr int CW_BAR = 4096;
constexpr int LDS_SCR = 155648;
constexpr int MISC_OFF = LDS_SCR;
constexpr int LDS_BYTES = LDS_SCR + 1024;
constexpr int WAVE_SCR = LDS_SCR / 8;

#define GAS __attribute__((address_space(1)))
#define LAS __attribute__((address_space(3)))
typedef unsigned short bf16;
typedef unsigned v4u __attribute__((ext_vector_type(4)));
typedef unsigned v2u __attribute__((ext_vector_type(2)));
typedef float f32x4 __attribute__((ext_vector_type(4)));
typedef float f32x2 __attribute__((ext_vector_type(2)));
typedef GAS unsigned gu32;
#define RLX_AGENT __ATOMIC_RELAXED, __HIP_MEMORY_SCOPE_AGENT
#define LDS_WAIT() asm volatile("s_waitcnt lgkmcnt(0)" ::: "memory")
__device__ __forceinline__ unsigned f2bf(float f) { unsigned u = __builtin_bit_cast(unsigned, f); return (u + 0x7fffu + ((u >> 16) & 1u)) >> 16; }
__device__ __forceinline__ float bf2f(unsigned b) { return __builtin_bit_cast(float, b << 16); }
__device__ __forceinline__ unsigned pk2(float lo, float hi) { return f2bf(lo) | (f2bf(hi) << 16); }
__device__ __forceinline__ float lo_of(float v) { return v - bf2f(f2bf(v)); }
__device__ __forceinline__ void storeA1(bf16* rowp, int Kreal, int col, float v) { const unsigned h = f2bf(v); rowp[col] = (bf16)h;
#if KS == 3
    rowp[Kreal + col] = (bf16)h; rowp[2 * Kreal + col] = (bf16)f2bf(v - bf2f(h));
#endif
}
__device__ __forceinline__ void storeA2(bf16* rowp, int Kreal, int col, float a, float b) { *(unsigned*)(rowp + col) = pk2(a, b);
#if KS == 3
    *(unsigned*)(rowp + Kreal + col) = pk2(a, b); *(unsigned*)(rowp + 2 * Kreal + col) = pk2(lo_of(a), lo_of(b));
#endif
}
__device__ __forceinline__ void storeA4(bf16* rowp, int Kreal, int col, f32x4 v) { v2u w; w.x = pk2(v[0], v[1]); w.y = pk2(v[2], v[3]); *(v2u*)(rowp + col) = w;
#if KS == 3
    *(v2u*)(rowp + Kreal + col) = w; v2u l; l.x = pk2(lo_of(v[0]), lo_of(v[1])); l.y = pk2(lo_of(v[2]), lo_of(v[3])); *(v2u*)(rowp + 2 * Kreal + col) = l;
#endif
}
__device__ __forceinline__ float wave_sum(float v) { v += sxor<1>(v); v += sxor<2>(v); v += sxor<4>(v); v += sxor<8>(v); v += sxor<16>(v); return half_sum(v); }
__device__ __forceinline__ float wave_max(float v) { v = fmaxf(v, sxor<1>(v)); v = fmaxf(v, sxor<2>(v)); v = fmaxf(v, sxor<4>(v)); v = fmaxf(v, sxor<8>(v)); v = fmaxf(v, sxor<16>(v)); return half_max(v); }
#define ARGMAX_STEP(M) do { const float ov_ = sxor<M>(bv); const int oi_ = sxori<M>(bi); if (ov_ > bv || (ov_ == bv && oi_ < bi)) { bv = ov_; bi = oi_; } } while (0)
__device__ __forceinline__ void wave_argmax(float& bv, int& bi) { ARGMAX_STEP(1); ARGMAX_STEP(2); ARGMAX_STEP(4); ARGMAX_STEP(8); ARGMAX_STEP(16);
    unsigned va = __builtin_bit_cast(unsigned, bv), vb = va, ia = (unsigned)bi, ib = ia; swap32(va, vb); swap32(ia, ib);
    const float v0 = __builtin_bit_cast(float, va), v1 = __builtin_bit_cast(float, vb); const int i0 = (int)ia, i1 = (int)ib;
    if (v0 > v1 || (v0 == v1 && i0 < i1)) { bv = v0; bi = i0; } else { bv = v1; bi = i1; } }
__device__ __forceinline__ float sigmoidf_(float x) { return 1.0f / (1.0f + __expf(-x)); }
#define XB_TMO      128
#define XB_XCNT(j)  (256  + 64 * (j))
#define XB_XSUB(j)  (1280 + 64 * (j))
#define XB_XGEN(j)  (2304 + 64 * (j))
#define XB_TOP      3328
#define XB_TOPGEN   3392
#define XCD_BAR_WORDS 3456
#define XB_SPIN_CAP (1u << 18)

__device__ __forceinline__ unsigned xb_ld(unsigned* p)              { return __hip_atomic_load(p, __ATOMIC_RELAXED, __HIP_MEMORY_SCOPE_AGENT); }
__device__ __forceinline__ unsigned xb_add(unsigned* p, unsigned v) { return __hip_atomic_fetch_add(p, v, __ATOMIC_RELAXED, __HIP_MEMORY_SCOPE_AGENT); }
__device__ __forceinline__ unsigned xb_xcc_id() { return (unsigned)__builtin_amdgcn_s_getreg((3 << 11) | 20) & 0xFu; }
#define XB_SPIN(cond, bar) do { unsigned _sp = 0; while (cond) { __builtin_amdgcn_s_sleep(1); \
    if ((++_sp & 255u) == 0u) { if (xb_ld(&(bar)[XB_TMO])) break; if (_sp > XB_SPIN_CAP) { atomicAdd(&(bar)[XB_TMO], 1u); break; } } } } while (0)

struct XcdBarrier {
    unsigned* bar; unsigned x;
    volatile LAS unsigned* st;
};

__device__ __forceinline__ XcdBarrier xcd_barrier_post(unsigned* bar, volatile LAS unsigned* st) {
    XcdBarrier b; b.bar = bar; b.x = xb_xcc_id(); b.st = st;
    if (threadIdx.x == 0) (void)xb_add(&bar[XB_XCNT(b.x)], 1u);
    return b;
}
__device__ __forceinline__ void xcd_barrier_complete(unsigned* bar, unsigned x, unsigned& nloc, unsigned& nx) {
    const unsigned G = gridDim.x * gridDim.y * gridDim.z;
    unsigned sum, cnt, mine, sp = 0u;
    for (;;) {
        sum = 0u; cnt = 0u; mine = 0u;
#pragma unroll
        for (unsigned j = 0; j < 16; ++j) { const unsigned c = xb_ld(&bar[XB_XCNT(j)]); sum += c; cnt += (c > 0u) ? 1u : 0u; mine = (j == x) ? c : mine; }
        if (sum == G) break;
        __builtin_amdgcn_s_sleep(1);
        if ((++sp & 255u) == 0u) { if (xb_ld(&bar[XB_TMO])) break; if (sp > XB_SPIN_CAP) { atomicAdd(&bar[XB_TMO], 1u); break; } }
    }
    nloc = mine > 0u ? mine : 1u; nx = cnt > 0u ? cnt : 1u;
}

__device__ __forceinline__ void xcd_barrier(const XcdBarrier& b) {
    asm volatile("s_waitcnt vmcnt(0)" ::: "memory");
    __syncthreads();
    if (threadIdx.x == 0) {
        unsigned* bar = b.bar;
        __builtin_amdgcn_s_waitcnt(0);
        unsigned nloc = b.st[0], nx = b.st[1];
        if (nloc == 0u) { xcd_barrier_complete(bar, b.x, nloc, nx); b.st[0] = nloc; b.st[1] = nx; }
        const unsigned old = xb_add(&bar[XB_XSUB(b.x)], 1u);
        const unsigned gen = old / nloc;
        if (old + 1u == (gen + 1u) * nloc) {
            __builtin_amdgcn_fence(__ATOMIC_RELEASE, "agent");
            asm volatile("s_waitcnt vmcnt(0)" ::: "memory");
            const unsigned og = xb_add(&bar[XB_TOP], 1u);
            const unsigned tg = og / nx;
            if (og + 1u == (tg + 1u) * nx) xb_add(&bar[XB_TOPGEN], 1u);
            else XB_SPIN(xb_ld(&bar[XB_TOPGEN]) == tg, bar);
            __builtin_amdgcn_fence(__ATOMIC_ACQUIRE, "agent");
            xb_add(&bar[XB_XGEN(b.x)], 1u);
            asm volatile("s_waitcnt vmcnt(0)" ::: "memory");
        } else {
            XB_SPIN(xb_ld(&bar[XB_XGEN(b.x)]) == gen, bar);
            __builtin_amdgcn_fence(__ATOMIC_ACQUIRE, "agent");
            asm volatile("s_waitcnt vmcnt(0)" ::: "memory");
        }
    }
    __syncthreads();
}


__device__ __forceinline__ void xcd_barrier_arrive(const XcdBarrier& b) {
    asm volatile("s_waitcnt vmcnt(0)" ::: "memory");
    __syncthreads();
    if (threadIdx.x == 0) {
        unsigned* bar = b.bar;
        __builtin_amdgcn_s_waitcnt(0);
        unsigned nloc = b.st[0], nx = b.st[1];
        if (nloc == 0u) { xcd_barrier_complete(bar, b.x, nloc, nx); b.st[0] = nloc; b.st[1] = nx; }
        const unsigned old = xb_add(&bar[XB_XSUB(b.x)], 1u);
        const unsigned gen = old / nloc;
        if (old + 1u == (gen + 1u) * nloc) {
            __builtin_amdgcn_fence(__ATOMIC_RELEASE, "agent");
            asm volatile("s_waitcnt vmcnt(0)" ::: "memory");
            const unsigned og = xb_add(&bar[XB_TOP], 1u);
            const unsigned tg = og / nx;
            if (og + 1u == (tg + 1u) * nx) xb_add(&bar[XB_TOPGEN], 1u);
            else XB_SPIN(xb_ld(&bar[XB_TOPGEN]) == tg, bar);
            __builtin_amdgcn_fence(__ATOMIC_ACQUIRE, "agent");
            xb_add(&bar[XB_XGEN(b.x)], 1u);
            asm volatile("s_waitcnt vmcnt(0)" ::: "memory");
            b.st[2] = 0xFFFFFFFFu;
        } else b.st[2] = gen;
    }
}
__device__ __forceinline__ void xcd_barrier_wait(const XcdBarrier& b) {
    if (threadIdx.x == 0) {
        const unsigned gen = b.st[2];
        if (gen != 0xFFFFFFFFu) {
            XB_SPIN(xb_ld(&b.bar[XB_XGEN(b.x)]) == gen, b.bar);
            __builtin_amdgcn_fence(__ATOMIC_ACQUIRE, "agent");
            asm volatile("s_waitcnt vmcnt(0)" ::: "memory");
        }
    }
    __syncthreads();
}
struct KArgs { const float* in[25]; float* out; unsigned char* ws; int ph_lo, ph_hi, li, pad; };
struct Frame {
    LAS unsigned char* lds;
    volatile LAS unsigned* MISC;
    gu32* ctl;
    int tid, lane, wave, G, bid;
    size_t wofs;
    unsigned char* ws;
    const KArgs __attribute__((address_space(4)))* ap;
};
#define INP(i) ((const float*)F.ap->in[i])
#define OUTP   ((float*)F.ap->out)
#define LAUNDER() do { asm volatile("" : "+s"(F.ws)); asm volatile("" : "+s"(F.ap)); int z_ = 0; asm volatile("" : "+s"(z_)); F.lane = (int)__builtin_amdgcn_mbcnt_hi(~0u, __builtin_amdgcn_mbcnt_lo(~0u, (unsigned)z_)); F.tid = F.wave * 64 + F.lane; } while (0)
#define WSP(type, off) ((type*)(F.ws + (off)))
#define WSL(type, off) ((type*)(F.ws + (off) + F.wofs))
#define WSO(type, off, wo) ((type*)(F.ws + (off) + (wo)))
#define EXPF(x) __expf(x)
#define LOGF(x) __logf(x)
__device__ __forceinline__ float sigm(float x) { return __builtin_amdgcn_rcpf(1.0f + EXPF(-x)); }
__device__ __forceinline__ float siluf_(float x) { return x * __builtin_amdgcn_rcpf(1.0f + EXPF(-x)); }

__device__ const float c_invf[64] = {1.000000000e+00f, 8.659643531e-01f, 7.498942018e-01f, 6.493816376e-01f, 5.623413324e-01f, 4.869675338e-01f, 4.216965139e-01f, 3.651741147e-01f, 3.162277639e-01f, 2.738419771e-01f, 2.371373773e-01f, 2.053525001e-01f, 1.778279394e-01f, 1.539926529e-01f, 1.333521456e-01f, 1.154781953e-01f, 1.000000015e-01f, 8.659642935e-02f, 7.498942316e-02f, 6.493816525e-02f, 5.623413250e-02f, 4.869675264e-02f, 4.216964915e-02f, 3.651741147e-02f, 3.162277490e-02f, 2.738419548e-02f, 2.371373773e-02f, 2.053525113e-02f, 1.778279431e-02f, 1.539926510e-02f, 1.333521400e-02f, 1.154781971e-02f, 9.999999776e-03f, 8.659643121e-03f, 7.498942316e-03f, 6.493816152e-03f, 5.623413250e-03f, 4.869675264e-03f, 4.216964822e-03f, 3.651741194e-03f, 3.162277630e-03f, 2.738419687e-03f, 2.371373819e-03f, 2.053525066e-03f, 1.778279431e-03f, 1.539926510e-03f, 1.333521446e-03f, 1.154782018e-03f, 1.000000047e-03f, 8.659643354e-04f, 7.498941850e-04f, 6.493816036e-04f, 5.623413017e-04f, 4.869675322e-04f, 4.216965172e-04f, 3.651741135e-04f, 3.162277571e-04f, 2.738419571e-04f, 2.371373703e-04f, 2.053525095e-04f, 1.778279402e-04f, 1.539926598e-04f, 1.333521504e-04f, 1.154782003e-04f};

__device__ __forceinline__ void sincos_acc(float ang, float& s_out, float& c_out) {
    const double x = (double)ang;
    const double k = rint(x * 0.63661977236758134308);
    double r = fma(-k, 1.57079632679489655800e+00, x); r = fma(-k, 6.12323399573676603587e-17, r);
    const double r2 = r * r;
    double sp = -1.0 / 6227020800.0; sp = fma(sp, r2, 1.0 / 39916800.0); sp = fma(sp, r2, -1.0 / 362880.0); sp = fma(sp, r2, 1.0 / 5040.0); sp = fma(sp, r2, -1.0 / 120.0); sp = fma(sp, r2, 1.0 / 6.0);
    const double sn = fma(-sp * r2, r, r);
    double cp = -1.0 / 87178291200.0; cp = fma(cp, r2, 1.0 / 479001600.0); cp = fma(cp, r2, -1.0 / 3628800.0); cp = fma(cp, r2, 1.0 / 40320.0); cp = fma(cp, r2, -1.0 / 720.0); cp = fma(cp, r2, 1.0 / 24.0); cp = fma(cp, r2, -0.5);
    const double cs = fma(cp, r2, 1.0);
    const int q = ((int)k) & 3;
    const double s = (q == 0) ? sn : (q == 1) ? cs : (q == 2) ? -sn : -cs;
    const double c = (q == 0) ? cs : (q == 1) ? -sn : (q == 2) ? -cs : sn;
    s_out = (float)s; c_out = (float)c;
}

__device__ __forceinline__ void row_to_bf16_ssq(Frame& F, const float* xrow, bf16* orow, float* ssq_out, int np, int ldp) {
    const f32x4* xr = (const f32x4*)xrow + F.lane; float s = 0.f;
#pragma unroll
    for (int j = 0; j < D / 256; ++j) { const f32x4 v = xr[64 * j]; s += (v[0] * v[0] + v[1] * v[1]) + (v[2] * v[2] + v[3] * v[3]); storeA4(orow, D, 256 * j + 4 * F.lane, v); }
    s = wave_sum(s); if (F.lane < np) ssq_out[(size_t)F.lane * ldp] = (F.lane == 0) ? s : 0.f;
}

__device__ __forceinline__ void ph_prologue(Frame& F) {
    const int gw = F.bid * 8 + F.wave, NGW = F.G * 8, gt = F.bid * 512 + F.tid, NGT = F.G * 512;
    float* cosT = WSP(float, WS_COS); float* sinT = WSP(float, WS_SIN);
    for (int i = gt; i < T * 64; i += NGT) { const int pos = i >> 6, fi = i & 63; const float ang = (float)pos * c_invf[fi]; float s, c; sincos_acc(ang, s, c); cosT[i] = c; sinT[i] = s; }
    const float* lg = INP(5); float* lb = WSP(float, WS_LB);
    for (int j = gt; j < 512; j += NGT) { const float a0 = lg[j], a1 = lg[512 + j], a2 = lg[1024 + j], a3 = lg[1536 + j]; const float mx = fmaxf(fmaxf(a0, a1), fmaxf(a2, a3));
        const float e0 = EXPF(a0 - mx), e1 = EXPF(a1 - mx), e2 = EXPF(a2 - mx), e3 = EXPF(a3 - mx), inv = 1.0f / (((e0 + e1) + e2) + e3);
        const float p0 = e0 * inv, p1 = e1 * inv, p2 = e2 * inv, p3 = e3 * inv;
        lb[j] = p0 - p0; lb[512 + j] = (p0 + p1) - p0; lb[1024 + j] = ((p0 + p1) + p2) - p0; lb[1536 + j] = (((p0 + p1) + p2) + p3) - p0; }
    for (int m = gw; m < T; m += NGW) row_to_bf16_ssq(F, INP(0) + (size_t)m * D, WSP(bf16, WS_A0) + (size_t)m * (KS * D), WSP(float, WS_SSQA) + m, 32, T);
    for (int m = gw; m < MEM; m += NGW) row_to_bf16_ssq(F, INP(1) + (size_t)m * D, WSP(bf16, WS_MEMB) + (size_t)m * (KS * D), WSP(float, WS_SSQM) + m, 1, 0);
}

template <bool ZMAP, bool HSL = false>
__device__ __forceinline__ void wconv_item(const float* W, int K, int ldw, const float* gain, bf16* WT, LAS float* scr, int item, int nblk, int lane) {
    const int kb = item / nblk, nb = item % nblk, k0 = 64 * kb, n0 = 64 * nb;
    const int c4 = 4 * (lane & 15), rr = lane >> 4;
    const int nsrc = ZMAP ? zcol_src(n0 + c4) : (n0 + c4);
    f32x4 v[16];
#pragma unroll
    for (int i = 0; i < 16; ++i) v[i] = (nsrc >= 0) ? __builtin_nontemporal_load((const f32x4*)(W + (size_t)(k0 + 4 * i + rr) * ldw + nsrc)) : (f32x4){0.f, 0.f, 0.f, 0.f};
#pragma unroll
    for (int i = 0; i < 16; ++i) { const int kk = 4 * i + rr; const float gk = gain ? gain[k0 + kk] : 1.0f; LAS float* d = scr + kk * 65 + c4; d[0] = v[i][0] * gk; d[1] = v[i][1] * gk; d[2] = v[i][2] * gk; d[3] = v[i][3] * gk; }
    LDS_WAIT(); asm volatile("" ::: "memory");
    const int c = lane & 7;
#pragma unroll
    for (int j = 0; j < 8; ++j) { const int n = (lane >> 3) + 8 * j; const LAS float* s = scr + (8 * c) * 65 + n;
        float x[8];
#pragma unroll
        for (int q = 0; q < 8; ++q) x[q] = s[q * 65];
        v4u o; o.x = pk2(x[0], x[1]); o.y = pk2(x[2], x[3]); o.z = pk2(x[4], x[5]); o.w = pk2(x[6], x[7]);
        bf16* dst = HSL ? WT + ((size_t)(k0 >> 9) * (size_t)(nblk * 64) + (n0 + n)) * 512 + (k0 & 511) + 8 * c : WT + (size_t)(n0 + n) * (KS * K) + k0 + 8 * c;
        __builtin_nontemporal_store(o, (v4u*)dst);
#if KS == 3
        v4u l; l.x = pk2(lo_of(x[0]), lo_of(x[1])); l.y = pk2(lo_of(x[2]), lo_of(x[3])); l.z = pk2(lo_of(x[4]), lo_of(x[5])); l.w = pk2(lo_of(x[6]), lo_of(x[7]));
        *(v4u*)(dst + K) = l; *(v4u*)(dst + 2 * K) = o;
#endif
    }
    LDS_WAIT(); asm volatile("" ::: "memory");
}
constexpr int WC_I_IN = (D / 64) * (NIN / 64), WC_I_DD = (D / 64) * (D / 64), WC_I_1 = (D / 64) * (DFF / 64), WC_I_2 = (DFF / 64) * (D / 64);
constexpr int WC_NT = WC_I_IN + 5 * WC_I_DD + WC_I_1 + WC_I_2, WC_NALL = WC_NT + 2048 + NIN / 256;
constexpr int K4_PER = K4PER_, K4_CONV = 128 * K4_PER;
constexpr int K1_PER = 32, K1_CONV = 140 * K1_PER;
__device__ __forceinline__ void wcf_item(Frame& F, int L, size_t wo, int item);
constexpr int WC_DEF_LO = WC_I_IN + 5 * WC_I_DD, WC_DEF_N = WC_I_1 + WC_I_2;
__device__ __forceinline__ void ph_wconv(Frame& F, int L, size_t wo, int lo, int hi, int skip_lo = 1 << 30, int skip_len = 0, int w_lo = 0) {
    LAS float* scr = (LAS float*)(F.lds + F.wave * WAVE_SCR);
    const float* w_in = INP(3) + (size_t)L * D * DIN; const float* g_mix = INP(2) + L * D;
    const float* w_out = INP(13) + (size_t)L * D * D;
    const float* wq = INP(16) + (size_t)L * D * D; const float* wk = INP(17) + (size_t)L * D * D; const float* wv = INP(18) + (size_t)L * D * D; const float* wo_ = INP(19) + (size_t)L * D * D;
    const float* g_xa = INP(14) + L * D; const float* g_mem = INP(15) + L * D; const float* g_mlp = INP(22) + L * D;
    const float* w1 = INP(23) + (size_t)L * D * DFF; const float* w2 = INP(24) + (size_t)L * DFF * D;
    if (F.wave < w_lo) return;
    for (int it = lo + (F.wave - w_lo); it < hi; it += 8 - w_lo) {
        int r = it + (it >= skip_lo ? skip_len : 0);
        if (r < WC_I_IN) { wconv_item<true>(w_in, D, DIN, g_mix, WSO(bf16, WS_WIN, wo), scr, r, NIN / 64, F.lane); continue; } r -= WC_I_IN;
        if (r < WC_I_DD) { wconv_item<false>(w_out, D, D, nullptr, WSO(bf16, WS_WOUT, wo), scr, r, D / 64, F.lane); continue; } r -= WC_I_DD;
        if (r < WC_I_DD) { wconv_item<false>(wq, D, D, g_xa, WSO(bf16, WS_WQ, wo), scr, r, D / 64, F.lane); continue; } r -= WC_I_DD;
        if (r < WC_I_DD) { wconv_item<false, XFUSE != 0>(wo_, D, D, nullptr, WSO(bf16, WS_WO, wo), scr, r, D / 64, F.lane); continue; } r -= WC_I_DD;
        if (r < WC_I_DD) { wconv_item<false>(wk, D, D, g_mem, WSO(bf16, WS_WKV, wo), scr, r, D / 64, F.lane); continue; } r -= WC_I_DD;
        if (r < WC_I_DD) { wconv_item<false>(wv, D, D, g_mem, WSO(bf16, WS_WKV, wo) + (size_t)D * (KS * D), scr, r, D / 64, F.lane); continue; } r -= WC_I_DD;
        if (r < WC_I_1) { wconv_item<false>(w1, D, DFF, g_mlp, WSO(bf16, WS_W1, wo), scr, r, DFF / 64, F.lane); continue; } r -= WC_I_1;
        if (r < WC_I_2) { wconv_item<false>(w2, DFF, D, nullptr, WSO(bf16, WS_W2, wo), scr, r, D / 64, F.lane); continue; } r -= WC_I_2;
        if (r < 2048) { wcf_item(F, L, wo, r); continue; } r -= 2048;
        { float* bp = WSO(float, WS_BPERM, wo); const float* b_in = INP(4) + (size_t)L * DIN;
          for (int j = 256 * r + F.lane; j < 256 * r + 256; j += 64) { const int s = zcol_src(j); bp[j] = (s >= 0) ? b_in[s] : 0.f; } }
    }
}

__device__ __forceinline__ void normrope_head(const float* src, const float* gain, const float* cosr, const float* sinr, float& o1, float& o2, int lane) {
    const float x1 = src[lane], x2 = src[lane + 64];
    const float ss = wave_sum(x1 * x1 + x2 * x2);
    const float rs = 1.0f / sqrtf(ss * (1.0f / 128.0f) + EPS);
    const float y1 = x1 * rs * gain[lane], y2 = x2 * rs * gain[lane + 64];
    const float c = cosr[lane], s = sinr[lane];
    o1 = y1 * c - y2 * s; o2 = y2 * c + y1 * s;
}
__device__ __forceinline__ int swap23_(int r) { return (r & ~12) | ((r & 4) << 1) | ((r & 8) >> 1); }
__device__ __forceinline__ size_t kf_index_(int g, int t, int d) { return ((size_t)(g * 256 + (t >> 5)) * 4096) + (d >> 4) * 512 + (swap23_(t & 31) + 32 * ((d >> 3) & 1)) * 8 + (d & 7); }
__device__ __forceinline__ void ph_prep(Frame& F, int L, int w_lo) {
    if (F.wave < w_lo) return;
    const int gw = F.bid * (8 - w_lo) + (F.wave - w_lo), NGW = F.G * (8 - w_lo), lane = F.lane;
    const float* z = WSP(float, WS_Z);
    const float* qg = INP(7) + L * 128; const float* kg = INP(8) + L * 3 * 128; const float* cw = INP(11) + (size_t)L * 4 * 1024;
    const float* cosT = WSP(float, WS_COS); const float* sinT = WSP(float, WS_SIN);
#if ORACLE_ATTN
    float* nsq = WSP(float, WS_NSQ); float* nks = WSP(float, WS_NKS); float* nkw = WSP(float, WS_NKW);
#endif
    float* mlq = WSP(float, WS_MLQ); float* mlk = WSP(float, WS_MLK);
    const float qscale = 0.08838834764831845f;
    bf16* qn = WSP(bf16, WS_QN); bf16* ksf = WSP(bf16, WS_KSF); bf16* kwf = WSP(bf16, WS_KWF);
    for (int t = gw; t < T; t += NGW) {
        const float* zr = z + (size_t)t * NIN; const float c = cosT[t * 64 + lane], s = sinT[t * 64 + lane];
        float x1[12], x2[12], ss[12];
#pragma unroll
        for (int i = 0; i < 12; ++i) { const int col = (i < 8) ? ZC_NSQ + i * 128 : (i < 10) ? ZC_NKS + (i - 8) * 128 : ZC_NKW + (i - 10) * 128; x1[i] = zr[col + lane]; x2[i] = zr[col + lane + 64]; ss[i] = x1[i] * x1[i] + x2[i] * x2[i]; }
#pragma unroll
        for (int i = 0; i < 12; ++i) ss[i] += sxor<1>(ss[i]);
#pragma unroll
        for (int i = 0; i < 12; ++i) ss[i] += sxor<2>(ss[i]);
#pragma unroll
        for (int i = 0; i < 12; ++i) ss[i] += sxor<4>(ss[i]);
#pragma unroll
        for (int i = 0; i < 12; ++i) ss[i] += sxor<8>(ss[i]);
#pragma unroll
        for (int i = 0; i < 12; ++i) ss[i] += sxor<16>(ss[i]);
#pragma unroll
        for (int i = 0; i < 12; ++i) ss[i] = half_sum(ss[i]);
#pragma unroll
        for (int i = 0; i < 12; ++i) { const float* gn = (i < 8) ? qg : (i < 10) ? kg + 128 : kg + 256; const float rs = 1.0f / sqrtf(ss[i] * (1.0f / 128.0f) + EPS);
            const float y1 = x1[i] * rs * gn[lane], y2 = x2[i] * rs * gn[lane + 64]; const float o1 = y1 * c - y2 * s, o2 = y2 * c + y1 * s;
            if (i < 8) { qn[(size_t)t * 1024 + i * 128 + lane] = (bf16)f2bf(o1 * (qscale * 1.4426950408889634f)); qn[(size_t)t * 1024 + i * 128 + lane + 64] = (bf16)f2bf(o2 * (qscale * 1.4426950408889634f));
#if ORACLE_ATTN
                nsq[(size_t)t * 1024 + i * 128 + lane] = o1 * qscale; nsq[(size_t)t * 1024 + i * 128 + lane + 64] = o2 * qscale;
#endif
            } else { bf16* kf = (i < 10) ? ksf : kwf; const int hh = (i - 8) & 1; kf[kf_index_(hh, t, lane)] = (bf16)f2bf(o1); kf[kf_index_(hh, t, lane + 64)] = (bf16)f2bf(o2);
#if ORACLE_ATTN
                float* kn = (i < 10) ? nks : nkw; kn[(size_t)t * 256 + hh * 128 + lane] = o1; kn[(size_t)t * 256 + hh * 128 + lane + 64] = o2;
#endif
            } }
#if ORACLE_MIX
        for (int i = 0; i < 16; ++i) { const int ch = lane + 64 * i; const int zc = (ch < 512) ? (ZC_MLQ + ch) : (ZC_MLK + ch - 512); float a = 0.f;
#pragma unroll
            for (int j = 0; j < 4; ++j) { const int tt = t - 3 + j; if (tt >= 0) a += cw[j * 1024 + ch] * z[(size_t)tt * NIN + zc]; }
            a = siluf_(a); if (ch < 512) mlq[(size_t)t * 512 + ch] = a * qscale; else mlk[(size_t)t * 512 + ch - 512] = a; }
#endif
    }
    { bf16* vsf = WSP(bf16, WS_VSF); bf16* vwf = WSP(bf16, WS_VWF);
      for (int tg8 = gw; tg8 < T / 8; tg8 += NGW) { const int t0 = 8 * tg8;
#pragma unroll
          for (int which = 0; which < 2; ++which)
#pragma unroll
              for (int g = 0; g < 2; ++g)
#pragma unroll
                  for (int dd = 0; dd < 2; ++dd) { const int d = lane + 64 * dd; const float* src = z + (size_t)t0 * NIN + (which ? ZC_NVW : ZC_NVS) + g * 128 + d; float v[8];
#pragma unroll
                      for (int j = 0; j < 8; ++j) v[j] = src[(size_t)j * NIN];
                      v4u o; o.x = pk2(v[0], v[1]); o.y = pk2(v[2], v[3]); o.z = pk2(v[4], v[5]); o.w = pk2(v[6], v[7]);
                      const size_t idx = ((size_t)(g * 256 + (t0 >> 5)) * 4096) + ((d >> 5) * 2 + ((t0 & 31) >> 4)) * 512 + ((d & 31) + 32 * ((t0 >> 3) & 1)) * 8;
                      *(v4u*)((which ? vwf : vsf) + idx) = o; } } }
    const float* kvx = WSP(float, WS_KVX); const float* xkg = INP(21) + L * 512; const float* xqg = INP(20) + L * 512; bf16* kxf = WSP(bf16, WS_KXF);
#if ORACLE_ATTN
    float* kxn = WSP(float, WS_KXN);
#endif
    for (int it = gw; it < MEM * 4; it += NGW) { const int m = it >> 2, h = it & 3; const float* src = kvx + (size_t)m * (2 * D) + h * 512; float v[8]; float ss = 0.f;
#pragma unroll
        for (int j = 0; j < 8; ++j) { v[j] = src[lane + 64 * j]; ss += v[j] * v[j]; }
        ss = wave_sum(ss); const float rs = 1.0f / sqrtf(ss * (1.0f / 512.0f) + EPS);
#pragma unroll
        for (int j = 0; j < 8; ++j) { const int d = lane + 64 * j; const float y = v[j] * rs * xkg[d]; const float yq = y * xqg[d] * (0.04419417382415922f * 1.4426950408889634f);
#if ORACLE_ATTN
            kxn[((size_t)h * MEM + m) * 512 + d] = y;
#endif
            kxf[((size_t)h * MEM + m) * 512 + d] = (bf16)f2bf(yq); } }
#if XFUSE
    { bf16* vxr = WSP(bf16, WS_VXF);
      for (int it = gw; it < MEM * 4; it += NGW) { const int m = it >> 2, h = it & 3; const float* src = kvx + (size_t)m * (2 * D) + D + h * 512 + 8 * lane;
          const f32x4 a = *(const f32x4*)src, b2 = *(const f32x4*)(src + 4);
          v4u o; o.x = pk2(a[0], a[1]); o.y = pk2(a[2], a[3]); o.z = pk2(b2[0], b2[1]); o.w = pk2(b2[2], b2[3]);
          *(v4u*)(vxr + ((size_t)h * MEM + m) * 512 + 8 * lane) = o; } }
#else
    { bf16* vxf = WSP(bf16, WS_VXF);
      for (int it = gw; it < (MEM / 8) * 4; it += NGW) { const int m0 = 8 * (it >> 2), h = it & 3;
#pragma unroll
          for (int dd = 0; dd < 8; ++dd) { const int d = lane + 64 * dd; const float* src = kvx + (size_t)m0 * (2 * D) + D + h * 512 + d; float v[8];
#pragma unroll
              for (int j = 0; j < 8; ++j) v[j] = src[(size_t)j * (2 * D)];
              v4u o; o.x = pk2(v[0], v[1]); o.y = pk2(v[2], v[3]); o.z = pk2(v[4], v[5]); o.w = pk2(v[6], v[7]);
              *(v4u*)(vxf + ((size_t)h * 512 + d) * MEM + m0) = o; } } }
#endif
}
constexpr int HP = 129;
__device__ __forceinline__ void hg_gates(Frame& F, int L, int c, int h, LAS float* B, LAS float* KY) {
    const float* z = WSP(float, WS_Z); const float* lb = WSP(float, WS_LB) + L * 512 + h * 128;
    for (int i = F.tid; i < 64 * 128; i += 512) { const int s = i >> 7, d = i & 127; const float zf = z[(size_t)(64 * c + s) * NIN + ZC_HGF + h * 128 + d]; const float l = lb[d];
        const float e = EXPF(-fabsf(zf)); const float sp = (zf >= 0.f) ? 1.0f / (1.0f + e) : e / (1.0f + e);
        const float sn = (zf >= 0.f) ? e / (1.0f + e) : 1.0f / (1.0f + e);
        const float forget = l + (1.0f - l) * sp;
        B[s * HP + d] = LOGF(fmaxf(forget, 1e-20f)); KY[s * HP + d] = (1.0f - l) * sn; }
    __syncthreads();
    float offs[2];
    for (int k = 0; k < 2; ++k) { const int i = F.tid + 512 * k, d = i & 127, s0 = (i >> 7) * 8; float a = 0.f;
#pragma unroll
        for (int j = 0; j < 8; ++j) { a += B[(s0 + j) * HP + d]; B[(s0 + j) * HP + d] = a; } }
    __syncthreads();
    for (int k = 0; k < 2; ++k) { const int i = F.tid + 512 * k, d = i & 127, ch = i >> 7; float off = 0.f;
        for (int c2 = 0; c2 < ch; ++c2) off += B[(8 * c2 + 7) * HP + d];
        offs[k] = off; }
    __syncthreads();
    for (int k = 0; k < 2; ++k) { const int i = F.tid + 512 * k, d = i & 127, s0 = (i >> 7) * 8;
#pragma unroll
        for (int j = 0; j < 8; ++j) B[(s0 + j) * HP + d] += offs[k]; }
    __syncthreads();
}
__device__ __forceinline__ void hg_summary_item(Frame& F, int L, int c, int h) {
    LAS float* B = (LAS float*)F.lds; LAS float* KY = B + 64 * HP; LAS float* V = KY + 64 * HP;
    const float* z = WSP(float, WS_Z);
    hg_gates(F, L, c, h, B, KY);
    for (int i = F.tid; i < 64 * 128; i += 512) { const int s = i >> 7, d = i & 127; KY[s * HP + d] *= EXPF(B[63 * HP + d] - B[s * HP + d]); V[s * HP + d] = z[(size_t)(64 * c + s) * NIN + ZC_HGI + h * 128 + d]; }
    if (F.tid < 128) WSP(float, WS_HGDEC)[(c * 4 + h) * 128 + F.tid] = EXPF(B[63 * HP + F.tid]);
    __syncthreads();
    const int e = F.tid & 127, dg = F.tid >> 7; float acc[32];
#pragma unroll
    for (int j = 0; j < 32; ++j) acc[j] = 0.f;
    for (int s = 0; s < 64; ++s) { const float v = V[s * HP + e];
#pragma unroll
        for (int j = 0; j < 32; ++j) acc[j] += KY[s * HP + dg * 32 + j] * v; }
    float* U = WSP(float, WS_HGU) + (size_t)(c * 4 + h) * 16384;
#pragma unroll
    for (int j = 0; j < 32; ++j) U[(dg * 32 + j) * 128 + e] = acc[j];
    __syncthreads();
}
template <bool SILU>
__device__ __forceinline__ void finish_rows(Frame& F, LAS float* O, const float* gain, const float* gate_src, int gate_col, int ycol, int c) {
    bf16* y = WSP(bf16, WS_A1);
    for (int rr = 0; rr < 8; ++rr) { const int t = F.wave * 8 + rr; const float o1 = O[t * HP + F.lane], o2 = O[t * HP + F.lane + 64];
        const float ss = wave_sum(o1 * o1 + o2 * o2); const float rs = 1.0f / sqrtf(ss * (1.0f / 128.0f) + EPS);
        const float* gr = gate_src + (size_t)(64 * c + t) * NIN + gate_col; const float g1 = gr[F.lane], g2 = gr[F.lane + 64];
        const float a1 = SILU ? siluf_(g1) : sigm(g1), a2 = SILU ? siluf_(g2) : sigm(g2);
        bf16* yr = y + (size_t)(64 * c + t) * (KS * D);
        storeA1(yr, D, ycol + F.lane, o1 * rs * gain[F.lane] * a1); storeA1(yr, D, ycol + F.lane + 64, o2 * rs * gain[F.lane + 64] * a2); }
}
__device__ __forceinline__ void hg_output_item(Frame& F, int L, int c, int h) {
    LAS float* B = (LAS float*)F.lds; LAS float* KY = B + 64 * HP; LAS float* Q = KY + 64 * HP; LAS float* SC = Q + 64 * HP;
    const float* z = WSP(float, WS_Z);
    hg_gates(F, L, c, h, B, KY);
    for (int i = F.tid; i < 64 * 128; i += 512) { const int s = i >> 7, d = i & 127; Q[s * HP + d] = z[(size_t)(64 * c + s) * NIN + ZC_HGQ + h * 128 + d]; }
    __syncthreads();
    for (int p = F.tid; p < 4096; p += 512) { const int t = p >> 6, s = p & 63; float a = 0.f;
        if (s <= t) { for (int d = 0; d < 128; ++d) a += Q[t * HP + d] * KY[s * HP + d] * EXPF(B[t * HP + d] - B[s * HP + d]); }
        SC[t * 65 + s] = a; }
    __syncthreads();
    for (int i = F.tid; i < 64 * 128; i += 512) { const int s = i >> 7, d = i & 127; Q[s * HP + d] *= EXPF(B[s * HP + d]); }
    __syncthreads();
    const int e = F.tid & 127, tg = F.tid >> 7; float acc[16];
#pragma unroll
    for (int j = 0; j < 16; ++j) acc[j] = 0.f;
    for (int s = 0; s < 64; ++s) { const float v = z[(size_t)(64 * c + s) * NIN + ZC_HGI + h * 128 + e];
#pragma unroll
        for (int j = 0; j < 16; ++j) acc[j] += SC[(tg * 16 + j) * 65 + s] * v; }
    const float* S = WSP(float, WS_HGS) + (size_t)(c * 4 + h) * 16384;
    for (int d = 0; d < 128; ++d) { const float sv = S[d * 128 + e];
#pragma unroll
        for (int j = 0; j < 16; ++j) acc[j] += Q[(tg * 16 + j) * HP + d] * sv; }
    __syncthreads();
#pragma unroll
    for (int j = 0; j < 16; ++j) KY[(tg * 16 + j) * HP + e] = acc[j];
    __syncthreads();
    finish_rows<true>(F, KY, INP(6) + L * 512 + h * 128, z, ZC_HGG + h * 128, h * 128, c);
    __syncthreads();
}

__device__ __forceinline__ void ml_gates(Frame& F, int c, int h, LAS float* BL, LAS float* LI) {
    const float* z = WSP(float, WS_Z);
    if (F.tid < 64) { const float f = z[(size_t)(64 * c + F.tid) * NIN + ZC_MLF + h]; BL[F.tid] = fminf(f, 0.f) - log1pf(EXPF(-fabsf(f))); LI[F.tid] = z[(size_t)(64 * c + F.tid) * NIN + ZC_MLI + h]; }
    __syncthreads();
    if (F.tid < 64) { float a = 0.f; for (int s = 0; s < 64; ++s) { const float v = BL[s]; a += (s <= F.tid) ? v : 0.f; } LDS_WAIT(); asm volatile("" ::: "memory"); BL[F.tid] = a; }
    __syncthreads();
}
__device__ __forceinline__ void ml_summary_item(Frame& F, int c, int h) {
    LAS float* KW = (LAS float*)F.lds; LAS float* V = KW + 64 * HP; LAS float* BL = V + 64 * HP; LAS float* LI = BL + 64; LAS float* WS_ = LI + 64;
    const float* z = WSP(float, WS_Z); const float* mlk = WSP(float, WS_MLK);
    ml_gates(F, c, h, BL, LI);
    float mloc = -3.0e38f; for (int s = 0; s < 64; ++s) mloc = fmaxf(mloc, BL[63] - BL[s] + LI[s]);
    if (F.tid < 64) WS_[F.tid] = EXPF(BL[63] - BL[F.tid] + LI[F.tid] - mloc);
    __syncthreads();
    for (int i = F.tid; i < 64 * 128; i += 512) { const int s = i >> 7, d = i & 127; KW[s * HP + d] = mlk[(size_t)(64 * c + s) * 512 + h * 128 + d] * WS_[s]; V[s * HP + d] = z[(size_t)(64 * c + s) * NIN + ZC_MLV + h * 128 + d]; }
    float* msc = WSP(float, WS_MLSC);
    if (F.tid == 0) { msc[c * 4 + h] = mloc; msc[NCH * 4 + c * 4 + h] = BL[63]; }
    __syncthreads();
    const int e = F.tid & 127, dg = F.tid >> 7; float acc[32];
#pragma unroll
    for (int j = 0; j < 32; ++j) acc[j] = 0.f;
    for (int s = 0; s < 64; ++s) { const float v = V[s * HP + e];
#pragma unroll
        for (int j = 0; j < 32; ++j) acc[j] += KW[s * HP + dg * 32 + j] * v; }
    float* U = WSP(float, WS_MLU) + (size_t)(c * 4 + h) * 16384;
#pragma unroll
    for (int j = 0; j < 32; ++j) U[(dg * 32 + j) * 128 + e] = acc[j];
    if (F.tid < 128) { float a = 0.f; for (int s = 0; s < 64; ++s) a += KW[s * HP + F.tid]; WSP(float, WS_MLNL)[(c * 4 + h) * 128 + F.tid] = a; }
    __syncthreads();
}
__device__ __forceinline__ void ml_output_item(Frame& F, int L, int c, int h) {
    LAS float* Q = (LAS float*)F.lds; LAS float* KK = Q + 64 * HP; LAS float* SC = KK + 64 * HP; LAS float* BL = SC + 64 * 65; LAS float* LI = BL + 64; LAS float* MT = LI + 64; LAS float* WI = MT + 64; LAS float* QN = WI + 64;
    const float* z = WSP(float, WS_Z); const float* mlq = WSP(float, WS_MLQ); const float* mlk = WSP(float, WS_MLK);
    ml_gates(F, c, h, BL, LI);
    const float mprev = WSP(float, WS_MLSC)[2 * NCH * 4 + c * 4 + h];
    for (int i = F.tid; i < 64 * 128; i += 512) { const int s = i >> 7, d = i & 127; Q[s * HP + d] = mlq[(size_t)(64 * c + s) * 512 + h * 128 + d]; KK[s * HP + d] = mlk[(size_t)(64 * c + s) * 512 + h * 128 + d]; }
    if (F.tid < 64) { const int t = F.tid; const float inter = BL[t] + mprev; float mt = inter; for (int s = 0; s <= t; ++s) mt = fmaxf(mt, BL[t] - BL[s] + LI[s]); MT[t] = mt; WI[t] = EXPF(inter - mt); }
    __syncthreads();
    for (int p = F.tid; p < 4096; p += 512) { const int t = p >> 6, s = p & 63; float a = 0.f;
        if (s <= t) { for (int d = 0; d < 128; ++d) a += Q[t * HP + d] * KK[s * HP + d]; a *= EXPF(BL[t] - BL[s] + LI[s] - MT[t]); }
        SC[t * 65 + s] = a; }
    __syncthreads();
    if (F.tid < 64) { const int t = F.tid; const float* nst = WSP(float, WS_MLN) + (c * 4 + h) * 128; float a = 0.f; for (int d = 0; d < 128; ++d) a += Q[t * HP + d] * nst[d]; a *= WI[t];
        float r = 0.f; for (int s = 0; s < 64; ++s) r += SC[t * 65 + s]; QN[t] = a + r; }
    const int e = F.tid & 127, tg = F.tid >> 7; float acc[16];
#pragma unroll
    for (int j = 0; j < 16; ++j) acc[j] = 0.f;
    const float* Cst = WSP(float, WS_MLS) + (size_t)(c * 4 + h) * 16384;
    for (int d = 0; d < 128; ++d) { const float sv = Cst[d * 128 + e];
#pragma unroll
        for (int j = 0; j < 16; ++j) acc[j] += Q[(tg * 16 + j) * HP + d] * sv; }
#pragma unroll
    for (int j = 0; j < 16; ++j) acc[j] *= WI[tg * 16 + j];
    for (int s = 0; s < 64; ++s) { const float v = z[(size_t)(64 * c + s) * NIN + ZC_MLV + h * 128 + e];
#pragma unroll
        for (int j = 0; j < 16; ++j) acc[j] += SC[(tg * 16 + j) * 65 + s] * v; }
    __syncthreads();
#pragma unroll
    for (int j = 0; j < 16; ++j) { const int t = tg * 16 + j; KK[t * HP + e] = acc[j] / fmaxf(fabsf(QN[t]), EXPF(-MT[t])); }
    __syncthreads();
    finish_rows<false>(F, KK, INP(12) + L * 512 + h * 128, z, ZC_MLO + h * 128, 1536 + h * 128, c);
    __syncthreads();
}

__device__ __forceinline__ void cmp_item(Frame& F, int L, int item) {
    const int which = item & 1, g = (item >> 1) & 1, c0 = (item >> 2) * 8;
    LAS float* A = (LAS float*)F.lds;
    LAS float* PE = A + 144 * HP;
    LAS float* O = PE + 32 * 128;
    const float* z = WSP(float, WS_Z); const int zc = (which ? ZC_NVC : ZC_NKC) + g * 128;
    const float* pe = INP(9) + ((size_t)(L * 2 + which) * 32) * 128; const float* w = INP(10) + ((size_t)(L * 2 + which) * 32) * 128 * 128;
    for (int i = F.tid; i < 144 * 128; i += 512) { const int r = i >> 7, d = i & 127; const int tok = 16 * c0 + r; A[r * HP + d] = (tok < T) ? z[(size_t)tok * NIN + zc + d] : 0.f; }
    for (int i = F.tid; i < 32 * 128; i += 512) PE[i] = pe[i];
    __syncthreads();
    const int e = F.tid & 127, rg = F.tid >> 7;
    float a0 = 0.f, a1 = 0.f;
    for (int l = 0; l < 32; ++l) { const LAS float* r0 = A + (16 * (2 * rg) + l) * HP; const LAS float* r1 = A + (16 * (2 * rg + 1) + l) * HP; const LAS float* pr = PE + l * 128; const float* wl = w + (size_t)l * 16384 + e;
        for (int d = 0; d < 128; ++d) { const float wv = wl[d * 128], p = pr[d]; a0 += (r0[d] + p) * wv; a1 += (r1[d] + p) * wv; } }
    O[(2 * rg) * HP + e] = a0; O[(2 * rg + 1) * HP + e] = a1;
    __syncthreads();
    if (!which) { const int c = c0 + F.wave; const float o1 = O[F.wave * HP + F.lane], o2 = O[F.wave * HP + F.lane + 64];
        const float* kg = INP(8) + L * 384; const float ss = wave_sum(o1 * o1 + o2 * o2); const float rs = 1.0f / sqrtf(ss * (1.0f / 128.0f) + EPS);
        const float y1 = o1 * rs * kg[F.lane], y2 = o2 * rs * kg[F.lane + 64]; const int pos = (c < NCMP) ? 16 * c + 31 : 0; const float cs = WSP(float, WS_COS)[pos * 64 + F.lane], sn = WSP(float, WS_SIN)[pos * 64 + F.lane];
        const float r1 = y1 * cs - y2 * sn, r2 = y2 * cs + y1 * sn;
        bf16* kcf = WSP(bf16, WS_KCF) + (size_t)g * 16 * 4096 + (size_t)(c >> 5) * 4096;
        { const int d = F.lane; kcf[(d >> 4) * 512 + (swap23_(c & 31) + 32 * ((d >> 3) & 1)) * 8 + (d & 7)] = (bf16)f2bf(r1); }
        { const int d = F.lane + 64; kcf[(d >> 4) * 512 + (swap23_(c & 31) + 32 * ((d >> 3) & 1)) * 8 + (d & 7)] = (bf16)f2bf(r2); }
#if ORACLE_ATTN
        if (c < NCMP) { float* dst = WSP(float, WS_KCN) + (size_t)g * 512 * 128; dst[c * 128 + F.lane] = r1; dst[c * 128 + F.lane + 64] = r2; }
#endif
    } else {
        if (F.tid < 128) { const int d = F.tid; float v[8];
#pragma unroll
            for (int j = 0; j < 8; ++j) v[j] = O[j * HP + d];
            v4u o; o.x = pk2(v[0], v[1]); o.y = pk2(v[2], v[3]); o.z = pk2(v[4], v[5]); o.w = pk2(v[6], v[7]);
            *(v4u*)(WSP(bf16, WS_VCF) + (size_t)g * 16 * 4096 + (size_t)(c0 >> 5) * 4096 + ((d >> 5) * 2 + ((c0 & 31) >> 4)) * 512 + ((d & 31) + 32 * ((c0 >> 3) & 1)) * 8) = o; }
#if ORACLE_ATTN
        { const int c = c0 + F.wave; if (c < NCMP) { float* dst = WSP(float, WS_VCN) + (size_t)g * 512 * 128; dst[c * 128 + F.lane] = O[F.wave * HP + F.lane]; dst[c * 128 + F.lane + 64] = O[F.wave * HP + F.lane + 64]; } }
#endif
    }
    __syncthreads();
}

__device__ __forceinline__ void ph_scan(Frame& F) {
    const int gt = F.bid * 512 + F.tid, NGT = F.G * 512;
    const float* msc = WSP(float, WS_MLSC);
    for (int id = gt; id < 131072; id += NGT) { const int i = id & 65535; const int h = i >> 14, de = i & 16383, d = de >> 7;
        if (id < 65536) { const float* U = WSP(float, WS_HGU); float* S = WSP(float, WS_HGS); const float* dec = WSP(float, WS_HGDEC); float st = 0.f;
            for (int c = 0; c < NCH; ++c) { const size_t o = (size_t)(c * 4 + h) * 16384 + de; S[o] = st; st = dec[(c * 4 + h) * 128 + d] * st + U[o]; } }
        else { const float* U = WSP(float, WS_MLU); float* S = WSP(float, WS_MLS); float st = 0.f, m = 0.f;
            for (int c = 0; c < NCH; ++c) { const size_t o = (size_t)(c * 4 + h) * 16384 + de; S[o] = st; const float mloc = msc[c * 4 + h], bend = msc[NCH * 4 + c * 4 + h]; const float mn = fmaxf(bend + m, mloc);
                st = EXPF(bend + m - mn) * st + EXPF(mloc - mn) * U[o]; m = mn; } } }
    for (int i = gt; i < 512; i += NGT) { const int h = i >> 7, d = i & 127; const float* nl = WSP(float, WS_MLNL); float* ns = WSP(float, WS_MLN); float st = 0.f, m = 0.f;
        for (int c = 0; c < NCH; ++c) { const int o = (c * 4 + h) * 128 + d; ns[o] = st; const float mloc = msc[c * 4 + h], bend = msc[NCH * 4 + c * 4 + h]; const float mn = fmaxf(bend + m, mloc);
            st = EXPF(bend + m - mn) * st + EXPF(mloc - mn) * nl[o]; m = mn; } }
    for (int i = gt; i < 4; i += NGT) { float* mp = WSP(float, WS_MLSC) + 2 * NCH * 4; float m = 0.f;
        for (int c = 0; c < NCH; ++c) { mp[c * 4 + i] = m; m = fmaxf(msc[NCH * 4 + c * 4 + i] + m, msc[c * 4 + i]); } }
}
#if ORACLE_ATTN
__device__ __forceinline__ void nsa_scores(const float* kbase, int kstride, int kfirst, int nk, LAS float* QV, LAS float* SCW, int off, int lane) {
    const int sub = lane & 3, slot = lane >> 2;
    for (int p = 0; p < nk; p += 16) { const int i = p + slot; const bool ok = i < nk; const float* row = kbase + (size_t)(kfirst + (ok ? i : 0)) * kstride + 4 * sub;
        float a0 = 0.f, a1 = 0.f, a2 = 0.f, a3 = 0.f;
#pragma unroll 2
        for (int j = 0; j < 8; ++j) { const f32x4 kv = *(const f32x4*)(row + 16 * j); const LAS float* q = QV + 16 * j + 4 * sub;
            const f32x4 q0 = *(const LAS f32x4*)q, q1 = *(const LAS f32x4*)(q + 128), q2 = *(const LAS f32x4*)(q + 256), q3 = *(const LAS f32x4*)(q + 384);
            a0 += kv[0] * q0[0] + kv[1] * q0[1] + kv[2] * q0[2] + kv[3] * q0[3]; a1 += kv[0] * q1[0] + kv[1] * q1[1] + kv[2] * q1[2] + kv[3] * q1[3];
            a2 += kv[0] * q2[0] + kv[1] * q2[1] + kv[2] * q2[2] + kv[3] * q2[3]; a3 += kv[0] * q3[0] + kv[1] * q3[1] + kv[2] * q3[2] + kv[3] * q3[3]; }
        a0 += sxor<1>(a0); a1 += sxor<1>(a1); a2 += sxor<1>(a2); a3 += sxor<1>(a3);
        a0 += sxor<2>(a0); a1 += sxor<2>(a1); a2 += sxor<2>(a2); a3 += sxor<2>(a3);
        if (ok && sub == 0) *(LAS f32x4*)(SCW + (size_t)(off + i) * 4) = (f32x4){a0, a1, a2, a3}; }
}
__device__ __forceinline__ f32x4 nsa_softmax(LAS float* SCW, int n, int lane) {
    f32x4 mx = {-3.0e38f, -3.0e38f, -3.0e38f, -3.0e38f};
    for (int i = lane; i < n; i += 64) { const f32x4 s = *(const LAS f32x4*)(SCW + i * 4); mx[0] = fmaxf(mx[0], s[0]); mx[1] = fmaxf(mx[1], s[1]); mx[2] = fmaxf(mx[2], s[2]); mx[3] = fmaxf(mx[3], s[3]); }
#pragma unroll
    for (int h = 0; h < 4; ++h) mx[h] = wave_max(mx[h]);
    f32x4 sm = {0.f, 0.f, 0.f, 0.f};
    for (int i = lane; i < n; i += 64) { f32x4 s = *(const LAS f32x4*)(SCW + i * 4);
#pragma unroll
        for (int h = 0; h < 4; ++h) { s[h] = EXPF(s[h] - mx[h]); sm[h] += s[h]; }
        *(LAS f32x4*)(SCW + i * 4) = s; }
#pragma unroll
    for (int h = 0; h < 4; ++h) { sm[h] = wave_sum(sm[h]); sm[h] = (n > 0) ? 1.0f / sm[h] : 0.f; }
    LDS_WAIT();
    return sm;
}
__device__ __forceinline__ void nsa_pv(const float* vbase, int vstride, int vfirst, int nk, const LAS float* SCW, int off, f32x2 (&acc)[4], int lane) {
    const float* vp = vbase + (size_t)vfirst * vstride + 2 * lane;
    for (int i = 0; i < nk; ++i) { const f32x4 p = *(const LAS f32x4*)(SCW + (size_t)(off + i) * 4); const f32x2 v = *(const f32x2*)(vp + (size_t)i * vstride);
#pragma unroll
        for (int h = 0; h < 4; ++h) { acc[h][0] += p[h] * v[0]; acc[h][1] += p[h] * v[1]; } }
}
__device__ __forceinline__ void ph_nsa(Frame& F, int L) {
    const int lane = F.lane; LAS float* SCW = (LAS float*)(F.lds + F.wave * WAVE_SCR);
    LAS float* QV = SCW + 4096; LAS float* IMP = QV + 512; LAS int* SEL = (LAS int*)(IMP + 128);
    const float* z = WSP(float, WS_Z); const float* nsq = WSP(float, WS_NSQ); const float* nks = WSP(float, WS_NKS); const float* nkw = WSP(float, WS_NKW);
    bf16* y = WSP(bf16, WS_A1);
    for (int it = F.bid * 8 + F.wave; it < 2 * T; it += F.G * 8) {
        const int t = it >> 1, g = it & 1, cur = t >> 6;
        { const f32x4* qs = (const f32x4*)(nsq + (size_t)t * 1024 + g * 512); *(LAS f32x4*)(QV + 4 * lane) = qs[lane]; *(LAS f32x4*)(QV + 256 + 4 * lane) = qs[64 + lane]; }
        LDS_WAIT();
        f32x4 gate[3];
#pragma unroll
        for (int h = 0; h < 4; ++h)
#pragma unroll
            for (int b = 0; b < 3; ++b) gate[b][h] = sigm(z[(size_t)t * NIN + ZC_GATE + (g * 4 + h) * 3 + b]);
        f32x2 tot[4], acc[4];
#pragma unroll
        for (int h = 0; h < 4; ++h) tot[h] = (f32x2){0.f, 0.f};
        const int ncv = (t >= 31) ? ((t - 31) >> 4) + 1 : 0;
        const float* kcn = WSP(float, WS_KCN) + (size_t)g * 512 * 128; const float* vcn = WSP(float, WS_VCN) + (size_t)g * 512 * 128;
        nsa_scores(kcn, 128, 0, ncv, QV, SCW, 0, lane); LDS_WAIT();
        f32x4 inv = nsa_softmax(SCW, ncv, lane);
#pragma unroll
        for (int h = 0; h < 4; ++h) acc[h] = (f32x2){0.f, 0.f};
        nsa_pv(vcn, 128, 0, ncv, SCW, 0, acc, lane);
#pragma unroll
        for (int h = 0; h < 4; ++h) { tot[h][0] += acc[h][0] * inv[h] * gate[0][h]; tot[h][1] += acc[h][1] * inv[h] * gate[0][h]; }
        float v0, v1;
        { float im[2];
#pragma unroll
          for (int k = 0; k < 2; ++k) { const int s = lane + 64 * k; float a = 0.f;
              for (int c = 4 * s - 1; c <= 4 * s + 3; ++c) if (c >= 0 && c < ncv) { const f32x4 p = *(const LAS f32x4*)(SCW + c * 4); a += ((p[0] * inv[0] + p[1] * inv[1]) + p[2] * inv[2]) + p[3] * inv[3]; }
              im[k] = a; }
          v0 = im[0]; v1 = im[1]; }
        int nsel;
        if (cur < 16) { nsel = cur + 1; if (lane < 16) SEL[lane] = lane; }
        else { nsel = 16;
            { const int s0 = lane, s1 = lane + 64;
              v0 = (s0 > cur) ? -3.0e38f : ((s0 == 0 || s0 == cur || s0 == cur - 1) ? 3.0e38f : v0);
              v1 = (s1 > cur) ? -3.0e38f : ((s1 == cur || s1 == cur - 1) ? 3.0e38f : v1); }
            for (int k = 0; k < 16; ++k) { float bv; int bi; if (v0 >= v1) { bv = v0; bi = lane; } else { bv = v1; bi = lane + 64; }
                wave_argmax(bv, bi);
                if (bi == lane) v0 = -3.0e38f; if (bi == lane + 64) v1 = -3.0e38f;
                if (lane == 0) SEL[k] = bi; } }
        LDS_WAIT();
        int n = 0;
        for (int k = 0; k < nsel; ++k) { const int b = SEL[k]; const int nk = (b == cur) ? (t - 64 * cur + 1) : 64; nsa_scores(nks + g * 128, 256, 64 * b, nk, QV, SCW, n, lane); n += nk; }
        LDS_WAIT();
        inv = nsa_softmax(SCW, n, lane);
#pragma unroll
        for (int h = 0; h < 4; ++h) acc[h] = (f32x2){0.f, 0.f};
        n = 0;
        for (int k = 0; k < nsel; ++k) { const int b = SEL[k]; const int nk = (b == cur) ? (t - 64 * cur + 1) : 64; nsa_pv(z + ZC_NVS + g * 128, NIN, 64 * b, nk, SCW, n, acc, lane); n += nk; }
#pragma unroll
        for (int h = 0; h < 4; ++h) { tot[h][0] += acc[h][0] * inv[h] * gate[1][h]; tot[h][1] += acc[h][1] * inv[h] * gate[1][h]; }
        const int lo = (t >= 511) ? t - 511 : 0; n = t - lo + 1;
        nsa_scores(nkw + g * 128, 256, lo, n, QV, SCW, 0, lane); LDS_WAIT();
        inv = nsa_softmax(SCW, n, lane);
#pragma unroll
        for (int h = 0; h < 4; ++h) acc[h] = (f32x2){0.f, 0.f};
        nsa_pv(z + ZC_NVW + g * 128, NIN, lo, n, SCW, 0, acc, lane);
        bf16* yr = y + (size_t)t * (KS * D);
#pragma unroll
        for (int h = 0; h < 4; ++h) { const float o0 = tot[h][0] + acc[h][0] * inv[h] * gate[2][h], o1 = tot[h][1] + acc[h][1] * inv[h] * gate[2][h];
            storeA2(yr, D, 512 + (g * 4 + h) * 128 + 2 * lane, o0, o1); }
    }
}

__device__ __forceinline__ void ph_xattn(Frame& F, int L) {
    const int lane = F.lane; LAS float* QV = (LAS float*)(F.lds + F.wave * WAVE_SCR); LAS float* SC = QV + 512;
    const float* xq = WSP(float, WS_XQ); const float* kxn = WSP(float, WS_KXN); const float* kvx = WSP(float, WS_KVX); const float* qg = INP(20) + L * 512;
    bf16* y = WSP(bf16, WS_A1); const int sub = lane & 3, slot = lane >> 2;
    for (int it = F.bid * 8 + F.wave; it < 4 * T; it += F.G * 8) {
        const int t = it >> 2, h = it & 3;
        { const float* src = xq + (size_t)t * D + h * 512; const f32x4 a = *(const f32x4*)(src + 4 * lane), b = *(const f32x4*)(src + 256 + 4 * lane);
          float ss = (a[0] * a[0] + a[1] * a[1]) + (a[2] * a[2] + a[3] * a[3]) + (b[0] * b[0] + b[1] * b[1]) + (b[2] * b[2] + b[3] * b[3]); ss = wave_sum(ss);
          const float rs = (1.0f / sqrtf(ss * (1.0f / 512.0f) + EPS)) * 0.04419417382415922f;
          const f32x4 g0 = *(const f32x4*)(qg + 4 * lane), g1 = *(const f32x4*)(qg + 256 + 4 * lane);
          *(LAS f32x4*)(QV + 4 * lane) = a * rs * g0; *(LAS f32x4*)(QV + 256 + 4 * lane) = b * rs * g1; }
        LDS_WAIT();
        const float* kb = kxn + (size_t)h * MEM * 512;
        for (int p = 0; p < MEM; p += 16) { const int i = p + slot; const float* row = kb + (size_t)i * 512 + 4 * sub; float a = 0.f;
#pragma unroll 8
            for (int j = 0; j < 32; ++j) { const f32x4 kv = *(const f32x4*)(row + 16 * j); const f32x4 q = *(const LAS f32x4*)(QV + 16 * j + 4 * sub); a += (kv[0] * q[0] + kv[1] * q[1]) + (kv[2] * q[2] + kv[3] * q[3]); }
            a += sxor<1>(a); a += sxor<2>(a);
            if (sub == 0) SC[i] = a; }
        LDS_WAIT();
        float s4[4], mx = -3.0e38f;
#pragma unroll
        for (int k = 0; k < 4; ++k) { s4[k] = SC[lane + 64 * k]; mx = fmaxf(mx, s4[k]); }
        mx = wave_max(mx); float sm = 0.f;
#pragma unroll
        for (int k = 0; k < 4; ++k) { s4[k] = EXPF(s4[k] - mx); sm += s4[k]; }
        sm = wave_sum(sm); const float inv = 1.0f / sm;
#pragma unroll
        for (int k = 0; k < 4; ++k) SC[lane + 64 * k] = s4[k] * inv;
        LDS_WAIT();
        f32x4 o0 = {0.f, 0.f, 0.f, 0.f}, o1 = {0.f, 0.f, 0.f, 0.f};
        const float* vb = kvx + D + h * 512 + 4 * lane;
        for (int m = 0; m < MEM; ++m) { const float p = SC[m]; const f32x4 a = *(const f32x4*)(vb + (size_t)m * (2 * D)), b = *(const f32x4*)(vb + (size_t)m * (2 * D) + 256); o0 += a * p; o1 += b * p; }
        bf16* yr = y + (size_t)t * (KS * D);
        storeA4(yr, D, h * 512 + 4 * lane, o0); storeA4(yr, D, h * 512 + 256 + 4 * lane, o1);
        LDS_WAIT();
    }
}
#endif
typedef short bf16x8 __attribute__((ext_vector_type(8)));
typedef float f32x16 __attribute__((ext_vector_type(16)));
typedef __bf16 bf16x2_t __attribute__((ext_vector_type(2)));
#define MFMA32(a, b, c) __builtin_amdgcn_mfma_f32_32x32x16_bf16((a), (b), (c), 0, 0, 0)
__device__ __forceinline__ unsigned cvtpk(float lo, float hi) { const f32x2 v = {lo, hi}; const bf16x2_t b = __builtin_convertvector(v, bf16x2_t); return __builtin_bit_cast(unsigned, b); }
__device__ __forceinline__ bf16x8 pack8(const f32x16& x, int s) { v4u w; w.x = cvtpk(x[8 * s], x[8 * s + 1]); w.y = cvtpk(x[8 * s + 2], x[8 * s + 3]); w.z = cvtpk(x[8 * s + 4], x[8 * s + 5]); w.w = cvtpk(x[8 * s + 6], x[8 * s + 7]); return __builtin_bit_cast(bf16x8, w); }
__device__ __forceinline__ int swap23(int r) { return (r & ~12) | ((r & 4) << 1) | ((r & 8) >> 1); }
__device__ __forceinline__ size_t kf_index(int g, int t, int d) { return ((size_t)(g * 256 + (t >> 5)) * 4096) + (d >> 4) * 512 + (swap23(t & 31) + 32 * ((d >> 3) & 1)) * 8 + (d & 7); }
__device__ __forceinline__ size_t vf_chunk(int g, int t0, int d) { return ((size_t)(g * 256 + (t0 >> 5)) * 4096) + ((d >> 5) * 2 + ((t0 & 31) >> 4)) * 512 + ((d & 31) + 32 * ((t0 >> 3) & 1)) * 8; }
__device__ __forceinline__ f32x16 zero16() { f32x16 z; for (int i = 0; i < 16; ++i) z[i] = 0.f; return z; }
__device__ __forceinline__ float gain_absmax128(const float* g, int lane) { return wave_max(fmaxf(fabsf(g[lane]), fabsf(g[lane + 64]))); }
constexpr float LOG2E = 1.4426950408889634f;

__device__ __forceinline__ f32x16 st_tile128(const bf16* ktile, const bf16x8 (&qf)[8], int lane) {
    f32x16 s = zero16(); const bf16x8* kp = (const bf16x8*)ktile + lane;
#pragma unroll
    for (int sp = 0; sp < 8; ++sp) s = MFMA32(kp[sp * 64], qf[sp], s);
    return s;
}
__device__ __forceinline__ void pv_tile128(const bf16* vtile, const bf16x8 (&pb)[2], f32x16 (&o)[4], int lane) {
    const bf16x8* vp = (const bf16x8*)vtile + lane;
#pragma unroll
    for (int dt = 0; dt < 4; ++dt)
#pragma unroll
        for (int s = 0; s < 2; ++s) o[dt] = MFMA32(vp[(dt * 2 + s) * 64], pb[s], o[dt]);
}
__device__ __forceinline__ void load_qf128(const bf16* qrow, int h, bf16x8 (&qf)[8]) {
#pragma unroll
    for (int sp = 0; sp < 8; ++sp) qf[sp] = *(const bf16x8*)(qrow + 16 * sp + 8 * h);
}

__device__ __forceinline__ void nsa_wave_item(Frame& F, int L, int tg, int g, LAS float* IMPW) {
    const int lane = F.lane, r = lane & 31, h = lane >> 5, slot = r >> 2, jh = r & 3;
    const int tq = 8 * tg + slot, head = 4 * g + jh, cur = tg >> 3;
    const float gq = gain_absmax128(INP(7) + L * 128, lane); const float* kgn = INP(8) + L * 384;
    const float bc = 11.313708498984761f * LOG2E * 1.02f;
    const float bound_c = bc * gq * gain_absmax128(kgn, lane), bound_s = bc * gq * gain_absmax128(kgn + 128, lane), bound_w = bc * gq * gain_absmax128(kgn + 256, lane);
    bf16x8 qf[8]; load_qf128(WSP(bf16, WS_QN) + (size_t)tq * 1024 + head * 128, h, qf);
    const float* zg = WSP(float, WS_Z) + (size_t)tq * NIN + ZC_GATE + head * 3;
    const float g0 = sigm(zg[0]), g1 = sigm(zg[1]), g2 = sigm(zg[2]);
    f32x16 o[4];
    float* ocr = WSP(float, WS_OC) + (size_t)tq * 1024 + head * 128;
    for (int i = lane; i < 2 * 8 * 129; i += 64) IMPW[i] = 0.f;
    LDS_WAIT();
    { const bf16* kc = WSP(bf16, WS_KCF) + (size_t)g * 16 * 4096; const bf16* vc = WSP(bf16, WS_VCF) + (size_t)g * 16 * 4096;
      const int cmaxq = (tq >= 31) ? ((tq - 31) >> 4) : -1;
      const int tmax = 8 * tg + 7; const int ntile = (tmax >= 31) ? (((tmax - 31) >> 4) >> 5) + 1 : 0;
      float lsum = 0.f;
      for (int kt = 0; kt < ntile; ++kt) { const f32x16 s = st_tile128(kc + (size_t)kt * 4096, qf, lane);
#pragma unroll
          for (int R = 0; R < 16; ++R) { const int c = 32 * kt + 16 * (R >> 3) + 8 * h + (R & 7); lsum += (c <= cmaxq) ? __builtin_amdgcn_exp2f(s[R] - bound_c) : 0.f; } }
      lsum = half_sum(lsum);
      const float inv = (lsum > 0.f) ? 1.0f / lsum : 0.f;
      o[0] = zero16(); o[1] = zero16(); o[2] = zero16(); o[3] = zero16();
      LAS float* imrow = IMPW + (h * 8 + slot) * 129;
      for (int kt = 0; kt < ntile; ++kt) { f32x16 s = st_tile128(kc + (size_t)kt * 4096, qf, lane);
#pragma unroll
          for (int R = 0; R < 16; ++R) { const int c = 32 * kt + 16 * (R >> 3) + 8 * h + (R & 7); s[R] = (c <= cmaxq) ? __builtin_amdgcn_exp2f(s[R] - bound_c) * inv : 0.f; }
#pragma unroll
          for (int s2 = 0; s2 < 2; ++s2) { const int sb = 8 * kt + 4 * s2 + 2 * h;
              float a = (s[8 * s2] + s[8 * s2 + 1]) + (s[8 * s2 + 2] + s[8 * s2 + 3]), b = ((s[8 * s2 + 4] + s[8 * s2 + 5]) + (s[8 * s2 + 6] + s[8 * s2 + 7])) + s[8 * s2 + 3], c7 = s[8 * s2 + 7];
              a += sxor<1>(a); b += sxor<1>(b); c7 += sxor<1>(c7); a += sxor<2>(a); b += sxor<2>(b); c7 += sxor<2>(c7);
              if (jh == 0) { imrow[sb] = a; imrow[sb + 1] = b; imrow[sb + 2] = c7; } }
          bf16x8 pb[2]; pb[0] = pack8(s, 0); pb[1] = pack8(s, 1);
          pv_tile128(vc + (size_t)kt * 4096, pb, o, lane); }
#pragma unroll
      for (int dt = 0; dt < 4; ++dt)
#pragma unroll
          for (int rg = 0; rg < 4; ++rg) { f32x4 v = {o[dt][4 * rg], o[dt][4 * rg + 1], o[dt][4 * rg + 2], o[dt][4 * rg + 3]}; *(f32x4*)(ocr + 32 * dt + 8 * rg + 4 * h) = v * g0; } }
    LDS_WAIT();
    unsigned my[4] = {0u, 0u, 0u, 0u}, un[4] = {0u, 0u, 0u, 0u};
    if (cur < 16) { my[0] = un[0] = (cur == 31) ? 0xffffffffu : ((1u << (cur + 1)) - 1u); }
    else {
        for (int ts = 0; ts < 8; ++ts) { const int s0 = lane, s1 = lane + 64;
            float v0 = IMPW[ts * 129 + s0] + IMPW[(8 + ts) * 129 + s0], v1 = IMPW[ts * 129 + s1] + IMPW[(8 + ts) * 129 + s1];
            v0 = (s0 > cur) ? -3.0e38f : ((s0 == 0 || s0 == cur || s0 == cur - 1) ? 3.0e38f : v0);
            v1 = (s1 > cur) ? -3.0e38f : ((s1 == cur || s1 == cur - 1) ? 3.0e38f : v1);
            for (int k = 0; k < 16; ++k) { float bv; int bi; if (v0 >= v1) { bv = v0; bi = lane; } else { bv = v1; bi = lane + 64; }
                wave_argmax(bv, bi);
                if (bi == lane) v0 = -3.0e38f; if (bi == lane + 64) v1 = -3.0e38f;
                bi = __builtin_amdgcn_readfirstlane(bi);
                const unsigned bit = 1u << (bi & 31); const int wi = bi >> 5; const bool mine = (slot == ts);
#pragma unroll
                for (int q4 = 0; q4 < 4; ++q4) { if (wi == q4) { un[q4] |= bit; if (mine) my[q4] |= bit; } } } } }
    { const bf16* ksf = WSP(bf16, WS_KSF) + (size_t)g * 256 * 4096; const bf16* vsf = WSP(bf16, WS_VSF) + (size_t)g * 256 * 4096;
      o[0] = zero16(); o[1] = zero16(); o[2] = zero16(); o[3] = zero16(); float lsum = 0.f;
#pragma unroll
      for (int q4 = 0; q4 < 4; ++q4) { unsigned um = __builtin_amdgcn_readfirstlane(un[q4]);
          while (um) { const int jb = __builtin_ctz(um); um &= um - 1; const int j = 32 * q4 + jb; const bool sel = (my[q4] >> jb) & 1u;
#pragma unroll 1
              for (int half = 0; half < 2; ++half) { const int kt = 2 * j + half; f32x16 s = st_tile128(ksf + (size_t)kt * 4096, qf, lane);
#pragma unroll
                  for (int R = 0; R < 16; ++R) { const int key = 32 * kt + 16 * (R >> 3) + 8 * h + (R & 7); const float p = (sel && key <= tq) ? __builtin_amdgcn_exp2f(s[R] - bound_s) : 0.f; s[R] = p; lsum += p; }
                  bf16x8 pb[2]; pb[0] = pack8(s, 0); pb[1] = pack8(s, 1);
                  pv_tile128(vsf + (size_t)kt * 4096, pb, o, lane); } } }
      lsum = half_sum(lsum); const float cs = (lsum > 0.f) ? g1 / lsum : 0.f;
#pragma unroll
      for (int dt = 0; dt < 4; ++dt)
#pragma unroll
          for (int rg = 0; rg < 4; ++rg) { f32x4 v = {o[dt][4 * rg], o[dt][4 * rg + 1], o[dt][4 * rg + 2], o[dt][4 * rg + 3]}; f32x4* p = (f32x4*)(ocr + 32 * dt + 8 * rg + 4 * h); *p = *p + v * cs; } }
    { const bf16* kwf = WSP(bf16, WS_KWF) + (size_t)g * 256 * 4096; const bf16* vwf = WSP(bf16, WS_VWF) + (size_t)g * 256 * 4096;
      o[0] = zero16(); o[1] = zero16(); o[2] = zero16(); o[3] = zero16(); float lsum = 0.f;
      const int tmin = 8 * tg, tmax = 8 * tg + 7; const int kt0 = (tmin >= 511) ? ((tmin - 511) >> 5) : 0, ktl = tmax >> 5;
      for (int kt = kt0; kt <= ktl; ++kt) { f32x16 s = st_tile128(kwf + (size_t)kt * 4096, qf, lane);
#pragma unroll
          for (int R = 0; R < 16; ++R) { const int key = 32 * kt + 16 * (R >> 3) + 8 * h + (R & 7); const float p = (key <= tq && tq - key < 512) ? __builtin_amdgcn_exp2f(s[R] - bound_w) : 0.f; s[R] = p; lsum += p; }
          bf16x8 pb[2]; pb[0] = pack8(s, 0); pb[1] = pack8(s, 1);
          pv_tile128(vwf + (size_t)kt * 4096, pb, o, lane); }
      lsum = half_sum(lsum); const float cw = g2 / lsum;
      bf16* yr = WSP(bf16, WS_A1) + (size_t)tq * (KS * D);
#pragma unroll
      for (int dt = 0; dt < 4; ++dt)
#pragma unroll
          for (int rg = 0; rg < 4; ++rg) { const f32x4 c4 = *(const f32x4*)(ocr + 32 * dt + 8 * rg + 4 * h); f32x4 v;
#pragma unroll
              for (int e = 0; e < 4; ++e) v[e] = c4[e] + cw * o[dt][4 * rg + e];
              storeA4(yr, D, 512 + head * 128 + 32 * dt + 8 * rg + 4 * h, v); } }
}
__device__ __forceinline__ void ph_nsa_mfma(Frame& F, int L) {
    LAS float* IMPW = (LAS float*)(F.lds + F.wave * WAVE_SCR);
    for (int v = F.bid * 8 + F.wave; v < 2048; v += F.G * 8) { const int b = v >> 3, w = v & 7, s = b * 4 + (w & 3);
        const int tg = (w < 4) ? s : 1023 - s, g = (w < 4) ? 0 : 1;
        nsa_wave_item(F, L, tg, g, IMPW); }
}

constexpr int NS_KB = 0, NS_VB = 16384, NS_IMP = 32768, NS_TL = 131072, NS_UNI = NS_TL + 4 * 640, NS_MYM = NS_UNI + 64, NS_S2K = 0, NS_S2V = 65536, NS_NT = 4;
__device__ __forceinline__ f32x16 st_tile_lds(const LAS unsigned char* kslot, const bf16x8 (&qf)[8], int lane) {
    f32x16 s = zero16(); const LAS bf16x8* kp = (const LAS bf16x8*)kslot + lane;
    const unsigned ka = (unsigned)(size_t)kp;
#pragma unroll
    for (int hf = 0; hf < 2; ++hf) { bf16x8 k0, k1, k2, k3;
        if (hf == 0) asm volatile("ds_read_b128 %0, %4\n\tds_read_b128 %1, %4 offset:1024\n\tds_read_b128 %2, %4 offset:2048\n\tds_read_b128 %3, %4 offset:3072\n\ts_waitcnt lgkmcnt(0)" : "=&v"(k0), "=&v"(k1), "=&v"(k2), "=&v"(k3) : "v"(ka) : "memory");
        else         asm volatile("ds_read_b128 %0, %4 offset:4096\n\tds_read_b128 %1, %4 offset:5120\n\tds_read_b128 %2, %4 offset:6144\n\tds_read_b128 %3, %4 offset:7168\n\ts_waitcnt lgkmcnt(0)" : "=&v"(k0), "=&v"(k1), "=&v"(k2), "=&v"(k3) : "v"(ka) : "memory");
        s = MFMA32(k0, qf[4 * hf], s); s = MFMA32(k1, qf[4 * hf + 1], s); s = MFMA32(k2, qf[4 * hf + 2], s); s = MFMA32(k3, qf[4 * hf + 3], s); }
    return s;
}
__device__ __forceinline__ void pv_tile_lds(const LAS unsigned char* vslot, const bf16x8 (&pb)[2], f32x16 (&o)[4], int lane) {
    const LAS bf16x8* vp = (const LAS bf16x8*)vslot + lane;
#pragma unroll
    for (int dt = 0; dt < 4; dt += 2) { bf16x8 v0, v1, v2, v3; const unsigned va = (unsigned)(size_t)vp;
        if (dt == 0) asm volatile("ds_read_b128 %0, %4\n\tds_read_b128 %1, %4 offset:1024\n\tds_read_b128 %2, %4 offset:2048\n\tds_read_b128 %3, %4 offset:3072\n\ts_waitcnt lgkmcnt(0)" : "=&v"(v0), "=&v"(v1), "=&v"(v2), "=&v"(v3) : "v"(va) : "memory");
        else         asm volatile("ds_read_b128 %0, %4 offset:4096\n\tds_read_b128 %1, %4 offset:5120\n\tds_read_b128 %2, %4 offset:6144\n\tds_read_b128 %3, %4 offset:7168\n\ts_waitcnt lgkmcnt(0)" : "=&v"(v0), "=&v"(v1), "=&v"(v2), "=&v"(v3) : "v"(va) : "memory");
        o[dt] = MFMA32(v0, pb[0], o[dt]); o[dt] = MFMA32(v1, pb[1], o[dt]); o[dt + 1] = MFMA32(v2, pb[0], o[dt + 1]); o[dt + 1] = MFMA32(v3, pb[1], o[dt + 1]); }
}
__device__ __forceinline__ void nsa_block_unit(Frame& F, int L, int qb, int g) {
    const int lane = F.lane, w = F.wave, r = lane & 31, h = lane >> 5, slot = r >> 2, jh = r & 3;
    const int tg = 8 * qb + w, tq = 8 * tg + slot, head = 4 * g + jh, cur = qb;
    LAS unsigned char* lds = F.lds; LAS int* TL = (LAS int*)(lds + NS_TL); LAS unsigned* UNI = (LAS unsigned*)(lds + NS_UNI); LAS float* IMPW = (LAS float*)(lds + NS_IMP) + w * (2 * 8 * 129);
    const float* kgn = INP(8) + L * 384;
    const float bc = 11.313708498984761f * LOG2E * 1.02f * gain_absmax128(INP(7) + L * 128, lane);
#define UNIF(x) __builtin_bit_cast(float, __builtin_amdgcn_readfirstlane(__builtin_bit_cast(int, (x))))
    const float bound_c = UNIF(bc * gain_absmax128(kgn, lane)), bound_s = UNIF(bc * gain_absmax128(kgn + 128, lane)), bound_w = UNIF(bc * gain_absmax128(kgn + 256, lane));
    bf16x8 qf[8]; load_qf128(WSP(bf16, WS_QN) + (size_t)tq * 1024 + head * 128, h, qf);
#define NS_GATE(b) sigm(WSP(float, WS_Z)[(size_t)tq * NIN + ZC_GATE + head * 3 + (b)])
#define NS_OCR (WSP(float, WS_OC) + (size_t)tq * 1024 + head * 128)
    const unsigned char* wsb = F.ws;
#define NS_KT(src, kt) ((const v4u*)(wsb + ((src) == 0 ? WS_KCF + (size_t)g * 16 * 8192 : (src) == 1 ? WS_KSF + (size_t)g * 256 * 8192 : WS_KWF + (size_t)g * 256 * 8192) + (size_t)(kt) * 8192) + F.tid)
#define NS_VT(src, kt) ((const v4u*)(wsb + ((src) == 0 ? WS_VCF + (size_t)g * 16 * 8192 : (src) == 1 ? WS_VSF + (size_t)g * 256 * 8192 : WS_VWF + (size_t)g * 256 * 8192) + (size_t)(kt) * 8192) + F.tid)
#define NS_COPY(src, kt, sl) do { __builtin_amdgcn_global_load_lds((const unsigned*)NS_KT(src, kt), (LAS unsigned*)(lds + NS_KB + (sl) * 8192 + w * 1024), 16, 0, 0); \
                                  __builtin_amdgcn_global_load_lds((const unsigned*)NS_VT(src, kt), (LAS unsigned*)(lds + NS_VB + (sl) * 8192 + w * 1024), 16, 0, 0); } while (0)
#define NS_COPYK(src, kt, sl) __builtin_amdgcn_global_load_lds((const unsigned*)NS_KT(src, kt), (LAS unsigned*)(lds + NS_KB + (sl) * 8192 + w * 1024), 16, 0, 0)
#define NS_LAND() asm volatile("s_waitcnt vmcnt(0)" ::: "memory")
    f32x16 o[4]; o[0] = zero16(); o[1] = zero16(); o[2] = zero16(); o[3] = zero16();
    for (int i = lane; i < 2 * 8 * 129; i += 64) IMPW[i] = 0.f;
    if (F.tid < 4) UNI[F.tid] = 0u;
    const int ntb = (((64 * qb + 63 - 31) >> 4) >> 5) + 1;
    const int cmaxq = (tq >= 31) ? ((tq - 31) >> 4) : -1;
    const int ntw = (8 * tg + 7 >= 31) ? (((8 * tg + 7 - 31) >> 4) >> 5) + 1 : 0;
    float lsum = 0.f, inv = 0.f;
    { const int n = 2 * ntb;
      NS_COPYK(0, 0, 0); NS_LAND();
      __syncthreads();
      LAS float* imrow = IMPW + (h * 8 + slot) * 129;
#pragma unroll 1
      for (int i = 0; i < n; ++i) { const int kt = (i < ntb) ? i : i - ntb; const bool pass2 = i >= ntb;
          if (i + 1 < n) { if (i + 1 < ntb) NS_COPYK(0, i + 1, (i + 1) & 1); else NS_COPY(0, i + 1 - ntb, (i + 1) & 1); }
          if (i == ntb) { lsum = half_sum(lsum); inv = (lsum > 0.f) ? 1.0f / lsum : 0.f; }
          if (kt < ntw) { const LAS unsigned char* ks = lds + NS_KB + (i & 1) * 8192; f32x16 s = st_tile_lds(ks, qf, lane);
              if (!pass2) {
#pragma unroll
                  for (int R = 0; R < 16; ++R) { const int c = 32 * kt + 16 * (R >> 3) + 8 * h + (R & 7); lsum += (c <= cmaxq) ? __builtin_amdgcn_exp2f(s[R] - bound_c) : 0.f; } }
              else {
#pragma unroll
                  for (int R = 0; R < 16; ++R) { const int c = 32 * kt + 16 * (R >> 3) + 8 * h + (R & 7); s[R] = (c <= cmaxq) ? __builtin_amdgcn_exp2f(s[R] - bound_c) * inv : 0.f; }
#pragma unroll
                  for (int s2 = 0; s2 < 2; ++s2) { const int sb = 8 * kt + 4 * s2 + 2 * h;
                      float a = (s[8 * s2] + s[8 * s2 + 1]) + (s[8 * s2 + 2] + s[8 * s2 + 3]), b = ((s[8 * s2 + 4] + s[8 * s2 + 5]) + (s[8 * s2 + 6] + s[8 * s2 + 7])) + s[8 * s2 + 3], c7 = s[8 * s2 + 7];
                      a += sxor<1>(a); b += sxor<1>(b); c7 += sxor<1>(c7); a += sxor<2>(a); b += sxor<2>(b); c7 += sxor<2>(c7);
                      if (jh == 0) { imrow[sb] = a; imrow[sb + 1] = b; imrow[sb + 2] = c7; } }
                  bf16x8 pb[2]; pb[0] = pack8(s, 0); pb[1] = pack8(s, 1);
                  pv_tile_lds(lds + NS_VB + (i & 1) * 8192, pb, o, lane); } }
          NS_LAND();
          __syncthreads(); } }
    { const float g0 = NS_GATE(0); float* ocr = NS_OCR;
#pragma unroll
    for (int dt = 0; dt < 4; ++dt)
#pragma unroll
        for (int rg = 0; rg < 4; ++rg) { f32x4 v = {o[dt][4 * rg], o[dt][4 * rg + 1], o[dt][4 * rg + 2], o[dt][4 * rg + 3]}; *(f32x4*)(ocr + 32 * dt + 8 * rg + 4 * h) = v * g0; } }
    LDS_WAIT();
    unsigned my[4] = {0u, 0u, 0u, 0u}, un[4] = {0u, 0u, 0u, 0u};
    if (cur < 16) { my[0] = un[0] = (1u << (cur + 1)) - 1u; }
    else {
        float v0[8], v1[8];
#pragma unroll
        for (int ts = 0; ts < 8; ++ts) { const int s0 = lane, s1 = lane + 64;
            const float a0 = IMPW[ts * 129 + s0] + IMPW[(8 + ts) * 129 + s0], a1 = IMPW[ts * 129 + s1] + IMPW[(8 + ts) * 129 + s1];
            v0[ts] = (s0 > cur) ? -3.0e38f : ((s0 == 0 || s0 == cur || s0 == cur - 1) ? 3.0e38f : a0);
            v1[ts] = (s1 > cur) ? -3.0e38f : ((s1 == cur || s1 == cur - 1) ? 3.0e38f : a1); }
#pragma unroll 1
        for (int k = 0; k < 16; ++k) { float bv[8]; int bi[8];
#pragma unroll
            for (int ts = 0; ts < 8; ++ts) { if (v0[ts] >= v1[ts]) { bv[ts] = v0[ts]; bi[ts] = lane; } else { bv[ts] = v1[ts]; bi[ts] = lane + 64; } }
#define AMX(M) _Pragma("unroll") for (int ts = 0; ts < 8; ++ts) { const float ov_ = sxor<M>(bv[ts]); const int oi_ = sxori<M>(bi[ts]); if (ov_ > bv[ts] || (ov_ == bv[ts] && oi_ < bi[ts])) { bv[ts] = ov_; bi[ts] = oi_; } }
            AMX(1) AMX(2) AMX(4) AMX(8) AMX(16)
#undef AMX
#pragma unroll
            for (int ts = 0; ts < 8; ++ts) { unsigned va = __builtin_bit_cast(unsigned, bv[ts]), vb = va, ia = (unsigned)bi[ts], ib = ia; swap32(va, vb); swap32(ia, ib);
                const float x0 = __builtin_bit_cast(float, va), x1 = __builtin_bit_cast(float, vb); const int i0 = (int)ia, i1 = (int)ib;
                int win = (x0 > x1 || (x0 == x1 && i0 < i1)) ? i0 : i1;
                if (win == lane) v0[ts] = -3.0e38f; if (win == lane + 64) v1[ts] = -3.0e38f;
                win = __builtin_amdgcn_readfirstlane(win);
                const unsigned bit = 1u << (win & 31); const int wi = win >> 5; const bool mine = (slot == ts);
#pragma unroll
                for (int q4 = 0; q4 < 4; ++q4) { if (wi == q4) { un[q4] |= bit; if (mine) my[q4] |= bit; } } } } }
    LAS unsigned* MYM = (LAS unsigned*)(lds + NS_MYM) + (w * 64 + lane) * 4;
    *(LAS v4u*)MYM = (v4u){my[0], my[1], my[2], my[3]};
    if (lane == 0) {
#pragma unroll
        for (int q4 = 0; q4 < 4; ++q4) (void)__hip_atomic_fetch_or(UNI + q4, un[q4], __ATOMIC_RELAXED, __HIP_MEMORY_SCOPE_WORKGROUP); }
    __syncthreads();
    unsigned u0 = UNI[0], u1 = UNI[1], u2 = UNI[2], u3 = UNI[3];
    const int nsel = 2 * (__builtin_popcount(u0) + __builtin_popcount(u1) + __builtin_popcount(u2) + __builtin_popcount(u3));
    const int ktl = 2 * qb + 1, kt0 = (ktl >= 17) ? ktl - 17 : 0, nwin = ktl - kt0 + 1, ntl = nsel + nwin;
    int jt_ = F.tid; asm volatile("" : "+v"(jt_));
    if (jt_ < 128) { const int j = jt_; const unsigned wsel = (j < 32) ? u0 : (j < 64) ? u1 : (j < 96) ? u2 : u3;
        if ((wsel >> (j & 31)) & 1u) { int pos = __builtin_popcount(wsel & ((1u << (j & 31)) - 1u)); if (j >= 32) pos += __builtin_popcount(u0); if (j >= 64) pos += __builtin_popcount(u1); if (j >= 96) pos += __builtin_popcount(u2);
            TL[2 * pos] = (2 * j) | (1 << 16); TL[2 * pos + 1] = (2 * j + 1) | (1 << 16); } }
    else if (jt_ < 128 + 32) { const int i = jt_ - 128; if (i < nwin) TL[nsel + i] = (kt0 + i) | (2 << 16); }
    __syncthreads();
    o[0] = zero16(); o[1] = zero16(); o[2] = zero16(); o[3] = zero16(); lsum = 0.f;
    {
#define NS_COPY2(src, kt, sl) do { __builtin_amdgcn_global_load_lds((const unsigned*)NS_KT(src, kt), (LAS unsigned*)(lds + NS_S2K + (sl) * 8192 + w * 1024), 16, 0, 0); \
                                   __builtin_amdgcn_global_load_lds((const unsigned*)NS_VT(src, kt), (LAS unsigned*)(lds + NS_S2V + (sl) * 8192 + w * 1024), 16, 0, 0); } while (0)
#pragma unroll 1
      for (int u2 = 0; u2 < NS_NT; ++u2) if (u2 < ntl) { const int e0 = TL[u2]; NS_COPY2(e0 >> 16, e0 & 0xffff, u2); }
      NS_LAND();
      __syncthreads();
      const int wkt0 = (8 * tg >= 511) ? ((8 * tg - 511) >> 5) : 0, wktl = (8 * tg + 7) >> 5;
      const int nst = (ntl + NS_NT - 1) / NS_NT, nss = nsel / NS_NT;
#pragma unroll 1
      for (int st = 0; st < nst; ++st) {
          if (st + 1 < nst) {
#pragma unroll 1
              for (int u2 = 0; u2 < NS_NT; ++u2) { const int ix = NS_NT * (st + 1) + u2; if (ix < ntl) { const int ea = TL[ix]; NS_COPY2(ea >> 16, ea & 0xffff, ((st + 1) & 1) * NS_NT + u2); } } }
#pragma unroll 1
          for (int u2 = 0; u2 < NS_NT; ++u2) { const int i = NS_NT * st + u2; if (i >= ntl) break;
          if (i == nsel) {
              lsum = half_sum(lsum); const float cs = (lsum > 0.f) ? NS_GATE(1) / lsum : 0.f; float* ocr = NS_OCR;
#pragma unroll
              for (int dt = 0; dt < 4; ++dt)
#pragma unroll
                  for (int rg = 0; rg < 4; ++rg) { f32x4 v = {o[dt][4 * rg], o[dt][4 * rg + 1], o[dt][4 * rg + 2], o[dt][4 * rg + 3]}; f32x4* p = (f32x4*)(ocr + 32 * dt + 8 * rg + 4 * h); *p = *p + v * cs; }
              o[0] = zero16(); o[1] = zero16(); o[2] = zero16(); o[3] = zero16(); lsum = 0.f; }
          const int en = TL[i], src = en >> 16, kt = en & 0xffff; const int sl = (st & 1) * NS_NT + u2;
          bool need, full; int lo, hi; float bnd;
          if (src == 1) { const int j = kt >> 1; const unsigned wu = (j < 32) ? un[0] : (j < 64) ? un[1] : (j < 96) ? un[2] : un[3]; const unsigned wm = MYM[j >> 5];
              need = (__builtin_amdgcn_readfirstlane(wu) >> (j & 31)) & 1u; const bool sel = (wm >> (j & 31)) & 1u; lo = 0; hi = tq; bnd = sel ? bound_s : 3.0e38f; full = (j < cur); }
          else { need = (kt >= wkt0 && kt <= wktl); lo = tq - 511; hi = tq; bnd = bound_w; full = (32 * kt + 31 <= 8 * tg) && (32 * kt >= 8 * tg + 7 - 511); }
          if (need) { f32x16 s = st_tile_lds(lds + NS_S2K + sl * 8192, qf, lane);
              if (full) {
#pragma unroll
                  for (int R = 0; R < 16; ++R) { const float p = __builtin_amdgcn_exp2f(s[R] - bnd); s[R] = p; lsum += p; } }
              else {
#pragma unroll
              for (int R = 0; R < 16; ++R) { const int key = 32 * kt + 16 * (R >> 3) + 8 * h + (R & 7); const float p = (key >= lo && key <= hi) ? __builtin_amdgcn_exp2f(s[R] - bnd) : 0.f; s[R] = p; lsum += p; } }
              bf16x8 pb[2]; pb[0] = pack8(s, 0); pb[1] = pack8(s, 1);
              pv_tile_lds(lds + NS_S2V + sl * 8192, pb, o, lane); } }
          NS_LAND();
          __syncthreads(); } }
    { lsum = half_sum(lsum); const float cw = NS_GATE(2) / lsum; const float* ocr = NS_OCR;
      bf16* yr = WSP(bf16, WS_A1) + (size_t)tq * (KS * D);
#pragma unroll
      for (int dt = 0; dt < 4; ++dt)
#pragma unroll
          for (int rg = 0; rg < 4; ++rg) { const f32x4 c4 = *(const f32x4*)(ocr + 32 * dt + 8 * rg + 4 * h); f32x4 v;
#pragma unroll
              for (int e = 0; e < 4; ++e) v[e] = c4[e] + cw * o[dt][4 * rg + e];
              storeA4(yr, D, 512 + head * 128 + 32 * dt + 8 * rg + 4 * h, v); } }
    __syncthreads();
#undef NS_KT
#undef NS_VT
#undef NS_COPY
#undef NS_LAND
#undef NS_COPY2
#undef NS_GATE
#undef NS_OCR
#undef UNIF
}
__device__ __forceinline__ void ph_nsa_block(Frame& F, int L) {
    for (int u = F.bid; u < 256; u += F.G) { const int g = u & 1, qb = u >> 1; nsa_block_unit(F, L, qb, g); }
}

__device__ __forceinline__ f32x16 st_tile_lds_q(const LAS unsigned char* kslot, const LAS unsigned char* qlds, const bf16x8 (&qh)[4], int lane) {
    f32x16 s = zero16(); const unsigned ka = (unsigned)(size_t)((const LAS bf16x8*)kslot + lane), qa = (unsigned)(size_t)((const LAS bf16x8*)qlds + lane);
    { bf16x8 k0, k1, k2, k3, q0, q1, q2, q3;
      asm volatile("ds_read_b128 %0, %8\n\tds_read_b128 %1, %8 offset:1024\n\tds_read_b128 %2, %8 offset:2048\n\tds_read_b128 %3, %8 offset:3072\n\t"
                   "ds_read_b128 %4, %9\n\tds_read_b128 %5, %9 offset:1024\n\tds_read_b128 %6, %9 offset:2048\n\tds_read_b128 %7, %9 offset:3072\n\ts_waitcnt lgkmcnt(0)"
                   : "=&v"(k0), "=&v"(k1), "=&v"(k2), "=&v"(k3), "=&v"(q0), "=&v"(q1), "=&v"(q2), "=&v"(q3) : "v"(ka), "v"(qa) : "memory");
      s = MFMA32(k0, q0, s); s = MFMA32(k1, q1, s); s = MFMA32(k2, q2, s); s = MFMA32(k3, q3, s); }
    { bf16x8 k0, k1, k2, k3;
      asm volatile("ds_read_b128 %0, %4 offset:4096\n\tds_read_b128 %1, %4 offset:5120\n\tds_read_b128 %2, %4 offset:6144\n\tds_read_b128 %3, %4 offset:7168\n\ts_waitcnt lgkmcnt(0)" : "=&v"(k0), "=&v"(k1), "=&v"(k2), "=&v"(k3) : "v"(ka) : "memory");
      s = MFMA32(k0, qh[0], s); s = MFMA32(k1, qh[1], s); s = MFMA32(k2, qh[2], s); s = MFMA32(k3, qh[3], s); }
    return s;
}
constexpr int N3_QL = 119616;
constexpr int N3_KB = 0, N3_VB = 32768, N3_TL = 65536, N3_UNI = N3_TL + 2560, N3_LX = N3_UNI + 64, N3_IMP = N3_LX + 2048, N3_MYM = N3_IMP + 4 * 2 * 8 * 129 * 4;
__device__ __forceinline__ void n3_tile(const LAS unsigned char* ks, const LAS unsigned char* vs, const LAS unsigned char* ql, const bf16x8 (&qf)[4], f32x16 (&o)[4], float& lsum, float bnd, bool full, int lo, int hi, int kt, int h, bool do_pv, int lane) {
    f32x16 s = st_tile_lds_q(ks, ql, qf, lane);
    if (full) {
#pragma unroll
        for (int R = 0; R < 16; ++R) { const float p = __builtin_amdgcn_exp2f(s[R] - bnd); s[R] = p; lsum += p; } }
    else {
#pragma unroll
        for (int R = 0; R < 16; ++R) { const int key = 32 * kt + 16 * (R >> 3) + 8 * h + (R & 7); const float p = (key >= lo && key <= hi) ? __builtin_amdgcn_exp2f(s[R] - bnd) : 0.f; s[R] = p; lsum += p; } }
    if (do_pv) { bf16x8 pb[2]; pb[0] = pack8(s, 0); pb[1] = pack8(s, 1); pv_tile_lds(vs, pb, o, lane); }
}
__device__ __forceinline__ void nsa_unit3(Frame& F, int L, int qbh, int g) {
#define OPQL() ({ int l_ = F.lane; asm volatile("" : "+v"(l_)); l_; })
    const int lane = OPQL(), w = F.wave, r = lane & 31, h = lane >> 5, slot = r >> 2, jh = r & 3, tgw = w & 3, par = w >> 2;
    const int tg = 4 * qbh + tgw, tq = 8 * tg + slot, head = 4 * g + jh, cur = qbh >> 1;
    LAS unsigned char* lds = F.lds; LAS int* TL = (LAS int*)(lds + N3_TL); LAS unsigned* UNI = (LAS unsigned*)(lds + N3_UNI); LAS float* LX = (LAS float*)(lds + N3_LX);
    LAS float* IMPG = (LAS float*)(lds + N3_IMP) + tgw * (2 * 8 * 129);
    const float* kgn = INP(8) + L * 384;
    const float bc = 11.313708498984761f * LOG2E * 1.02f * gain_absmax128(INP(7) + L * 128, lane);
#define UNIF(x) __builtin_bit_cast(float, __builtin_amdgcn_readfirstlane(__builtin_bit_cast(int, (x))))
    const float bound_c = UNIF(bc * gain_absmax128(kgn, lane)), bound_s = UNIF(bc * gain_absmax128(kgn + 128, lane)), bound_w = UNIF(bc * gain_absmax128(kgn + 256, lane));
    bf16x8 qf[4]; LAS unsigned char* ql = lds + N3_QL + w * 4096;
    { const bf16* qrow = WSP(bf16, WS_QN) + (size_t)tq * 1024 + head * 128 + 8 * h;
#pragma unroll
      for (int sp = 0; sp < 4; ++sp) { *((LAS bf16x8*)ql + sp * 64 + lane) = *(const bf16x8*)(qrow + 16 * sp); qf[sp] = *(const bf16x8*)(qrow + 16 * (sp + 4)); } }
#define N3_GATE(b) sigm(*(const float*)(F.ws + WS_Z + (size_t)(32 * qbh) * NIN * 4 + (unsigned)((((tq - 32 * qbh) * NIN) + ZC_GATE + head * 3 + (b)) * 4)))
#define N3_OCR ({ const int l2_ = OPQL(); const int r2_ = l2_ & 31; (float*)(F.ws + WS_OC + (unsigned)((((8 * tg + (r2_ >> 2)) * 1024 + (4 * g + (r2_ & 3)) * 128) + 4 * (l2_ >> 5)) * 4)); })
    const unsigned char* wsb = F.ws;
    const unsigned dmaoff = (unsigned)(w * 1024 + lane * 16);
#define N3_KT(src, kt) ((const unsigned*)((wsb + ((src) == 0 ? WS_KCF + (size_t)g * 16 * 8192 : (src) == 1 ? WS_KSF + (size_t)g * 256 * 8192 : WS_KWF + (size_t)g * 256 * 8192) + (size_t)(kt) * 8192) + dmaoff))
#define N3_VT(src, kt) ((const unsigned*)((wsb + ((src) == 0 ? WS_VCF + (size_t)g * 16 * 8192 : (src) == 1 ? WS_VSF + (size_t)g * 256 * 8192 : WS_VWF + (size_t)g * 256 * 8192) + (size_t)(kt) * 8192) + dmaoff))
#define N3_COPY(src, kt, sl) do { __builtin_amdgcn_global_load_lds(N3_KT(src, kt), (LAS unsigned*)(lds + N3_KB + (sl) * 8192 + w * 1024), 16, 0, 0); \
                                  __builtin_amdgcn_global_load_lds(N3_VT(src, kt), (LAS unsigned*)(lds + N3_VB + (sl) * 8192 + w * 1024), 16, 0, 0); } while (0)
#define N3_LAND() asm volatile("s_waitcnt vmcnt(0)" ::: "memory")
#define N3_FOLD(COEF, FIRST) do { const float cf_ = (COEF); float* ocr_ = N3_OCR; \
        for (int pp_ = 0; pp_ < 2; ++pp_) { if (pp_ == par) { _Pragma("unroll") for (int dt = 0; dt < 4; ++dt) _Pragma("unroll") for (int rg = 0; rg < 4; ++rg) { \
            f32x4 v_ = {o[dt][4 * rg], o[dt][4 * rg + 1], o[dt][4 * rg + 2], o[dt][4 * rg + 3]}; f32x4* p_ = (f32x4*)(ocr_ + 32 * dt + 8 * rg); if ((FIRST) && pp_ == 0) *p_ = v_ * cf_; else *p_ = *p_ + v_ * cf_; } \
            asm volatile("s_waitcnt vmcnt(0)" ::: "memory"); } __syncthreads(); } } while (0)
#define N3_LTOT(dst) do { const int l3_ = OPQL(); lsum = half_sum(lsum); LX[w * 64 + l3_] = lsum; __syncthreads(); dst = LX[tgw * 64 + l3_] + LX[(tgw + 4) * 64 + l3_]; __syncthreads(); } while (0)
    f32x16 o[4]; o[0] = zero16(); o[1] = zero16(); o[2] = zero16(); o[3] = zero16();
    for (int i = OPQL() + 64 * par; i < 2 * 8 * 129; i += 128) IMPG[i] = 0.f;
    if (F.tid < 4) UNI[F.tid] = 0u;
    const int tlast = 32 * qbh + 31; const int ntb = (tlast >= 31) ? (((tlast - 31) >> 4) >> 5) + 1 : 0;
    const int cmaxq = (tq >= 31) ? ((tq - 31) >> 4) : -1;
    const int cmin_w = (8 * tg >= 31) ? ((8 * tg - 31) >> 4) : -1;
    const int ntw = (8 * tg + 7 >= 31) ? (((8 * tg + 7 - 31) >> 4) >> 5) + 1 : 0;
    float lsum = 0.f; float bnd2 = 3.0e38f;
    { const int s1 = (ntb + 1) >> 1, n = 2 * s1;
      if (n > 0) { if (0 < ntb) N3_COPY(0, 0, 0); if (1 < ntb) N3_COPY(0, 1, 1); }
      N3_LAND(); __syncthreads();
      LAS float* imrow = IMPG + (h * 8 + slot) * 129;
#pragma unroll 1
      for (int i = 0; i < n; ++i) { const int ii = (i < s1) ? i : i - s1, kt = 2 * ii + par; const bool pass2 = i >= s1;
          if (i + 1 < n) { const int in = (i + 1 < s1) ? i + 1 : i + 1 - s1; if (2 * in < ntb) N3_COPY(0, 2 * in, ((i + 1) & 1) * 2); if (2 * in + 1 < ntb) N3_COPY(0, 2 * in + 1, ((i + 1) & 1) * 2 + 1); }
          if (i == s1) { float lt; N3_LTOT(lt); bnd2 = (lt > 0.f) ? bound_c + __builtin_amdgcn_logf(lt) : 3.0e38f; lsum = 0.f; }
          if (kt < ntb && kt < ntw) { const LAS unsigned char* ks = lds + N3_KB + ((i & 1) * 2 + par) * 8192; const LAS unsigned char* vs = lds + N3_VB + ((i & 1) * 2 + par) * 8192;
              const bool full = (32 * kt + 31 <= cmin_w);
              if (!pass2) n3_tile(ks, vs, ql, qf, o, lsum, bound_c, full, 0, cmaxq, kt, h, false, lane);
              else { f32x16 s = st_tile_lds_q(ks, ql, qf, lane);
#pragma unroll
                  for (int R = 0; R < 16; ++R) { const int c = 32 * kt + 16 * (R >> 3) + 8 * h + (R & 7); s[R] = (full || c <= cmaxq) ? __builtin_amdgcn_exp2f(s[R] - bnd2) : 0.f; }
#pragma unroll
                  for (int s2 = 0; s2 < 2; ++s2) { const int sb = 8 * kt + 4 * s2 + 2 * h;
                      float a = (s[8 * s2] + s[8 * s2 + 1]) + (s[8 * s2 + 2] + s[8 * s2 + 3]), b = ((s[8 * s2 + 4] + s[8 * s2 + 5]) + (s[8 * s2 + 6] + s[8 * s2 + 7])) + s[8 * s2 + 3], c7 = s[8 * s2 + 7];
                      a += sxor<1>(a); b += sxor<1>(b); c7 += sxor<1>(c7); a += sxor<2>(a); b += sxor<2>(b); c7 += sxor<2>(c7);
                      if (jh == 0) { imrow[sb] = a; imrow[sb + 1] = b; imrow[sb + 2] = c7; } }
                  bf16x8 pb[2]; pb[0] = pack8(s, 0); pb[1] = pack8(s, 1);
                  pv_tile_lds(vs, pb, o, lane); } }
          N3_LAND(); __syncthreads(); } }
    N3_FOLD(N3_GATE(0), true);
    unsigned my[4] = {0u, 0u, 0u, 0u}, un[4] = {0u, 0u, 0u, 0u};
    if (cur < 16) { my[0] = un[0] = (1u << (cur + 1)) - 1u; }
    else {
        const int lk_ = OPQL();
#pragma unroll 1
        for (int ts = 0; ts < 8; ++ts) { const int s0 = lk_, s1 = lk_ + 64;
            float v0 = IMPG[ts * 129 + s0] + IMPG[(8 + ts) * 129 + s0], v1 = IMPG[ts * 129 + s1] + IMPG[(8 + ts) * 129 + s1];
            v0 = (s0 > cur) ? -3.0e38f : ((s0 == 0 || s0 == cur || s0 == cur - 1) ? 3.0e38f : v0);
            v1 = (s1 > cur) ? -3.0e38f : ((s1 == cur || s1 == cur - 1) ? 3.0e38f : v1);
#pragma unroll 1
            for (int k = 0; k < 16; ++k) { float bv; int bi; if (v0 >= v1) { bv = v0; bi = lk_; } else { bv = v1; bi = lk_ + 64; }
                wave_argmax(bv, bi);
                if (bi == lk_) v0 = -3.0e38f; if (bi == lk_ + 64) v1 = -3.0e38f;
                bi = __builtin_amdgcn_readfirstlane(bi);
                const unsigned bit = 1u << (bi & 31); const int wi = bi >> 5; const bool mine = (slot == ts);
#pragma unroll
                for (int q4 = 0; q4 < 4; ++q4) { if (wi == q4) { un[q4] |= bit; if (mine) my[q4] |= bit; } } } } }
    LAS unsigned* MYM = (LAS unsigned*)(lds + N3_MYM) + (w * 64 + OPQL()) * 4;
    *(LAS v4u*)MYM = (v4u){my[0], my[1], my[2], my[3]};
    if (lane == 0) {
#pragma unroll
        for (int q4 = 0; q4 < 4; ++q4) (void)__hip_atomic_fetch_or(UNI + q4, un[q4], __ATOMIC_RELAXED, __HIP_MEMORY_SCOPE_WORKGROUP); }
    __syncthreads();
    const unsigned u0 = UNI[0], u1 = UNI[1], u2 = UNI[2], u3 = UNI[3];
    const int nsel = 2 * (__builtin_popcount(u0) + __builtin_popcount(u1) + __builtin_popcount(u2) + __builtin_popcount(u3));
    const int ktl = qbh, kt0 = (ktl >= 16) ? ktl - 16 : 0, nwin = ktl - kt0 + 1, ntl = nsel + nwin;
    { int jt_ = F.tid; asm volatile("" : "+v"(jt_));
      if (jt_ < 128) { const int j = jt_; const unsigned wsel = (j < 32) ? u0 : (j < 64) ? u1 : (j < 96) ? u2 : u3;
          if ((wsel >> (j & 31)) & 1u) { int pos = __builtin_popcount(wsel & ((1u << (j & 31)) - 1u)); if (j >= 32) pos += __builtin_popcount(u0); if (j >= 64) pos += __builtin_popcount(u1); if (j >= 96) pos += __builtin_popcount(u2);
              TL[2 * pos] = (2 * j) | (1 << 16); TL[2 * pos + 1] = (2 * j + 1) | (1 << 16); } }
      else if (jt_ < 128 + 32) { const int i = jt_ - 128; if (i < nwin) TL[nsel + i] = (kt0 + i) | (2 << 16); } }
    __syncthreads();
    o[0] = zero16(); o[1] = zero16(); o[2] = zero16(); o[3] = zero16(); lsum = 0.f;
    { const int nst = (ntl + 1) >> 1, nss = nsel >> 1;
      { const int e0 = TL[0]; N3_COPY(e0 >> 16, e0 & 0xffff, 0); if (1 < ntl) { const int e1 = TL[1]; N3_COPY(e1 >> 16, e1 & 0xffff, 1); } }
      N3_LAND(); __syncthreads();
      const int wkt0 = (8 * tg >= 511) ? ((8 * tg - 511) >> 5) : 0, wktl = (8 * tg + 7) >> 5;
#pragma unroll 1
      for (int i = 0; i < nst; ++i) {
          if (i + 1 < nst) { const int ea = TL[2 * i + 2]; N3_COPY(ea >> 16, ea & 0xffff, ((i + 1) & 1) * 2); if (2 * i + 3 < ntl) { const int eb = TL[2 * i + 3]; N3_COPY(eb >> 16, eb & 0xffff, ((i + 1) & 1) * 2 + 1); } }
          if (i == nss) { float lt; N3_LTOT(lt); N3_FOLD((lt > 0.f) ? N3_GATE(1) / lt : 0.f, false); o[0] = zero16(); o[1] = zero16(); o[2] = zero16(); o[3] = zero16(); lsum = 0.f; }
          const int ei = 2 * i + par;
          if (ei < ntl) { const int en = TL[ei], src = en >> 16, kt = en & 0xffff; bool need, full; int lo, hi; float bnd;
              if (src == 1) { const int j = kt >> 1; const unsigned wu = (j < 32) ? un[0] : (j < 64) ? un[1] : (j < 96) ? un[2] : un[3];
                  need = (__builtin_amdgcn_readfirstlane(wu) >> (j & 31)) & 1u; const bool sel = (MYM[j >> 5] >> (j & 31)) & 1u; bnd = sel ? bound_s : 3.0e38f; lo = 0; hi = tq; full = (j < cur); }
              else { need = (kt >= wkt0 && kt <= wktl); lo = tq - 511; hi = tq; bnd = bound_w; full = (32 * kt + 31 <= 8 * tg) && (32 * kt >= 8 * tg + 7 - 511); }
              if (need) n3_tile(lds + N3_KB + ((i & 1) * 2 + par) * 8192, lds + N3_VB + ((i & 1) * 2 + par) * 8192, ql, qf, o, lsum, bnd, full, lo, hi, kt, h, true, lane); }
          N3_LAND(); __syncthreads(); } }
    { float lt; N3_LTOT(lt); const float cw = N3_GATE(2) / lt; float* ocr = N3_OCR;
      if (par == 0) {
#pragma unroll
          for (int dt = 0; dt < 4; ++dt)
#pragma unroll
              for (int rg = 0; rg < 4; ++rg) { f32x4 v = {o[dt][4 * rg], o[dt][4 * rg + 1], o[dt][4 * rg + 2], o[dt][4 * rg + 3]}; f32x4* p = (f32x4*)(ocr + 32 * dt + 8 * rg); *p = *p + v * cw; }
          asm volatile("s_waitcnt vmcnt(0)" ::: "memory"); }
      __syncthreads();
      if (par == 1) { const int l4_ = OPQL(); const int hh_ = l4_ >> 5; bf16* yr = (bf16*)(F.ws + WS_A1 + (size_t)(32 * qbh) * (KS * D) * 2 + (unsigned)(((8 * tgw + ((l4_ & 31) >> 2)) * (KS * D)) * 2));
#pragma unroll
          for (int dt = 0; dt < 4; ++dt)
#pragma unroll
              for (int rg = 0; rg < 4; ++rg) { const f32x4 c4 = *(const f32x4*)(ocr + 32 * dt + 8 * rg); f32x4 v;
#pragma unroll
                  for (int e = 0; e < 4; ++e) v[e] = c4[e] + cw * o[dt][4 * rg + e];
                  storeA4(yr, D, 512 + head * 128 + 32 * dt + 8 * rg + 4 * hh_, v); } } }
    __syncthreads();
#undef OPQL
#undef UNIF
#undef N3_GATE
#undef N3_OCR
#undef N3_KT
#undef N3_VT
#undef N3_COPY
#undef N3_LAND
#undef N3_FOLD
#undef N3_LTOT
}
__device__ __forceinline__ void ph_nsa3(Frame& F, int L) {
    for (int b = F.bid; b < 256; b += F.G) {
#pragma unroll 1
        for (int k = 0; k < 2; ++k) { const int u = k ? 511 - b : b; nsa_unit3(F, L, u >> 1, u & 1); } }
}

__device__ __forceinline__ void ph_xattn_mfma(Frame& F, int L) {
    const int lane = F.lane, q = lane & 31, h = lane >> 5;
    const float* qg = INP(20) + L * 512; const float* kg = INP(21) + L * 512;
    float gm_q = 0.f, gm_k = 0.f;
#pragma unroll
    for (int i = 0; i < 8; ++i) { gm_q = fmaxf(gm_q, fabsf(qg[lane + 64 * i])); gm_k = fmaxf(gm_k, fabsf(kg[lane + 64 * i])); }
    const float bound = 22.627416997969522f * LOG2E * 1.02f * wave_max(gm_q) * wave_max(gm_k);
    const bf16* xqb = WSP(bf16, WS_XQB);
    for (int it = F.bid * 8 + F.wave; it < (T / 32) * 4; it += F.G * 8) {
        const int tg = it >> 2, hd = it & 3, t = 32 * tg + q;
        const bf16x8* qp = (const bf16x8*)(xqb + (size_t)t * D + hd * 512 + 8 * h);
        float ss = 0.f;
#pragma unroll 8
        for (int sp = 0; sp < 32; ++sp) { const v4u wv = __builtin_bit_cast(v4u, qp[2 * sp]);
#pragma unroll
            for (int e = 0; e < 4; ++e) { const float lo = bf2f(wv[e] & 0xffffu), hi = bf2f(wv[e] >> 16); ss += lo * lo + hi * hi; } }
        ss = half_sum(ss);
        const float rs = 1.0f / sqrtf(ss * (1.0f / 512.0f) + EPS);
        const bf16x8* kx = (const bf16x8*)(WSP(bf16, WS_KXF) + (size_t)hd * 8 * 16384) + lane;
        bf16x8 pb[16]; float lsum = 0.f;
#pragma unroll
        for (int kt = 0; kt < 8; ++kt) { f32x16 s = zero16();
#pragma unroll 4
            for (int sp = 0; sp < 32; ++sp) s = MFMA32(kx[(kt * 32 + sp) * 64], qp[2 * sp], s);
#pragma unroll
            for (int R = 0; R < 16; ++R) { const float p = __builtin_amdgcn_exp2f(s[R] * rs - bound); s[R] = p; lsum += p; }
            pb[2 * kt] = pack8(s, 0); pb[2 * kt + 1] = pack8(s, 1); }
        lsum = half_sum(lsum); const float inv = 1.0f / lsum;
        const bf16x8* vx = (const bf16x8*)(WSP(bf16, WS_VXF) + (size_t)hd * 8 * 16384) + lane;
        bf16* yr = WSP(bf16, WS_A1) + (size_t)t * (KS * D);
#pragma unroll 1
        for (int dt = 0; dt < 16; ++dt) { f32x16 o = zero16();
#pragma unroll
            for (int kt = 0; kt < 8; ++kt)
#pragma unroll
                for (int s = 0; s < 2; ++s) o = MFMA32(vx[((kt * 16 + dt) * 2 + s) * 64], pb[2 * kt + s], o);
#pragma unroll
            for (int rg = 0; rg < 4; ++rg) { f32x4 v = {o[4 * rg] * inv, o[4 * rg + 1] * inv, o[4 * rg + 2] * inv, o[4 * rg + 3] * inv}; storeA4(yr, D, hd * 512 + 32 * dt + 8 * rg + 4 * h, v); } }
    }
}
__device__ __forceinline__ bf16x8 ldsfrag(const LAS bf16* p) { return *(const LAS bf16x8*)p; }
__device__ __forceinline__ v4u pack8f(const float (&v)[8]) { v4u o; o.x = cvtpk(v[0], v[1]); o.y = cvtpk(v[2], v[3]); o.z = cvtpk(v[4], v[5]); o.w = cvtpk(v[6], v[7]); return o; }
constexpr int PQ = 136, PV = 72;
__device__ __forceinline__ size_t st_chunk(int c, int h, int e, int doct) { return ((((size_t)(c * 4 + h) * 4 + (e >> 5)) * 8 + (doct >> 1)) * 512) + ((e & 31) + 32 * (doct & 1)) * 8; }

__device__ __forceinline__ void summary_mma(Frame& F, const LAS bf16* AT, const LAS bf16* VT, float* U) {
    const int lane = F.lane, r = lane & 31, h = lane >> 5;
#pragma unroll
    for (int i = 0; i < 2; ++i) { const int tile = F.wave * 2 + i, dt = tile >> 2, et = tile & 3; f32x16 c = zero16();
#pragma unroll
        for (int ks = 0; ks < 4; ++ks) c = MFMA32(ldsfrag(AT + (32 * dt + r) * PV + 16 * ks + 8 * h), ldsfrag(VT + (32 * et + r) * PV + 16 * ks + 8 * h), c);
#pragma unroll
        for (int R = 0; R < 16; ++R) U[(size_t)(32 * dt + (R & 3) + 8 * (R >> 2) + 4 * h) * 128 + 32 * et + r] = c[R]; }
}
__device__ __forceinline__ void fill_vt(Frame& F, const float* vsrc  , LAS bf16* VT) {
    for (int i = F.tid; i < 1024; i += 512) { const int e = i & 127, s0 = (i >> 7) * 8; float v[8];
#pragma unroll
        for (int j = 0; j < 8; ++j) v[j] = vsrc[(size_t)(s0 + j) * NIN + e];
        *(LAS v4u*)(VT + e * PV + s0) = pack8f(v); }
}
__device__ __forceinline__ void hg_summary_mfma(Frame& F, int L, int c, int h) {
    LAS float* B = (LAS float*)F.lds; LAS float* KY = B + 64 * HP; LAS bf16* AT = (LAS bf16*)(KY + 64 * HP); LAS bf16* VT = AT + 128 * PV;
    const float* z = WSP(float, WS_Z);
    hg_gates(F, L, c, h, B, KY);
    for (int i = F.tid; i < 1024; i += 512) { const int d = i & 127, s0 = (i >> 7) * 8; const float be = B[63 * HP + d]; float v[8];
#pragma unroll
        for (int j = 0; j < 8; ++j) v[j] = KY[(s0 + j) * HP + d] * EXPF(be - B[(s0 + j) * HP + d]);
        *(LAS v4u*)(AT + d * PV + s0) = pack8f(v); }
    fill_vt(F, z + (size_t)(64 * c) * NIN + ZC_HGI + h * 128, VT);
    if (F.tid < 128) WSP(float, WS_HGDEC)[(c * 4 + h) * 128 + F.tid] = EXPF(B[63 * HP + F.tid]);
    __syncthreads();
    summary_mma(F, AT, VT, WSP(float, WS_HGU) + (size_t)(c * 4 + h) * 16384);
    __syncthreads();
}
__device__ __forceinline__ void ml_summary_mfma(Frame& F, int L, int c, int h) {
    LAS float* BL = (LAS float*)F.lds; LAS float* LI = BL + 64; LAS float* WS_ = LI + 64; LAS bf16* AT = (LAS bf16*)(WS_ + 64); LAS bf16* VT = AT + 128 * PV; LAS float* KC = (LAS float*)(VT + 128 * PV);
    const float* z = WSP(float, WS_Z); float* mlq = WSP(float, WS_MLQ); float* mlk = WSP(float, WS_MLK); const float* cw = INP(11) + (size_t)L * 4 * 1024;
    ml_gates(F, c, h, BL, LI);
    if (F.tid < 64) { const float a = BL[63] - BL[F.tid] + LI[F.tid]; const float mloc = wave_max(a); WS_[F.tid] = EXPF(a - mloc); if (F.tid == 0) { float* msc = WSP(float, WS_MLSC); msc[c * 4 + h] = mloc; msc[NCH * 4 + c * 4 + h] = BL[63]; } }
    { const int d = F.tid & 127; const float wq0 = cw[h * 128 + d], wq1 = cw[1024 + h * 128 + d], wq2 = cw[2048 + h * 128 + d], wq3 = cw[3072 + h * 128 + d];
      const float wk0 = cw[512 + h * 128 + d], wk1 = cw[1536 + h * 128 + d], wk2 = cw[2560 + h * 128 + d], wk3 = cw[3584 + h * 128 + d];
#pragma unroll 1
      for (int s = F.tid >> 7; s < 64; s += 4) { const int t = 64 * c + s; const float* zq = z + (size_t)t * NIN + ZC_MLQ + h * 128 + d; const float* zk = z + (size_t)t * NIN + ZC_MLK + h * 128 + d;
          const long b1 = (t >= 1) ? -(long)NIN : 0, b2 = (t >= 2) ? -2L * NIN : 0, b3 = (t >= 3) ? -3L * NIN : 0;
          const float f1 = (t >= 1) ? 1.f : 0.f, f2 = (t >= 2) ? 1.f : 0.f, f3 = (t >= 3) ? 1.f : 0.f;
          const float q0 = zq[0], q1 = zq[b1], q2 = zq[b2], q3 = zq[b3], k0_ = zk[0], k1_ = zk[b1], k2_ = zk[b2], k3_ = zk[b3];
          float aq = wq3 * q0 + f1 * wq2 * q1 + f2 * wq1 * q2 + f3 * wq0 * q3, ak = wk3 * k0_ + f1 * wk2 * k1_ + f2 * wk1 * k2_ + f3 * wk0 * k3_;
          aq = siluf_(aq) * 0.08838834764831845f; ak = siluf_(ak);
          mlq[(size_t)t * 512 + h * 128 + d] = aq; mlk[(size_t)t * 512 + h * 128 + d] = ak; KC[s * HP + d] = ak; } }
    __syncthreads();
    for (int i = F.tid; i < 1024; i += 512) { const int d = i & 127, s0 = (i >> 7) * 8; float v[8];
#pragma unroll
        for (int j = 0; j < 8; ++j) v[j] = KC[(s0 + j) * HP + d] * WS_[s0 + j];
        *(LAS v4u*)(AT + d * PV + s0) = pack8f(v); }
    fill_vt(F, z + (size_t)(64 * c) * NIN + ZC_MLV + h * 128, VT);
    if (F.tid < 128) { float a = 0.f; for (int s = 0; s < 64; ++s) a += KC[s * HP + F.tid] * WS_[s]; WSP(float, WS_MLNL)[(c * 4 + h) * 128 + F.tid] = a; }
    __syncthreads();
    summary_mma(F, AT, VT, WSP(float, WS_MLU) + (size_t)(c * 4 + h) * 16384);
    __syncthreads();
}


__device__ __forceinline__ void ph_scan_v2(Frame& F, int nblk, int nw) {
    const float* msc = WSP(float, WS_MLSC);
    const bool main_ = F.bid < nblk;
    const bool nst_ = (nw < 8) ? (main_ && F.wave == nw) : (F.bid >= nblk && F.bid < nblk + 8 && F.wave == 0); const int nsb_ = (nw < 8) ? F.bid : F.bid - nblk;
    if (main_ && F.wave < nw) for (int id = (F.bid * nw + F.wave) * 64 + F.lane; id < 32768; id += nblk * nw * 64) { const bool ml = id >= 16384; const int i = id & 16383, h = i >> 12, dq = (i >> 7) & 31, e = i & 127;
        const float* U = WSP(float, ml ? WS_MLU : WS_HGU) + (size_t)h * 16384 + (size_t)(4 * dq) * 128 + e; bf16* ST = WSP(bf16, ml ? WS_MLST : WS_HGST);
        const float* dec = WSP(float, WS_HGDEC) + h * 128 + 4 * dq;
        float st[4] = {0.f, 0.f, 0.f, 0.f}; float m = 0.f;
#pragma unroll 1
        for (int c0 = 0; c0 < NCH; c0 += 8) { float u[8][4], dk[8][4];
#pragma unroll
            for (int cc = 0; cc < 8; ++cc)
#pragma unroll
                for (int j = 0; j < 4; ++j) { u[cc][j] = U[(size_t)(c0 + cc) * 65536 + j * 128]; dk[cc][j] = ml ? 0.f : dec[(c0 + cc) * 512 + j]; }
#pragma unroll
            for (int cc = 0; cc < 8; ++cc) { const int c = c0 + cc;
                { v2u pk; pk.x = cvtpk(st[0], st[1]); pk.y = cvtpk(st[2], st[3]); *(v2u*)(ST + st_chunk(c, h, e, dq >> 1) + 4 * (dq & 1)) = pk; }
                if (ml) { const float mloc = msc[c * 4 + h], bend = msc[NCH * 4 + c * 4 + h]; const float mn = fmaxf(bend + m, mloc); const float fa = EXPF(bend + m - mn), fb = EXPF(mloc - mn); m = mn;
#pragma unroll
                    for (int j = 0; j < 4; ++j) st[j] = fa * st[j] + fb * u[cc][j]; }
                else {
#pragma unroll
                    for (int j = 0; j < 4; ++j) st[j] = dk[cc][j] * st[j] + u[cc][j]; } } } }
    const int gt = F.bid * 512 + F.tid, NGT = nblk * 512;
    if (nst_) for (int i = nsb_ * 64 + F.lane; i < 512; i += 512) { const int h = i >> 7, d = i & 127; const float* nl = WSP(float, WS_MLNL); float* ns = WSP(float, WS_MLN); float st = 0.f, m = 0.f;
        for (int c = 0; c < NCH; ++c) { const int o = (c * 4 + h) * 128 + d; ns[o] = st; const float mloc = msc[c * 4 + h], bend = msc[NCH * 4 + c * 4 + h]; const float mn = fmaxf(bend + m, mloc);
            st = EXPF(bend + m - mn) * st + EXPF(mloc - mn) * nl[o]; m = mn; } }
    if (main_) for (int i = gt; i < 4; i += NGT) { float* mp = WSP(float, WS_MLSC) + 2 * NCH * 4; float m = 0.f;
        for (int c = 0; c < NCH; ++c) { mp[c * 4 + i] = m; m = fmaxf(msc[NCH * 4 + c * 4 + i] + m, msc[c * 4 + i]); } }
}

template <bool SILU>
__device__ __forceinline__ void finish_tile(Frame& F, const f32x16& o, LAS float* PART, const float* gain, const float* gate_base  , int ycol, int c) {
    const int lane = F.lane, r = lane & 31, h = lane >> 5, et = F.wave & 3, tt = F.wave >> 2, t = 32 * tt + r;
    float ss = 0.f;
#pragma unroll
    for (int R = 0; R < 16; ++R) ss += o[R] * o[R];
    ss = half_sum(ss);
    if (h == 0) PART[t * 4 + et] = ss;
    __syncthreads();
    const f32x4 p4 = *(const LAS f32x4*)(PART + t * 4); const float rs = 1.0f / sqrtf(((p4[0] + p4[1]) + (p4[2] + p4[3])) * (1.0f / 128.0f) + EPS);
    bf16* yr = WSP(bf16, WS_A1) + (size_t)(64 * c + t) * (KS * D); const float* gr = gate_base + (size_t)t * NIN;
#pragma unroll
    for (int rg = 0; rg < 4; ++rg) { const int e = 32 * et + 8 * rg + 4 * h; const f32x4 gv = *(const f32x4*)(gr + e), gn = *(const f32x4*)(gain + e); f32x4 v;
#pragma unroll
        for (int q = 0; q < 4; ++q) v[q] = o[4 * rg + q] * rs * gn[q] * (SILU ? siluf_(gv[q]) : sigm(gv[q]));
        storeA4(yr, D, ycol + e, v); }
}
__device__ __forceinline__ void hg_output_mfma(Frame& F, int L, int c, int h) {
    LAS float* B = (LAS float*)F.lds; LAS float* KY = B + 64 * HP; LAS bf16* QA = (LAS bf16*)(KY + 64 * HP); LAS bf16* KA = QA + 64 * PQ; LAS bf16* QE = KA + 64 * PQ; LAS bf16* VT = QE + 64 * PQ; LAS float* PART = (LAS float*)(VT + 128 * PV);
    const float* z = WSP(float, WS_Z);
    hg_gates(F, L, c, h, B, KY);
    for (int i = F.tid; i < 1024; i += 512) { const int t = i >> 4, d0 = (i & 15) * 8; const float* qs = z + (size_t)(64 * c + t) * NIN + ZC_HGQ + h * 128 + d0; const f32x4 qa = *(const f32x4*)qs, qb = *(const f32x4*)(qs + 4);
        float vq[8], vk[8], ve[8];
#pragma unroll
        for (int j = 0; j < 8; ++j) { const float b = B[t * HP + d0 + j], br = B[31 * HP + d0 + j], qv = (j < 4) ? qa[j & 3] : qb[j & 3];
            vq[j] = qv * EXPF(fminf(fmaxf(b - br, -80.f), 80.f)); vk[j] = KY[t * HP + d0 + j] * EXPF(fminf(fmaxf(br - b, -80.f), 80.f)); ve[j] = qv * EXPF(b); }
        *(LAS v4u*)(QA + t * PQ + d0) = pack8f(vq); *(LAS v4u*)(KA + t * PQ + d0) = pack8f(vk); *(LAS v4u*)(QE + t * PQ + d0) = pack8f(ve); }
    fill_vt(F, z + (size_t)(64 * c) * NIN + ZC_HGI + h * 128, VT);
    __syncthreads();
    const int lane = F.lane, r = lane & 31, hh = lane >> 5, et = F.wave & 3, tt = F.wave >> 2, t = 32 * tt + r;
    f32x16 o = zero16();
#pragma unroll
    for (int st = 0; st <= 1; ++st) { if (st <= tt) { f32x16 sc = zero16();
#pragma unroll
        for (int kd = 0; kd < 8; ++kd) sc = MFMA32(ldsfrag(KA + (32 * st + swap23(r)) * PQ + 16 * kd + 8 * hh), ldsfrag(QA + t * PQ + 16 * kd + 8 * hh), sc);
#pragma unroll
        for (int R = 0; R < 16; ++R) { const int s = 32 * st + 16 * (R >> 3) + 8 * hh + (R & 7); sc[R] = (s <= t) ? sc[R] : 0.f; }
        bf16x8 pb[2]; pb[0] = pack8(sc, 0); pb[1] = pack8(sc, 1);
#pragma unroll
        for (int ks = 0; ks < 2; ++ks) o = MFMA32(ldsfrag(VT + (32 * et + r) * PV + 32 * st + 16 * ks + 8 * hh), pb[ks], o); } }
    { const bf16x8* sp = (const bf16x8*)(WSP(bf16, WS_HGST) + (((size_t)(c * 4 + h) * 4 + et) * 8) * 512) + lane;
#pragma unroll
      for (int kd = 0; kd < 8; ++kd) o = MFMA32(sp[kd * 64], ldsfrag(QE + t * PQ + 16 * kd + 8 * hh), o); }
    finish_tile<true>(F, o, PART, INP(6) + L * 512 + h * 128, z + (size_t)(64 * c) * NIN + ZC_HGG + h * 128, h * 128, c);
    __syncthreads();
}
__device__ __forceinline__ void ml_output_mfma(Frame& F, int L, int c, int h) {
    LAS float* BL = (LAS float*)F.lds; LAS float* LI = BL + 64; LAS float* MT = LI + 64; LAS float* WI = MT + 64; LAS float* QNN = WI + 64; LAS float* PART = QNN + 64;
    LAS bf16* QA = (LAS bf16*)(PART + 256); LAS bf16* KA = QA + 64 * PQ; LAS bf16* VT = KA + 64 * PQ;
    const float* z = WSP(float, WS_Z); const float* mlq = WSP(float, WS_MLQ); const float* mlk = WSP(float, WS_MLK);
    ml_gates(F, c, h, BL, LI);
    const float mprev = WSP(float, WS_MLSC)[2 * NCH * 4 + c * 4 + h];
    for (int i = F.tid; i < 1024; i += 512) { const int t = i >> 4, d0 = (i & 15) * 8; const float* qs = mlq + (size_t)(64 * c + t) * 512 + h * 128 + d0; const float* ks = mlk + (size_t)(64 * c + t) * 512 + h * 128 + d0;
        const f32x4 qa = *(const f32x4*)qs, qb = *(const f32x4*)(qs + 4), ka = *(const f32x4*)ks, kb = *(const f32x4*)(ks + 4);
        float vq[8] = {qa[0], qa[1], qa[2], qa[3], qb[0], qb[1], qb[2], qb[3]}, vk[8] = {ka[0], ka[1], ka[2], ka[3], kb[0], kb[1], kb[2], kb[3]};
        *(LAS v4u*)(QA + t * PQ + d0) = pack8f(vq); *(LAS v4u*)(KA + t * PQ + d0) = pack8f(vk); }
    fill_vt(F, z + (size_t)(64 * c) * NIN + ZC_MLV + h * 128, VT);
    if (F.tid < 64) { const int t = F.tid; const float inter = BL[t] + mprev; float mt = inter; for (int s = 0; s <= t; ++s) mt = fmaxf(mt, BL[t] - BL[s] + LI[s]); MT[t] = mt; WI[t] = EXPF(inter - mt);
    }
    { const int t = F.tid >> 3, p = F.tid & 7; const float* nst = WSP(float, WS_MLN) + (c * 4 + h) * 128 + 16 * p; const float* qs = mlq + (size_t)(64 * c + t) * 512 + h * 128 + 16 * p; float a = 0.f;
#pragma unroll
      for (int d = 0; d < 16; ++d) a += qs[d] * nst[d];
      a += sxor<1>(a); a += sxor<2>(a); a += sxor<4>(a); if (p == 0) QNN[t] = a; }
    __syncthreads();
    const int lane = F.lane, r = lane & 31, hh = lane >> 5, et = F.wave & 3, tt = F.wave >> 2, t = 32 * tt + r;
    const float mt = MT[t], wi = WI[t], blt = BL[t];
    f32x16 o = zero16(); float rsum = 0.f;
#pragma unroll
    for (int st = 0; st <= 1; ++st) { if (st <= tt) { f32x16 sc = zero16();
#pragma unroll
        for (int kd = 0; kd < 8; ++kd) sc = MFMA32(ldsfrag(KA + (32 * st + swap23(r)) * PQ + 16 * kd + 8 * hh), ldsfrag(QA + t * PQ + 16 * kd + 8 * hh), sc);
#pragma unroll
        for (int R = 0; R < 16; ++R) { const int s = 32 * st + 16 * (R >> 3) + 8 * hh + (R & 7); const float wgt = (s <= t) ? EXPF(blt - BL[s] + LI[s] - mt) : 0.f; sc[R] = sc[R] * wgt; rsum += sc[R]; }
        bf16x8 pb[2]; pb[0] = pack8(sc, 0); pb[1] = pack8(sc, 1);
#pragma unroll
        for (int ks = 0; ks < 2; ++ks) o = MFMA32(ldsfrag(VT + (32 * et + r) * PV + 32 * st + 16 * ks + 8 * hh), pb[ks], o); } }
    rsum = half_sum(rsum);
    f32x16 oi = zero16();
    { const bf16x8* sp = (const bf16x8*)(WSP(bf16, WS_MLST) + (((size_t)(c * 4 + h) * 4 + et) * 8) * 512) + lane;
#pragma unroll
      for (int kd = 0; kd < 8; ++kd) oi = MFMA32(sp[kd * 64], ldsfrag(QA + t * PQ + 16 * kd + 8 * hh), oi); }
    const float qn = wi * QNN[t] + rsum; const float den = 1.0f / fmaxf(fabsf(qn), EXPF(-mt));
#pragma unroll
    for (int R = 0; R < 16; ++R) o[R] = (o[R] + wi * oi[R]) * den;
    finish_tile<false>(F, o, PART, INP(12) + L * 512 + h * 128, z + (size_t)(64 * c) * NIN + ZC_MLO + h * 128, 1536 + h * 128, c);
    __syncthreads();
}

__device__ __forceinline__ void cmp_item_mfma(Frame& F, int L, int item) {
    const int which = item & 1, g = (item >> 1) & 1, rt = item >> 2, c0 = 32 * rt;
    const int lane = F.lane, r = lane & 31, hh = lane >> 5, ct = F.wave & 3, kh = F.wave >> 2;
    LAS float* PARTC = (LAS float*)F.lds;
    LAS float* O = PARTC + 4096;
    const float* z = WSP(float, WS_Z); const int zc = (which ? ZC_NVC : ZC_NKC) + g * 128;
    const float* pe = INP(9) + ((size_t)(L * 2 + which) * 32) * 128;
    const bf16x8* wf = (const bf16x8*)(WSL(bf16, WS_WCF) + ((size_t)(which * 4 + ct) * 256) * 512) + lane;
    f32x16 acc = zero16();
    for (int l = 16 * kh; l < 16 * kh + 16; ++l) { int tok = 16 * (c0 + r) + l; const bool ok = tok < T; if (!ok) tok = T - 1; const float* zr = z + (size_t)tok * NIN + zc + 8 * hh; const float* pr = pe + l * 128 + 8 * hh;
#pragma unroll
        for (int sp = 0; sp < 8; ++sp) { const f32x4 a = *(const f32x4*)(zr + 16 * sp), b = *(const f32x4*)(zr + 16 * sp + 4), pa = *(const f32x4*)(pr + 16 * sp), pb = *(const f32x4*)(pr + 16 * sp + 4);
            float v[8];
#pragma unroll
            for (int j = 0; j < 4; ++j) { v[j] = ok ? a[j] + pa[j] : 0.f; v[4 + j] = ok ? b[j] + pb[j] : 0.f; }
            acc = MFMA32(__builtin_bit_cast(bf16x8, pack8f(v)), wf[(8 * l + sp) * 64], acc); } }
    if (kh == 1) {
#pragma unroll
        for (int R = 0; R < 16; ++R) PARTC[(ct * 16 + R) * 64 + lane] = acc[R]; }
    __syncthreads();
    if (kh == 0) {
#pragma unroll
        for (int R = 0; R < 16; ++R) O[((R & 3) + 8 * (R >> 2) + 4 * hh) * HP + 32 * ct + r] = acc[R] + PARTC[(ct * 16 + R) * 64 + lane]; }
    __syncthreads();
    if (!which) { const float* kg = INP(8) + L * 384;
        for (int rr = 0; rr < 4; ++rr) { const int cl = 4 * F.wave + rr, c = c0 + cl; const float o1 = O[cl * HP + lane], o2 = O[cl * HP + lane + 64];
            const float ss = wave_sum(o1 * o1 + o2 * o2); const float rs = 1.0f / sqrtf(ss * (1.0f / 128.0f) + EPS);
            const float y1 = o1 * rs * kg[lane], y2 = o2 * rs * kg[lane + 64]; const int pos = (c < NCMP) ? 16 * c + 31 : 0; const float cs = WSP(float, WS_COS)[pos * 64 + lane], sn = WSP(float, WS_SIN)[pos * 64 + lane];
            const float r1 = y1 * cs - y2 * sn, r2 = y2 * cs + y1 * sn;
            bf16* kcf = WSP(bf16, WS_KCF) + (size_t)g * 16 * 4096 + (size_t)rt * 4096;
            { const int d = lane; kcf[(d >> 4) * 512 + (swap23(cl) + 32 * ((d >> 3) & 1)) * 8 + (d & 7)] = (bf16)f2bf(r1); }
            { const int d = lane + 64; kcf[(d >> 4) * 512 + (swap23(cl) + 32 * ((d >> 3) & 1)) * 8 + (d & 7)] = (bf16)f2bf(r2); } } }
    else { const int d = F.tid & 127, cg = F.tid >> 7; float v[8];
#pragma unroll
        for (int j = 0; j < 8; ++j) v[j] = O[(8 * cg + j) * HP + d];
        *(v4u*)(WSP(bf16, WS_VCF) + (size_t)g * 16 * 4096 + (size_t)rt * 4096 + ((d >> 5) * 2 + (cg >> 1)) * 512 + ((d & 31) + 32 * (cg & 1)) * 8) = pack8f(v); }
    __syncthreads();
}
__device__ __forceinline__ void wcf_item(Frame& F, int L, size_t wo, int item) {
    const int which = item >> 10, ct = (item >> 8) & 3, ks = item & 255, l = ks >> 3, sp = ks & 7, lane = F.lane, r = lane & 31, hh = lane >> 5;
    const float* w = INP(10) + (((size_t)(L * 2 + which) * 32 + l) * 128 + 16 * sp + 8 * hh) * 128 + 32 * ct + r; float v[8];
#pragma unroll
    for (int j = 0; j < 8; ++j) v[j] = w[j * 128];
    *(v4u*)(WSO(bf16, WS_WCF, wo) + ((size_t)((which * 4 + ct) * 256 + ks)) * 512 + lane * 8) = pack8f(v);
}
#ifndef SPLITB
#define SPLITB 1
#endif
#ifndef K5SQ
#define K5SQ 64
#endif
#ifndef K5A
#define K5A 265
#endif
#ifndef K5CUT
#define K5CUT 120
#endif
#ifndef K5S
#define K5S 100
#endif
#ifndef K5TO
#define K5TO 19
#endif
#ifndef K5TAB
#define K5TAB 1
#endif
#ifndef K5A0T
#define K5A0T 288
#endif
#ifndef K5CUT0
#define K5CUT0 128
#endif
struct K5Deal { unsigned short o[2][257]; unsigned cf[2][257]; };
constexpr K5Deal make_k5deal() {
    K5Deal d{};
    for (int cls = 0; cls < 2; ++cls) {
        long s[256] = {}; long tot = 0;
        for (int j = 0; j < 256; ++j) { const int q = j >> 1; long w = (cls ? K5A : K5A0T) - 2 * q - ((q < K5SQ) ? K5S : 0); if (q >= (cls ? K5CUT : K5CUT0) || w < 0) w = 0; s[j] = w; tot += w; }
        long cw = 0;
        for (int j = 0; j < 256; ++j) { d.o[cls][j] = (unsigned short)(1024 * cw / tot); cw += s[j]; }
        d.o[cls][256] = 1024;
        const long NC = (WC_NALL - K1_CONV - K4_CONV) + (cls == 0 ? WC_DEF_N : 0), W = 1024L * K5TO + NC;
        long r[256] = {}; long rtot = 0;
        for (int j = 0; j < 256; ++j) { const long outs = d.o[cls][j + 1] - d.o[cls][j]; long v = (s[j] * W * 16) / tot - outs * K5TO * 16; if (v < 0) v = 0; r[j] = v; rtot += v; }
        long cum = 0;
        for (int j = 0; j < 256; ++j) { d.cf[cls][j] = (unsigned)((cum << 20) / rtot); cum += r[j]; }
        d.cf[cls][256] = 1u << 20;
    }
    return d;
}
__device__ const K5Deal K5DEAL = make_k5deal();

typedef KArgs Args;
__global__ void __launch_bounds__(512, 2) fwd(Args args) {
    extern __shared__ __attribute__((aligned(16))) unsigned char lds[];
    Frame F;
    F.lds = (LAS unsigned char*)lds; F.MISC = (volatile LAS unsigned*)(F.lds + MISC_OFF);
    F.tid = threadIdx.x; F.lane = F.tid & 63; F.wave = __builtin_amdgcn_readfirstlane(F.tid >> 6); F.G = gridDim.x; F.bid = blockIdx.x;
    F.ap = (const KArgs __attribute__((address_space(4)))*)__builtin_amdgcn_kernarg_segment_ptr();
    F.ws = args.ws; F.ctl = (gu32*)(args.ws + WS_CTL);
    for (int u = F.tid; u < (LDS_BYTES - MISC_OFF) / 4; u += 512) ((LAS unsigned*)(F.lds + MISC_OFF))[u] = 0u;
    __syncthreads();
    const int lo = args.ph_lo, hi = args.ph_hi;
    XcdBarrier bar; bar.bar = (unsigned*)(F.ctl + CW_BAR) + args.li * XCD_BAR_WORDS; bar.x = 0; bar.st = nullptr;
    if (hi - lo > 1) bar = xcd_barrier_post((unsigned*)(F.ctl + CW_BAR) + args.li * XCD_BAR_WORDS, F.MISC + 8);
#if 1
#define IN(k) (lo <= (k) && (k) < hi)
#define SEAM(k) do { if (IN((k) + 1)) xcd_barrier(bar); } while (0)
#else
#define IN(k) 1
#define SEAM(k) do { if ((k) + 1 < NPHASES) xcd_barrier(bar); } while (0)
#endif
    LAS unsigned char* glds = F.lds;

#ifndef PHMASK
#define PHMASK 0x1fff
#endif
#define PHON(kk) (((PHMASK) >> (kk)) & 1)
#ifndef SPLITB
#define SPLITB 1
#endif
#ifndef K5SQ
#define K5SQ 64
#endif
#ifndef DEFER0
#define DEFER0 1
#endif
#ifndef DBLMASK
#define DBLMASK 0
#endif
#define NREP(kk) (1 + (((DBLMASK) >> (kk)) & 1))
    if (PHON(12) && IN(0)) { LAUNDER(); ph_prologue(F); SEAM(0); }
    for (int L = 0; L < DEPTH; ++L) {
        const int pb = 1 + L * NPH;
        F.wofs = WOVL ? (size_t)(L & 1) * WS_WSET : 0;
        if (PHON(0) && IN(pb + 0) && (!WOVL || L == 0)) for (int rep = 0; rep < NREP(0); ++rep) { LAUNDER(); if (rep) xcd_barrier(bar);
            { const bool df_ = WOVL && DEFER0 && F.G == 256 && NSA_V2 == 1; const int n0_ = df_ ? WC_NALL - WC_DEF_N : WC_NALL;
              const int per = (n0_ + F.G - 1) / F.G, lo_ = F.bid * per, hi_ = (lo_ + per < n0_) ? lo_ + per : n0_; ph_wconv(F, L, F.wofs, lo_, hi_, df_ ? WC_DEF_LO : (1 << 30), WC_DEF_N); }
            __syncthreads(); SEAM(pb + 0); }
        if (PHON(1) && IN(pb + 1)) for (int rep = 0; rep < NREP(1); ++rep) { LAUNDER(); if (rep) xcd_barrier(bar);
            { pg8::Gemm g{WSP(pg8::bf16_t, WS_A0), WSL(pg8::bf16_t, WS_WIN), T, NIN, KS * D}; pg8::StaticOrder S; S.init(T, NIN, F.G, F.bid);
              pg8::rs_table_fill(glds, S, WSP(float, WS_SSQA), T, 1.0f / D, EPS, F.wave);
              pg8::EpiScaleF32 E{WSP(float, WS_Z), NIN, WSL(float, WS_BPERM), WSP(float, WS_SSQA), 32, glds, 1.0f / D, EPS};
              pg8::gemm_phase<pg8::EpiScaleF32, pg8::StaticOrder, PG8_ALIGN, PG8_SP2>(glds, g, S, E, F.wave); }
            { pg8::Gemm g{WSP(pg8::bf16_t, WS_MEMB), WSL(pg8::bf16_t, WS_WKV), MEM, 2 * D, KS * D}; pg8::StaticOrder S; S.init(MEM, 2 * D, F.G, (F.bid + F.G - (F.G > 116 ? 100 : 0)) % F.G);
              pg8::EpiScaleF32 E{WSP(float, WS_KVX), 2 * D, nullptr, WSP(float, WS_SSQM), 1, glds, 1.0f / D, EPS};
              pg8::gemm_phase<pg8::EpiScaleF32, pg8::StaticOrder, PG8_ALIGN, PG8_SP2>(glds, g, S, E, F.wave); }
#if WOVL
            if (L + 1 < DEPTH && F.G == 256 && F.bid >= 116) { LAUNDER(); const int lo_ = (F.bid - 116) * K1_PER, hi_ = lo_ + K1_PER; ph_wconv(F, L + 1, (size_t)((L + 1) & 1) * WS_WSET, lo_, hi_); __syncthreads(); }
#endif
            SEAM(pb + 1); }
#if ORACLE_MIX
        if (PHON(2) && IN(pb + 2)) { LAUNDER(); ph_prep(F, L, 0); __syncthreads(); SEAM(pb + 2); }
#endif
        if (PHON(3) && IN(pb + 3)) for (int rep = 0; rep < NREP(3); ++rep) { LAUNDER(); if (rep) xcd_barrier(bar);
#if ORACLE_MIX
            for (int it = F.bid; it < 512; it += F.G) hg_summary_item(F, L, it >> 2, it & 3);
            for (int it = F.bid; it < 512; it += F.G) ml_summary_item(F, it >> 2, it & 3);
            for (int it = F.bid; it < 256; it += F.G) cmp_item(F, L, it);
#else
            { const bool g256 = (F.G == 256), cmpwg = g256 && F.bid >= 192;
              const int c_lo = g256 ? (cmpwg ? F.bid - 192 : 64) : F.G - 1 - F.bid, c_st = g256 ? 64 : F.G;
              const int s_lo = g256 ? (cmpwg ? 960 + F.bid - 192 : 5 * F.bid) : F.bid, s_hi = g256 ? s_lo + (cmpwg ? 1 : 5) : 1024, s_st = g256 ? 1 : F.G;
#pragma unroll 1
              for (int it = c_lo; it < 64; it += c_st) cmp_item_mfma(F, L, it);
              LAUNDER();
#pragma unroll 1
              for (int it = s_lo; it < s_hi; it += s_st) { if (it < 512) hg_summary_mfma(F, L, it >> 2, it & 3); else ml_summary_mfma(F, L, (it - 512) >> 2, it & 3); } }
#if SPLITB
            __syncthreads(); LAUNDER(); ph_prep(F, L, 0); __syncthreads();
#endif
#endif
            SEAM(pb + 3); }
        if (PHON(4) && IN(pb + 4)) for (int rep = 0; rep < NREP(4); ++rep) { LAUNDER(); if (rep) xcd_barrier(bar);
#if ORACLE_MIX
            ph_scan(F);
#else
#if SPLITB
            if (F.G == 256) { ph_scan_v2(F, 2 * K5SQ, (K5SQ == 32) ? 8 : 4);
#if WOVL
                if (K4_PER > 0 && L + 1 < DEPTH && F.bid < 128) { LAUNDER(); const int lo_ = K1_CONV + F.bid * K4_PER; ph_wconv(F, L + 1, (size_t)((L + 1) & 1) * WS_WSET, lo_, lo_ + K4_PER, 1 << 30, 0, 5); }
#endif
                xcd_barrier_arrive(bar); }
            else { ph_scan_v2(F, F.G, 2); __syncthreads(); xcd_barrier(bar); }
#else
            ph_scan_v2(F, F.G, 2); LAUNDER(); ph_prep(F, L, 3);
#endif
#endif
#if !SPLITB
            __syncthreads(); SEAM(pb + 4);
#endif
            }
        if (PHON(5) && IN(pb + 5)) for (int rep = 0; rep < NREP(5); ++rep) { LAUNDER(); if (rep) xcd_barrier(bar);
#if ORACLE_MIX
#define HG_OUT hg_output_item
#define ML_OUT ml_output_item
#else
#define HG_OUT hg_output_mfma
#define ML_OUT ml_output_mfma
#endif
#ifndef P5MASK
#define P5MASK 7
#endif
#ifndef P5DBL
#define P5DBL 0
#endif
            const bool g256_ = (F.G == 256) && (NSA_V2 == 1); const int q5_ = F.bid >> 1, r5_ = F.bid & 1;
#ifndef K5A
#define K5A 265
#endif
#ifndef K5A0
#define K5A0 265
#endif
#ifndef K5CUT
#define K5CUT 120
#endif
#ifndef K5S
#define K5S 100
#endif
            long cwa_ = 0, K5TOT = 0;
            const int k5a_ = (DEFER0 && L == 0) ? K5A0 : K5A;
#pragma unroll 1
            for (int qq = 0; qq < 128; ++qq) { const int wr_ = k5a_ - 2 * qq - ((SPLITB && qq < K5SQ) ? K5S : 0), wq_ = (qq >= K5CUT || wr_ < 0) ? 0 : wr_; if (qq < q5_) cwa_ += 2 * wq_; else if (qq == q5_) cwa_ += r5_ * wq_; K5TOT += 2 * wq_; }
            const int wm_ = k5a_ - 2 * q5_ - ((SPLITB && q5_ < K5SQ) ? K5S : 0); const long cwb_ = cwa_ + ((q5_ >= K5CUT || wm_ < 0) ? 0 : wm_);
#if !SPLITB
            { const int o_lo = g256_ ? ((SPLITB && K5TAB) ? (int)K5DEAL.o[(DEFER0 && L == 0) ? 0 : 1][F.bid] : (int)(1024L * cwa_ / K5TOT)) : F.bid, o_hi = g256_ ? ((SPLITB && K5TAB) ? (int)K5DEAL.o[(DEFER0 && L == 0) ? 0 : 1][F.bid + 1] : (int)(1024L * cwb_ / K5TOT)) : 1024, o_st = g256_ ? 1 : F.G;
#pragma unroll 1
              for (int r5 = 0; r5 < 1 + (P5DBL & 1); ++r5)
#pragma unroll 1
                for (int it = o_lo; it < o_hi; it += o_st) { LAUNDER(); if (it < 512) { if (P5MASK & 1) HG_OUT(F, L, it >> 2, it & 3); } else { if (P5MASK & 2) ML_OUT(F, L, (it - 512) >> 2, it & 3); } } }
#endif
#if ORACLE_ATTN
            if (P5MASK & 4) { ph_nsa(F, L); __syncthreads(); }
#else
            LAUNDER();
            if (P5MASK & 4) for (int r5 = 0; r5 < 1 + ((P5DBL >> 2) & 1); ++r5) {
#if NSA_V2 == 2
                ph_nsa3(F, L);
#elif NSA_V2
                ph_nsa_block(F, L);
#else
                ph_nsa_mfma(F, L);
#endif
                __syncthreads(); }
#if SPLITB
            LAUNDER(); if (F.G == 256) xcd_barrier_wait(bar);
            LAUNDER();
            { const int o_lo = g256_ ? ((SPLITB && K5TAB) ? (int)K5DEAL.o[(DEFER0 && L == 0) ? 0 : 1][F.bid] : (int)(1024L * cwa_ / K5TOT)) : F.bid, o_hi = g256_ ? ((SPLITB && K5TAB) ? (int)K5DEAL.o[(DEFER0 && L == 0) ? 0 : 1][F.bid + 1] : (int)(1024L * cwb_ / K5TOT)) : 1024, o_st = g256_ ? 1 : F.G;
#pragma unroll 1
              for (int r5 = 0; r5 < 1 + (P5DBL & 1); ++r5)
#pragma unroll 1
                for (int it = o_lo; it < o_hi; it += o_st) { LAUNDER(); if (it < 512) { if (P5MASK & 1) HG_OUT(F, L, it >> 2, it & 3); } else { if (P5MASK & 2) ML_OUT(F, L, (it - 512) >> 2, it & 3); } } }
            __syncthreads();
#endif
#if WOVL
            if (g256_) {
#pragma unroll 1
                for (int s5 = (DEFER0 && L == 0) ? 0 : 1; s5 < 2 && L + s5 < DEPTH; ++s5) { LAUNDER();
                    const int c0_ = s5 ? K1_CONV + (SPLITB ? K4_CONV : 0) : WC_DEF_LO, n5_ = s5 ? WC_NALL - K1_CONV - (SPLITB ? K4_CONV : 0) : WC_DEF_N; const int cl_ = (DEFER0 && L == 0) ? 0 : 1; const int lo_ = c0_ + ((SPLITB && K5TAB) ? (int)(((long)n5_ * K5DEAL.cf[cl_][F.bid]) >> 20) : (int)((long)n5_ * cwa_ / K5TOT)), hi_ = c0_ + ((SPLITB && K5TAB) ? (int)(((long)n5_ * K5DEAL.cf[cl_][F.bid + 1]) >> 20) : (int)((long)n5_ * cwb_ / K5TOT));
                    ph_wconv(F, L + s5, (size_t)((L + s5) & 1) * WS_WSET, lo_, hi_); __syncthreads(); } }
            else if (L + 1 < DEPTH) { LAUNDER(); const int per = (WC_NALL + F.G - 1) / F.G, lo_ = F.bid * per, hi_ = (lo_ + per < WC_NALL) ? lo_ + per : WC_NALL; ph_wconv(F, L + 1, (size_t)((L + 1) & 1) * WS_WSET, lo_, hi_); __syncthreads(); }
#endif
#endif
            SEAM(pb + 5); }
        if (PHON(6) && IN(pb + 6)) { LAUNDER(); pg8::Gemm g{WSP(pg8::bf16_t, WS_A1), WSL(pg8::bf16_t, WS_WOUT), T, D, KS * D}; pg8::StaticOrder S; S.init(T, D, F.G, F.bid);
            pg8::EpiResid E{L == 0 ? INP(0) : OUTP, OUTP, WSP(pg8::bf16_t, WS_A0), WSP(float, WS_SSQB), D, T};
            pg8::gemm_phase<pg8::EpiResid, pg8::StaticOrder, PG8_ALIGN, PG8_SP2>(glds, g, S, E, F.wave); SEAM(pb + 6); }
        if (PHON(7) && IN(pb + 7)) for (int rep = 0; rep < NREP(7); ++rep) { LAUNDER(); if (rep) xcd_barrier(bar); pg8::Gemm g{WSP(pg8::bf16_t, WS_A0), WSL(pg8::bf16_t, WS_WQ), T, D, KS * D}; pg8::StaticOrder S; S.init(T, D, F.G, F.bid);
#if ORACLE_ATTN
            pg8::rs_table_fill(glds, S, WSP(float, WS_SSQB), T, 1.0f / D, EPS, F.wave);
            pg8::EpiScaleF32 E{WSP(float, WS_XQ), D, nullptr, WSP(float, WS_SSQB), 32, glds, 1.0f / D, EPS};
            pg8::gemm_phase<pg8::EpiScaleF32, pg8::StaticOrder, PG8_ALIGN, PG8_SP2>(glds, g, S, E, F.wave);
#else
            pg8::rs_table_fill(glds, S, WSP(float, WS_SSQB), T, 1.0f / D, EPS, F.wave);
            pg8::EpiScaleBf16 E{WSP(pg8::bf16_t, WS_XQB), T, WSP(float, WS_SSQB), 32, glds, 1.0f / D, EPS, WSP(float, WS_QSS)};
            pg8::gemm_phase<pg8::EpiScaleBf16, pg8::StaticOrder, PG8_ALIGN, PG8_SP2>(glds, g, S, E, F.wave);
#endif
            SEAM(pb + 7); }
        if (PHON(8) && IN(pb + 8)) for (int rep = 0; rep < NREP(8); ++rep) { LAUNDER(); if (rep) xcd_barrier(bar);
#if ORACLE_ATTN
            ph_xattn(F, L);
            __syncthreads(); SEAM(pb + 8);
#else
#if XFUSE
            { const float* qg_ = INP(20) + L * 512; const float* kg_ = INP(21) + L * 512; float gq_ = 0.f, gk_ = 0.f;
#pragma unroll
              for (int i = 0; i < 8; ++i) { gq_ = fmaxf(gq_, fabsf(qg_[F.lane + 64 * i])); gk_ = fmaxf(gk_, fabsf(kg_[F.lane + 64 * i])); }
              const float bound_ = 22.627416997969522f * 1.4426950408889634f * 1.02f * wave_max(gq_) * wave_max(gk_);
#pragma unroll 1
              for (int h = 0; h < 4; ++h) { pg8::Gemm g{WSP(pg8::bf16_t, WS_XQB) + (size_t)h * T * 512, WSP(pg8::bf16_t, WS_KXF) + (size_t)h * MEM * 512, T, MEM, 512};
                  pg8::StaticOrder S; S.init(T, MEM, F.G, (F.bid + 64 * h) % F.G);
                  pg8::rs_table_fill(glds, S, WSP(float, WS_QSS), T, 1.0f / 512.0f, EPS, F.wave, 8 * h, 8, false);
                  pg8::EpiExpPN E{WSP(pg8::bf16_t, WS_PH), 1024, 256 * h, glds, bound_};
                  pg8::gemm_phase<pg8::EpiExpPN, pg8::StaticOrder, true, PG8_SP2>(glds, g, S, E, F.wave); __syncthreads(); }
#pragma unroll 1
              for (int h = 0; h < 4; ++h) { pg8::Gemm g{WSL(pg8::bf16_t, WS_WO) + (size_t)h * D * 512, WSP(pg8::bf16_t, WS_VXF) + (size_t)h * MEM * 512, D, MEM, 512};
                  pg8::StaticOrder S; S.init(D, MEM, F.G, (F.bid + 64 * h + 224) % F.G);
                  pg8::EpiPlainBf16 E{WSP(pg8::bf16_t, WS_BTC), 1024, 256 * h};
                  pg8::gemm_phase<pg8::EpiPlainBf16, pg8::StaticOrder, PG8_ALIGN, PG8_SP2>(glds, g, S, E, F.wave); __syncthreads(); } }
#else
            { const float* qg_ = INP(20) + L * 512; const float* kg_ = INP(21) + L * 512; float gq_ = 0.f, gk_ = 0.f;
#pragma unroll
              for (int i = 0; i < 8; ++i) { gq_ = fmaxf(gq_, fabsf(qg_[F.lane + 64 * i])); gk_ = fmaxf(gk_, fabsf(kg_[F.lane + 64 * i])); }
              const float bound_ = 22.627416997969522f * 1.4426950408889634f * 1.02f * wave_max(gq_) * wave_max(gk_);
#pragma unroll 1
              for (int h = 0; h < 4; ++h) { pg8::Gemm g{WSP(pg8::bf16_t, WS_XQB) + (size_t)h * T * 512, WSP(pg8::bf16_t, WS_KXF) + (size_t)h * MEM * 512, T, MEM, 512};
                  pg8::StaticOrder S; S.init(T, MEM, F.G, (F.bid + 64 * h) % F.G);
                  pg8::rs_table_fill(glds, S, WSP(float, WS_QSS), T, 1.0f / 512.0f, EPS, F.wave, 8 * h, 8, false);
                  pg8::EpiExpP E{WSP(pg8::bf16_t, WS_PH) + (size_t)h * T * MEM, WSP(float, WS_LPX) + (size_t)h * 4 * T, T, glds, bound_};
                  pg8::gemm_phase<pg8::EpiExpP, pg8::StaticOrder, PG8_ALIGN, PG8_SP2>(glds, g, S, E, F.wave); __syncthreads(); } }
            xcd_barrier(bar); LAUNDER();
#pragma unroll 1
            for (int h = 0; h < 4; ++h) { pg8::Gemm g{WSP(pg8::bf16_t, WS_PH) + (size_t)h * T * MEM, WSP(pg8::bf16_t, WS_VXF) + (size_t)h * 512 * MEM, T, 512, MEM};
                pg8::StaticOrder S; S.init(T, 512, F.G, (F.bid + 64 * h) % F.G);
                pg8::rs_table_fill(glds, S, WSP(float, WS_LPX) + (size_t)h * 4 * T, T, 1.0f, 0.f, F.wave, 0, 4, true);
                pg8::EpiRowScaleA E{WSP(pg8::bf16_t, WS_A1), D, 512 * h, glds};
                pg8::gemm_phase<pg8::EpiRowScaleA, pg8::StaticOrder, PG8_ALIGN, PG8_SP2>(glds, g, S, E, F.wave); __syncthreads(); }
#endif
            SEAM(pb + 8);
#endif
            }
        if (PHON(9) && IN(pb + 9)) { LAUNDER();
#if XFUSE
            pg8::Gemm g{WSP(pg8::bf16_t, WS_PH), WSP(pg8::bf16_t, WS_BTC), T, D, 1024};
#else
            pg8::Gemm g{WSP(pg8::bf16_t, WS_A1), WSL(pg8::bf16_t, WS_WO), T, D, KS * D};
#endif
            pg8::StaticOrder S; S.init(T, D, F.G, F.bid);
            pg8::EpiResid E{OUTP, OUTP, WSP(pg8::bf16_t, WS_A0), WSP(float, WS_SSQC), D, T};
            pg8::gemm_phase<pg8::EpiResid, pg8::StaticOrder, PG8_ALIGN, PG8_SP2>(glds, g, S, E, F.wave); SEAM(pb + 9); }
        if (PHON(10) && IN(pb + 10)) for (int rep = 0; rep < NREP(10); ++rep) { LAUNDER(); if (rep) xcd_barrier(bar); pg8::Gemm g{WSP(pg8::bf16_t, WS_A0), WSL(pg8::bf16_t, WS_W1), T, DFF, KS * D}; pg8::StaticOrder S; S.init(T, DFF, F.G, F.bid);
            pg8::rs_table_fill(glds, S, WSP(float, WS_SSQC), T, 1.0f / D, EPS, F.wave);
            pg8::EpiRelu2 E{WSP(pg8::bf16_t, WS_HM), DFF, WSP(float, WS_SSQC), 32, glds, 1.0f / D, EPS};
            pg8::gemm_phase<pg8::EpiRelu2, pg8::StaticOrder, PG8_ALIGN, PG8_SP2>(glds, g, S, E, F.wave); SEAM(pb + 10); }
        if (PHON(11) && IN(pb + 11)) { LAUNDER(); pg8::Gemm g{WSP(pg8::bf16_t, WS_HM), WSL(pg8::bf16_t, WS_W2), T, D, KS * DFF}; pg8::StaticOrder S; S.init(T, D, F.G, F.bid);
            pg8::EpiResid E{OUTP, OUTP, WSP(pg8::bf16_t, WS_A0), WSP(float, WS_SSQA), D, T};
            pg8::gemm_phase<pg8::EpiResid, pg8::StaticOrder, PG8_ALIGN, PG8_SP2>(glds, g, S, E, F.wave); SEAM(pb + 11); }
    }
    LAUNDER();
    if (hi - lo > 1 && hi == NPHASES) { __syncthreads(); if (xb_ld(&bar.bar[XB_TMO]) != 0u) { const float q = __builtin_nanf(""); for (int i = F.bid * 512 + F.tid; i < T * D; i += F.G * 512 * 64) OUTP[i] = q; } }
#undef IN
#undef SEAM
}

#ifndef MK_PER_PHASE
#define MK_PER_PHASE 0
#endif
extern "C" void kernel_launch(void* const* d_in, const int* in_sizes, int n_in, void* d_out, int out_size, void* d_ws, size_t ws_size, hipStream_t stream) {
    static int grid = 0;
    if (grid == 0) {
        if (n_in != 25 || out_size != T * D || ws_size < WS_END) { fprintf(stderr, "kernel_launch: unexpected sizes (n_in %d, out %d, ws %zu, need %zu); nothing launched\n", n_in, out_size, ws_size, (size_t)WS_END); grid = -1; return; }
        int dev = 0, cus = 0, per_cu = 0;
        if (hipGetDevice(&dev) != hipSuccess || hipDeviceGetAttribute(&cus, hipDeviceAttributeMultiprocessorCount, dev) != hipSuccess) { grid = -1; return; }
        if (hipFuncSetAttribute((const void*)fwd, hipFuncAttributeMaxDynamicSharedMemorySize, LDS_BYTES) != hipSuccess) { fprintf(stderr, "kernel_launch: hipFuncSetAttribute failed\n"); grid = -1; return; }
        if (hipOccupancyMaxActiveBlocksPerMultiprocessor(&per_cu, (const void*)fwd, 512, LDS_BYTES) != hipSuccess || per_cu < 1) { fprintf(stderr, "kernel_launch: occupancy query says %d\n", per_cu); }
        (void)hipGetLastError();
        grid = cus;
    }
    if (grid < 0) return;
    if (hipMemsetAsync((char*)d_ws + WS_CTL, 0, CTL_ZERO_BYTES, stream) != hipSuccess) return;
    Args a{};
    for (int i = 0; i < 25; ++i) a.in[i] = (const float*)d_in[i];
    a.out = (float*)d_out; a.ws = (unsigned char*)d_ws; a.pad = 0;
#if MK_PER_PHASE
    for (int p = 0; p < NPHASES; ++p) { a.ph_lo = p; a.ph_hi = p + 1; a.li = 0; hipLaunchKernelGGL(fwd, dim3(grid), dim3(512), LDS_BYTES, stream, a); }
#else
    a.ph_lo = 0; a.ph_hi = NPHASES; a.li = 0;
    hipLaunchKernelGGL(fwd, dim3(grid), dim3(512), LDS_BYTES, stream, a);
#endif
}
```

```cpp
#include <hip/hip_runtime.h>
#include <cstdio>
#include <cstdint>
#define MK_PER_PHASE 0
#ifndef ORACLE_MIX
#define ORACLE_MIX 0
#endif
#ifndef ORACLE_ATTN
#define ORACLE_ATTN 0
#endif
#ifndef NSA_V2
#define NSA_V2 1
#endif
#ifndef KS
#define KS 1
#endif
__device__ __forceinline__ void swap32(unsigned& a, unsigned& b) { asm volatile("s_nop 1\n\tv_permlane32_swap_b32 %0, %1\n\ts_nop 1" : "+v"(a), "+v"(b)); }
template <int M> __device__ __forceinline__ float sxor(float v) { static_assert(M < 32, "use half_sum / half_max for the two lane halves");
    return __builtin_bit_cast(float, __builtin_amdgcn_ds_swizzle(__builtin_bit_cast(int, v), (M << 10) | 0x1f)); }
template <int M> __device__ __forceinline__ int sxori(int v) { static_assert(M < 32, "");
    return __builtin_amdgcn_ds_swizzle(v, (M << 10) | 0x1f); }
__device__ __forceinline__ float half_sum(float v) { unsigned a = __builtin_bit_cast(unsigned, v), b = a; swap32(a, b); return __builtin_bit_cast(float, a) + __builtin_bit_cast(float, b); }
__device__ __forceinline__ float half_max(float v) { unsigned a = __builtin_bit_cast(unsigned, v), b = a; swap32(a, b); return fmaxf(__builtin_bit_cast(float, a), __builtin_bit_cast(float, b)); }
namespace pg8 {
#define PG8_LAS __attribute__((address_space(3)))
typedef unsigned short bf16_t;
typedef short bf16x8 __attribute__((ext_vector_type(8)));
typedef float f32x4 __attribute__((ext_vector_type(4)));
typedef unsigned u32x4 __attribute__((ext_vector_type(4)));
constexpr int BM = 256, BK = 64, HALF = 128, HTB = HALF * BK * 2  , STAGE_BYTES = 8 * HTB, NXCD = 8, WGM = 8;

__host__ __device__ __forceinline__ int lds_byte(int r, int c) { const int st = (r >> 4) * 2 + (c >> 5), rr = r & 15, cc = c & 31, ob = rr * 64 + cc * 2; return st * 1024 + (ob ^ (((ob >> 9) & 1) << 5)); }
__host__ __device__ __forceinline__ void stage_rc(int b, int& R, int& C) { const int st = b / 1024, sb = b % 1024, swz = sb ^ (((sb >> 9) & 1) << 5); R = (st >> 1) * 16 + swz / 64; C = (st & 1) * 32 + (swz % 64) / 2; }
__host__ __device__ __forceinline__ int perm32(int rho) { const int n = rho >> 4, i = rho & 15; return 8 * (i >> 2) + 4 * n + (i & 3); }

struct Unit { int pm, pn; };
struct Gemm { const bf16_t* A; const bf16_t* Bt; int M, N, K; };

struct StaticOrder {
    int nM, nN, nwg, G, c;
    __host__ __device__ void init(int M, int N, int G_, int c_) { nM = M / BM; nN = N / BM; nwg = nM * nN; G = G_; c = c_; }
    __host__ __device__ bool next(int i, Unit& u) const {
        const long L = (long)i * G + c; if (L >= nwg) return false;
        int wgid = (int)L; { const int q = nwg / NXCD, r = nwg % NXCD, xcd = wgid % NXCD, off = wgid / NXCD; wgid = (xcd < r ? xcd * (q + 1) : r * (q + 1) + (xcd - r) * q) + off; }
        const int nig = WGM * nN, gid = wgid / nig, fm = gid * WGM, gsz = (nM - fm) < WGM ? (nM - fm) : WGM;
        u.pm = fm + ((wgid % nig) % gsz); u.pn = (wgid % nig) / gsz; return true;
    }
    __device__ __forceinline__ void a_ready(const Unit&) const {}
    __device__ __forceinline__ void done(const Unit&) const {}
};

__device__ __forceinline__ unsigned cvt_pk_bf16(float lo, float hi) { unsigned r; asm volatile("v_cvt_pk_bf16_f32 %0, %1, %2" : "=v"(r) : "v"(lo), "v"(hi)); return r; }
__device__ __forceinline__ float bf_hi_f(unsigned pk) { return __builtin_bit_cast(float, pk << 16); }
__device__ __forceinline__ float bf_lo_of(float v) { unsigned h; { unsigned u = __builtin_bit_cast(unsigned, v); h = (u + 0x7fffu + ((u >> 16) & 1u)) & 0xffff0000u; } return v - __builtin_bit_cast(float, h); }
__device__ __forceinline__ void store_a8(bf16_t* rowp, int Kreal, int col, const f32x4& v0, const f32x4& v1) {
    u32x4 w; w.x = cvt_pk_bf16(v0[0], v0[1]); w.y = cvt_pk_bf16(v0[2], v0[3]); w.z = cvt_pk_bf16(v1[0], v1[1]); w.w = cvt_pk_bf16(v1[2], v1[3]);
    *(u32x4*)(rowp + col) = w;
#if KS == 3
    *(u32x4*)(rowp + Kreal + col) = w;
    u32x4 l; l.x = cvt_pk_bf16(bf_lo_of(v0[0]), bf_lo_of(v0[1])); l.y = cvt_pk_bf16(bf_lo_of(v0[2]), bf_lo_of(v0[3])); l.z = cvt_pk_bf16(bf_lo_of(v1[0]), bf_lo_of(v1[1])); l.w = cvt_pk_bf16(bf_lo_of(v1[2]), bf_lo_of(v1[3]));
    *(u32x4*)(rowp + 2 * Kreal + col) = l;
#endif
}

constexpr int RS_OFF = 131072, RS_TAG_OFF = RS_OFF + 4 * 256 * 4;
template <class Sched>
__device__ __forceinline__ void rs_table_fill(PG8_LAS unsigned char* lds, const Sched& S, const float* ssq, int ldp, float inv_n, float eps, int wid_, int p0 = 0, int npart = 32, bool recip = false) {
    int tid = 0;
    PG8_LAS float* rs = (PG8_LAS float*)(lds + RS_OFF); PG8_LAS int* tag = (PG8_LAS int*)(lds + RS_TAG_OFF);
    { int z_ = 0; asm volatile("" : "+s"(z_)); tid = (tid >> 6) * 0 + (int)__builtin_amdgcn_mbcnt_hi(~0u, __builtin_amdgcn_mbcnt_lo(~0u, (unsigned)z_)) + 64 * wid_; }
#pragma unroll 1
    for (int pass = 0; pass < 2; ++pass) { const int i = 2 * pass + (tid >> 8); Unit u; const bool ok = S.next(i, u);
        if (ok) { const int r = u.pm * BM + (tid & 255); float s = 0.f;
#pragma unroll 8
            for (int p = 0; p < npart; ++p) s += ssq[(size_t)(p0 + p) * ldp + r];
            rs[i * 256 + (tid & 255)] = recip ? ((s > 0.f) ? 1.0f / s : 0.f) : 1.0f / sqrtf(s * inv_n + eps); }
        if ((tid & 255) == 0) tag[i] = ok ? u.pm : -1; }
    __syncthreads();
}
__device__ __forceinline__ int rs_slot(PG8_LAS unsigned char* lds, const Unit& u) { const PG8_LAS int* tag = (const PG8_LAS int*)(lds + RS_TAG_OFF);
    const int t0 = __builtin_amdgcn_readfirstlane(tag[0]), t1 = __builtin_amdgcn_readfirstlane(tag[1]), t2 = __builtin_amdgcn_readfirstlane(tag[2]);
    return (t0 == u.pm) ? 0 : (t1 == u.pm) ? 1 : (t2 == u.pm) ? 2 : 3; }
__device__ __forceinline__ float row_rs(const float* ssq, int np, PG8_LAS unsigned char* lds, int slot, int r, float inv_n, float eps) {
    if (np == 1) return 1.0f / sqrtf(ssq[r] * inv_n + eps);
    return ((const PG8_LAS float*)(lds + RS_OFF))[slot * 256 + (r & 255)];
}

struct EpiScaleF32 {
    static constexpr bool PERM = false, AFTER_DRAIN = false;
    float* C; int ldc; const float* bias; const float* ssq; int np; PG8_LAS unsigned char* lds; float inv_n, eps;
    __device__ __forceinline__ void operator()(const f32x4 (&acc)[2][2][4][2], const Unit& u, int wr, int wc, int fr, int fq) const {
        const int row0 = u.pm * BM + wr * 64 + fr, col0 = u.pn * BM + wc * 32 + 4 * fq;
        const int slot = (np == 1) ? 0 : rs_slot(lds, u);
        f32x4 bv[2][2];
#pragma unroll
        for (int bj = 0; bj < 2; ++bj)
#pragma unroll
            for (int n = 0; n < 2; ++n) bv[bj][n] = bias ? *(const f32x4*)(bias + col0 + bj * HALF + n * 16) : (f32x4){0.f, 0.f, 0.f, 0.f};
#pragma unroll
        for (int ai = 0; ai < 2; ++ai)
#pragma unroll
            for (int m = 0; m < 4; ++m) { const int r = row0 + ai * HALF + m * 16; float* rowp = C + (size_t)r * ldc + col0;
                const float rs = row_rs(ssq, np, lds, slot, r, inv_n, eps);
#pragma unroll
                for (int bj = 0; bj < 2; ++bj)
#pragma unroll
                    for (int n = 0; n < 2; ++n) *(f32x4*)(rowp + bj * HALF + n * 16) = acc[ai][bj][m][n] * rs + bv[bj][n]; }
    }
};

struct EpiResid {
    static constexpr bool PERM = true, AFTER_DRAIN = false;
    const float* xres; float* xout; bf16_t* xb; float* ssq; int ld, ldp;
    __device__ __forceinline__ void operator()(const f32x4 (&acc)[2][2][4][2], const Unit& u, int wr, int wc, int fr, int fq) const {
        const int row0 = u.pm * BM + wr * 64 + fr, col0 = u.pn * BM + wc * 32 + 8 * fq;
#pragma unroll
        for (int ai = 0; ai < 2; ++ai)
#pragma unroll
            for (int m = 0; m < 4; ++m) { const int r = row0 + ai * HALF + m * 16; float s = 0.f;
#pragma unroll
                for (int bj = 0; bj < 2; ++bj) { const int c = col0 + bj * HALF; const float* xr = xres + (size_t)r * ld + c; float* xo = xout + (size_t)r * ld + c;
                    const f32x4 v0 = acc[ai][bj][m][0] + *(const f32x4*)xr, v1 = acc[ai][bj][m][1] + *(const f32x4*)(xr + 4);
                    *(f32x4*)xo = v0; *(f32x4*)(xo + 4) = v1;
                    s += (v0[0] * v0[0] + v0[1] * v0[1]) + (v0[2] * v0[2] + v0[3] * v0[3]) + (v1[0] * v1[0] + v1[1] * v1[1]) + (v1[2] * v1[2] + v1[3] * v1[3]);
                    store_a8(xb + (size_t)r * (KS * ld), ld, c, v0, v1); }
                s += sxor<16>(s); s = half_sum(s);
                if (fq == 0) ssq[(size_t)(u.pn * 4 + wc) * ldp + r] = s;
                if (m & 1) asm volatile("" ::: "memory"); }
    }
};

struct EpiRelu2 {
    static constexpr bool PERM = true, AFTER_DRAIN = false;
    bf16_t* H; int ld; const float* ssq; int np; PG8_LAS unsigned char* lds; float inv_n, eps;
    __device__ __forceinline__ void operator()(const f32x4 (&acc)[2][2][4][2], const Unit& u, int wr, int wc, int fr, int fq) const {
        const int row0 = u.pm * BM + wr * 64 + fr, col0 = u.pn * BM + wc * 32 + 8 * fq; const int slot = (np == 1) ? 0 : rs_slot(lds, u);
#pragma unroll
        for (int ai = 0; ai < 2; ++ai)
#pragma unroll
            for (int m = 0; m < 4; ++m) { const int r = row0 + ai * HALF + m * 16; const float rs = row_rs(ssq, np, lds, slot, r, inv_n, eps);
#pragma unroll
                for (int bj = 0; bj < 2; ++bj) { f32x4 v0 = acc[ai][bj][m][0] * rs, v1 = acc[ai][bj][m][1] * rs;
#pragma unroll
                    for (int j = 0; j < 4; ++j) { const float a = fmaxf(v0[j], 0.f), b = fmaxf(v1[j], 0.f); v0[j] = a * a; v1[j] = b * b; }
                    store_a8(H + (size_t)r * (KS * ld), ld, col0 + bj * HALF, v0, v1); } }
    }
};

struct EpiScaleBf16 {
    static constexpr bool PERM = true, AFTER_DRAIN = false;
    bf16_t* O; int M_; const float* ssq; int np; PG8_LAS unsigned char* lds; float inv_n, eps; float* qss;
    __device__ __forceinline__ void operator()(const f32x4 (&acc)[2][2][4][2], const Unit& u, int wr, int wc, int fr, int fq) const {
        const int row0 = u.pm * BM + wr * 64 + fr, col0 = (u.pn & 1) * BM + wc * 32 + 8 * fq; const int slot = (np == 1) ? 0 : rs_slot(lds, u);
        bf16_t* Oh = O + (size_t)(u.pn >> 1) * M_ * 512;
#pragma unroll
        for (int ai = 0; ai < 2; ++ai)
#pragma unroll
            for (int m = 0; m < 4; ++m) { const int r = row0 + ai * HALF + m * 16; const float rs = row_rs(ssq, np, lds, slot, r, inv_n, eps); float s = 0.f;
#pragma unroll
                for (int bj = 0; bj < 2; ++bj) { const f32x4 v0 = acc[ai][bj][m][0] * rs, v1 = acc[ai][bj][m][1] * rs;
                    s += (v0[0] * v0[0] + v0[1] * v0[1]) + (v0[2] * v0[2] + v0[3] * v0[3]) + (v1[0] * v1[0] + v1[1] * v1[1]) + (v1[2] * v1[2] + v1[3] * v1[3]);
                    u32x4 w; w.x = cvt_pk_bf16(v0[0], v0[1]); w.y = cvt_pk_bf16(v0[2], v0[3]); w.z = cvt_pk_bf16(v1[0], v1[1]); w.w = cvt_pk_bf16(v1[2], v1[3]);
                    *(u32x4*)(Oh + (size_t)r * 512 + col0 + bj * HALF) = w; }
                s += sxor<16>(s); s = half_sum(s);
                if (fq == 0) qss[(size_t)(u.pn * 4 + wc) * M_ + r] = s;
                asm volatile("" ::: "memory"); }
    }
};
#define EPI_FRESH_LANE() { int z_ = 0; asm volatile("" : "+s"(z_)); const int l_ = (int)__builtin_amdgcn_mbcnt_hi(~0u, __builtin_amdgcn_mbcnt_lo(~0u, (unsigned)z_)); fr = l_ & 15; fq = l_ >> 4; }
struct EpiExpP {
    static constexpr bool PERM = true, AFTER_DRAIN = false;
    bf16_t* P; float* lp; int M_; PG8_LAS unsigned char* lds; float bound;
    __device__ __forceinline__ void operator()(const f32x4 (&acc)[2][2][4][2], const Unit& u, int wr, int wc, int fr, int fq) const {
        EPI_FRESH_LANE();
        const int row0 = u.pm * BM + wr * 64 + fr, col0 = wc * 32 + 8 * fq; const int slot = rs_slot(lds, u);
#pragma unroll
        for (int ai = 0; ai < 2; ++ai)
#pragma unroll
            for (int m = 0; m < 4; ++m) { const int r = row0 + ai * HALF + m * 16; const float rs = ((const PG8_LAS float*)(lds + RS_OFF))[slot * 256 + (r & 255)]; float s = 0.f;
#pragma unroll
                for (int bj = 0; bj < 2; ++bj) { f32x4 v0, v1;
#pragma unroll
                    for (int j = 0; j < 4; ++j) { v0[j] = __builtin_amdgcn_exp2f(acc[ai][bj][m][0][j] * rs - bound); v1[j] = __builtin_amdgcn_exp2f(acc[ai][bj][m][1][j] * rs - bound); }
                    s += ((v0[0] + v0[1]) + (v0[2] + v0[3])) + ((v1[0] + v1[1]) + (v1[2] + v1[3]));
                    u32x4 w; w.x = cvt_pk_bf16(v0[0], v0[1]); w.y = cvt_pk_bf16(v0[2], v0[3]); w.z = cvt_pk_bf16(v1[0], v1[1]); w.w = cvt_pk_bf16(v1[2], v1[3]);
                    *(u32x4*)(P + (size_t)r * 256 + col0 + bj * HALF) = w; }
                s += sxor<16>(s); s = half_sum(s);
                if (fq == 0) lp[(size_t)wc * M_ + r] = s;
                asm volatile("" ::: "memory"); }
    }
};
struct EpiRowScaleA {
    static constexpr bool PERM = true, AFTER_DRAIN = false;
    bf16_t* Y; int ld, colbase; PG8_LAS unsigned char* lds;
    __device__ __forceinline__ void operator()(const f32x4 (&acc)[2][2][4][2], const Unit& u, int wr, int wc, int fr, int fq) const {
        EPI_FRESH_LANE();
        const int row0 = u.pm * BM + wr * 64 + fr, col0 = colbase + u.pn * BM + wc * 32 + 8 * fq; const int slot = rs_slot(lds, u);
#pragma unroll
        for (int ai = 0; ai < 2; ++ai)
#pragma unroll
            for (int m = 0; m < 4; ++m) { const int r = row0 + ai * HALF + m * 16; const float il = ((const PG8_LAS float*)(lds + RS_OFF))[slot * 256 + (r & 255)];
#pragma unroll
                for (int bj = 0; bj < 2; ++bj) store_a8(Y + (size_t)r * (KS * ld), ld, col0 + bj * HALF, acc[ai][bj][m][0] * il, acc[ai][bj][m][1] * il);
                asm volatile("" ::: "memory"); }
    }
};

struct EpiExpPN {
    static constexpr bool PERM = true, AFTER_DRAIN = false;
    bf16_t* P; int ldc, colbase; PG8_LAS unsigned char* lds; float bound;
    __device__ __forceinline__ void operator()(const f32x4 (&acc)[2][2][4][2], const Unit& u, int wr, int wc, int fr, int fq) const {
        EPI_FRESH_LANE();
        const int rin0 = wr * 64 + fr, col0 = colbase + wc * 32 + 8 * fq; const int slot = rs_slot(lds, u);
        const PG8_LAS float* rst = (const PG8_LAS float*)(lds + RS_OFF) + slot * 256; PG8_LAS float* part = (PG8_LAS float*)(lds + RS_OFF + 8192);
#pragma unroll
        for (int ai = 0; ai < 2; ++ai)
#pragma unroll
            for (int m = 0; m < 4; ++m) { const int rin = rin0 + ai * HALF + m * 16; const float rs = rst[rin]; float s = 0.f;
#pragma unroll
                for (int bj = 0; bj < 2; ++bj)
#pragma unroll
                    for (int j = 0; j < 4; ++j) s += __builtin_amdgcn_exp2f(acc[ai][bj][m][0][j] * rs - bound) + __builtin_amdgcn_exp2f(acc[ai][bj][m][1][j] * rs - bound);
                s += sxor<16>(s); s = half_sum(s);
                if (fq == 0) part[rin * 4 + wc] = s; }
        asm volatile("s_waitcnt lgkmcnt(0)" ::: "memory"); __builtin_amdgcn_s_barrier(); asm volatile("" ::: "memory");
#pragma unroll
        for (int ai = 0; ai < 2; ++ai)
#pragma unroll
            for (int m = 0; m < 4; ++m) { const int rin = rin0 + ai * HALF + m * 16; const float rs = rst[rin]; const f32x4 p4 = *(const PG8_LAS f32x4*)(part + rin * 4);
                const float inv = 1.0f / ((p4[0] + p4[1]) + (p4[2] + p4[3])); bf16_t* prow = P + (size_t)(u.pm * BM + rin) * ldc + col0;
#pragma unroll
                for (int bj = 0; bj < 2; ++bj) { f32x4 v0, v1;
#pragma unroll
                    for (int j = 0; j < 4; ++j) { v0[j] = __builtin_amdgcn_exp2f(acc[ai][bj][m][0][j] * rs - bound) * inv; v1[j] = __builtin_amdgcn_exp2f(acc[ai][bj][m][1][j] * rs - bound) * inv; }
                    u32x4 w; w.x = cvt_pk_bf16(v0[0], v0[1]); w.y = cvt_pk_bf16(v0[2], v0[3]); w.z = cvt_pk_bf16(v1[0], v1[1]); w.w = cvt_pk_bf16(v1[2], v1[3]);
                    *(u32x4*)(prow + bj * HALF) = w; }
                asm volatile("" ::: "memory"); }
    }
};
struct EpiPlainBf16 {
    static constexpr bool PERM = true, AFTER_DRAIN = false;
    bf16_t* O; int ldc, colbase;
    __device__ __forceinline__ void operator()(const f32x4 (&acc)[2][2][4][2], const Unit& u, int wr, int wc, int fr, int fq) const {
        EPI_FRESH_LANE();
        const int row0 = u.pm * BM + wr * 64 + fr, col0 = colbase + u.pn * BM + wc * 32 + 8 * fq;
#pragma unroll
        for (int ai = 0; ai < 2; ++ai)
#pragma unroll
            for (int m = 0; m < 4; ++m) { bf16_t* orow = O + (size_t)(row0 + ai * HALF + m * 16) * ldc + col0;
#pragma unroll
                for (int bj = 0; bj < 2; ++bj) { const f32x4 v0 = acc[ai][bj][m][0], v1 = acc[ai][bj][m][1];
                    u32x4 w; w.x = cvt_pk_bf16(v0[0], v0[1]); w.y = cvt_pk_bf16(v0[2], v0[3]); w.z = cvt_pk_bf16(v1[0], v1[1]); w.w = cvt_pk_bf16(v1[2], v1[3]);
                    *(u32x4*)(orow + bj * HALF) = w; }
                asm volatile("" ::: "memory"); }
    }
};
template <class Epi, class Sched, bool ALIGN_EPI = false, bool SP2 = false>
__device__ __forceinline__ void gemm_phase(PG8_LAS unsigned char* lds, const Gemm g, const Sched& S, const Epi& E, int wid_in) {
    int zero_ = 0; asm volatile("" : "+s"(zero_));
    const int lane = (int)__builtin_amdgcn_mbcnt_hi(~0u, __builtin_amdgcn_mbcnt_lo(~0u, (unsigned)zero_));
    const int wid = wid_in, tid = wid * 64 + lane, wr = wid >> 2, wc = wid & 3, fr = lane & 15, fq = lane >> 4;
    const int K = g.K, nt = K / BK;
    unsigned voffA[2], voffB[2];
#pragma unroll
    for (int i = 0; i < 2; ++i) { int R, C; stage_rc(tid * 16 + i * 8192, R, C); const int Rb = Epi::PERM ? ((R & ~31) + perm32(R & 31)) : R;
        voffA[i] = (unsigned)(R * K + C) * 2u; voffB[i] = (unsigned)(Rb * K + C) * 2u; }
    const size_t kstep = (size_t)(BK * 2);
    const size_t hstep = (size_t)HALF * K * 2;
    const size_t tstep = 2 * hstep;
    const unsigned ldsw = (unsigned)wid * 1024u;
    const int aoff = lds_byte(wr * 64 + fr, fq * 8), boff = lds_byte(wc * 32 + fr, fq * 8);
#define PG8_SA(b, h) (((b) * 2 + (h)) * HTB)
#define PG8_SB(b, h) ((4 + (b) * 2 + (h)) * HTB)
#define PG8_STAGE(bufoff, gbase, voff) do { _Pragma("unroll") for (int _i = 0; _i < 2; ++_i) \
        __builtin_amdgcn_global_load_lds((const unsigned*)((const char*)(gbase) + (voff)[_i]), (PG8_LAS unsigned*)(lds + (bufoff) + ldsw + _i * 8192), 16, 0, 0); } while (0)
#define PG8_LDA(dst, b, h) do { _Pragma("unroll") for (int m = 0; m < 4; ++m) _Pragma("unroll") for (int k = 0; k < 2; ++k) dst[m][k] = *(const PG8_LAS bf16x8*)(lds + PG8_SA(b, h) + aoff + m * 2048 + k * 1024); } while (0)
#define PG8_LDB(dst, b, h) do { _Pragma("unroll") for (int n = 0; n < 2; ++n) _Pragma("unroll") for (int k = 0; k < 2; ++k) dst[n][k] = *(const PG8_LAS bf16x8*)(lds + PG8_SB(b, h) + boff + n * 2048 + k * 1024); } while (0)
#define PG8_MMA(ai, bj, At, Bt) do { __builtin_amdgcn_s_setprio(1); _Pragma("unroll") for (int m = 0; m < 4; ++m) _Pragma("unroll") for (int n = 0; n < 2; ++n) _Pragma("unroll") for (int k = 0; k < 2; ++k) \
        acc[ai][bj][m][n] = __builtin_amdgcn_mfma_f32_16x16x32_bf16(Bt[n][k], At[m][k], acc[ai][bj][m][n], 0, 0, 0); __builtin_amdgcn_s_setprio(0); } while (0)
#define PG8_WAIT_V(n) asm volatile("s_waitcnt vmcnt(" #n ")" ::: "memory")
#define PG8_WAIT_L(n) asm volatile("s_waitcnt lgkmcnt(" #n ")" ::: "memory")
#define PG8_BAR __builtin_amdgcn_s_barrier()
#define PG8_SCHED __builtin_amdgcn_sched_barrier(0)
    Unit cur, nxt; int ui = 0;
    if (!S.next(0, cur)) return;
    f32x4 acc[2][2][4][2];
#pragma unroll
    for (int a = 0; a < 2; ++a)
#pragma unroll
        for (int b = 0; b < 2; ++b)
#pragma unroll
            for (int m = 0; m < 4; ++m)
#pragma unroll
                for (int n = 0; n < 2; ++n) acc[a][b][m][n] = (f32x4){0.f, 0.f, 0.f, 0.f};
    bf16x8 At[4][2], B0[2][2], B1[2][2];
    const char* cA = (const char*)g.A + (size_t)cur.pm * tstep; const char* cB = (const char*)g.Bt + (size_t)cur.pn * tstep;
    S.a_ready(cur);
    if constexpr (SP2) {
        PG8_STAGE(PG8_SB(0, 0), cB, voffB); PG8_STAGE(PG8_SB(0, 1), cB + hstep, voffB); PG8_STAGE(PG8_SA(0, 0), cA, voffA); PG8_STAGE(PG8_SA(0, 1), cA + hstep, voffA);
        if (wr == 1) PG8_BAR;
        PG8_WAIT_V(2); PG8_BAR;
        PG8_STAGE(PG8_SB(1, 0), cB + kstep, voffB); PG8_STAGE(PG8_SA(1, 0), cA + kstep, voffA); PG8_STAGE(PG8_SB(1, 1), cB + hstep + kstep, voffB);
        PG8_WAIT_V(6); PG8_BAR;
    } else {
        PG8_STAGE(PG8_SB(0, 0), cB, voffB); PG8_STAGE(PG8_SA(0, 0), cA, voffA); PG8_STAGE(PG8_SB(0, 1), cB + hstep, voffB); PG8_STAGE(PG8_SA(0, 1), cA + hstep, voffA);
        if (wr == 1) PG8_BAR;
        PG8_WAIT_V(4); PG8_BAR;
        PG8_STAGE(PG8_SB(1, 0), cB + kstep, voffB); PG8_STAGE(PG8_SA(1, 0), cA + kstep, voffA); PG8_STAGE(PG8_SB(1, 1), cB + hstep + kstep, voffB);
        PG8_WAIT_V(6); PG8_BAR;
    }
    for (;;) {
        const bool has_next = S.next(ui + 1, nxt);
        const char* nA = has_next ? (const char*)g.A + (size_t)nxt.pm * tstep : cA; const char* nB = has_next ? (const char*)g.Bt + (size_t)nxt.pn * tstep : cB;
        for (int t = 0; t < nt; t += 2) {
            const bool last = (t == nt - 2);
            const char* a1 = cA + (size_t)(t + 1) * kstep;
            const char* a2 = last ? nA : cA + (size_t)(t + 2) * kstep; const char* b2 = last ? nB : cB + (size_t)(t + 2) * kstep;
            const char* a3 = a2 + kstep; const char* b3 = b2 + kstep;
            if (last && has_next) S.a_ready(nxt);
            if constexpr (SP2) {
            PG8_LDB(B0, 0, 0); PG8_LDB(B1, 0, 1); PG8_SCHED; PG8_LDA(At, 0, 0); PG8_STAGE(PG8_SA(1, 1), a1 + hstep, voffA);
            PG8_WAIT_V(8); PG8_WAIT_L(0); PG8_BAR; PG8_MMA(0, 0, At, B0); PG8_MMA(0, 1, At, B1); PG8_BAR; PG8_SCHED;
            PG8_LDA(At, 0, 1); PG8_STAGE(PG8_SB(0, 0), b2, voffB); PG8_STAGE(PG8_SB(0, 1), b2 + hstep, voffB); PG8_STAGE(PG8_SA(0, 0), a2, voffA);
            PG8_WAIT_V(8); PG8_WAIT_L(0); PG8_BAR; PG8_MMA(1, 0, At, B0); PG8_MMA(1, 1, At, B1); PG8_BAR; PG8_SCHED;
            PG8_LDB(B0, 1, 0); PG8_LDB(B1, 1, 1); PG8_SCHED; PG8_LDA(At, 1, 0); PG8_STAGE(PG8_SA(0, 1), a2 + hstep, voffA);
            PG8_WAIT_V(8); PG8_WAIT_L(0); PG8_BAR; PG8_MMA(0, 0, At, B0); PG8_MMA(0, 1, At, B1); PG8_BAR; PG8_SCHED;
            PG8_LDA(At, 1, 1); PG8_STAGE(PG8_SB(1, 0), b3, voffB); PG8_STAGE(PG8_SB(1, 1), b3 + hstep, voffB); PG8_STAGE(PG8_SA(1, 0), a3, voffA);
            PG8_WAIT_V(8); PG8_WAIT_L(0); PG8_BAR; PG8_MMA(1, 0, At, B0); PG8_MMA(1, 1, At, B1); PG8_BAR; PG8_SCHED;
            } else {
            PG8_LDB(B0, 0, 0); PG8_SCHED; PG8_LDA(At, 0, 0); PG8_STAGE(PG8_SA(1, 1), a1 + hstep, voffA);
            PG8_WAIT_L(8); PG8_BAR; PG8_WAIT_L(0); PG8_MMA(0, 0, At, B0); PG8_BAR; PG8_SCHED;
            PG8_LDB(B1, 0, 1); PG8_STAGE(PG8_SB(0, 0), b2, voffB);
            PG8_BAR; PG8_WAIT_L(0); PG8_MMA(0, 1, At, B1); PG8_BAR;
            PG8_LDA(At, 0, 1); PG8_STAGE(PG8_SA(0, 0), a2, voffA);
            PG8_BAR; PG8_WAIT_L(0); PG8_MMA(1, 0, At, B0); PG8_BAR; PG8_SCHED;
            PG8_STAGE(PG8_SB(0, 1), b2 + hstep, voffB);
            PG8_WAIT_V(6); PG8_BAR; PG8_MMA(1, 1, At, B1); PG8_BAR;
            PG8_LDB(B0, 1, 0); PG8_SCHED; PG8_LDA(At, 1, 0); PG8_STAGE(PG8_SA(0, 1), a2 + hstep, voffA);
            PG8_WAIT_L(8); PG8_BAR; PG8_WAIT_L(0); PG8_MMA(0, 0, At, B0); PG8_BAR; PG8_SCHED;
            PG8_LDB(B1, 1, 1); PG8_STAGE(PG8_SB(1, 0), b3, voffB);
            PG8_BAR; PG8_WAIT_L(0); PG8_MMA(0, 1, At, B1); PG8_BAR;
            PG8_LDA(At, 1, 1); PG8_STAGE(PG8_SA(1, 0), a3, voffA);
            PG8_BAR; PG8_WAIT_L(0); PG8_MMA(1, 0, At, B0); PG8_BAR; PG8_SCHED;
            PG8_STAGE(PG8_SB(1, 1), b3 + hstep, voffB);
            PG8_WAIT_V(6); PG8_BAR; PG8_MMA(1, 1, At, B1); PG8_BAR;
            }
        }
        if constexpr (ALIGN_EPI) { if (wr == 0) PG8_BAR; }
        if constexpr (!Epi::AFTER_DRAIN) { E(acc, cur, wr, wc, fr, fq); S.done(cur); }
        if (!has_next) break;
#pragma unroll
        for (int a = 0; a < 2; ++a)
#pragma unroll
            for (int b = 0; b < 2; ++b)
#pragma unroll
                for (int m = 0; m < 4; ++m)
#pragma unroll
                    for (int n = 0; n < 2; ++n) acc[a][b][m][n] = (f32x4){0.f, 0.f, 0.f, 0.f};
        cur = nxt; cA = nA; cB = nB; ++ui;
        if constexpr (ALIGN_EPI) { if (wr == 1) PG8_BAR; }
    }
    PG8_WAIT_V(0);
    if constexpr (!ALIGN_EPI) { if (wr == 0) PG8_BAR; }
    PG8_BAR;
    if constexpr (Epi::AFTER_DRAIN) { E.fused(acc, cur, wr, wc, fr, fq, lds, wid, lane); S.done(cur); }
#undef PG8_SA
#undef PG8_SB
#undef PG8_STAGE
#undef PG8_LDA
#undef PG8_LDB
#undef PG8_MMA
#undef PG8_WAIT_V
#undef PG8_WAIT_L
#undef PG8_BAR
#undef PG8_SCHED
}
}
#define PG8_SP2 true
#define PG8_ALIGN true
constexpr int T = 8192, D = 2048, DIN = 6688, NIN = 6912, DFF = 8192, MEM = 256, DEPTH = 4;
constexpr int NCMP = 511, NCH = 128;
constexpr float EPS = 1e-6f;
constexpr int ZC_HGQ = 0, ZC_HGF = 512, ZC_HGI = 1024, ZC_HGG = 1536, ZC_NSQ = 2048, ZC_NKC = 3072, ZC_NVC = 3328, ZC_NKS = 3584, ZC_NVS = 3840, ZC_NKW = 4096, ZC_NVW = 4352,
              ZC_MLQ = 4608, ZC_MLK = 5120, ZC_MLV = 5632, ZC_MLO = 6144, ZC_GATE = 6656, ZC_MLI = 6680, ZC_MLF = 6684;
__host__ __device__ __forceinline__ int zcol_src(int j) {
    if (j < 4608) return j; if (j < 6656) return j + 24; if (j < 6680) return j - 6656 + 4608; if (j < 6688) return j; return -1; }
#ifndef K4PER_
#define K4PER_ 24
#endif
constexpr int NPH = 12;
constexpr int NPHASES = 1 + DEPTH * NPH;

constexpr size_t MiB = 1u << 20;
constexpr size_t al256(size_t x) { return (x + 255) & ~(size_t)255; }
constexpr size_t WS_CTL = 0, CTL_ZERO_BYTES = 1 * MiB;
constexpr size_t SZ_DD = (size_t)D * D * KS * 2;
constexpr size_t WS_WIN = CTL_ZERO_BYTES;
constexpr size_t WS_WOUT = WS_WIN + (size_t)NIN * D * KS * 2;
constexpr size_t WS_WQ = WS_WOUT + SZ_DD, WS_WO = WS_WQ + SZ_DD, WS_WKV = WS_WO + SZ_DD;
constexpr size_t WS_W1 = WS_WKV + 2 * SZ_DD;
constexpr size_t WS_W2 = WS_W1 + (size_t)DFF * D * KS * 2;
constexpr size_t WS_WCF = WS_W2 + (size_t)DFF * D * KS * 2;
constexpr size_t WS_BPERM = WS_WCF + (size_t)2 * 4 * 256 * 512 * 2;
constexpr size_t WS_WSET = al256(WS_BPERM + NIN * 4) - WS_WIN;
#ifndef XFUSE
#define XFUSE (KS == 1)
#endif
#ifndef WOVL
#define WOVL (KS == 1)
#endif
constexpr size_t WS_A0 = WS_WIN + (WOVL ? 2 : 1) * WS_WSET;
constexpr size_t WS_A1 = WS_A0 + (size_t)T * D * KS * 2;
constexpr size_t WS_MEMB = WS_A1 + (size_t)T * D * KS * 2;
constexpr size_t WS_SSQA = WS_MEMB + (size_t)MEM * D * KS * 2;
constexpr size_t WS_SSQB = WS_SSQA + 32 * T * 4, WS_SSQC = WS_SSQB + 32 * T * 4, WS_SSQM = WS_SSQC + 32 * T * 4;
constexpr size_t WS_LB = WS_SSQM + MEM * 4;
constexpr size_t WS_COS = WS_LB + DEPTH * 512 * 4, WS_SIN = WS_COS + (size_t)T * 64 * 4;
constexpr size_t WS_KVX = WS_SIN + (size_t)T * 64 * 4;
constexpr size_t WS_KXN = WS_KVX + (size_t)MEM * 2 * D * 4;
constexpr size_t WS_KCN = WS_KXN + (size_t)MEM * D * 4;
constexpr size_t WS_VCN = WS_KCN + 2 * 512 * 128 * 4;
constexpr size_t WS_HGDEC = WS_VCN + 2 * 512 * 128 * 4;
constexpr size_t WS_MLNL = WS_HGDEC + NCH * 512 * 4, WS_MLN = WS_MLNL + NCH * 512 * 4;
constexpr size_t WS_MLSC = WS_MLN + NCH * 512 * 4;
constexpr size_t WS_KXF = al256(WS_MLSC + 3 * NCH * 4 * 4);
constexpr size_t WS_VXF = WS_KXF + (size_t)MEM * D * 2;
constexpr size_t WS_QSS = WS_VXF + (size_t)MEM * D * 2;
constexpr size_t WS_LPX = WS_QSS + (size_t)32 * T * 4;
constexpr size_t WS_BTC = WS_LPX + (size_t)16 * T * 4;
constexpr size_t WS_R = al256(WS_BTC + (size_t)D * 1024 * 2);
constexpr size_t WS_Z = WS_R;
constexpr size_t WS_XQ = WS_R;
constexpr size_t WS_XQB = WS_R;
constexpr size_t WS_PH = WS_R + (size_t)T * D * 2;
constexpr size_t WS_NSQ = WS_Z + (size_t)T * NIN * 4;
constexpr size_t SZ_ORA = ORACLE_ATTN ? (size_t)T * 256 * 4 : 0;
constexpr size_t WS_NKS = WS_NSQ + 4 * SZ_ORA, WS_NKW = WS_NKS + SZ_ORA;
constexpr size_t WS_MLQ = WS_NKW + SZ_ORA, WS_MLK = WS_MLQ + (size_t)T * 512 * 4;
constexpr size_t SZ_ST = (size_t)NCH * 4 * 128 * 128 * 4;
constexpr size_t SZ_STO = ORACLE_MIX ? SZ_ST : 0;
constexpr size_t WS_HGU = WS_MLK + (size_t)T * 512 * 4, WS_HGS = WS_HGU + SZ_ST, WS_MLU = WS_HGS + SZ_STO, WS_MLS = WS_MLU + SZ_ST;
constexpr size_t WS_QN = WS_MLS + SZ_STO;
constexpr size_t SZ_KF = (size_t)2 * T * 128 * 2;
constexpr size_t WS_KSF = WS_QN + (size_t)T * 1024 * 2, WS_KWF = WS_KSF + SZ_KF, WS_VSF = WS_KWF + SZ_KF, WS_VWF = WS_VSF + SZ_KF;
constexpr size_t WS_KCF = WS_VWF + SZ_KF, WS_VCF = WS_KCF + 2 * 16 * 4096 * 2;
constexpr size_t WS_OC = WS_VCF + 2 * 16 * 4096 * 2;
constexpr size_t WS_SELG = WS_OC + (size_t)T * 1024 * 4;
constexpr size_t WS_HGST = WS_SELG + (size_t)T * 2 * 16 * 4;
constexpr size_t WS_MLST = WS_HGST + SZ_ST / 2;
constexpr size_t WS_MIX_END = WS_MLST + SZ_ST / 2;
constexpr size_t WS_HM = WS_R;
constexpr size_t WS_R_END1 = WS_MIX_END, WS_R_END2 = WS_HM + (size_t)T * DFF * KS * 2;
constexpr size_t WS_END = WS_R_END1 > WS_R_END2 ? WS_R_END1 : WS_R_END2;

constexpr int CW_TMO = 0;
constexpr int CW_BAR = 4096;
constexpr int LDS_SCR = 155648;
constexpr int MISC_OFF = LDS_SCR;
constexpr int LDS_BYTES = LDS_SCR + 1024;
constexpr int WAVE_SCR = LDS_SCR / 8;

#define GAS __attribute__((address_space(1)))
#define LAS __attribute__((address_space(3)))
typedef unsigned short bf16;
typedef unsigned v4u __attribute__((ext_vector_type(4)));
typedef unsigned v2u __attribute__((ext_vector_type(2)));
typedef float f32x4 __attribute__((ext_vector_type(4)));
typedef float f32x2 __attribute__((ext_vector_type(2)));
typedef GAS unsigned gu32;
#define RLX_AGENT __ATOMIC_RELAXED, __HIP_MEMORY_SCOPE_AGENT
#define LDS_WAIT() asm volatile("s_waitcnt lgkmcnt(0)" ::: "memory")
__device__ __forceinline__ unsigned f2bf(float f) { unsigned u = __builtin_bit_cast(unsigned, f); return (u + 0x7fffu + ((u >> 16) & 1u)) >> 16; }
__device__ __forceinline__ float bf2f(unsigned b) { return __builtin_bit_cast(float, b << 16); }
__device__ __forceinline__ unsigned pk2(float lo, float hi) { return f2bf(lo) | (f2bf(hi) << 16); }
__device__ __forceinline__ float lo_of(float v) { return v - bf2f(f2bf(v)); }
__device__ __forceinline__ void storeA1(bf16* rowp, int Kreal, int col, float v) { const unsigned h = f2bf(v); rowp[col] = (bf16)h;
#if KS == 3
    rowp[Kreal + col] = (bf16)h; rowp[2 * Kreal + col] = (bf16)f2bf(v - bf2f(h));
#endif
}
__device__ __forceinline__ void storeA2(bf16* rowp, int Kreal, int col, float a, float b) { *(unsigned*)(rowp + col) = pk2(a, b);
#if KS == 3
    *(unsigned*)(rowp + Kreal + col) = pk2(a, b); *(unsigned*)(rowp + 2 * Kreal + col) = pk2(lo_of(a), lo_of(b));
#endif
}
__device__ __forceinline__ void storeA4(bf16* rowp, int Kreal, int col, f32x4 v) { v2u w; w.x = pk2(v[0], v[1]); w.y = pk2(v[2], v[3]); *(v2u*)(rowp + col) = w;
#if KS == 3
    *(v2u*)(rowp + Kreal + col) = w; v2u l; l.x = pk2(lo_of(v[0]), lo_of(v[1])); l.y = pk2(lo_of(v[2]), lo_of(v[3])); *(v2u*)(rowp + 2 * Kreal + col) = l;
#endif
}
__device__ __forceinline__ float wave_sum(float v) { v += sxor<1>(v); v += sxor<2>(v); v += sxor<4>(v); v += sxor<8>(v); v += sxor<16>(v); return half_sum(v); }
__device__ __forceinline__ float wave_max(float v) { v = fmaxf(v, sxor<1>(v)); v = fmaxf(v, sxor<2>(v)); v = fmaxf(v, sxor<4>(v)); v = fmaxf(v, sxor<8>(v)); v = fmaxf(v, sxor<16>(v)); return half_max(v); }
#define ARGMAX_STEP(M) do { const float ov_ = sxor<M>(bv); const int oi_ = sxori<M>(bi); if (ov_ > bv || (ov_ == bv && oi_ < bi)) { bv = ov_; bi = oi_; } } while (0)
__device__ __forceinline__ void wave_argmax(float& bv, int& bi) { ARGMAX_STEP(1); ARGMAX_STEP(2); ARGMAX_STEP(4); ARGMAX_STEP(8); ARGMAX_STEP(16);
    unsigned va = __builtin_bit_cast(unsigned, bv), vb = va, ia = (unsigned)bi, ib = ia; swap32(va, vb); swap32(ia, ib);
    const float v0 = __builtin_bit_cast(float, va), v1 = __builtin_bit_cast(float, vb); const int i0 = (int)ia, i1 = (int)ib;
    if (v0 > v1 || (v0 == v1 && i0 < i1)) { bv = v0; bi = i0; } else { bv = v1; bi = i1; } }
__device__ __forceinline__ float sigmoidf_(float x) { return 1.0f / (1.0f + __expf(-x)); }
#define XB_TMO      128
#define XB_XCNT(j)  (256  + 64 * (j))
#define XB_XSUB(j)  (1280 + 64 * (j))
#define XB_XGEN(j)  (2304 + 64 * (j))
#define XB_TOP      3328
#define XB_TOPGEN   3392
#define XCD_BAR_WORDS 3456
#define XB_SPIN_CAP (1u << 18)

__device__ __forceinline__ unsigned xb_ld(unsigned* p)              { return __hip_atomic_load(p, __ATOMIC_RELAXED, __HIP_MEMORY_SCOPE_AGENT); }
__device__ __forceinline__ unsigned xb_add(unsigned* p, unsigned v) { return __hip_atomic_fetch_add(p, v, __ATOMIC_RELAXED, __HIP_MEMORY_SCOPE_AGENT); }
__device__ __forceinline__ unsigned xb_xcc_id() { return (unsigned)__builtin_amdgcn_s_getreg((3 << 11) | 20) & 0xFu; }
#define XB_SPIN(cond, bar) do { unsigned _sp = 0; while (cond) { __builtin_amdgcn_s_sleep(1); \
    if ((++_sp & 255u) == 0u) { if (xb_ld(&(bar)[XB_TMO])) break; if (_sp > XB_SPIN_CAP) { atomicAdd(&(bar)[XB_TMO], 1u); break; } } } } while (0)

struct XcdBarrier {
    unsigned* bar; unsigned x;
    volatile LAS unsigned* st;
};

__device__ __forceinline__ XcdBarrier xcd_barrier_post(unsigned* bar, volatile LAS unsigned* st) {
    XcdBarrier b; b.bar = bar; b.x = xb_xcc_id(); b.st = st;
    if (threadIdx.x == 0) (void)xb_add(&bar[XB_XCNT(b.x)], 1u);
    return b;
}
__device__ __forceinline__ void xcd_barrier_complete(unsigned* bar, unsigned x, unsigned& nloc, unsigned& nx) {
    const unsigned G = gridDim.x * gridDim.y * gridDim.z;
    unsigned sum, cnt, mine, sp = 0u;
    for (;;) {
        sum = 0u; cnt = 0u; mine = 0u;
#pragma unroll
        for (unsigned j = 0; j < 16; ++j) { const unsigned c = xb_ld(&bar[XB_XCNT(j)]); sum += c; cnt += (c > 0u) ? 1u : 0u; mine = (j == x) ? c : mine; }
        if (sum == G) break;
        __builtin_amdgcn_s_sleep(1);
        if ((++sp & 255u) == 0u) { if (xb_ld(&bar[XB_TMO])) break; if (sp > XB_SPIN_CAP) { atomicAdd(&bar[XB_TMO], 1u); break; } }
    }
    nloc = mine > 0u ? mine : 1u; nx = cnt > 0u ? cnt : 1u;
}

__device__ __forceinline__ void xcd_barrier(const XcdBarrier& b) {
    asm volatile("s_waitcnt vmcnt(0)" ::: "memory");
    __syncthreads();
    if (threadIdx.x == 0) {
        unsigned* bar = b.bar;
        __builtin_amdgcn_s_waitcnt(0);
        unsigned nloc = b.st[0], nx = b.st[1];
        if (nloc == 0u) { xcd_barrier_complete(bar, b.x, nloc, nx); b.st[0] = nloc; b.st[1] = nx; }
        const unsigned old = xb_add(&bar[XB_XSUB(b.x)], 1u);
        const unsigned gen = old / nloc;
        if (old + 1u == (gen + 1u) * nloc) {
            __builtin_amdgcn_fence(__ATOMIC_RELEASE, "agent");
            asm volatile("s_waitcnt vmcnt(0)" ::: "memory");
            const unsigned og = xb_add(&bar[XB_TOP], 1u);
            const unsigned tg = og / nx;
            if (og + 1u == (tg + 1u) * nx) xb_add(&bar[XB_TOPGEN], 1u);
            else XB_SPIN(xb_ld(&bar[XB_TOPGEN]) == tg, bar);
            __builtin_amdgcn_fence(__ATOMIC_ACQUIRE, "agent");
            xb_add(&bar[XB_XGEN(b.x)], 1u);
            asm volatile("s_waitcnt vmcnt(0)" ::: "memory");
        } else {
            XB_SPIN(xb_ld(&bar[XB_XGEN(b.x)]) == gen, bar);
            __builtin_amdgcn_fence(__ATOMIC_ACQUIRE, "agent");
            asm volatile("s_waitcnt vmcnt(0)" ::: "memory");
        }
    }
    __syncthreads();
}


__device__ __forceinline__ void xcd_barrier_arrive(const XcdBarrier& b) {
    asm volatile("s_waitcnt vmcnt(0)" ::: "memory");
    __syncthreads();
    if (threadIdx.x == 0) {
        unsigned* bar = b.bar;
        __builtin_amdgcn_s_waitcnt(0);
        unsigned nloc = b.st[0], nx = b.st[1];
        if (nloc == 0u) { xcd_barrier_complete(bar, b.x, nloc, nx); b.st[0] = nloc; b.st[1] = nx; }
        const unsigned old = xb_add(&bar[XB_XSUB(b.x)], 1u);
        const unsigned gen = old / nloc;
        if (old + 1u == (gen + 1u) * nloc) {
            __builtin_amdgcn_fence(__ATOMIC_RELEASE, "agent");
            asm volatile("s_waitcnt vmcnt(0)" ::: "memory");
            const unsigned og = xb_add(&bar[XB_TOP], 1u);
            const unsigned tg = og / nx;
            if (og + 1u == (tg + 1u) * nx) xb_add(&bar[XB_TOPGEN], 1u);
            else XB_SPIN(xb_ld(&bar[XB_TOPGEN]) == tg, bar);
            __builtin_amdgcn_fence(__ATOMIC_ACQUIRE, "agent");
            xb_add(&bar[XB_XGEN(b.x)], 1u);
            asm volatile("s_waitcnt vmcnt(0)" ::: "memory");
            b.st[2] = 0xFFFFFFFFu;
        } else b.st[2] = gen;
    }
}
__device__ __forceinline__ void xcd_barrier_wait(const XcdBarrier& b) {
    if (threadIdx.x == 0) {
        const unsigned gen = b.st[2];
        if (gen != 0xFFFFFFFFu) {
            XB_SPIN(xb_ld(&b.bar[XB_XGEN(b.x)]) == gen, b.bar);
            __builtin_amdgcn_fence(__ATOMIC_ACQUIRE, "agent");
            asm volatile("s_waitcnt vmcnt(0)" ::: "memory");
        }
    }
    __syncthreads();
}
struct KArgs { const float* in[25]; float* out; unsigned char* ws; int ph_lo, ph_hi, li, pad; };
struct Frame {
    LAS unsigned char* lds;
    volatile LAS unsigned* MISC;
    gu32* ctl;
    int tid, lane, wave, G, bid;
    size_t wofs;
    unsigned char* ws;
    const KArgs __attribute__((address_space(4)))* ap;
};
#define INP(i) ((const float*)F.ap->in[i])
#define OUTP   ((float*)F.ap->out)
#define LAUNDER() do { asm volatile("" : "+s"(F.ws)); asm volatile("" : "+s"(F.ap)); int z_ = 0; asm volatile("" : "+s"(z_)); F.lane = (int)__builtin_amdgcn_mbcnt_hi(~0u, __builtin_amdgcn_mbcnt_lo(~0u, (unsigned)z_)); F.tid = F.wave * 64 + F.lane; } while (0)
#define WSP(type, off) ((type*)(F.ws + (off)))
#define WSL(type, off) ((type*)(F.ws + (off) + F.wofs))
#define WSO(type, off, wo) ((type*)(F.ws + (off) + (wo)))
#define EXPF(x) __expf(x)
#define LOGF(x) __logf(x)
__device__ __forceinline__ float sigm(float x) { return __builtin_amdgcn_rcpf(1.0f + EXPF(-x)); }
__device__ __forceinline__ float siluf_(float x) { return x * __builtin_amdgcn_rcpf(1.0f + EXPF(-x)); }

__device__ const float c_invf[64] = {1.000000000e+00f, 8.659643531e-01f, 7.498942018e-01f, 6.493816376e-01f, 5.623413324e-01f, 4.869675338e-01f, 4.216965139e-01f, 3.651741147e-01f, 3.162277639e-01f, 2.738419771e-01f, 2.371373773e-01f, 2.053525001e-01f, 1.778279394e-01f, 1.539926529e-01f, 1.333521456e-01f, 1.154781953e-01f, 1.000000015e-01f, 8.659642935e-02f, 7.498942316e-02f, 6.493816525e-02f, 5.623413250e-02f, 4.869675264e-02f, 4.216964915e-02f, 3.651741147e-02f, 3.162277490e-02f, 2.738419548e-02f, 2.371373773e-02f, 2.053525113e-02f, 1.778279431e-02f, 1.539926510e-02f, 1.333521400e-02f, 1.154781971e-02f, 9.999999776e-03f, 8.659643121e-03f, 7.498942316e-03f, 6.493816152e-03f, 5.623413250e-03f, 4.869675264e-03f, 4.216964822e-03f, 3.651741194e-03f, 3.162277630e-03f, 2.738419687e-03f, 2.371373819e-03f, 2.053525066e-03f, 1.778279431e-03f, 1.539926510e-03f, 1.333521446e-03f, 1.154782018e-03f, 1.000000047e-03f, 8.659643354e-04f, 7.498941850e-04f, 6.493816036e-04f, 5.623413017e-04f, 4.869675322e-04f, 4.216965172e-04f, 3.651741135e-04f, 3.162277571e-04f, 2.738419571e-04f, 2.371373703e-04f, 2.053525095e-04f, 1.778279402e-04f, 1.539926598e-04f, 1.333521504e-04f, 1.154782003e-04f};

__device__ __forceinline__ void sincos_acc(float ang, float& s_out, float& c_out) {
    const double x = (double)ang;
    const double k = rint(x * 0.63661977236758134308);
    double r = fma(-k, 1.57079632679489655800e+00, x); r = fma(-k, 6.12323399573676603587e-17, r);
    const double r2 = r * r;
    double sp = -1.0 / 6227020800.0; sp = fma(sp, r2, 1.0 / 39916800.0); sp = fma(sp, r2, -1.0 / 362880.0); sp = fma(sp, r2, 1.0 / 5040.0); sp = fma(sp, r2, -1.0 / 120.0); sp = fma(sp, r2, 1.0 / 6.0);
    const double sn = fma(-sp * r2, r, r);
    double cp = -1.0 / 87178291200.0; cp = fma(cp, r2, 1.0 / 479001600.0); cp = fma(cp, r2, -1.0 / 3628800.0); cp = fma(cp, r2, 1.0 / 40320.0); cp = fma(cp, r2, -1.0 / 720.0); cp = fma(cp, r2, 1.0 / 24.0); cp = fma(cp, r2, -0.5);
    const double cs = fma(cp, r2, 1.0);
    const int q = ((int)k) & 3;
    const double s = (q == 0) ? sn : (q == 1) ? cs : (q == 2) ? -sn : -cs;
    const double c = (q == 0) ? cs : (q == 1) ? -sn : (q == 2) ? -cs : sn;
    s_out = (float)s; c_out = (float)c;
}

__device__ __forceinline__ void row_to_bf16_ssq(Frame& F, const float* xrow, bf16* orow, float* ssq_out, int np, int ldp) {
    const f32x4* xr = (const f32x4*)xrow + F.lane; float s = 0.f;
#pragma unroll
    for (int j = 0; j < D / 256; ++j) { const f32x4 v = xr[64 * j]; s += (v[0] * v[0] + v[1] * v[1]) + (v[2] * v[2] + v[3] * v[3]); storeA4(orow, D, 256 * j + 4 * F.lane, v); }
    s = wave_sum(s); if (F.lane < np) ssq_out[(size_t)F.lane * ldp] = (F.lane == 0) ? s : 0.f;
}

__device__ __forceinline__ void ph_prologue(Frame& F) {
    const int gw = F.bid * 8 + F.wave, NGW = F.G * 8, gt = F.bid * 512 + F.tid, NGT = F.G * 512;
    float* cosT = WSP(float, WS_COS); float* sinT = WSP(float, WS_SIN);
    for (int i = gt; i < T * 64; i += NGT) { const int pos = i >> 6, fi = i & 63; const float ang = (float)pos * c_invf[fi]; float s, c; sincos_acc(ang, s, c); cosT[i] = c; sinT[i] = s; }
    const float* lg = INP(5); float* lb = WSP(float, WS_LB);
    for (int j = gt; j < 512; j += NGT) { const float a0 = lg[j], a1 = lg[512 + j], a2 = lg[1024 + j], a3 = lg[1536 + j]; const float mx = fmaxf(fmaxf(a0, a1), fmaxf(a2, a3));
        const float e0 = EXPF(a0 - mx), e1 = EXPF(a1 - mx), e2 = EXPF(a2 - mx), e3 = EXPF(a3 - mx), inv = 1.0f / (((e0 + e1) + e2) + e3);
        const float p0 = e0 * inv, p1 = e1 * inv, p2 = e2 * inv, p3 = e3 * inv;
        lb[j] = p0 - p0; lb[512 + j] = (p0 + p1) - p0; lb[1024 + j] = ((p0 + p1) + p2) - p0; lb[1536 + j] = (((p0 + p1) + p2) + p3) - p0; }
    for (int m = gw; m < T; m += NGW) row_to_bf16_ssq(F, INP(0) + (size_t)m * D, WSP(bf16, WS_A0) + (size_t)m * (KS * D), WSP(float, WS_SSQA) + m, 32, T);
    for (int m = gw; m < MEM; m += NGW) row_to_bf16_ssq(F, INP(1) + (size_t)m * D, WSP(bf16, WS_MEMB) + (size_t)m * (KS * D), WSP(float, WS_SSQM) + m, 1, 0);
}

template <bool ZMAP, bool HSL = false>
__device__ __forceinline__ void wconv_item(const float* W, int K, int ldw, const float* gain, bf16* WT, LAS float* scr, int item, int nblk, int lane) {
    const int kb = item / nblk, nb = item % nblk, k0 = 64 * kb, n0 = 64 * nb;
    const int c4 = 4 * (lane & 15), rr = lane >> 4;
    const int nsrc = ZMAP ? zcol_src(n0 + c4) : (n0 + c4);
    f32x4 v[16];
#pragma unroll
    for (int i = 0; i < 16; ++i) v[i] = (nsrc >= 0) ? __builtin_nontemporal_load((const f32x4*)(W + (size_t)(k0 + 4 * i + rr) * ldw + nsrc)) : (f32x4){0.f, 0.f, 0.f, 0.f};
#pragma unroll
    for (int i = 0; i < 16; ++i) { const int kk = 4 * i + rr; const float gk = gain ? gain[k0 + kk] : 1.0f; LAS float* d = scr + kk * 65 + c4; d[0] = v[i][0] * gk; d[1] = v[i][1] * gk; d[2] = v[i][2] * gk; d[3] = v[i][3] * gk; }
    LDS_WAIT(); asm volatile("" ::: "memory");
    const int c = lane & 7;
#pragma unroll
    for (int j = 0; j < 8; ++j) { const int n = (lane >> 3) + 8 * j; const LAS float* s = scr + (8 * c) * 65 + n;
        float x[8];
#pragma unroll
        for (int q = 0; q < 8; ++q) x[q] = s[q * 65];
        v4u o; o.x = pk2(x[0], x[1]); o.y = pk2(x[2], x[3]); o.z = pk2(x[4], x[5]); o.w = pk2(x[6], x[7]);
        bf16* dst = HSL ? WT + ((size_t)(k0 >> 9) * (size_t)(nblk * 64) + (n0 + n)) * 512 + (k0 & 511) + 8 * c : WT + (size_t)(n0 + n) * (KS * K) + k0 + 8 * c;
        __builtin_nontemporal_store(o, (v4u*)dst);
#if KS == 3
        v4u l; l.x = pk2(lo_of(x[0]), lo_of(x[1])); l.y = pk2(lo_of(x[2]), lo_of(x[3])); l.z = pk2(lo_of(x[4]), lo_of(x[5])); l.w = pk2(lo_of(x[6]), lo_of(x[7]));
        *(v4u*)(dst + K) = l; *(v4u*)(dst + 2 * K) = o;
#endif
    }
    LDS_WAIT(); asm volatile("" ::: "memory");
}
constexpr int WC_I_IN = (D / 64) * (NIN / 64), WC_I_DD = (D / 64) * (D / 64), WC_I_1 = (D / 64) * (DFF / 64), WC_I_2 = (DFF / 64) * (D / 64);
constexpr int WC_NT = WC_I_IN + 5 * WC_I_DD + WC_I_1 + WC_I_2, WC_NALL = WC_NT + 2048 + NIN / 256;
constexpr int K4_PER = K4PER_, K4_CONV = 128 * K4_PER;
constexpr int K1_PER = 40, K1_CONV = 140 * K1_PER;
__device__ __forceinline__ void wcf_item(Frame& F, int L, size_t wo, int item);
constexpr int WC_DEF_LO = WC_I_IN + 5 * WC_I_DD, WC_DEF_N = WC_I_1 + WC_I_2;
__device__ __forceinline__ void ph_wconv(Frame& F, int L, size_t wo, int lo, int hi, int skip_lo = 1 << 30, int skip_len = 0, int w_lo = 0) {
    LAS float* scr = (LAS float*)(F.lds + F.wave * WAVE_SCR);
    const float* w_in = INP(3) + (size_t)L * D * DIN; const float* g_mix = INP(2) + L * D;
    const float* w_out = INP(13) + (size_t)L * D * D;
    const float* wq = INP(16) + (size_t)L * D * D; const float* wk = INP(17) + (size_t)L * D * D; const float* wv = INP(18) + (size_t)L * D * D; const float* wo_ = INP(19) + (size_t)L * D * D;
    const float* g_xa = INP(14) + L * D; const float* g_mem = INP(15) + L * D; const float* g_mlp = INP(22) + L * D;
    const float* w1 = INP(23) + (size_t)L * D * DFF; const float* w2 = INP(24) + (size_t)L * DFF * D;
    if (F.wave < w_lo) return;
    for (int it = lo + (F.wave - w_lo); it < hi; it += 8 - w_lo) {
        int r = it + (it >= skip_lo ? skip_len : 0);
        if (r < WC_I_IN) { wconv_item<true>(w_in, D, DIN, g_mix, WSO(bf16, WS_WIN, wo), scr, r, NIN / 64, F.lane); continue; } r -= WC_I_IN;
        if (r < WC_I_DD) { wconv_item<false>(w_out, D, D, nullptr, WSO(bf16, WS_WOUT, wo), scr, r, D / 64, F.lane); continue; } r -= WC_I_DD;
        if (r < WC_I_DD) { wconv_item<false>(wq, D, D, g_xa, WSO(bf16, WS_WQ, wo), scr, r, D / 64, F.lane); continue; } r -= WC_I_DD;
        if (r < WC_I_DD) { wconv_item<false, XFUSE != 0>(wo_, D, D, nullptr, WSO(bf16, WS_WO, wo), scr, r, D / 64, F.lane); continue; } r -= WC_I_DD;
        if (r < WC_I_DD) { wconv_item<false>(wk, D, D, g_mem, WSO(bf16, WS_WKV, wo), scr, r, D / 64, F.lane); continue; } r -= WC_I_DD;
        if (r < WC_I_DD) { wconv_item<false>(wv, D, D, g_mem, WSO(bf16, WS_WKV, wo) + (size_t)D * (KS * D), scr, r, D / 64, F.lane); continue; } r -= WC_I_DD;
        if (r < WC_I_1) { wconv_item<false>(w1, D, DFF, g_mlp, WSO(bf16, WS_W1, wo), scr, r, DFF / 64, F.lane); continue; } r -= WC_I_1;
        if (r < WC_I_2) { wconv_item<false>(w2, DFF, D, nullptr, WSO(bf16, WS_W2, wo), scr, r, D / 64, F.lane); continue; } r -= WC_I_2;
        if (r < 2048) { wcf_item(F, L, wo, r); continue; } r -= 2048;
        { float* bp = WSO(float, WS_BPERM, wo); const float* b_in = INP(4) + (size_t)L * DIN;
          for (int j = 256 * r + F.lane; j < 256 * r + 256; j += 64) { const int s = zcol_src(j); bp[j] = (s >= 0) ? b_in[s] : 0.f; } }
    }
}

__device__ __forceinline__ void normrope_head(const float* src, const float* gain, const float* cosr, const float* sinr, float& o1, float& o2, int lane) {
    const float x1 = src[lane], x2 = src[lane + 64];
    const float ss = wave_sum(x1 * x1 + x2 * x2);
    const float rs = 1.0f / sqrtf(ss * (1.0f / 128.0f) + EPS);
    const float y1 = x1 * rs * gain[lane], y2 = x2 * rs * gain[lane + 64];
    const float c = cosr[lane], s = sinr[lane];
    o1 = y1 * c - y2 * s; o2 = y2 * c + y1 * s;
}
__device__ __forceinline__ int swap23_(int r) { return (r & ~12) | ((r & 4) << 1) | ((r & 8) >> 1); }
__device__ __forceinline__ size_t kf_index_(int g, int t, int d) { return ((size_t)(g * 256 + (t >> 5)) * 4096) + (d >> 4) * 512 + (swap23_(t & 31) + 32 * ((d >> 3) & 1)) * 8 + (d & 7); }
__device__ __forceinline__ void ph_prep(Frame& F, int L, int w_lo) {
    if (F.wave < w_lo) return;
    const int gw = F.bid * (8 - w_lo) + (F.wave - w_lo), NGW = F.G * (8 - w_lo), lane = F.lane;
    const float* z = WSP(float, WS_Z);
    const float* qg = INP(7) + L * 128; const float* kg = INP(8) + L * 3 * 128; const float* cw = INP(11) + (size_t)L * 4 * 1024;
    const float* cosT = WSP(float, WS_COS); const float* sinT = WSP(float, WS_SIN);
#if ORACLE_ATTN
    float* nsq = WSP(float, WS_NSQ); float* nks = WSP(float, WS_NKS); float* nkw = WSP(float, WS_NKW);
#endif
    float* mlq = WSP(float, WS_MLQ); float* mlk = WSP(float, WS_MLK);
    const float qscale = 0.08838834764831845f;
    bf16* qn = WSP(bf16, WS_QN); bf16* ksf = WSP(bf16, WS_KSF); bf16* kwf = WSP(bf16, WS_KWF);
    for (int t = gw; t < T; t += NGW) {
        const float* zr = z + (size_t)t * NIN; const float c = cosT[t * 64 + lane], s = sinT[t * 64 + lane];
        float x1[12], x2[12], ss[12];
#pragma unroll
        for (int i = 0; i < 12; ++i) { const int col = (i < 8) ? ZC_NSQ + i * 128 : (i < 10) ? ZC_NKS + (i - 8) * 128 : ZC_NKW + (i - 10) * 128; x1[i] = zr[col + lane]; x2[i] = zr[col + lane + 64]; ss[i] = x1[i] * x1[i] + x2[i] * x2[i]; }
#pragma unroll
        for (int i = 0; i < 12; ++i) ss[i] += sxor<1>(ss[i]);
#pragma unroll
        for (int i = 0; i < 12; ++i) ss[i] += sxor<2>(ss[i]);
#pragma unroll
        for (int i = 0; i < 12; ++i) ss[i] += sxor<4>(ss[i]);
#pragma unroll
        for (int i = 0; i < 12; ++i) ss[i] += sxor<8>(ss[i]);
#pragma unroll
        for (int i = 0; i < 12; ++i) ss[i] += sxor<16>(ss[i]);
#pragma unroll
        for (int i = 0; i < 12; ++i) ss[i] = half_sum(ss[i]);
#pragma unroll
        for (int i = 0; i < 12; ++i) { const float* gn = (i < 8) ? qg : (i < 10) ? kg + 128 : kg + 256; const float rs = 1.0f / sqrtf(ss[i] * (1.0f / 128.0f) + EPS);
            const float y1 = x1[i] * rs * gn[lane], y2 = x2[i] * rs * gn[lane + 64]; const float o1 = y1 * c - y2 * s, o2 = y2 * c + y1 * s;
            if (i < 8) { qn[(size_t)t * 1024 + i * 128 + lane] = (bf16)f2bf(o1 * (qscale * 1.4426950408889634f)); qn[(size_t)t * 1024 + i * 128 + lane + 64] = (bf16)f2bf(o2 * (qscale * 1.4426950408889634f));
#if ORACLE_ATTN
                nsq[(size_t)t * 1024 + i * 128 + lane] = o1 * qscale; nsq[(size_t)t * 1024 + i * 128 + lane + 64] = o2 * qscale;
#endif
            } else { bf16* kf = (i < 10) ? ksf : kwf; const int hh = (i - 8) & 1; kf[kf_index_(hh, t, lane)] = (bf16)f2bf(o1); kf[kf_index_(hh, t, lane + 64)] = (bf16)f2bf(o2);
#if ORACLE_ATTN
                float* kn = (i < 10) ? nks : nkw; kn[(size_t)t * 256 + hh * 128 + lane] = o1; kn[(size_t)t * 256 + hh * 128 + lane + 64] = o2;
#endif
            } }
#if ORACLE_MIX
        for (int i = 0; i < 16; ++i) { const int ch = lane + 64 * i; const int zc = (ch < 512) ? (ZC_MLQ + ch) : (ZC_MLK + ch - 512); float a = 0.f;
#pragma unroll
            for (int j = 0; j < 4; ++j) { const int tt = t - 3 + j; if (tt >= 0) a += cw[j * 1024 + ch] * z[(size_t)tt * NIN + zc]; }
            a = siluf_(a); if (ch < 512) mlq[(size_t)t * 512 + ch] = a * qscale; else mlk[(size_t)t * 512 + ch - 512] = a; }
#endif
    }
    { bf16* vsf = WSP(bf16, WS_VSF); bf16* vwf = WSP(bf16, WS_VWF);
      for (int tg8 = gw; tg8 < T / 8; tg8 += NGW) { const int t0 = 8 * tg8;
#pragma unroll
          for (int which = 0; which < 2; ++which)
#pragma unroll
              for (int g = 0; g < 2; ++g)
#pragma unroll
                  for (int dd = 0; dd < 2; ++dd) { const int d = lane + 64 * dd; const float* src = z + (size_t)t0 * NIN + (which ? ZC_NVW : ZC_NVS) + g * 128 + d; float v[8];
#pragma unroll
                      for (int j = 0; j < 8; ++j) v[j] = src[(size_t)j * NIN];
                      v4u o; o.x = pk2(v[0], v[1]); o.y = pk2(v[2], v[3]); o.z = pk2(v[4], v[5]); o.w = pk2(v[6], v[7]);
                      const size_t idx = ((size_t)(g * 256 + (t0 >> 5)) * 4096) + ((d >> 5) * 2 + ((t0 & 31) >> 4)) * 512 + ((d & 31) + 32 * ((t0 >> 3) & 1)) * 8;
                      *(v4u*)((which ? vwf : vsf) + idx) = o; } } }
    const float* kvx = WSP(float, WS_KVX); const float* xkg = INP(21) + L * 512; const float* xqg = INP(20) + L * 512; bf16* kxf = WSP(bf16, WS_KXF);
#if ORACLE_ATTN
    float* kxn = WSP(float, WS_KXN);
#endif
    for (int it = gw; it < MEM * 4; it += NGW) { const int m = it >> 2, h = it & 3; const float* src = kvx + (size_t)m * (2 * D) + h * 512; float v[8]; float ss = 0.f;
#pragma unroll
        for (int j = 0; j < 8; ++j) { v[j] = src[lane + 64 * j]; ss += v[j] * v[j]; }
        ss = wave_sum(ss); const float rs = 1.0f / sqrtf(ss * (1.0f / 512.0f) + EPS);
#pragma unroll
        for (int j = 0; j < 8; ++j) { const int d = lane + 64 * j; const float y = v[j] * rs * xkg[d]; const float yq = y * xqg[d] * (0.04419417382415922f * 1.4426950408889634f);
#if ORACLE_ATTN
            kxn[((size_t)h * MEM + m) * 512 + d] = y;
#endif
            kxf[((size_t)h * MEM + m) * 512 + d] = (bf16)f2bf(yq); } }
#if XFUSE
    { bf16* vxr = WSP(bf16, WS_VXF);
      for (int it = gw; it < MEM * 4; it += NGW) { const int m = it >> 2, h = it & 3; const float* src = kvx + (size_t)m * (2 * D) + D + h * 512 + 8 * lane;
          const f32x4 a = *(const f32x4*)src, b2 = *(const f32x4*)(src + 4);
          v4u o; o.x = pk2(a[0], a[1]); o.y = pk2(a[2], a[3]); o.z = pk2(b2[0], b2[1]); o.w = pk2(b2[2], b2[3]);
          *(v4u*)(vxr + ((size_t)h * MEM + m) * 512 + 8 * lane) = o; } }
#else
    { bf16* vxf = WSP(bf16, WS_VXF);
      for (int it = gw; it < (MEM / 8) * 4; it += NGW) { const int m0 = 8 * (it >> 2), h = it & 3;
#pragma unroll
          for (int dd = 0; dd < 8; ++dd) { const int d = lane + 64 * dd; const float* src = kvx + (size_t)m0 * (2 * D) + D + h * 512 + d; float v[8];
#pragma unroll
              for (int j = 0; j < 8; ++j) v[j] = src[(size_t)j * (2 * D)];
              v4u o; o.x = pk2(v[0], v[1]); o.y = pk2(v[2], v[3]); o.z = pk2(v[4], v[5]); o.w = pk2(v[6], v[7]);
              *(v4u*)(vxf + ((size_t)h * 512 + d) * MEM + m0) = o; } } }
#endif
}
constexpr int HP = 129;
__device__ __forceinline__ void hg_gates(Frame& F, int L, int c, int h, LAS float* B, LAS float* KY) {
    const float* z = WSP(float, WS_Z); const float* lb = WSP(float, WS_LB) + L * 512 + h * 128;
    for (int i = F.tid; i < 64 * 128; i += 512) { const int s = i >> 7, d = i & 127; const float zf = z[(size_t)(64 * c + s) * NIN + ZC_HGF + h * 128 + d]; const float l = lb[d];
        const float e = EXPF(-fabsf(zf)); const float sp = (zf >= 0.f) ? 1.0f / (1.0f + e) : e / (1.0f + e);
        const float sn = (zf >= 0.f) ? e / (1.0f + e) : 1.0f / (1.0f + e);
        const float forget = l + (1.0f - l) * sp;
        B[s * HP + d] = LOGF(fmaxf(forget, 1e-20f)); KY[s * HP + d] = (1.0f - l) * sn; }
    __syncthreads();
    float offs[2];
    for (int k = 0; k < 2; ++k) { const int i = F.tid + 512 * k, d = i & 127, s0 = (i >> 7) * 8; float a = 0.f;
#pragma unroll
        for (int j = 0; j < 8; ++j) { a += B[(s0 + j) * HP + d]; B[(s0 + j) * HP + d] = a; } }
    __syncthreads();
    for (int k = 0; k < 2; ++k) { const int i = F.tid + 512 * k, d = i & 127, ch = i >> 7; float off = 0.f;
        for (int c2 = 0; c2 < ch; ++c2) off += B[(8 * c2 + 7) * HP + d];
        offs[k] = off; }
    __syncthreads();
    for (int k = 0; k < 2; ++k) { const int i = F.tid + 512 * k, d = i & 127, s0 = (i >> 7) * 8;
#pragma unroll
        for (int j = 0; j < 8; ++j) B[(s0 + j) * HP + d] += offs[k]; }
    __syncthreads();
}
__device__ __forceinline__ void hg_summary_item(Frame& F, int L, int c, int h) {
    LAS float* B = (LAS float*)F.lds; LAS float* KY = B + 64 * HP; LAS float* V = KY + 64 * HP;
    const float* z = WSP(float, WS_Z);
    hg_gates(F, L, c, h, B, KY);
    for (int i = F.tid; i < 64 * 128; i += 512) { const int s = i >> 7, d = i & 127; KY[s * HP + d] *= EXPF(B[63 * HP + d] - B[s * HP + d]); V[s * HP + d] = z[(size_t)(64 * c + s) * NIN + ZC_HGI + h * 128 + d]; }
    if (F.tid < 128) WSP(float, WS_HGDEC)[(c * 4 + h) * 128 + F.tid] = EXPF(B[63 * HP + F.tid]);
    __syncthreads();
    const int e = F.tid & 127, dg = F.tid >> 7; float acc[32];
#pragma unroll
    for (int j = 0; j < 32; ++j) acc[j] = 0.f;
    for (int s = 0; s < 64; ++s) { const float v = V[s * HP + e];
#pragma unroll
        for (int j = 0; j < 32; ++j) acc[j] += KY[s * HP + dg * 32 + j] * v; }
    float* U = WSP(float, WS_HGU) + (size_t)(c * 4 + h) * 16384;
#pragma unroll
    for (int j = 0; j < 32; ++j) U[(dg * 32 + j) * 128 + e] = acc[j];
    __syncthreads();
}
template <bool SILU>
__device__ __forceinline__ void finish_rows(Frame& F, LAS float* O, const float* gain, const float* gate_src, int gate_col, int ycol, int c) {
    bf16* y = WSP(bf16, WS_A1);
    for (int rr = 0; rr < 8; ++rr) { const int t = F.wave * 8 + rr; const float o1 = O[t * HP + F.lane], o2 = O[t * HP + F.lane + 64];
        const float ss = wave_sum(o1 * o1 + o2 * o2); const float rs = 1.0f / sqrtf(ss * (1.0f / 128.0f) + EPS);
        const float* gr = gate_src + (size_t)(64 * c + t) * NIN + gate_col; const float g1 = gr[F.lane], g2 = gr[F.lane + 64];
        const float a1 = SILU ? siluf_(g1) : sigm(g1), a2 = SILU ? siluf_(g2) : sigm(g2);
        bf16* yr = y + (size_t)(64 * c + t) * (KS * D);
        storeA1(yr, D, ycol + F.lane, o1 * rs * gain[F.lane] * a1); storeA1(yr, D, ycol + F.lane + 64, o2 * rs * gain[F.lane + 64] * a2); }
}
__device__ __forceinline__ void hg_output_item(Frame& F, int L, int c, int h) {
    LAS float* B = (LAS float*)F.lds; LAS float* KY = B + 64 * HP; LAS float* Q = KY + 64 * HP; LAS float* SC = Q + 64 * HP;
    const float* z = WSP(float, WS_Z);
    hg_gates(F, L, c, h, B, KY);
    for (int i = F.tid; i < 64 * 128; i += 512) { const int s = i >> 7, d = i & 127; Q[s * HP + d] = z[(size_t)(64 * c + s) * NIN + ZC_HGQ + h * 128 + d]; }
    __syncthreads();
    for (int p = F.tid; p < 4096; p += 512) { const int t = p >> 6, s = p & 63; float a = 0.f;
        if (s <= t) { for (int d = 0; d < 128; ++d) a += Q[t * HP + d] * KY[s * HP + d] * EXPF(B[t * HP + d] - B[s * HP + d]); }
        SC[t * 65 + s] = a; }
    __syncthreads();
    for (int i = F.tid; i < 64 * 128; i += 512) { const int s = i >> 7, d = i & 127; Q[s * HP + d] *= EXPF(B[s * HP + d]); }
    __syncthreads();
    const int e = F.tid & 127, tg = F.tid >> 7; float acc[16];
#pragma unroll
    for (int j = 0; j < 16; ++j) acc[j] = 0.f;
    for (int s = 0; s < 64; ++s) { const float v = z[(size_t)(64 * c + s) * NIN + ZC_HGI + h * 128 + e];
#pragma unroll
        for (int j = 0; j < 16; ++j) acc[j] += SC[(tg * 16 + j) * 65 + s] * v; }
    const float* S = WSP(float, WS_HGS) + (size_t)(c * 4 + h) * 16384;
    for (int d = 0; d < 128; ++d) { const float sv = S[d * 128 + e];
#pragma unroll
        for (int j = 0; j < 16; ++j) acc[j] += Q[(tg * 16 + j) * HP + d] * sv; }
    __syncthreads();
#pragma unroll
    for (int j = 0; j < 16; ++j) KY[(tg * 16 + j) * HP + e] = acc[j];
    __syncthreads();
    finish_rows<true>(F, KY, INP(6) + L * 512 + h * 128, z, ZC_HGG + h * 128, h * 128, c);
    __syncthreads();
}

__device__ __forceinline__ void ml_gates(Frame& F, int c, int h, LAS float* BL, LAS float* LI) {
    const float* z = WSP(float, WS_Z);
    if (F.tid < 64) { const float f = z[(size_t)(64 * c + F.tid) * NIN + ZC_MLF + h]; BL[F.tid] = fminf(f, 0.f) - log1pf(EXPF(-fabsf(f))); LI[F.tid] = z[(size_t)(64 * c + F.tid) * NIN + ZC_MLI + h]; }
    __syncthreads();
    if (F.tid < 64) { float a = 0.f; for (int s = 0; s < 64; ++s) { const float v = BL[s]; a += (s <= F.tid) ? v : 0.f; } LDS_WAIT(); asm volatile("" ::: "memory"); BL[F.tid] = a; }
    __syncthreads();
}
__device__ __forceinline__ void ml_summary_item(Frame& F, int c, int h) {
    LAS float* KW = (LAS float*)F.lds; LAS float* V = KW + 64 * HP; LAS float* BL = V + 64 * HP; LAS float* LI = BL + 64; LAS float* WS_ = LI + 64;
    const float* z = WSP(float, WS_Z); const float* mlk = WSP(float, WS_MLK);
    ml_gates(F, c, h, BL, LI);
    float mloc = -3.0e38f; for (int s = 0; s < 64; ++s) mloc = fmaxf(mloc, BL[63] - BL[s] + LI[s]);
    if (F.tid < 64) WS_[F.tid] = EXPF(BL[63] - BL[F.tid] + LI[F.tid] - mloc);
    __syncthreads();
    for (int i = F.tid; i < 64 * 128; i += 512) { const int s = i >> 7, d = i & 127; KW[s * HP + d] = mlk[(size_t)(64 * c + s) * 512 + h * 128 + d] * WS_[s]; V[s * HP + d] = z[(size_t)(64 * c + s) * NIN + ZC_MLV + h * 128 + d]; }
    float* msc = WSP(float, WS_MLSC);
    if (F.tid == 0) { msc[c * 4 + h] = mloc; msc[NCH * 4 + c * 4 + h] = BL[63]; }
    __syncthreads();
    const int e = F.tid & 127, dg = F.tid >> 7; float acc[32];
#pragma unroll
    for (int j = 0; j < 32; ++j) acc[j] = 0.f;
    for (int s = 0; s < 64; ++s) { const float v = V[s * HP + e];
#pragma unroll
        for (int j = 0; j < 32; ++j) acc[j] += KW[s * HP + dg * 32 + j] * v; }
    float* U = WSP(float, WS_MLU) + (size_t)(c * 4 + h) * 16384;
#pragma unroll
    for (int j = 0; j < 32; ++j) U[(dg * 32 + j) * 128 + e] = acc[j];
    if (F.tid < 128) { float a = 0.f; for (int s = 0; s < 64; ++s) a += KW[s * HP + F.tid]; WSP(float, WS_MLNL)[(c * 4 + h) * 128 + F.tid] = a; }
    __syncthreads();
}
__device__ __forceinline__ void ml_output_item(Frame& F, int L, int c, int h) {
    LAS float* Q = (LAS float*)F.lds; LAS float* KK = Q + 64 * HP; LAS float* SC = KK + 64 * HP; LAS float* BL = SC + 64 * 65; LAS float* LI = BL + 64; LAS float* MT = LI + 64; LAS float* WI = MT + 64; LAS float* QN = WI + 64;
    const float* z = WSP(float, WS_Z); const float* mlq = WSP(float, WS_MLQ); const float* mlk = WSP(float, WS_MLK);
    ml_gates(F, c, h, BL, LI);
    const float mprev = WSP(float, WS_MLSC)[2 * NCH * 4 + c * 4 + h];
    for (int i = F.tid; i < 64 * 128; i += 512) { const int s = i >> 7, d = i & 127; Q[s * HP + d] = mlq[(size_t)(64 * c + s) * 512 + h * 128 + d]; KK[s * HP + d] = mlk[(size_t)(64 * c + s) * 512 + h * 128 + d]; }
    if (F.tid < 64) { const int t = F.tid; const float inter = BL[t] + mprev; float mt = inter; for (int s = 0; s <= t; ++s) mt = fmaxf(mt, BL[t] - BL[s] + LI[s]); MT[t] = mt; WI[t] = EXPF(inter - mt); }
    __syncthreads();
    for (int p = F.tid; p < 4096; p += 512) { const int t = p >> 6, s = p & 63; float a = 0.f;
        if (s <= t) { for (int d = 0; d < 128; ++d) a += Q[t * HP + d] * KK[s * HP + d]; a *= EXPF(BL[t] - BL[s] + LI[s] - MT[t]); }
        SC[t * 65 + s] = a; }
    __syncthreads();
    if (F.tid < 64) { const int t = F.tid; const float* nst = WSP(float, WS_MLN) + (c * 4 + h) * 128; float a = 0.f; for (int d = 0; d < 128; ++d) a += Q[t * HP + d] * nst[d]; a *= WI[t];
        float r = 0.f; for (int s = 0; s < 64; ++s) r += SC[t * 65 + s]; QN[t] = a + r; }
    const int e = F.tid & 127, tg = F.tid >> 7; float acc[16];
#pragma unroll
    for (int j = 0; j < 16; ++j) acc[j] = 0.f;
    const float* Cst = WSP(float, WS_MLS) + (size_t)(c * 4 + h) * 16384;
    for (int d = 0; d < 128; ++d) { const float sv = Cst[d * 128 + e];
#pragma unroll
        for (int j = 0; j < 16; ++j) acc[j] += Q[(tg * 16 + j) * HP + d] * sv; }
#pragma unroll
    for (int j = 0; j < 16; ++j) acc[j] *= WI[tg * 16 + j];
    for (int s = 0; s < 64; ++s) { const float v = z[(size_t)(64 * c + s) * NIN + ZC_MLV + h * 128 + e];
#pragma unroll
        for (int j = 0; j < 16; ++j) acc[j] += SC[(tg * 16 + j) * 65 + s] * v; }
    __syncthreads();
#pragma unroll
    for (int j = 0; j < 16; ++j) { const int t = tg * 16 + j; KK[t * HP + e] = acc[j] / fmaxf(fabsf(QN[t]), EXPF(-MT[t])); }
    __syncthreads();
    finish_rows<false>(F, KK, INP(12) + L * 512 + h * 128, z, ZC_MLO + h * 128, 1536 + h * 128, c);
    __syncthreads();
}

__device__ __forceinline__ void cmp_item(Frame& F, int L, int item) {
    const int which = item & 1, g = (item >> 1) & 1, c0 = (item >> 2) * 8;
    LAS float* A = (LAS float*)F.lds;
    LAS float* PE = A + 144 * HP;
    LAS float* O = PE + 32 * 128;
    const float* z = WSP(float, WS_Z); const int zc = (which ? ZC_NVC : ZC_NKC) + g * 128;
    const float* pe = INP(9) + ((size_t)(L * 2 + which) * 32) * 128; const float* w = INP(10) + ((size_t)(L * 2 + which) * 32) * 128 * 128;
    for (int i = F.tid; i < 144 * 128; i += 512) { const int r = i >> 7, d = i & 127; const int tok = 16 * c0 + r; A[r * HP + d] = (tok < T) ? z[(size_t)tok * NIN + zc + d] : 0.f; }
    for (int i = F.tid; i < 32 * 128; i += 512) PE[i] = pe[i];
    __syncthreads();
    const int e = F.tid & 127, rg = F.tid >> 7;
    float a0 = 0.f, a1 = 0.f;
    for (int l = 0; l < 32; ++l) { const LAS float* r0 = A + (16 * (2 * rg) + l) * HP; const LAS float* r1 = A + (16 * (2 * rg + 1) + l) * HP; const LAS float* pr = PE + l * 128; const float* wl = w + (size_t)l * 16384 + e;
        for (int d = 0; d < 128; ++d) { const float wv = wl[d * 128], p = pr[d]; a0 += (r0[d] + p) * wv; a1 += (r1[d] + p) * wv; } }
    O[(2 * rg) * HP + e] = a0; O[(2 * rg + 1) * HP + e] = a1;
    __syncthreads();
    if (!which) { const int c = c0 + F.wave; const float o1 = O[F.wave * HP + F.lane], o2 = O[F.wave * HP + F.lane + 64];
        const float* kg = INP(8) + L * 384; const float ss = wave_sum(o1 * o1 + o2 * o2); const float rs = 1.0f / sqrtf(ss * (1.0f / 128.0f) + EPS);
        const float y1 = o1 * rs * kg[F.lane], y2 = o2 * rs * kg[F.lane + 64]; const int pos = (c < NCMP) ? 16 * c + 31 : 0; const float cs = WSP(float, WS_COS)[pos * 64 + F.lane], sn = WSP(float, WS_SIN)[pos * 64 + F.lane];
        const float r1 = y1 * cs - y2 * sn, r2 = y2 * cs + y1 * sn;
        bf16* kcf = WSP(bf16, WS_KCF) + (size_t)g * 16 * 4096 + (size_t)(c >> 5) * 4096;
        { const int d = F.lane; kcf[(d >> 4) * 512 + (swap23_(c & 31) + 32 * ((d >> 3) & 1)) * 8 + (d & 7)] = (bf16)f2bf(r1); }
        { const int d = F.lane + 64; kcf[(d >> 4) * 512 + (swap23_(c & 31) + 32 * ((d >> 3) & 1)) * 8 + (d & 7)] = (bf16)f2bf(r2); }
#if ORACLE_ATTN
        if (c < NCMP) { float* dst = WSP(float, WS_KCN) + (size_t)g * 512 * 128; dst[c * 128 + F.lane] = r1; dst[c * 128 + F.lane + 64] = r2; }
#endif
    } else {
        if (F.tid < 128) { const int d = F.tid; float v[8];
#pragma unroll
            for (int j = 0; j < 8; ++j) v[j] = O[j * HP + d];
            v4u o; o.x = pk2(v[0], v[1]); o.y = pk2(v[2], v[3]); o.z = pk2(v[4], v[5]); o.w = pk2(v[6], v[7]);
            *(v4u*)(WSP(bf16, WS_VCF) + (size_t)g * 16 * 4096 + (size_t)(c0 >> 5) * 4096 + ((d >> 5) * 2 + ((c0 & 31) >> 4)) * 512 + ((d & 31) + 32 * ((c0 >> 3) & 1)) * 8) = o; }
#if ORACLE_ATTN
        { const int c = c0 + F.wave; if (c < NCMP) { float* dst = WSP(float, WS_VCN) + (size_t)g * 512 * 128; dst[c * 128 + F.lane] = O[F.wave * HP + F.lane]; dst[c * 128 + F.lane + 64] = O[F.wave * HP + F.lane + 64]; } }
#endif
    }
    __syncthreads();
}

__device__ __forceinline__ void ph_scan(Frame& F) {
    const int gt = F.bid * 512 + F.tid, NGT = F.G * 512;
    const float* msc = WSP(float, WS_MLSC);
    for (int id = gt; id < 131072; id += NGT) { const int i = id & 65535; const int h = i >> 14, de = i & 16383, d = de >> 7;
        if (id < 65536) { const float* U = WSP(float, WS_HGU); float* S = WSP(float, WS_HGS); const float* dec = WSP(float, WS_HGDEC); float st = 0.f;
            for (int c = 0; c < NCH; ++c) { const size_t o = (size_t)(c * 4 + h) * 16384 + de; S[o] = st; st = dec[(c * 4 + h) * 128 + d] * st + U[o]; } }
        else { const float* U = WSP(float, WS_MLU); float* S = WSP(float, WS_MLS); float st = 0.f, m = 0.f;
            for (int c = 0; c < NCH; ++c) { const size_t o = (size_t)(c * 4 + h) * 16384 + de; S[o] = st; const float mloc = msc[c * 4 + h], bend = msc[NCH * 4 + c * 4 + h]; const float mn = fmaxf(bend + m, mloc);
                st = EXPF(bend + m - mn) * st + EXPF(mloc - mn) * U[o]; m = mn; } } }
    for (int i = gt; i < 512; i += NGT) { const int h = i >> 7, d = i & 127; const float* nl = WSP(float, WS_MLNL); float* ns = WSP(float, WS_MLN); float st = 0.f, m = 0.f;
        for (int c = 0; c < NCH; ++c) { const int o = (c * 4 + h) * 128 + d; ns[o] = st; const float mloc = msc[c * 4 + h], bend = msc[NCH * 4 + c * 4 + h]; const float mn = fmaxf(bend + m, mloc);
            st = EXPF(bend + m - mn) * st + EXPF(mloc - mn) * nl[o]; m = mn; } }
    for (int i = gt; i < 4; i += NGT) { float* mp = WSP(float, WS_MLSC) + 2 * NCH * 4; float m = 0.f;
        for (int c = 0; c < NCH; ++c) { mp[c * 4 + i] = m; m = fmaxf(msc[NCH * 4 + c * 4 + i] + m, msc[c * 4 + i]); } }
}
#if ORACLE_ATTN
__device__ __forceinline__ void nsa_scores(const float* kbase, int kstride, int kfirst, int nk, LAS float* QV, LAS float* SCW, int off, int lane) {
    const int sub = lane & 3, slot = lane >> 2;
    for (int p = 0; p < nk; p += 16) { const int i = p + slot; const bool ok = i < nk; const float* row = kbase + (size_t)(kfirst + (ok ? i : 0)) * kstride + 4 * sub;
        float a0 = 0.f, a1 = 0.f, a2 = 0.f, a3 = 0.f;
#pragma unroll 2
        for (int j = 0; j < 8; ++j) { const f32x4 kv = *(const f32x4*)(row + 16 * j); const LAS float* q = QV + 16 * j + 4 * sub;
            const f32x4 q0 = *(const LAS f32x4*)q, q1 = *(const LAS f32x4*)(q + 128), q2 = *(const LAS f32x4*)(q + 256), q3 = *(const LAS f32x4*)(q + 384);
            a0 += kv[0] * q0[0] + kv[1] * q0[1] + kv[2] * q0[2] + kv[3] * q0[3]; a1 += kv[0] * q1[0] + kv[1] * q1[1] + kv[2] * q1[2] + kv[3] * q1[3];
            a2 += kv[0] * q2[0] + kv[1] * q2[1] + kv[2] * q2[2] + kv[3] * q2[3]; a3 += kv[0] * q3[0] + kv[1] * q3[1] + kv[2] * q3[2] + kv[3] * q3[3]; }
        a0 += sxor<1>(a0); a1 += sxor<1>(a1); a2 += sxor<1>(a2); a3 += sxor<1>(a3);
        a0 += sxor<2>(a0); a1 += sxor<2>(a1); a2 += sxor<2>(a2); a3 += sxor<2>(a3);
        if (ok && sub == 0) *(LAS f32x4*)(SCW + (size_t)(off + i) * 4) = (f32x4){a0, a1, a2, a3}; }
}
__device__ __forceinline__ f32x4 nsa_softmax(LAS float* SCW, int n, int lane) {
    f32x4 mx = {-3.0e38f, -3.0e38f, -3.0e38f, -3.0e38f};
    for (int i = lane; i < n; i += 64) { const f32x4 s = *(const LAS f32x4*)(SCW + i * 4); mx[0] = fmaxf(mx[0], s[0]); mx[1] = fmaxf(mx[1], s[1]); mx[2] = fmaxf(mx[2], s[2]); mx[3] = fmaxf(mx[3], s[3]); }
#pragma unroll
    for (int h = 0; h < 4; ++h) mx[h] = wave_max(mx[h]);
    f32x4 sm = {0.f, 0.f, 0.f, 0.f};
    for (int i = lane; i < n; i += 64) { f32x4 s = *(const LAS f32x4*)(SCW + i * 4);
#pragma unroll
        for (int h = 0; h < 4; ++h) { s[h] = EXPF(s[h] - mx[h]); sm[h] += s[h]; }
        *(LAS f32x4*)(SCW + i * 4) = s; }
#pragma unroll
    for (int h = 0; h < 4; ++h) { sm[h] = wave_sum(sm[h]); sm[h] = (n > 0) ? 1.0f / sm[h] : 0.f; }
    LDS_WAIT();
    return sm;
}
__device__ __forceinline__ void nsa_pv(const float* vbase, int vstride, int vfirst, int nk, const LAS float* SCW, int off, f32x2 (&acc)[4], int lane) {
    const float* vp = vbase + (size_t)vfirst * vstride + 2 * lane;
    for (int i = 0; i < nk; ++i) { const f32x4 p = *(const LAS f32x4*)(SCW + (size_t)(off + i) * 4); const f32x2 v = *(const f32x2*)(vp + (size_t)i * vstride);
#pragma unroll
        for (int h = 0; h < 4; ++h) { acc[h][0] += p[h] * v[0]; acc[h][1] += p[h] * v[1]; } }
}
__device__ __forceinline__ void ph_nsa(Frame& F, int L) {
    const int lane = F.lane; LAS float* SCW = (LAS float*)(F.lds + F.wave * WAVE_SCR);
    LAS float* QV = SCW + 4096; LAS float* IMP = QV + 512; LAS int* SEL = (LAS int*)(IMP + 128);
    const float* z = WSP(float, WS_Z); const float* nsq = WSP(float, WS_NSQ); const float* nks = WSP(float, WS_NKS); const float* nkw = WSP(float, WS_NKW);
    bf16* y = WSP(bf16, WS_A1);
    for (int it = F.bid * 8 + F.wave; it < 2 * T; it += F.G * 8) {
        const int t = it >> 1, g = it & 1, cur = t >> 6;
        { const f32x4* qs = (const f32x4*)(nsq + (size_t)t * 1024 + g * 512); *(LAS f32x4*)(QV + 4 * lane) = qs[lane]; *(LAS f32x4*)(QV + 256 + 4 * lane) = qs[64 + lane]; }
        LDS_WAIT();
        f32x4 gate[3];
#pragma unroll
        for (int h = 0; h < 4; ++h)
#pragma unroll
            for (int b = 0; b < 3; ++b) gate[b][h] = sigm(z[(size_t)t * NIN + ZC_GATE + (g * 4 + h) * 3 + b]);
        f32x2 tot[4], acc[4];
#pragma unroll
        for (int h = 0; h < 4; ++h) tot[h] = (f32x2){0.f, 0.f};
        const int ncv = (t >= 31) ? ((t - 31) >> 4) + 1 : 0;
        const float* kcn = WSP(float, WS_KCN) + (size_t)g * 512 * 128; const float* vcn = WSP(float, WS_VCN) + (size_t)g * 512 * 128;
        nsa_scores(kcn, 128, 0, ncv, QV, SCW, 0, lane); LDS_WAIT();
        f32x4 inv = nsa_softmax(SCW, ncv, lane);
#pragma unroll
        for (int h = 0; h < 4; ++h) acc[h] = (f32x2){0.f, 0.f};
        nsa_pv(vcn, 128, 0, ncv, SCW, 0, acc, lane);
#pragma unroll
        for (int h = 0; h < 4; ++h) { tot[h][0] += acc[h][0] * inv[h] * gate[0][h]; tot[h][1] += acc[h][1] * inv[h] * gate[0][h]; }
        float v0, v1;
        { float im[2];
#pragma unroll
          for (int k = 0; k < 2; ++k) { const int s = lane + 64 * k; float a = 0.f;
              for (int c = 4 * s - 1; c <= 4 * s + 3; ++c) if (c >= 0 && c < ncv) { const f32x4 p = *(const LAS f32x4*)(SCW + c * 4); a += ((p[0] * inv[0] + p[1] * inv[1]) + p[2] * inv[2]) + p[3] * inv[3]; }
              im[k] = a; }
          v0 = im[0]; v1 = im[1]; }
        int nsel;
        if (cur < 16) { nsel = cur + 1; if (lane < 16) SEL[lane] = lane; }
        else { nsel = 16;
            { const int s0 = lane, s1 = lane + 64;
              v0 = (s0 > cur) ? -3.0e38f : ((s0 == 0 || s0 == cur || s0 == cur - 1) ? 3.0e38f : v0);
              v1 = (s1 > cur) ? -3.0e38f : ((s1 == cur || s1 == cur - 1) ? 3.0e38f : v1); }
            for (int k = 0; k < 16; ++k) { float bv; int bi; if (v0 >= v1) { bv = v0; bi = lane; } else { bv = v1; bi = lane + 64; }
                wave_argmax(bv, bi);
                if (bi == lane) v0 = -3.0e38f; if (bi == lane + 64) v1 = -3.0e38f;
                if (lane == 0) SEL[k] = bi; } }
        LDS_WAIT();
        int n = 0;
        for (int k = 0; k < nsel; ++k) { const int b = SEL[k]; const int nk = (b == cur) ? (t - 64 * cur + 1) : 64; nsa_scores(nks + g * 128, 256, 64 * b, nk, QV, SCW, n, lane); n += nk; }
        LDS_WAIT();
        inv = nsa_softmax(SCW, n, lane);
#pragma unroll
        for (int h = 0; h < 4; ++h) acc[h] = (f32x2){0.f, 0.f};
        n = 0;
        for (int k = 0; k < nsel; ++k) { const int b = SEL[k]; const int nk = (b == cur) ? (t - 64 * cur + 1) : 64; nsa_pv(z + ZC_NVS + g * 128, NIN, 64 * b, nk, SCW, n, acc, lane); n += nk; }
#pragma unroll
        for (int h = 0; h < 4; ++h) { tot[h][0] += acc[h][0] * inv[h] * gate[1][h]; tot[h][1] += acc[h][1] * inv[h] * gate[1][h]; }
        const int lo = (t >= 511) ? t - 511 : 0; n = t - lo + 1;
        nsa_scores(nkw + g * 128, 256, lo, n, QV, SCW, 0, lane); LDS_WAIT();
        inv = nsa_softmax(SCW, n, lane);
#pragma unroll
        for (int h = 0; h < 4; ++h) acc[h] = (f32x2){0.f, 0.f};
        nsa_pv(z + ZC_NVW + g * 128, NIN, lo, n, SCW, 0, acc, lane);
        bf16* yr = y + (size_t)t * (KS * D);
#pragma unroll
        for (int h = 0; h < 4; ++h) { const float o0 = tot[h][0] + acc[h][0] * inv[h] * gate[2][h], o1 = tot[h][1] + acc[h][1] * inv[h] * gate[2][h];
            storeA2(yr, D, 512 + (g * 4 + h) * 128 + 2 * lane, o0, o1); }
    }
}

__device__ __forceinline__ void ph_xattn(Frame& F, int L) {
    const int lane = F.lane; LAS float* QV = (LAS float*)(F.lds + F.wave * WAVE_SCR); LAS float* SC = QV + 512;
    const float* xq = WSP(float, WS_XQ); const float* kxn = WSP(float, WS_KXN); const float* kvx = WSP(float, WS_KVX); const float* qg = INP(20) + L * 512;
    bf16* y = WSP(bf16, WS_A1); const int sub = lane & 3, slot = lane >> 2;
    for (int it = F.bid * 8 + F.wave; it < 4 * T; it += F.G * 8) {
        const int t = it >> 2, h = it & 3;
        { const float* src = xq + (size_t)t * D + h * 512; const f32x4 a = *(const f32x4*)(src + 4 * lane), b = *(const f32x4*)(src + 256 + 4 * lane);
          float ss = (a[0] * a[0] + a[1] * a[1]) + (a[2] * a[2] + a[3] * a[3]) + (b[0] * b[0] + b[1] * b[1]) + (b[2] * b[2] + b[3] * b[3]); ss = wave_sum(ss);
          const float rs = (1.0f / sqrtf(ss * (1.0f / 512.0f) + EPS)) * 0.04419417382415922f;
          const f32x4 g0 = *(const f32x4*)(qg + 4 * lane), g1 = *(const f32x4*)(qg + 256 + 4 * lane);
          *(LAS f32x4*)(QV + 4 * lane) = a * rs * g0; *(LAS f32x4*)(QV + 256 + 4 * lane) = b * rs * g1; }
        LDS_WAIT();
        const float* kb = kxn + (size_t)h * MEM * 512;
        for (int p = 0; p < MEM; p += 16) { const int i = p + slot; const float* row = kb + (size_t)i * 512 + 4 * sub; float a = 0.f;
#pragma unroll 8
            for (int j = 0; j < 32; ++j) { const f32x4 kv = *(const f32x4*)(row + 16 * j); const f32x4 q = *(const LAS f32x4*)(QV + 16 * j + 4 * sub); a += (kv[0] * q[0] + kv[1] * q[1]) + (kv[2] * q[2] + kv[3] * q[3]); }
            a += sxor<1>(a); a += sxor<2>(a);
            if (sub == 0) SC[i] = a; }
        LDS_WAIT();
        float s4[4], mx = -3.0e38f;
#pragma unroll
        for (int k = 0; k < 4; ++k) { s4[k] = SC[lane + 64 * k]; mx = fmaxf(mx, s4[k]); }
        mx = wave_max(mx); float sm = 0.f;
#pragma unroll
        for (int k = 0; k < 4; ++k) { s4[k] = EXPF(s4[k] - mx); sm += s4[k]; }
        sm = wave_sum(sm); const float inv = 1.0f / sm;
#pragma unroll
        for (int k = 0; k < 4; ++k) SC[lane + 64 * k] = s4[k] * inv;
        LDS_WAIT();
        f32x4 o0 = {0.f, 0.f, 0.f, 0.f}, o1 = {0.f, 0.f, 0.f, 0.f};
        const float* vb = kvx + D + h * 512 + 4 * lane;
        for (int m = 0; m < MEM; ++m) { const float p = SC[m]; const f32x4 a = *(const f32x4*)(vb + (size_t)m * (2 * D)), b = *(const f32x4*)(vb + (size_t)m * (2 * D) + 256); o0 += a * p; o1 += b * p; }
        bf16* yr = y + (size_t)t * (KS * D);
        storeA4(yr, D, h * 512 + 4 * lane, o0); storeA4(yr, D, h * 512 + 256 + 4 * lane, o1);
        LDS_WAIT();
    }
}
#endif
typedef short bf16x8 __attribute__((ext_vector_type(8)));
typedef float f32x16 __attribute__((ext_vector_type(16)));
typedef __bf16 bf16x2_t __attribute__((ext_vector_type(2)));
#define MFMA32(a, b, c) __builtin_amdgcn_mfma_f32_32x32x16_bf16((a), (b), (c), 0, 0, 0)
__device__ __forceinline__ unsigned cvtpk(float lo, float hi) { const f32x2 v = {lo, hi}; const bf16x2_t b = __builtin_convertvector(v, bf16x2_t); return __builtin_bit_cast(unsigned, b); }
__device__ __forceinline__ bf16x8 pack8(const f32x16& x, int s) { v4u w; w.x = cvtpk(x[8 * s], x[8 * s + 1]); w.y = cvtpk(x[8 * s + 2], x[8 * s + 3]); w.z = cvtpk(x[8 * s + 4], x[8 * s + 5]); w.w = cvtpk(x[8 * s + 6], x[8 * s + 7]); return __builtin_bit_cast(bf16x8, w); }
__device__ __forceinline__ int swap23(int r) { return (r & ~12) | ((r & 4) << 1) | ((r & 8) >> 1); }
__device__ __forceinline__ size_t kf_index(int g, int t, int d) { return ((size_t)(g * 256 + (t >> 5)) * 4096) + (d >> 4) * 512 + (swap23(t & 31) + 32 * ((d >> 3) & 1)) * 8 + (d & 7); }
__device__ __forceinline__ size_t vf_chunk(int g, int t0, int d) { return ((size_t)(g * 256 + (t0 >> 5)) * 4096) + ((d >> 5) * 2 + ((t0 & 31) >> 4)) * 512 + ((d & 31) + 32 * ((t0 >> 3) & 1)) * 8; }
__device__ __forceinline__ f32x16 zero16() { f32x16 z; for (int i = 0; i < 16; ++i) z[i] = 0.f; return z; }
__device__ __forceinline__ float gain_absmax128(const float* g, int lane) { return wave_max(fmaxf(fabsf(g[lane]), fabsf(g[lane + 64]))); }
constexpr float LOG2E = 1.4426950408889634f;

__device__ __forceinline__ f32x16 st_tile128(const bf16* ktile, const bf16x8 (&qf)[8], int lane) {
    f32x16 s = zero16(); const bf16x8* kp = (const bf16x8*)ktile + lane;
#pragma unroll
    for (int sp = 0; sp < 8; ++sp) s = MFMA32(kp[sp * 64], qf[sp], s);
    return s;
}
__device__ __forceinline__ void pv_tile128(const bf16* vtile, const bf16x8 (&pb)[2], f32x16 (&o)[4], int lane) {
    const bf16x8* vp = (const bf16x8*)vtile + lane;
#pragma unroll
    for (int dt = 0; dt < 4; ++dt)
#pragma unroll
        for (int s = 0; s < 2; ++s) o[dt] = MFMA32(vp[(dt * 2 + s) * 64], pb[s], o[dt]);
}
__device__ __forceinline__ void load_qf128(const bf16* qrow, int h, bf16x8 (&qf)[8]) {
#pragma unroll
    for (int sp = 0; sp < 8; ++sp) qf[sp] = *(const bf16x8*)(qrow + 16 * sp + 8 * h);
}

__device__ __forceinline__ void nsa_wave_item(Frame& F, int L, int tg, int g, LAS float* IMPW) {
    const int lane = F.lane, r = lane & 31, h = lane >> 5, slot = r >> 2, jh = r & 3;
    const int tq = 8 * tg + slot, head = 4 * g + jh, cur = tg >> 3;
    const float gq = gain_absmax128(INP(7) + L * 128, lane); const float* kgn = INP(8) + L * 384;
    const float bc = 11.313708498984761f * LOG2E * 1.02f;
    const float bound_c = bc * gq * gain_absmax128(kgn, lane), bound_s = bc * gq * gain_absmax128(kgn + 128, lane), bound_w = bc * gq * gain_absmax128(kgn + 256, lane);
    bf16x8 qf[8]; load_qf128(WSP(bf16, WS_QN) + (size_t)tq * 1024 + head * 128, h, qf);
    const float* zg = WSP(float, WS_Z) + (size_t)tq * NIN + ZC_GATE + head * 3;
    const float g0 = sigm(zg[0]), g1 = sigm(zg[1]), g2 = sigm(zg[2]);
    f32x16 o[4];
    float* ocr = WSP(float, WS_OC) + (size_t)tq * 1024 + head * 128;
    for (int i = lane; i < 2 * 8 * 129; i += 64) IMPW[i] = 0.f;
    LDS_WAIT();
    { const bf16* kc = WSP(bf16, WS_KCF) + (size_t)g * 16 * 4096; const bf16* vc = WSP(bf16, WS_VCF) + (size_t)g * 16 * 4096;
      const int cmaxq = (tq >= 31) ? ((tq - 31) >> 4) : -1;
      const int tmax = 8 * tg + 7; const int ntile = (tmax >= 31) ? (((tmax - 31) >> 4) >> 5) + 1 : 0;
      float lsum = 0.f;
      for (int kt = 0; kt < ntile; ++kt) { const f32x16 s = st_tile128(kc + (size_t)kt * 4096, qf, lane);
#pragma unroll
          for (int R = 0; R < 16; ++R) { const int c = 32 * kt + 16 * (R >> 3) + 8 * h + (R & 7); lsum += (c <= cmaxq) ? __builtin_amdgcn_exp2f(s[R] - bound_c) : 0.f; } }
      lsum = half_sum(lsum);
      const float inv = (lsum > 0.f) ? 1.0f / lsum : 0.f;
      o[0] = zero16(); o[1] = zero16(); o[2] = zero16(); o[3] = zero16();
      LAS float* imrow = IMPW + (h * 8 + slot) * 129;
      for (int kt = 0; kt < ntile; ++kt) { f32x16 s = st_tile128(kc + (size_t)kt * 4096, qf, lane);
#pragma unroll
          for (int R = 0; R < 16; ++R) { const int c = 32 * kt + 16 * (R >> 3) + 8 * h + (R & 7); s[R] = (c <= cmaxq) ? __builtin_amdgcn_exp2f(s[R] - bound_c) * inv : 0.f; }
#pragma unroll
          for (int s2 = 0; s2 < 2; ++s2) { const int sb = 8 * kt + 4 * s2 + 2 * h;
              float a = (s[8 * s2] + s[8 * s2 + 1]) + (s[8 * s2 + 2] + s[8 * s2 + 3]), b = ((s[8 * s2 + 4] + s[8 * s2 + 5]) + (s[8 * s2 + 6] + s[8 * s2 + 7])) + s[8 * s2 + 3], c7 = s[8 * s2 + 7];
              a += sxor<1>(a); b += sxor<1>(b); c7 += sxor<1>(c7); a += sxor<2>(a); b += sxor<2>(b); c7 += sxor<2>(c7);
              if (jh == 0) { imrow[sb] = a; imrow[sb + 1] = b; imrow[sb + 2] = c7; } }
          bf16x8 pb[2]; pb[0] = pack8(s, 0); pb[1] = pack8(s, 1);
          pv_tile128(vc + (size_t)kt * 4096, pb, o, lane); }
#pragma unroll
      for (int dt = 0; dt < 4; ++dt)
#pragma unroll
          for (int rg = 0; rg < 4; ++rg) { f32x4 v = {o[dt][4 * rg], o[dt][4 * rg + 1], o[dt][4 * rg + 2], o[dt][4 * rg + 3]}; *(f32x4*)(ocr + 32 * dt + 8 * rg + 4 * h) = v * g0; } }
    LDS_WAIT();
    unsigned my[4] = {0u, 0u, 0u, 0u}, un[4] = {0u, 0u, 0u, 0u};
    if (cur < 16) { my[0] = un[0] = (cur == 31) ? 0xffffffffu : ((1u << (cur + 1)) - 1u); }
    else {
        for (int ts = 0; ts < 8; ++ts) { const int s0 = lane, s1 = lane + 64;
            float v0 = IMPW[ts * 129 + s0] + IMPW[(8 + ts) * 129 + s0], v1 = IMPW[ts * 129 + s1] + IMPW[(8 + ts) * 129 + s1];
            v0 = (s0 > cur) ? -3.0e38f : ((s0 == 0 || s0 == cur || s0 == cur - 1) ? 3.0e38f : v0);
            v1 = (s1 > cur) ? -3.0e38f : ((s1 == cur || s1 == cur - 1) ? 3.0e38f : v1);
            for (int k = 0; k < 16; ++k) { float bv; int bi; if (v0 >= v1) { bv = v0; bi = lane; } else { bv = v1; bi = lane + 64; }
                wave_argmax(bv, bi);
                if (bi == lane) v0 = -3.0e38f; if (bi == lane + 64) v1 = -3.0e38f;
                bi = __builtin_amdgcn_readfirstlane(bi);
                const unsigned bit = 1u << (bi & 31); const int wi = bi >> 5; const bool mine = (slot == ts);
#pragma unroll
                for (int q4 = 0; q4 < 4; ++q4) { if (wi == q4) { un[q4] |= bit; if (mine) my[q4] |= bit; } } } } }
    { const bf16* ksf = WSP(bf16, WS_KSF) + (size_t)g * 256 * 4096; const bf16* vsf = WSP(bf16, WS_VSF) + (size_t)g * 256 * 4096;
      o[0] = zero16(); o[1] = zero16(); o[2] = zero16(); o[3] = zero16(); float lsum = 0.f;
#pragma unroll
      for (int q4 = 0; q4 < 4; ++q4) { unsigned um = __builtin_amdgcn_readfirstlane(un[q4]);
          while (um) { const int jb = __builtin_ctz(um); um &= um - 1; const int j = 32 * q4 + jb; const bool sel = (my[q4] >> jb) & 1u;
#pragma unroll 1
              for (int half = 0; half < 2; ++half) { const int kt = 2 * j + half; f32x16 s = st_tile128(ksf + (size_t)kt * 4096, qf, lane);
#pragma unroll
                  for (int R = 0; R < 16; ++R) { const int key = 32 * kt + 16 * (R >> 3) + 8 * h + (R & 7); const float p = (sel && key <= tq) ? __builtin_amdgcn_exp2f(s[R] - bound_s) : 0.f; s[R] = p; lsum += p; }
                  bf16x8 pb[2]; pb[0] = pack8(s, 0); pb[1] = pack8(s, 1);
                  pv_tile128(vsf + (size_t)kt * 4096, pb, o, lane); } } }
      lsum = half_sum(lsum); const float cs = (lsum > 0.f) ? g1 / lsum : 0.f;
#pragma unroll
      for (int dt = 0; dt < 4; ++dt)
#pragma unroll
          for (int rg = 0; rg < 4; ++rg) { f32x4 v = {o[dt][4 * rg], o[dt][4 * rg + 1], o[dt][4 * rg + 2], o[dt][4 * rg + 3]}; f32x4* p = (f32x4*)(ocr + 32 * dt + 8 * rg + 4 * h); *p = *p + v * cs; } }
    { const bf16* kwf = WSP(bf16, WS_KWF) + (size_t)g * 256 * 4096; const bf16* vwf = WSP(bf16, WS_VWF) + (size_t)g * 256 * 4096;
      o[0] = zero16(); o[1] = zero16(); o[2] = zero16(); o[3] = zero16(); float lsum = 0.f;
      const int tmin = 8 * tg, tmax = 8 * tg + 7; const int kt0 = (tmin >= 511) ? ((tmin - 511) >> 5) : 0, ktl = tmax >> 5;
      for (int kt = kt0; kt <= ktl; ++kt) { f32x16 s = st_tile128(kwf + (size_t)kt * 4096, qf, lane);
#pragma unroll
          for (int R = 0; R < 16; ++R) { const int key = 32 * kt + 16 * (R >> 3) + 8 * h + (R & 7); const float p = (key <= tq && tq - key < 512) ? __builtin_amdgcn_exp2f(s[R] - bound_w) : 0.f; s[R] = p; lsum += p; }
          bf16x8 pb[2]; pb[0] = pack8(s, 0); pb[1] = pack8(s, 1);
          pv_tile128(vwf + (size_t)kt * 4096, pb, o, lane); }
      lsum = half_sum(lsum); const float cw = g2 / lsum;
      bf16* yr = WSP(bf16, WS_A1) + (size_t)tq * (KS * D);
#pragma unroll
      for (int dt = 0; dt < 4; ++dt)
#pragma unroll
          for (int rg = 0; rg < 4; ++rg) { const f32x4 c4 = *(const f32x4*)(ocr + 32 * dt + 8 * rg + 4 * h); f32x4 v;
#pragma unroll
              for (int e = 0; e < 4; ++e) v[e] = c4[e] + cw * o[dt][4 * rg + e];
              storeA4(yr, D, 512 + head * 128 + 32 * dt + 8 * rg + 4 * h, v); } }
}
__device__ __forceinline__ void ph_nsa_mfma(Frame& F, int L) {
    LAS float* IMPW = (LAS float*)(F.lds + F.wave * WAVE_SCR);
    for (int v = F.bid * 8 + F.wave; v < 2048; v += F.G * 8) { const int b = v >> 3, w = v & 7, s = b * 4 + (w & 3);
        const int tg = (w < 4) ? s : 1023 - s, g = (w < 4) ? 0 : 1;
        nsa_wave_item(F, L, tg, g, IMPW); }
}

constexpr int NS_KB = 0, NS_VB = 16384, NS_IMP = 32768, NS_TL = 131072, NS_UNI = NS_TL + 4 * 640, NS_MYM = NS_UNI + 64, NS_S2K = 0, NS_S2V = 65536, NS_NT = 4;
__device__ __forceinline__ f32x16 st_tile_lds(const LAS unsigned char* kslot, const bf16x8 (&qf)[8], int lane) {
    f32x16 s = zero16(); const LAS bf16x8* kp = (const LAS bf16x8*)kslot + lane;
    const unsigned ka = (unsigned)(size_t)kp;
#pragma unroll
    for (int hf = 0; hf < 2; ++hf) { bf16x8 k0, k1, k2, k3;
        if (hf == 0) asm volatile("ds_read_b128 %0, %4\n\tds_read_b128 %1, %4 offset:1024\n\tds_read_b128 %2, %4 offset:2048\n\tds_read_b128 %3, %4 offset:3072\n\ts_waitcnt lgkmcnt(0)" : "=&v"(k0), "=&v"(k1), "=&v"(k2), "=&v"(k3) : "v"(ka) : "memory");
        else         asm volatile("ds_read_b128 %0, %4 offset:4096\n\tds_read_b128 %1, %4 offset:5120\n\tds_read_b128 %2, %4 offset:6144\n\tds_read_b128 %3, %4 offset:7168\n\ts_waitcnt lgkmcnt(0)" : "=&v"(k0), "=&v"(k1), "=&v"(k2), "=&v"(k3) : "v"(ka) : "memory");
        s = MFMA32(k0, qf[4 * hf], s); s = MFMA32(k1, qf[4 * hf + 1], s); s = MFMA32(k2, qf[4 * hf + 2], s); s = MFMA32(k3, qf[4 * hf + 3], s); }
    return s;
}
__device__ __forceinline__ void pv_tile_lds(const LAS unsigned char* vslot, const bf16x8 (&pb)[2], f32x16 (&o)[4], int lane) {
    const LAS bf16x8* vp = (const LAS bf16x8*)vslot + lane;
#pragma unroll
    for (int dt = 0; dt < 4; dt += 2) { bf16x8 v0, v1, v2, v3; const unsigned va = (unsigned)(size_t)vp;
        if (dt == 0) asm volatile("ds_read_b128 %0, %4\n\tds_read_b128 %1, %4 offset:1024\n\tds_read_b128 %2, %4 offset:2048\n\tds_read_b128 %3, %4 offset:3072\n\ts_waitcnt lgkmcnt(0)" : "=&v"(v0), "=&v"(v1), "=&v"(v2), "=&v"(v3) : "v"(va) : "memory");
        else         asm volatile("ds_read_b128 %0, %4 offset:4096\n\tds_read_b128 %1, %4 offset:5120\n\tds_read_b128 %2, %4 offset:6144\n\tds_read_b128 %3, %4 offset:7168\n\ts_waitcnt lgkmcnt(0)" : "=&v"(v0), "=&v"(v1), "=&v"(v2), "=&v"(v3) : "v"(va) : "memory");
        o[dt] = MFMA32(v0, pb[0], o[dt]); o[dt] = MFMA32(v1, pb[1], o[dt]); o[dt + 1] = MFMA32(v2, pb[0], o[dt + 1]); o[dt + 1] = MFMA32(v3, pb[1], o[dt + 1]); }
}
__device__ __forceinline__ void nsa_block_unit(Frame& F, int L, int qb, int g) {
    const int lane = F.lane, w = F.wave, r = lane & 31, h = lane >> 5, slot = r >> 2, jh = r & 3;
    const int tg = 8 * qb + w, tq = 8 * tg + slot, head = 4 * g + jh, cur = qb;
    LAS unsigned char* lds = F.lds; LAS int* TL = (LAS int*)(lds + NS_TL); LAS unsigned* UNI = (LAS unsigned*)(lds + NS_UNI); LAS float* IMPW = (LAS float*)(lds + NS_IMP) + w * (2 * 8 * 129);
    const float* kgn = INP(8) + L * 384;
    const float bc = 11.313708498984761f * LOG2E * 1.02f * gain_absmax128(INP(7) + L * 128, lane);
#define UNIF(x) __builtin_bit_cast(float, __builtin_amdgcn_readfirstlane(__builtin_bit_cast(int, (x))))
    const float bound_c = UNIF(bc * gain_absmax128(kgn, lane)), bound_s = UNIF(bc * gain_absmax128(kgn + 128, lane)), bound_w = UNIF(bc * gain_absmax128(kgn + 256, lane));
    bf16x8 qf[8]; load_qf128(WSP(bf16, WS_QN) + (size_t)tq * 1024 + head * 128, h, qf);
#define NS_GATE(b) sigm(WSP(float, WS_Z)[(size_t)tq * NIN + ZC_GATE + head * 3 + (b)])
#define NS_OCR (WSP(float, WS_OC) + (size_t)tq * 1024 + head * 128)
    const unsigned char* wsb = F.ws;
#define NS_KT(src, kt) ((const v4u*)(wsb + ((src) == 0 ? WS_KCF + (size_t)g * 16 * 8192 : (src) == 1 ? WS_KSF + (size_t)g * 256 * 8192 : WS_KWF + (size_t)g * 256 * 8192) + (size_t)(kt) * 8192) + F.tid)
#define NS_VT(src, kt) ((const v4u*)(wsb + ((src) == 0 ? WS_VCF + (size_t)g * 16 * 8192 : (src) == 1 ? WS_VSF + (size_t)g * 256 * 8192 : WS_VWF + (size_t)g * 256 * 8192) + (size_t)(kt) * 8192) + F.tid)
#define NS_COPY(src, kt, sl) do { __builtin_amdgcn_global_load_lds((const unsigned*)NS_KT(src, kt), (LAS unsigned*)(lds + NS_KB + (sl) * 8192 + w * 1024), 16, 0, 0); \
                                  __builtin_amdgcn_global_load_lds((const unsigned*)NS_VT(src, kt), (LAS unsigned*)(lds + NS_VB + (sl) * 8192 + w * 1024), 16, 0, 0); } while (0)
#define NS_COPYK(src, kt, sl) __builtin_amdgcn_global_load_lds((const unsigned*)NS_KT(src, kt), (LAS unsigned*)(lds + NS_KB + (sl) * 8192 + w * 1024), 16, 0, 0)
#define NS_LAND() asm volatile("s_waitcnt vmcnt(0)" ::: "memory")
    f32x16 o[4]; o[0] = zero16(); o[1] = zero16(); o[2] = zero16(); o[3] = zero16();
    for (int i = lane; i < 2 * 8 * 129; i += 64) IMPW[i] = 0.f;
    if (F.tid < 4) UNI[F.tid] = 0u;
    const int ntb = (((64 * qb + 63 - 31) >> 4) >> 5) + 1;
    const int cmaxq = (tq >= 31) ? ((tq - 31) >> 4) : -1;
    const int ntw = (8 * tg + 7 >= 31) ? (((8 * tg + 7 - 31) >> 4) >> 5) + 1 : 0;
    float lsum = 0.f, inv = 0.f;
    { const int n = 2 * ntb;
      NS_COPYK(0, 0, 0); NS_LAND();
      __syncthreads();
      LAS float* imrow = IMPW + (h * 8 + slot) * 129;
#pragma unroll 1
      for (int i = 0; i < n; ++i) { const int kt = (i < ntb) ? i : i - ntb; const bool pass2 = i >= ntb;
          if (i + 1 < n) { if (i + 1 < ntb) NS_COPYK(0, i + 1, (i + 1) & 1); else NS_COPY(0, i + 1 - ntb, (i + 1) & 1); }
          if (i == ntb) { lsum = half_sum(lsum); inv = (lsum > 0.f) ? 1.0f / lsum : 0.f; }
          if (kt < ntw) { const LAS unsigned char* ks = lds + NS_KB + (i & 1) * 8192; f32x16 s = st_tile_lds(ks, qf, lane);
              if (!pass2) {
#pragma unroll
                  for (int R = 0; R < 16; ++R) { const int c = 32 * kt + 16 * (R >> 3) + 8 * h + (R & 7); lsum += (c <= cmaxq) ? __builtin_amdgcn_exp2f(s[R] - bound_c) : 0.f; } }
              else {
#pragma unroll
                  for (int R = 0; R < 16; ++R) { const int c = 32 * kt + 16 * (R >> 3) + 8 * h + (R & 7); s[R] = (c <= cmaxq) ? __builtin_amdgcn_exp2f(s[R] - bound_c) * inv : 0.f; }
#pragma unroll
                  for (int s2 = 0; s2 < 2; ++s2) { const int sb = 8 * kt + 4 * s2 + 2 * h;
                      float a = (s[8 * s2] + s[8 * s2 + 1]) + (s[8 * s2 + 2] + s[8 * s2 + 3]), b = ((s[8 * s2 + 4] + s[8 * s2 + 5]) + (s[8 * s2 + 6] + s[8 * s2 + 7])) + s[8 * s2 + 3], c7 = s[8 * s2 + 7];
                      a += sxor<1>(a); b += sxor<1>(b); c7 += sxor<1>(c7); a += sxor<2>(a); b += sxor<2>(b); c7 += sxor<2>(c7);
                      if (jh == 0) { imrow[sb] = a; imrow[sb + 1] = b; imrow[sb + 2] = c7; } }
                  bf16x8 pb[2]; pb[0] = pack8(s, 0); pb[1] = pack8(s, 1);
                  pv_tile_lds(lds + NS_VB + (i & 1) * 8192, pb, o, lane); } }
          NS_LAND();
          __syncthreads(); } }
    { const float g0 = NS_GATE(0); float* ocr = NS_OCR;
#pragma unroll
    for (int dt = 0; dt < 4; ++dt)
#pragma unroll
        for (int rg = 0; rg < 4; ++rg) { f32x4 v = {o[dt][4 * rg], o[dt][4 * rg + 1], o[dt][4 * rg + 2], o[dt][4 * rg + 3]}; *(f32x4*)(ocr + 32 * dt + 8 * rg + 4 * h) = v * g0; } }
    LDS_WAIT();
    unsigned my[4] = {0u, 0u, 0u, 0u}, un[4] = {0u, 0u, 0u, 0u};
    if (cur < 16) { my[0] = un[0] = (1u << (cur + 1)) - 1u; }
    else {
        float v0[8], v1[8];
#pragma unroll
        for (int ts = 0; ts < 8; ++ts) { const int s0 = lane, s1 = lane + 64;
            const float a0 = IMPW[ts * 129 + s0] + IMPW[(8 + ts) * 129 + s0], a1 = IMPW[ts * 129 + s1] + IMPW[(8 + ts) * 129 + s1];
            v0[ts] = (s0 > cur) ? -3.0e38f : ((s0 == 0 || s0 == cur || s0 == cur - 1) ? 3.0e38f : a0);
            v1[ts] = (s1 > cur) ? -3.0e38f : ((s1 == cur || s1 == cur - 1) ? 3.0e38f : a1); }
#pragma unroll 1
        for (int k = 0; k < 16; ++k) { float bv[8]; int bi[8];
#pragma unroll
            for (int ts = 0; ts < 8; ++ts) { if (v0[ts] >= v1[ts]) { bv[ts] = v0[ts]; bi[ts] = lane; } else { bv[ts] = v1[ts]; bi[ts] = lane + 64; } }
#define AMX(M) _Pragma("unroll") for (int ts = 0; ts < 8; ++ts) { const float ov_ = sxor<M>(bv[ts]); const int oi_ = sxori<M>(bi[ts]); if (ov_ > bv[ts] || (ov_ == bv[ts] && oi_ < bi[ts])) { bv[ts] = ov_; bi[ts] = oi_; } }
            AMX(1) AMX(2) AMX(4) AMX(8) AMX(16)
#undef AMX
#pragma unroll
            for (int ts = 0; ts < 8; ++ts) { unsigned va = __builtin_bit_cast(unsigned, bv[ts]), vb = va, ia = (unsigned)bi[ts], ib = ia; swap32(va, vb); swap32(ia, ib);
                const float x0 = __builtin_bit_cast(float, va), x1 = __builtin_bit_cast(float, vb); const int i0 = (int)ia, i1 = (int)ib;
                int win = (x0 > x1 || (x0 == x1 && i0 < i1)) ? i0 : i1;
                if (win == lane) v0[ts] = -3.0e38f; if (win == lane + 64) v1[ts] = -3.0e38f;
                win = __builtin_amdgcn_readfirstlane(win);
                const unsigned bit = 1u << (win & 31); const int wi = win >> 5; const bool mine = (slot == ts);
#pragma unroll
                for (int q4 = 0; q4 < 4; ++q4) { if (wi == q4) { un[q4] |= bit; if (mine) my[q4] |= bit; } } } } }
    LAS unsigned* MYM = (LAS unsigned*)(lds + NS_MYM) + (w * 64 + lane) * 4;
    *(LAS v4u*)MYM = (v4u){my[0], my[1], my[2], my[3]};
    if (lane == 0) {
#pragma unroll
        for (int q4 = 0; q4 < 4; ++q4) (void)__hip_atomic_fetch_or(UNI + q4, un[q4], __ATOMIC_RELAXED, __HIP_MEMORY_SCOPE_WORKGROUP); }
    __syncthreads();
    unsigned u0 = UNI[0], u1 = UNI[1], u2 = UNI[2], u3 = UNI[3];
    const int nsel = 2 * (__builtin_popcount(u0) + __builtin_popcount(u1) + __builtin_popcount(u2) + __builtin_popcount(u3));
    const int ktl = 2 * qb + 1, kt0 = (ktl >= 17) ? ktl - 17 : 0, nwin = ktl - kt0 + 1, ntl = nsel + nwin;
    int jt_ = F.tid; asm volatile("" : "+v"(jt_));
    if (jt_ < 128) { const int j = jt_; const unsigned wsel = (j < 32) ? u0 : (j < 64) ? u1 : (j < 96) ? u2 : u3;
        if ((wsel >> (j & 31)) & 1u) { int pos = __builtin_popcount(wsel & ((1u << (j & 31)) - 1u)); if (j >= 32) pos += __builtin_popcount(u0); if (j >= 64) pos += __builtin_popcount(u1); if (j >= 96) pos += __builtin_popcount(u2);
            TL[2 * pos] = (2 * j) | (1 << 16); TL[2 * pos + 1] = (2 * j + 1) | (1 << 16); } }
    else if (jt_ < 128 + 32) { const int i = jt_ - 128; if (i < nwin) TL[nsel + i] = (kt0 + i) | (2 << 16); }
    __syncthreads();
    o[0] = zero16(); o[1] = zero16(); o[2] = zero16(); o[3] = zero16(); lsum = 0.f;
    {
#define NS_COPY2(src, kt, sl) do { __builtin_amdgcn_global_load_lds((const unsigned*)NS_KT(src, kt), (LAS unsigned*)(lds + NS_S2K + (sl) * 8192 + w * 1024), 16, 0, 0); \
                                   __builtin_amdgcn_global_load_lds((const unsigned*)NS_VT(src, kt), (LAS unsigned*)(lds + NS_S2V + (sl) * 8192 + w * 1024), 16, 0, 0); } while (0)
#pragma unroll 1
      for (int u2 = 0; u2 < NS_NT; ++u2) if (u2 < ntl) { const int e0 = TL[u2]; NS_COPY2(e0 >> 16, e0 & 0xffff, u2); }
      NS_LAND();
      __syncthreads();
      const int wkt0 = (8 * tg >= 511) ? ((8 * tg - 511) >> 5) : 0, wktl = (8 * tg + 7) >> 5;
      const int nst = (ntl + NS_NT - 1) / NS_NT, nss = nsel / NS_NT;
#pragma unroll 1
      for (int st = 0; st < nst; ++st) {
          if (st + 1 < nst) {
#pragma unroll 1
              for (int u2 = 0; u2 < NS_NT; ++u2) { const int ix = NS_NT * (st + 1) + u2; if (ix < ntl) { const int ea = TL[ix]; NS_COPY2(ea >> 16, ea & 0xffff, ((st + 1) & 1) * NS_NT + u2); } } }
#pragma unroll 1
          for (int u2 = 0; u2 < NS_NT; ++u2) { const int i = NS_NT * st + u2; if (i >= ntl) break;
          if (i == nsel) {
              lsum = half_sum(lsum); const float cs = (lsum > 0.f) ? NS_GATE(1) / lsum : 0.f; float* ocr = NS_OCR;
#pragma unroll
              for (int dt = 0; dt < 4; ++dt)
#pragma unroll
                  for (int rg = 0; rg < 4; ++rg) { f32x4 v = {o[dt][4 * rg], o[dt][4 * rg + 1], o[dt][4 * rg + 2], o[dt][4 * rg + 3]}; f32x4* p = (f32x4*)(ocr + 32 * dt + 8 * rg + 4 * h); *p = *p + v * cs; }
              o[0] = zero16(); o[1] = zero16(); o[2] = zero16(); o[3] = zero16(); lsum = 0.f; }
          const int en = TL[i], src = en >> 16, kt = en & 0xffff; const int sl = (st & 1) * NS_NT + u2;
          bool need, full; int lo, hi; float bnd;
          if (src == 1) { const int j = kt >> 1; const unsigned wu = (j < 32) ? un[0] : (j < 64) ? un[1] : (j < 96) ? un[2] : un[3]; const unsigned wm = MYM[j >> 5];
              need = (__builtin_amdgcn_readfirstlane(wu) >> (j & 31)) & 1u; const bool sel = (wm >> (j & 31)) & 1u; lo = 0; hi = tq; bnd = sel ? bound_s : 3.0e38f; full = (j < cur); }
          else { need = (kt >= wkt0 && kt <= wktl); lo = tq - 511; hi = tq; bnd = bound_w; full = (32 * kt + 31 <= 8 * tg) && (32 * kt >= 8 * tg + 7 - 511); }
          if (need) { f32x16 s = st_tile_lds(lds + NS_S2K + sl * 8192, qf, lane);
              if (full) {
#pragma unroll
                  for (int R = 0; R < 16; ++R) { const float p = __builtin_amdgcn_exp2f(s[R] - bnd); s[R] = p; lsum += p; } }
              else {
#pragma unroll
              for (int R = 0; R < 16; ++R) { const int key = 32 * kt + 16 * (R >> 3) + 8 * h + (R & 7); const float p = (key >= lo && key <= hi) ? __builtin_amdgcn_exp2f(s[R] - bnd) : 0.f; s[R] = p; lsum += p; } }
              bf16x8 pb[2]; pb[0] = pack8(s, 0); pb[1] = pack8(s, 1);
              pv_tile_lds(lds + NS_S2V + sl * 8192, pb, o, lane); } }
          NS_LAND();
          __syncthreads(); } }
    { lsum = half_sum(lsum); const float cw = NS_GATE(2) / lsum; const float* ocr = NS_OCR;
      bf16* yr = WSP(bf16, WS_A1) + (size_t)tq * (KS * D);
#pragma unroll
      for (int dt = 0; dt < 4; ++dt)
#pragma unroll
          for (int rg = 0; rg < 4; ++rg) { const f32x4 c4 = *(const f32x4*)(ocr + 32 * dt + 8 * rg + 4 * h); f32x4 v;
#pragma unroll
              for (int e = 0; e < 4; ++e) v[e] = c4[e] + cw * o[dt][4 * rg + e];
              storeA4(yr, D, 512 + head * 128 + 32 * dt + 8 * rg + 4 * h, v); } }
    __syncthreads();
#undef NS_KT
#undef NS_VT
#undef NS_COPY
#undef NS_LAND
#undef NS_COPY2
#undef NS_GATE
#undef NS_OCR
#undef UNIF
}
__device__ __forceinline__ void ph_nsa_block(Frame& F, int L) {
    for (int u = F.bid; u < 256; u += F.G) { const int g = u & 1, qb = u >> 1; nsa_block_unit(F, L, qb, g); }
}

__device__ __forceinline__ f32x16 st_tile_lds_q(const LAS unsigned char* kslot, const LAS unsigned char* qlds, const bf16x8 (&qh)[4], int lane) {
    f32x16 s = zero16(); const unsigned ka = (unsigned)(size_t)((const LAS bf16x8*)kslot + lane), qa = (unsigned)(size_t)((const LAS bf16x8*)qlds + lane);
    { bf16x8 k0, k1, k2, k3, q0, q1, q2, q3;
      asm volatile("ds_read_b128 %0, %8\n\tds_read_b128 %1, %8 offset:1024\n\tds_read_b128 %2, %8 offset:2048\n\tds_read_b128 %3, %8 offset:3072\n\t"
                   "ds_read_b128 %4, %9\n\tds_read_b128 %5, %9 offset:1024\n\tds_read_b128 %6, %9 offset:2048\n\tds_read_b128 %7, %9 offset:3072\n\ts_waitcnt lgkmcnt(0)"
                   : "=&v"(k0), "=&v"(k1), "=&v"(k2), "=&v"(k3), "=&v"(q0), "=&v"(q1), "=&v"(q2), "=&v"(q3) : "v"(ka), "v"(qa) : "memory");
      s = MFMA32(k0, q0, s); s = MFMA32(k1, q1, s); s = MFMA32(k2, q2, s); s = MFMA32(k3, q3, s); }
    { bf16x8 k0, k1, k2, k3;
      asm volatile("ds_read_b128 %0, %4 offset:4096\n\tds_read_b128 %1, %4 offset:5120\n\tds_read_b128 %2, %4 offset:6144\n\tds_read_b128 %3, %4 offset:7168\n\ts_waitcnt lgkmcnt(0)" : "=&v"(k0), "=&v"(k1), "=&v"(k2), "=&v"(k3) : "v"(ka) : "memory");
      s = MFMA32(k0, qh[0], s); s = MFMA32(k1, qh[1], s); s = MFMA32(k2, qh[2], s); s = MFMA32(k3, qh[3], s); }
    return s;
}
constexpr int N3_QL = 119616;
constexpr int N3_KB = 0, N3_VB = 32768, N3_TL = 65536, N3_UNI = N3_TL + 2560, N3_LX = N3_UNI + 64, N3_IMP = N3_LX + 2048, N3_MYM = N3_IMP + 4 * 2 * 8 * 129 * 4;
__device__ __forceinline__ void n3_tile(const LAS unsigned char* ks, const LAS unsigned char* vs, const LAS unsigned char* ql, const bf16x8 (&qf)[4], f32x16 (&o)[4], float& lsum, float bnd, bool full, int lo, int hi, int kt, int h, bool do_pv, int lane) {
    f32x16 s = st_tile_lds_q(ks, ql, qf, lane);
    if (full) {
#pragma unroll
        for (int R = 0; R < 16; ++R) { const float p = __builtin_amdgcn_exp2f(s[R] - bnd); s[R] = p; lsum += p; } }
    else {
#pragma unroll
        for (int R = 0; R < 16; ++R) { const int key = 32 * kt + 16 * (R >> 3) + 8 * h + (R & 7); const float p = (key >= lo && key <= hi) ? __builtin_amdgcn_exp2f(s[R] - bnd) : 0.f; s[R] = p; lsum += p; } }
    if (do_pv) { bf16x8 pb[2]; pb[0] = pack8(s, 0); pb[1] = pack8(s, 1); pv_tile_lds(vs, pb, o, lane); }
}
__device__ __forceinline__ void nsa_unit3(Frame& F, int L, int qbh, int g) {
#define OPQL() ({ int l_ = F.lane; asm volatile("" : "+v"(l_)); l_; })
    const int lane = OPQL(), w = F.wave, r = lane & 31, h = lane >> 5, slot = r >> 2, jh = r & 3, tgw = w & 3, par = w >> 2;
    const int tg = 4 * qbh + tgw, tq = 8 * tg + slot, head = 4 * g + jh, cur = qbh >> 1;
    LAS unsigned char* lds = F.lds; LAS int* TL = (LAS int*)(lds + N3_TL); LAS unsigned* UNI = (LAS unsigned*)(lds + N3_UNI); LAS float* LX = (LAS float*)(lds + N3_LX);
    LAS float* IMPG = (LAS float*)(lds + N3_IMP) + tgw * (2 * 8 * 129);
    const float* kgn = INP(8) + L * 384;
    const float bc = 11.313708498984761f * LOG2E * 1.02f * gain_absmax128(INP(7) + L * 128, lane);
#define UNIF(x) __builtin_bit_cast(float, __builtin_amdgcn_readfirstlane(__builtin_bit_cast(int, (x))))
    const float bound_c = UNIF(bc * gain_absmax128(kgn, lane)), bound_s = UNIF(bc * gain_absmax128(kgn + 128, lane)), bound_w = UNIF(bc * gain_absmax128(kgn + 256, lane));
    bf16x8 qf[4]; LAS unsigned char* ql = lds + N3_QL + w * 4096;
    { const bf16* qrow = WSP(bf16, WS_QN) + (size_t)tq * 1024 + head * 128 + 8 * h;
#pragma unroll
      for (int sp = 0; sp < 4; ++sp) { *((LAS bf16x8*)ql + sp * 64 + lane) = *(const bf16x8*)(qrow + 16 * sp); qf[sp] = *(const bf16x8*)(qrow + 16 * (sp + 4)); } }
#define N3_GATE(b) sigm(*(const float*)(F.ws + WS_Z + (size_t)(32 * qbh) * NIN * 4 + (unsigned)((((tq - 32 * qbh) * NIN) + ZC_GATE + head * 3 + (b)) * 4)))
#define N3_OCR ({ const int l2_ = OPQL(); const int r2_ = l2_ & 31; (float*)(F.ws + WS_OC + (unsigned)((((8 * tg + (r2_ >> 2)) * 1024 + (4 * g + (r2_ & 3)) * 128) + 4 * (l2_ >> 5)) * 4)); })
    const unsigned char* wsb = F.ws;
    const unsigned dmaoff = (unsigned)(w * 1024 + lane * 16);
#define N3_KT(src, kt) ((const unsigned*)((wsb + ((src) == 0 ? WS_KCF + (size_t)g * 16 * 8192 : (src) == 1 ? WS_KSF + (size_t)g * 256 * 8192 : WS_KWF + (size_t)g * 256 * 8192) + (size_t)(kt) * 8192) + dmaoff))
#define N3_VT(src, kt) ((const unsigned*)((wsb + ((src) == 0 ? WS_VCF + (size_t)g * 16 * 8192 : (src) == 1 ? WS_VSF + (size_t)g * 256 * 8192 : WS_VWF + (size_t)g * 256 * 8192) + (size_t)(kt) * 8192) + dmaoff))
#define N3_COPY(src, kt, sl) do { __builtin_amdgcn_global_load_lds(N3_KT(src, kt), (LAS unsigned*)(lds + N3_KB + (sl) * 8192 + w * 1024), 16, 0, 0); \
                                  __builtin_amdgcn_global_load_lds(N3_VT(src, kt), (LAS unsigned*)(lds + N3_VB + (sl) * 8192 + w * 1024), 16, 0, 0); } while (0)
#define N3_LAND() asm volatile("s_waitcnt vmcnt(0)" ::: "memory")
#define N3_FOLD(COEF, FIRST) do { const float cf_ = (COEF); float* ocr_ = N3_OCR; \
        for (int pp_ = 0; pp_ < 2; ++pp_) { if (pp_ == par) { _Pragma("unroll") for (int dt = 0; dt < 4; ++dt) _Pragma("unroll") for (int rg = 0; rg < 4; ++rg) { \
            f32x4 v_ = {o[dt][4 * rg], o[dt][4 * rg + 1], o[dt][4 * rg + 2], o[dt][4 * rg + 3]}; f32x4* p_ = (f32x4*)(ocr_ + 32 * dt + 8 * rg); if ((FIRST) && pp_ == 0) *p_ = v_ * cf_; else *p_ = *p_ + v_ * cf_; } \
            asm volatile("s_waitcnt vmcnt(0)" ::: "memory"); } __syncthreads(); } } while (0)
#define N3_LTOT(dst) do { const int l3_ = OPQL(); lsum = half_sum(lsum); LX[w * 64 + l3_] = lsum; __syncthreads(); dst = LX[tgw * 64 + l3_] + LX[(tgw + 4) * 64 + l3_]; __syncthreads(); } while (0)
    f32x16 o[4]; o[0] = zero16(); o[1] = zero16(); o[2] = zero16(); o[3] = zero16();
    for (int i = OPQL() + 64 * par; i < 2 * 8 * 129; i += 128) IMPG[i] = 0.f;
    if (F.tid < 4) UNI[F.tid] = 0u;
    const int tlast = 32 * qbh + 31; const int ntb = (tlast >= 31) ? (((tlast - 31) >> 4) >> 5) + 1 : 0;
    const int cmaxq = (tq >= 31) ? ((tq - 31) >> 4) : -1;
    const int cmin_w = (8 * tg >= 31) ? ((8 * tg - 31) >> 4) : -1;
    const int ntw = (8 * tg + 7 >= 31) ? (((8 * tg + 7 - 31) >> 4) >> 5) + 1 : 0;
    float lsum = 0.f; float bnd2 = 3.0e38f;
    { const int s1 = (ntb + 1) >> 1, n = 2 * s1;
      if (n > 0) { if (0 < ntb) N3_COPY(0, 0, 0); if (1 < ntb) N3_COPY(0, 1, 1); }
      N3_LAND(); __syncthreads();
      LAS float* imrow = IMPG + (h * 8 + slot) * 129;
#pragma unroll 1
      for (int i = 0; i < n; ++i) { const int ii = (i < s1) ? i : i - s1, kt = 2 * ii + par; const bool pass2 = i >= s1;
          if (i + 1 < n) { const int in = (i + 1 < s1) ? i + 1 : i + 1 - s1; if (2 * in < ntb) N3_COPY(0, 2 * in, ((i + 1) & 1) * 2); if (2 * in + 1 < ntb) N3_COPY(0, 2 * in + 1, ((i + 1) & 1) * 2 + 1); }
          if (i == s1) { float lt; N3_LTOT(lt); bnd2 = (lt > 0.f) ? bound_c + __builtin_amdgcn_logf(lt) : 3.0e38f; lsum = 0.f; }
          if (kt < ntb && kt < ntw) { const LAS unsigned char* ks = lds + N3_KB + ((i & 1) * 2 + par) * 8192; const LAS unsigned char* vs = lds + N3_VB + ((i & 1) * 2 + par) * 8192;
              const bool full = (32 * kt + 31 <= cmin_w);
              if (!pass2) n3_tile(ks, vs, ql, qf, o, lsum, bound_c, full, 0, cmaxq, kt, h, false, lane);
              else { f32x16 s = st_tile_lds_q(ks, ql, qf, lane);
#pragma unroll
                  for (int R = 0; R < 16; ++R) { const int c = 32 * kt + 16 * (R >> 3) + 8 * h + (R & 7); s[R] = (full || c <= cmaxq) ? __builtin_amdgcn_exp2f(s[R] - bnd2) : 0.f; }
#pragma unroll
                  for (int s2 = 0; s2 < 2; ++s2) { const int sb = 8 * kt + 4 * s2 + 2 * h;
                      float a = (s[8 * s2] + s[8 * s2 + 1]) + (s[8 * s2 + 2] + s[8 * s2 + 3]), b = ((s[8 * s2 + 4] + s[8 * s2 + 5]) + (s[8 * s2 + 6] + s[8 * s2 + 7])) + s[8 * s2 + 3], c7 = s[8 * s2 + 7];
                      a += sxor<1>(a); b += sxor<1>(b); c7 += sxor<1>(c7); a += sxor<2>(a); b += sxor<2>(b); c7 += sxor<2>(c7);
                      if (jh == 0) { imrow[sb] = a; imrow[sb + 1] = b; imrow[sb + 2] = c7; } }
                  bf16x8 pb[2]; pb[0] = pack8(s, 0); pb[1] = pack8(s, 1);
                  pv_tile_lds(vs, pb, o, lane); } }
          N3_LAND(); __syncthreads(); } }
    N3_FOLD(N3_GATE(0), true);
    unsigned my[4] = {0u, 0u, 0u, 0u}, un[4] = {0u, 0u, 0u, 0u};
    if (cur < 16) { my[0] = un[0] = (1u << (cur + 1)) - 1u; }
    else {
        const int lk_ = OPQL();
#pragma unroll 1
        for (int ts = 0; ts < 8; ++ts) { const int s0 = lk_, s1 = lk_ + 64;
            float v0 = IMPG[ts * 129 + s0] + IMPG[(8 + ts) * 129 + s0], v1 = IMPG[ts * 129 + s1] + IMPG[(8 + ts) * 129 + s1];
            v0 = (s0 > cur) ? -3.0e38f : ((s0 == 0 || s0 == cur || s0 == cur - 1) ? 3.0e38f : v0);
            v1 = (s1 > cur) ? -3.0e38f : ((s1 == cur || s1 == cur - 1) ? 3.0e38f : v1);
#pragma unroll 1
            for (int k = 0; k < 16; ++k) { float bv; int bi; if (v0 >= v1) { bv = v0; bi = lk_; } else { bv = v1; bi = lk_ + 64; }
                wave_argmax(bv, bi);
                if (bi == lk_) v0 = -3.0e38f; if (bi == lk_ + 64) v1 = -3.0e38f;
                bi = __builtin_amdgcn_readfirstlane(bi);
                const unsigned bit = 1u << (bi & 31); const int wi = bi >> 5; const bool mine = (slot == ts);
#pragma unroll
                for (int q4 = 0; q4 < 4; ++q4) { if (wi == q4) { un[q4] |= bit; if (mine) my[q4] |= bit; } } } } }
    LAS unsigned* MYM = (LAS unsigned*)(lds + N3_MYM) + (w * 64 + OPQL()) * 4;
    *(LAS v4u*)MYM = (v4u){my[0], my[1], my[2], my[3]};
    if (lane == 0) {
#pragma unroll
        for (int q4 = 0; q4 < 4; ++q4) (void)__hip_atomic_fetch_or(UNI + q4, un[q4], __ATOMIC_RELAXED, __HIP_MEMORY_SCOPE_WORKGROUP); }
    __syncthreads();
    const unsigned u0 = UNI[0], u1 = UNI[1], u2 = UNI[2], u3 = UNI[3];
    const int nsel = 2 * (__builtin_popcount(u0) + __builtin_popcount(u1) + __builtin_popcount(u2) + __builtin_popcount(u3));
    const int ktl = qbh, kt0 = (ktl >= 16) ? ktl - 16 : 0, nwin = ktl - kt0 + 1, ntl = nsel + nwin;
    { int jt_ = F.tid; asm volatile("" : "+v"(jt_));
      if (jt_ < 128) { const int j = jt_; const unsigned wsel = (j < 32) ? u0 : (j < 64) ? u1 : (j < 96) ? u2 : u3;
          if ((wsel >> (j & 31)) & 1u) { int pos = __builtin_popcount(wsel & ((1u << (j & 31)) - 1u)); if (j >= 32) pos += __builtin_popcount(u0); if (j >= 64) pos += __builtin_popcount(u1); if (j >= 96) pos += __builtin_popcount(u2);
              TL[2 * pos] = (2 * j) | (1 << 16); TL[2 * pos + 1] = (2 * j + 1) | (1 << 16); } }
      else if (jt_ < 128 + 32) { const int i = jt_ - 128; if (i < nwin) TL[nsel + i] = (kt0 + i) | (2 << 16); } }
    __syncthreads();
    o[0] = zero16(); o[1] = zero16(); o[2] = zero16(); o[3] = zero16(); lsum = 0.f;
    { const int nst = (ntl + 1) >> 1, nss = nsel >> 1;
      { const int e0 = TL[0]; N3_COPY(e0 >> 16, e0 & 0xffff, 0); if (1 < ntl) { const int e1 = TL[1]; N3_COPY(e1 >> 16, e1 & 0xffff, 1); } }
      N3_LAND(); __syncthreads();
      const int wkt0 = (8 * tg >= 511) ? ((8 * tg - 511) >> 5) : 0, wktl = (8 * tg + 7) >> 5;
#pragma unroll 1
      for (int i = 0; i < nst; ++i) {
          if (i + 1 < nst) { const int ea = TL[2 * i + 2]; N3_COPY(ea >> 16, ea & 0xffff, ((i + 1) & 1) * 2); if (2 * i + 3 < ntl) { const int eb = TL[2 * i + 3]; N3_COPY(eb >> 16, eb & 0xffff, ((i + 1) & 1) * 2 + 1); } }
          if (i == nss) { float lt; N3_LTOT(lt); N3_FOLD((lt > 0.f) ? N3_GATE(1) / lt : 0.f, false); o[0] = zero16(); o[1] = zero16(); o[2] = zero16(); o[3] = zero16(); lsum = 0.f; }
          const int ei = 2 * i + par;
          if (ei < ntl) { const int en = TL[ei], src = en >> 16, kt = en & 0xffff; bool need, full; int lo, hi; float bnd;
              if (src == 1) { const int j = kt >> 1; const unsigned wu = (j < 32) ? un[0] : (j < 64) ? un[1] : (j < 96) ? un[2] : un[3];
                  need = (__builtin_amdgcn_readfirstlane(wu) >> (j & 31)) & 1u; const bool sel = (MYM[j >> 5] >> (j & 31)) & 1u; bnd = sel ? bound_s : 3.0e38f; lo = 0; hi = tq; full = (j < cur); }
              else { need = (kt >= wkt0 && kt <= wktl); lo = tq - 511; hi = tq; bnd = bound_w; full = (32 * kt + 31 <= 8 * tg) && (32 * kt >= 8 * tg + 7 - 511); }
              if (need) n3_tile(lds + N3_KB + ((i & 1) * 2 + par) * 8192, lds + N3_VB + ((i & 1) * 2 + par) * 8192, ql, qf, o, lsum, bnd, full, lo, hi, kt, h, true, lane); }
          N3_LAND(); __syncthreads(); } }
    { float lt; N3_LTOT(lt); const float cw = N3_GATE(2) / lt; float* ocr = N3_OCR;
      if (par == 0) {
#pragma unroll
          for (int dt = 0; dt < 4; ++dt)
#pragma unroll
              for (int rg = 0; rg < 4; ++rg) { f32x4 v = {o[dt][4 * rg], o[dt][4 * rg + 1], o[dt][4 * rg + 2], o[dt][4 * rg + 3]}; f32x4* p = (f32x4*)(ocr + 32 * dt + 8 * rg); *p = *p + v * cw; }
          asm volatile("s_waitcnt vmcnt(0)" ::: "memory"); }
      __syncthreads();
      if (par == 1) { const int l4_ = OPQL(); const int hh_ = l4_ >> 5; bf16* yr = (bf16*)(F.ws + WS_A1 + (size_t)(32 * qbh) * (KS * D) * 2 + (unsigned)(((8 * tgw + ((l4_ & 31) >> 2)) * (KS * D)) * 2));
#pragma unroll
          for (int dt = 0; dt < 4; ++dt)
#pragma unroll
              for (int rg = 0; rg < 4; ++rg) { const f32x4 c4 = *(const f32x4*)(ocr + 32 * dt + 8 * rg); f32x4 v;
#pragma unroll
                  for (int e = 0; e < 4; ++e) v[e] = c4[e] + cw * o[dt][4 * rg + e];
                  storeA4(yr, D, 512 + head * 128 + 32 * dt + 8 * rg + 4 * hh_, v); } } }
    __syncthreads();
#undef OPQL
#undef UNIF
#undef N3_GATE
#undef N3_OCR
#undef N3_KT
#undef N3_VT
#undef N3_COPY
#undef N3_LAND
#undef N3_FOLD
#undef N3_LTOT
}
__device__ __forceinline__ void ph_nsa3(Frame& F, int L) {
    for (int b = F.bid; b < 256; b += F.G) {
#pragma unroll 1
        for (int k = 0; k < 2; ++k) { const int u = k ? 511 - b : b; nsa_unit3(F, L, u >> 1, u & 1); } }
}

__device__ __forceinline__ void ph_xattn_mfma(Frame& F, int L) {
    const int lane = F.lane, q = lane & 31, h = lane >> 5;
    const float* qg = INP(20) + L * 512; const float* kg = INP(21) + L * 512;
    float gm_q = 0.f, gm_k = 0.f;
#pragma unroll
    for (int i = 0; i < 8; ++i) { gm_q = fmaxf(gm_q, fabsf(qg[lane + 64 * i])); gm_k = fmaxf(gm_k, fabsf(kg[lane + 64 * i])); }
    const float bound = 22.627416997969522f * LOG2E * 1.02f * wave_max(gm_q) * wave_max(gm_k);
    const bf16* xqb = WSP(bf16, WS_XQB);
    for (int it = F.bid * 8 + F.wave; it < (T / 32) * 4; it += F.G * 8) {
        const int tg = it >> 2, hd = it & 3, t = 32 * tg + q;
        const bf16x8* qp = (const bf16x8*)(xqb + (size_t)t * D + hd * 512 + 8 * h);
        float ss = 0.f;
#pragma unroll 8
        for (int sp = 0; sp < 32; ++sp) { const v4u wv = __builtin_bit_cast(v4u, qp[2 * sp]);
#pragma unroll
            for (int e = 0; e < 4; ++e) { const float lo = bf2f(wv[e] & 0xffffu), hi = bf2f(wv[e] >> 16); ss += lo * lo + hi * hi; } }
        ss = half_sum(ss);
        const float rs = 1.0f / sqrtf(ss * (1.0f / 512.0f) + EPS);
        const bf16x8* kx = (const bf16x8*)(WSP(bf16, WS_KXF) + (size_t)hd * 8 * 16384) + lane;
        bf16x8 pb[16]; float lsum = 0.f;
#pragma unroll
        for (int kt = 0; kt < 8; ++kt) { f32x16 s = zero16();
#pragma unroll 4
            for (int sp = 0; sp < 32; ++sp) s = MFMA32(kx[(kt * 32 + sp) * 64], qp[2 * sp], s);
#pragma unroll
            for (int R = 0; R < 16; ++R) { const float p = __builtin_amdgcn_exp2f(s[R] * rs - bound); s[R] = p; lsum += p; }
            pb[2 * kt] = pack8(s, 0); pb[2 * kt + 1] = pack8(s, 1); }
        lsum = half_sum(lsum); const float inv = 1.0f / lsum;
        const bf16x8* vx = (const bf16x8*)(WSP(bf16, WS_VXF) + (size_t)hd * 8 * 16384) + lane;
        bf16* yr = WSP(bf16, WS_A1) + (size_t)t * (KS * D);
#pragma unroll 1
        for (int dt = 0; dt < 16; ++dt) { f32x16 o = zero16();
#pragma unroll
            for (int kt = 0; kt < 8; ++kt)
#pragma unroll
                for (int s = 0; s < 2; ++s) o = MFMA32(vx[((kt * 16 + dt) * 2 + s) * 64], pb[2 * kt + s], o);
#pragma unroll
            for (int rg = 0; rg < 4; ++rg) { f32x4 v = {o[4 * rg] * inv, o[4 * rg + 1] * inv, o[4 * rg + 2] * inv, o[4 * rg + 3] * inv}; storeA4(yr, D, hd * 512 + 32 * dt + 8 * rg + 4 * h, v); } }
    }
}
__device__ __forceinline__ bf16x8 ldsfrag(const LAS bf16* p) { return *(const LAS bf16x8*)p; }
__device__ __forceinline__ v4u pack8f(const float (&v)[8]) { v4u o; o.x = cvtpk(v[0], v[1]); o.y = cvtpk(v[2], v[3]); o.z = cvtpk(v[4], v[5]); o.w = cvtpk(v[6], v[7]); return o; }
constexpr int PQ = 136, PV = 72;
__device__ __forceinline__ size_t st_chunk(int c, int h, int e, int doct) { return ((((size_t)(c * 4 + h) * 4 + (e >> 5)) * 8 + (doct >> 1)) * 512) + ((e & 31) + 32 * (doct & 1)) * 8; }

__device__ __forceinline__ void summary_mma(Frame& F, const LAS bf16* AT, const LAS bf16* VT, float* U) {
    const int lane = F.lane, r = lane & 31, h = lane >> 5;
#pragma unroll
    for (int i = 0; i < 2; ++i) { const int tile = F.wave * 2 + i, dt = tile >> 2, et = tile & 3; f32x16 c = zero16();
#pragma unroll
        for (int ks = 0; ks < 4; ++ks) c = MFMA32(ldsfrag(AT + (32 * dt + r) * PV + 16 * ks + 8 * h), ldsfrag(VT + (32 * et + r) * PV + 16 * ks + 8 * h), c);
#pragma unroll
        for (int R = 0; R < 16; ++R) U[(size_t)(32 * dt + (R & 3) + 8 * (R >> 2) + 4 * h) * 128 + 32 * et + r] = c[R]; }
}
__device__ __forceinline__ void fill_vt(Frame& F, const float* vsrc  , LAS bf16* VT) {
    for (int i = F.tid; i < 1024; i += 512) { const int e = i & 127, s0 = (i >> 7) * 8; float v[8];
#pragma unroll
        for (int j = 0; j < 8; ++j) v[j] = vsrc[(size_t)(s0 + j) * NIN + e];
        *(LAS v4u*)(VT + e * PV + s0) = pack8f(v); }
}
__device__ __forceinline__ void hg_summary_mfma(Frame& F, int L, int c, int h) {
    LAS float* B = (LAS float*)F.lds; LAS float* KY = B + 64 * HP; LAS bf16* AT = (LAS bf16*)(KY + 64 * HP); LAS bf16* VT = AT + 128 * PV;
    const float* z = WSP(float, WS_Z);
    hg_gates(F, L, c, h, B, KY);
    for (int i = F.tid; i < 1024; i += 512) { const int d = i & 127, s0 = (i >> 7) * 8; const float be = B[63 * HP + d]; float v[8];
#pragma unroll
        for (int j = 0; j < 8; ++j) v[j] = KY[(s0 + j) * HP + d] * EXPF(be - B[(s0 + j) * HP + d]);
        *(LAS v4u*)(AT + d * PV + s0) = pack8f(v); }
    fill_vt(F, z + (size_t)(64 * c) * NIN + ZC_HGI + h * 128, VT);
    if (F.tid < 128) WSP(float, WS_HGDEC)[(c * 4 + h) * 128 + F.tid] = EXPF(B[63 * HP + F.tid]);
    __syncthreads();
    summary_mma(F, AT, VT, WSP(float, WS_HGU) + (size_t)(c * 4 + h) * 16384);
    __syncthreads();
}
__device__ __forceinline__ void ml_summary_mfma(Frame& F, int L, int c, int h) {
    LAS float* BL = (LAS float*)F.lds; LAS float* LI = BL + 64; LAS float* WS_ = LI + 64; LAS bf16* AT = (LAS bf16*)(WS_ + 64); LAS bf16* VT = AT + 128 * PV; LAS float* KC = (LAS float*)(VT + 128 * PV);
    const float* z = WSP(float, WS_Z); float* mlq = WSP(float, WS_MLQ); float* mlk = WSP(float, WS_MLK); const float* cw = INP(11) + (size_t)L * 4 * 1024;
    ml_gates(F, c, h, BL, LI);
    if (F.tid < 64) { const float a = BL[63] - BL[F.tid] + LI[F.tid]; const float mloc = wave_max(a); WS_[F.tid] = EXPF(a - mloc); if (F.tid == 0) { float* msc = WSP(float, WS_MLSC); msc[c * 4 + h] = mloc; msc[NCH * 4 + c * 4 + h] = BL[63]; } }
    { const int d = F.tid & 127; const float wq0 = cw[h * 128 + d], wq1 = cw[1024 + h * 128 + d], wq2 = cw[2048 + h * 128 + d], wq3 = cw[3072 + h * 128 + d];
      const float wk0 = cw[512 + h * 128 + d], wk1 = cw[1536 + h * 128 + d], wk2 = cw[2560 + h * 128 + d], wk3 = cw[3584 + h * 128 + d];
#pragma unroll 1
      for (int s = F.tid >> 7; s < 64; s += 4) { const int t = 64 * c + s; const float* zq = z + (size_t)t * NIN + ZC_MLQ + h * 128 + d; const float* zk = z + (size_t)t * NIN + ZC_MLK + h * 128 + d;
          const long b1 = (t >= 1) ? -(long)NIN : 0, b2 = (t >= 2) ? -2L * NIN : 0, b3 = (t >= 3) ? -3L * NIN : 0;
          const float f1 = (t >= 1) ? 1.f : 0.f, f2 = (t >= 2) ? 1.f : 0.f, f3 = (t >= 3) ? 1.f : 0.f;
          const float q0 = zq[0], q1 = zq[b1], q2 = zq[b2], q3 = zq[b3], k0_ = zk[0], k1_ = zk[b1], k2_ = zk[b2], k3_ = zk[b3];
          float aq = wq3 * q0 + f1 * wq2 * q1 + f2 * wq1 * q2 + f3 * wq0 * q3, ak = wk3 * k0_ + f1 * wk2 * k1_ + f2 * wk1 * k2_ + f3 * wk0 * k3_;
          aq = siluf_(aq) * 0.08838834764831845f; ak = siluf_(ak);
          mlq[(size_t)t * 512 + h * 128 + d] = aq; mlk[(size_t)t * 512 + h * 128 + d] = ak; KC[s * HP + d] = ak; } }
    __syncthreads();
    for (int i = F.tid; i < 1024; i += 512) { const int d = i & 127, s0 = (i >> 7) * 8; float v[8];
#pragma unroll
        for (int j = 0; j < 8; ++j) v[j] = KC[(s0 + j) * HP + d] * WS_[s0 + j];
        *(LAS v4u*)(AT + d * PV + s0) = pack8f(v); }
    fill_vt(F, z + (size_t)(64 * c) * NIN + ZC_MLV + h * 128, VT);
    if (F.tid < 128) { float a = 0.f; for (int s = 0; s < 64; ++s) a += KC[s * HP + F.tid] * WS_[s]; WSP(float, WS_MLNL)[(c * 4 + h) * 128 + F.tid] = a; }
    __syncthreads();
    summary_mma(F, AT, VT, WSP(float, WS_MLU) + (size_t)(c * 4 + h) * 16384);
    __syncthreads();
}


__device__ __forceinline__ void ph_scan_v2(Frame& F, int nblk, int nw) {
    const float* msc = WSP(float, WS_MLSC);
    const bool main_ = F.bid < nblk;
    const bool nst_ = (nw < 8) ? (main_ && F.wave == nw) : (F.bid >= nblk && F.bid < nblk + 8 && F.wave == 0); const int nsb_ = (nw < 8) ? F.bid : F.bid - nblk;
    if (main_ && F.wave < nw) for (int id = (F.bid * nw + F.wave) * 64 + F.lane; id < 32768; id += nblk * nw * 64) { const bool ml = id >= 16384; const int i = id & 16383, h = i >> 12, dq = (i >> 7) & 31, e = i & 127;
        const float* U = WSP(float, ml ? WS_MLU : WS_HGU) + (size_t)h * 16384 + (size_t)(4 * dq) * 128 + e; bf16* ST = WSP(bf16, ml ? WS_MLST : WS_HGST);
        const float* dec = WSP(float, WS_HGDEC) + h * 128 + 4 * dq;
        float st[4] = {0.f, 0.f, 0.f, 0.f}; float m = 0.f;
#pragma unroll 1
        for (int c0 = 0; c0 < NCH; c0 += 8) { float u[8][4], dk[8][4];
#pragma unroll
            for (int cc = 0; cc < 8; ++cc)
#pragma unroll
                for (int j = 0; j < 4; ++j) { u[cc][j] = U[(size_t)(c0 + cc) * 65536 + j * 128]; dk[cc][j] = ml ? 0.f : dec[(c0 + cc) * 512 + j]; }
#pragma unroll
            for (int cc = 0; cc < 8; ++cc) { const int c = c0 + cc;
                { v2u pk; pk.x = cvtpk(st[0], st[1]); pk.y = cvtpk(st[2], st[3]); *(v2u*)(ST + st_chunk(c, h, e, dq >> 1) + 4 * (dq & 1)) = pk; }
                if (ml) { const float mloc = msc[c * 4 + h], bend = msc[NCH * 4 + c * 4 + h]; const float mn = fmaxf(bend + m, mloc); const float fa = EXPF(bend + m - mn), fb = EXPF(mloc - mn); m = mn;
#pragma unroll
                    for (int j = 0; j < 4; ++j) st[j] = fa * st[j] + fb * u[cc][j]; }
                else {
#pragma unroll
                    for (int j = 0; j < 4; ++j) st[j] = dk[cc][j] * st[j] + u[cc][j]; } } } }
    const int gt = F.bid * 512 + F.tid, NGT = nblk * 512;
    if (nst_) for (int i = nsb_ * 64 + F.lane; i < 512; i += 512) { const int h = i >> 7, d = i & 127; const float* nl = WSP(float, WS_MLNL); float* ns = WSP(float, WS_MLN); float st = 0.f, m = 0.f;
        for (int c = 0; c < NCH; ++c) { const int o = (c * 4 + h) * 128 + d; ns[o] = st; const float mloc = msc[c * 4 + h], bend = msc[NCH * 4 + c * 4 + h]; const float mn = fmaxf(bend + m, mloc);
            st = EXPF(bend + m - mn) * st + EXPF(mloc - mn) * nl[o]; m = mn; } }
    if (main_) for (int i = gt; i < 4; i += NGT) { float* mp = WSP(float, WS_MLSC) + 2 * NCH * 4; float m = 0.f;
        for (int c = 0; c < NCH; ++c) { mp[c * 4 + i] = m; m = fmaxf(msc[NCH * 4 + c * 4 + i] + m, msc[c * 4 + i]); } }
}

template <bool SILU>
__device__ __forceinline__ void finish_tile(Frame& F, const f32x16& o, LAS float* PART, const float* gain, const float* gate_base  , int ycol, int c) {
    const int lane = F.lane, r = lane & 31, h = lane >> 5, et = F.wave & 3, tt = F.wave >> 2, t = 32 * tt + r;
    float ss = 0.f;
#pragma unroll
    for (int R = 0; R < 16; ++R) ss += o[R] * o[R];
    ss = half_sum(ss);
    if (h == 0) PART[t * 4 + et] = ss;
    __syncthreads();
    const f32x4 p4 = *(const LAS f32x4*)(PART + t * 4); const float rs = 1.0f / sqrtf(((p4[0] + p4[1]) + (p4[2] + p4[3])) * (1.0f / 128.0f) + EPS);
    bf16* yr = WSP(bf16, WS_A1) + (size_t)(64 * c + t) * (KS * D); const float* gr = gate_base + (size_t)t * NIN;
#pragma unroll
    for (int rg = 0; rg < 4; ++rg) { const int e = 32 * et + 8 * rg + 4 * h; const f32x4 gv = *(const f32x4*)(gr + e), gn = *(const f32x4*)(gain + e); f32x4 v;
#pragma unroll
        for (int q = 0; q < 4; ++q) v[q] = o[4 * rg + q] * rs * gn[q] * (SILU ? siluf_(gv[q]) : sigm(gv[q]));
        storeA4(yr, D, ycol + e, v); }
}
__device__ __forceinline__ void hg_output_mfma(Frame& F, int L, int c, int h) {
    LAS float* B = (LAS float*)F.lds; LAS float* KY = B + 64 * HP; LAS bf16* QA = (LAS bf16*)(KY + 64 * HP); LAS bf16* KA = QA + 64 * PQ; LAS bf16* QE = KA + 64 * PQ; LAS bf16* VT = QE + 64 * PQ; LAS float* PART = (LAS float*)(VT + 128 * PV);
    const float* z = WSP(float, WS_Z);
    hg_gates(F, L, c, h, B, KY);
    for (int i = F.tid; i < 1024; i += 512) { const int t = i >> 4, d0 = (i & 15) * 8; const float* qs = z + (size_t)(64 * c + t) * NIN + ZC_HGQ + h * 128 + d0; const f32x4 qa = *(const f32x4*)qs, qb = *(const f32x4*)(qs + 4);
        float vq[8], vk[8], ve[8];
#pragma unroll
        for (int j = 0; j < 8; ++j) { const float b = B[t * HP + d0 + j], br = B[31 * HP + d0 + j], qv = (j < 4) ? qa[j & 3] : qb[j & 3];
            vq[j] = qv * EXPF(fminf(fmaxf(b - br, -80.f), 80.f)); vk[j] = KY[t * HP + d0 + j] * EXPF(fminf(fmaxf(br - b, -80.f), 80.f)); ve[j] = qv * EXPF(b); }
        *(LAS v4u*)(QA + t * PQ + d0) = pack8f(vq); *(LAS v4u*)(KA + t * PQ + d0) = pack8f(vk); *(LAS v4u*)(QE + t * PQ + d0) = pack8f(ve); }
    fill_vt(F, z + (size_t)(64 * c) * NIN + ZC_HGI + h * 128, VT);
    __syncthreads();
    const int lane = F.lane, r = lane & 31, hh = lane >> 5, et = F.wave & 3, tt = F.wave >> 2, t = 32 * tt + r;
    f32x16 o = zero16();
#pragma unroll
    for (int st = 0; st <= 1; ++st) { if (st <= tt) { f32x16 sc = zero16();
#pragma unroll
        for (int kd = 0; kd < 8; ++kd) sc = MFMA32(ldsfrag(KA + (32 * st + swap23(r)) * PQ + 16 * kd + 8 * hh), ldsfrag(QA + t * PQ + 16 * kd + 8 * hh), sc);
#pragma unroll
        for (int R = 0; R < 16; ++R) { const int s = 32 * st + 16 * (R >> 3) + 8 * hh + (R & 7); sc[R] = (s <= t) ? sc[R] : 0.f; }
        bf16x8 pb[2]; pb[0] = pack8(sc, 0); pb[1] = pack8(sc, 1);
#pragma unroll
        for (int ks = 0; ks < 2; ++ks) o = MFMA32(ldsfrag(VT + (32 * et + r) * PV + 32 * st + 16 * ks + 8 * hh), pb[ks], o); } }
    { const bf16x8* sp = (const bf16x8*)(WSP(bf16, WS_HGST) + (((size_t)(c * 4 + h) * 4 + et) * 8) * 512) + lane;
#pragma unroll
      for (int kd = 0; kd < 8; ++kd) o = MFMA32(sp[kd * 64], ldsfrag(QE + t * PQ + 16 * kd + 8 * hh), o); }
    finish_tile<true>(F, o, PART, INP(6) + L * 512 + h * 128, z + (size_t)(64 * c) * NIN + ZC_HGG + h * 128, h * 128, c);
    __syncthreads();
}
__device__ __forceinline__ void ml_output_mfma(Frame& F, int L, int c, int h) {
    LAS float* BL = (LAS float*)F.lds; LAS float* LI = BL + 64; LAS float* MT = LI + 64; LAS float* WI = MT + 64; LAS float* QNN = WI + 64; LAS float* PART = QNN + 64;
    LAS bf16* QA = (LAS bf16*)(PART + 256); LAS bf16* KA = QA + 64 * PQ; LAS bf16* VT = KA + 64 * PQ;
    const float* z = WSP(float, WS_Z); const float* mlq = WSP(float, WS_MLQ); const float* mlk = WSP(float, WS_MLK);
    ml_gates(F, c, h, BL, LI);
    const float mprev = WSP(float, WS_MLSC)[2 * NCH * 4 + c * 4 + h];
    for (int i = F.tid; i < 1024; i += 512) { const int t = i >> 4, d0 = (i & 15) * 8; const float* qs = mlq + (size_t)(64 * c + t) * 512 + h * 128 + d0; const float* ks = mlk + (size_t)(64 * c + t) * 512 + h * 128 + d0;
        const f32x4 qa = *(const f32x4*)qs, qb = *(const f32x4*)(qs + 4), ka = *(const f32x4*)ks, kb = *(const f32x4*)(ks + 4);
        float vq[8] = {qa[0], qa[1], qa[2], qa[3], qb[0], qb[1], qb[2], qb[3]}, vk[8] = {ka[0], ka[1], ka[2], ka[3], kb[0], kb[1], kb[2], kb[3]};
        *(LAS v4u*)(QA + t * PQ + d0) = pack8f(vq); *(LAS v4u*)(KA + t * PQ + d0) = pack8f(vk); }
    fill_vt(F, z + (size_t)(64 * c) * NIN + ZC_MLV + h * 128, VT);
    if (F.tid < 64) { const int t = F.tid; const float inter = BL[t] + mprev; float mt = inter; for (int s = 0; s <= t; ++s) mt = fmaxf(mt, BL[t] - BL[s] + LI[s]); MT[t] = mt; WI[t] = EXPF(inter - mt);
    }
    { const int t = F.tid >> 3, p = F.tid & 7; const float* nst = WSP(float, WS_MLN) + (c * 4 + h) * 128 + 16 * p; const float* qs = mlq + (size_t)(64 * c + t) * 512 + h * 128 + 16 * p; float a = 0.f;
#pragma unroll
      for (int d = 0; d < 16; ++d) a += qs[d] * nst[d];
      a += sxor<1>(a); a += sxor<2>(a); a += sxor<4>(a); if (p == 0) QNN[t] = a; }
    __syncthreads();
    const int lane = F.lane, r = lane & 31, hh = lane >> 5, et = F.wave & 3, tt = F.wave >> 2, t = 32 * tt + r;
    const float mt = MT[t], wi = WI[t], blt = BL[t];
    f32x16 o = zero16(); float rsum = 0.f;
#pragma unroll
    for (int st = 0; st <= 1; ++st) { if (st <= tt) { f32x16 sc = zero16();
#pragma unroll
        for (int kd = 0; kd < 8; ++kd) sc = MFMA32(ldsfrag(KA + (32 * st + swap23(r)) * PQ + 16 * kd + 8 * hh), ldsfrag(QA + t * PQ + 16 * kd + 8 * hh), sc);
#pragma unroll
        for (int R = 0; R < 16; ++R) { const int s = 32 * st + 16 * (R >> 3) + 8 * hh + (R & 7); const float wgt = (s <= t) ? EXPF(blt - BL[s] + LI[s] - mt) : 0.f; sc[R] = sc[R] * wgt; rsum += sc[R]; }
        bf16x8 pb[2]; pb[0] = pack8(sc, 0); pb[1] = pack8(sc, 1);
#pragma unroll
        for (int ks = 0; ks < 2; ++ks) o = MFMA32(ldsfrag(VT + (32 * et + r) * PV + 32 * st + 16 * ks + 8 * hh), pb[ks], o); } }
    rsum = half_sum(rsum);
    f32x16 oi = zero16();
    { const bf16x8* sp = (const bf16x8*)(WSP(bf16, WS_MLST) + (((size_t)(c * 4 + h) * 4 + et) * 8) * 512) + lane;
#pragma unroll
      for (int kd = 0; kd < 8; ++kd) oi = MFMA32(sp[kd * 64], ldsfrag(QA + t * PQ + 16 * kd + 8 * hh), oi); }
    const float qn = wi * QNN[t] + rsum; const float den = 1.0f / fmaxf(fabsf(qn), EXPF(-mt));
#pragma unroll
    for (int R = 0; R < 16; ++R) o[R] = (o[R] + wi * oi[R]) * den;
    finish_tile<false>(F, o, PART, INP(12) + L * 512 + h * 128, z + (size_t)(64 * c) * NIN + ZC_MLO + h * 128, 1536 + h * 128, c);
    __syncthreads();
}

__device__ __forceinline__ void cmp_item_mfma(Frame& F, int L, int item) {
    const int which = item & 1, g = (item >> 1) & 1, rt = item >> 2, c0 = 32 * rt;
    const int lane = F.lane, r = lane & 31, hh = lane >> 5, ct = F.wave & 3, kh = F.wave >> 2;
    LAS float* PARTC = (LAS float*)F.lds;
    LAS float* O = PARTC + 4096;
    const float* z = WSP(float, WS_Z); const int zc = (which ? ZC_NVC : ZC_NKC) + g * 128;
    const float* pe = INP(9) + ((size_t)(L * 2 + which) * 32) * 128;
    const bf16x8* wf = (const bf16x8*)(WSL(bf16, WS_WCF) + ((size_t)(which * 4 + ct) * 256) * 512) + lane;
    f32x16 acc = zero16();
    for (int l = 16 * kh; l < 16 * kh + 16; ++l) { int tok = 16 * (c0 + r) + l; const bool ok = tok < T; if (!ok) tok = T - 1; const float* zr = z + (size_t)tok * NIN + zc + 8 * hh; const float* pr = pe + l * 128 + 8 * hh;
#pragma unroll
        for (int sp = 0; sp < 8; ++sp) { const f32x4 a = *(const f32x4*)(zr + 16 * sp), b = *(const f32x4*)(zr + 16 * sp + 4), pa = *(const f32x4*)(pr + 16 * sp), pb = *(const f32x4*)(pr + 16 * sp + 4);
            float v[8];
#pragma unroll
            for (int j = 0; j < 4; ++j) { v[j] = ok ? a[j] + pa[j] : 0.f; v[4 + j] = ok ? b[j] + pb[j] : 0.f; }
            acc = MFMA32(__builtin_bit_cast(bf16x8, pack8f(v)), wf[(8 * l + sp) * 64], acc); } }
    if (kh == 1) {
#pragma unroll
        for (int R = 0; R < 16; ++R) PARTC[(ct * 16 + R) * 64 + lane] = acc[R]; }
    __syncthreads();
    if (kh == 0) {
#pragma unroll
        for (int R = 0; R < 16; ++R) O[((R & 3) + 8 * (R >> 2) + 4 * hh) * HP + 32 * ct + r] = acc[R] + PARTC[(ct * 16 + R) * 64 + lane]; }
    __syncthreads();
    if (!which) { const float* kg = INP(8) + L * 384;
        for (int rr = 0; rr < 4; ++rr) { const int cl = 4 * F.wave + rr, c = c0 + cl; const float o1 = O[cl * HP + lane], o2 = O[cl * HP + lane + 64];
            const float ss = wave_sum(o1 * o1 + o2 * o2); const float rs = 1.0f / sqrtf(ss * (1.0f / 128.0f) + EPS);
            const float y1 = o1 * rs * kg[lane], y2 = o2 * rs * kg[lane + 64]; const int pos = (c < NCMP) ? 16 * c + 31 : 0; const float cs = WSP(float, WS_COS)[pos * 64 + lane], sn = WSP(float, WS_SIN)[pos * 64 + lane];
            const float r1 = y1 * cs - y2 * sn, r2 = y2 * cs + y1 * sn;
            bf16* kcf = WSP(bf16, WS_KCF) + (size_t)g * 16 * 4096 + (size_t)rt * 4096;
            { const int d = lane; kcf[(d >> 4) * 512 + (swap23(cl) + 32 * ((d >> 3) & 1)) * 8 + (d & 7)] = (bf16)f2bf(r1); }
            { const int d = lane + 64; kcf[(d >> 4) * 512 + (swap23(cl) + 32 * ((d >> 3) & 1)) * 8 + (d & 7)] = (bf16)f2bf(r2); } } }
    else { const int d = F.tid & 127, cg = F.tid >> 7; float v[8];
#pragma unroll
        for (int j = 0; j < 8; ++j) v[j] = O[(8 * cg + j) * HP + d];
        *(v4u*)(WSP(bf16, WS_VCF) + (size_t)g * 16 * 4096 + (size_t)rt * 4096 + ((d >> 5) * 2 + (cg >> 1)) * 512 + ((d & 31) + 32 * (cg & 1)) * 8) = pack8f(v); }
    __syncthreads();
}
__device__ __forceinline__ void wcf_item(Frame& F, int L, size_t wo, int item) {
    const int which = item >> 10, ct = (item >> 8) & 3, ks = item & 255, l = ks >> 3, sp = ks & 7, lane = F.lane, r = lane & 31, hh = lane >> 5;
    const float* w = INP(10) + (((size_t)(L * 2 + which) * 32 + l) * 128 + 16 * sp + 8 * hh) * 128 + 32 * ct + r; float v[8];
#pragma unroll
    for (int j = 0; j < 8; ++j) v[j] = w[j * 128];
    *(v4u*)(WSO(bf16, WS_WCF, wo) + ((size_t)((which * 4 + ct) * 256 + ks)) * 512 + lane * 8) = pack8f(v);
}
#ifndef SPLITB
#define SPLITB 1
#endif
#ifndef K5SQ
#define K5SQ 64
#endif
#ifndef K5A
#define K5A 265
#endif
#ifndef K5CUT
#define K5CUT 120
#endif
#ifndef K5S
#define K5S 100
#endif
#ifndef K5TO
#define K5TO 19
#endif
#ifndef K5TAB
#define K5TAB 1
#endif
#ifndef K5A0T
#define K5A0T 300
#endif
#ifndef K5CUT0
#define K5CUT0 128
#endif
struct K5Deal { unsigned short o[2][257]; unsigned cf[2][257]; };
constexpr K5Deal make_k5deal() {
    K5Deal d{};
    for (int cls = 0; cls < 2; ++cls) {
        long s[256] = {}; long tot = 0;
        for (int j = 0; j < 256; ++j) { const int q = j >> 1; long w = (cls ? K5A : K5A0T) - 2 * q - ((q < K5SQ) ? K5S : 0); if (q >= (cls ? K5CUT : K5CUT0) || w < 0) w = 0; s[j] = w; tot += w; }
        long cw = 0;
        for (int j = 0; j < 256; ++j) { d.o[cls][j] = (unsigned short)(1024 * cw / tot); cw += s[j]; }
        d.o[cls][256] = 1024;
        const long NC = (WC_NALL - K1_CONV - K4_CONV) + (cls == 0 ? WC_DEF_N : 0), W = 1024L * K5TO + NC;
        long r[256] = {}; long rtot = 0;
        for (int j = 0; j < 256; ++j) { const long outs = d.o[cls][j + 1] - d.o[cls][j]; long v = (s[j] * W * 16) / tot - outs * K5TO * 16; if (v < 0) v = 0; r[j] = v; rtot += v; }
        long cum = 0;
        for (int j = 0; j < 256; ++j) { d.cf[cls][j] = (unsigned)((cum << 20) / rtot); cum += r[j]; }
        d.cf[cls][256] = 1u << 20;
    }
    return d;
}
__device__ const K5Deal K5DEAL = make_k5deal();

typedef KArgs Args;
__global__ void __launch_bounds__(512, 2) fwd(Args args) {
    extern __shared__ __attribute__((aligned(16))) unsigned char lds[];
    Frame F;
    F.lds = (LAS unsigned char*)lds; F.MISC = (volatile LAS unsigned*)(F.lds + MISC_OFF);
    F.tid = threadIdx.x; F.lane = F.tid & 63; F.wave = __builtin_amdgcn_readfirstlane(F.tid >> 6); F.G = gridDim.x; F.bid = blockIdx.x;
    F.ap = (const KArgs __attribute__((address_space(4)))*)__builtin_amdgcn_kernarg_segment_ptr();
    F.ws = args.ws; F.ctl = (gu32*)(args.ws + WS_CTL);
    for (int u = F.tid; u < (LDS_BYTES - MISC_OFF) / 4; u += 512) ((LAS unsigned*)(F.lds + MISC_OFF))[u] = 0u;
    __syncthreads();
    const int lo = args.ph_lo, hi = args.ph_hi;
    XcdBarrier bar; bar.bar = (unsigned*)(F.ctl + CW_BAR) + args.li * XCD_BAR_WORDS; bar.x = 0; bar.st = nullptr;
    if (hi - lo > 1) bar = xcd_barrier_post((unsigned*)(F.ctl + CW_BAR) + args.li * XCD_BAR_WORDS, F.MISC + 8);
#if 1
#define IN(k) (lo <= (k) && (k) < hi)
#define SEAM(k) do { if (IN((k) + 1)) xcd_barrier(bar); } while (0)
#else
#define IN(k) 1
#define SEAM(k) do { if ((k) + 1 < NPHASES) xcd_barrier(bar); } while (0)
#endif
    LAS unsigned char* glds = F.lds;

#ifndef PHMASK
#define PHMASK 0x1fff
#endif
#define PHON(kk) (((PHMASK) >> (kk)) & 1)
#ifndef SPLITB
#define SPLITB 1
#endif
#ifndef K5SQ
#define K5SQ 64
#endif
#ifndef DEFER0
#define DEFER0 1
#endif
#ifndef DBLMASK
#define DBLMASK 0
#endif
#define NREP(kk) (1 + (((DBLMASK) >> (kk)) & 1))
    if (PHON(12) && IN(0)) { LAUNDER(); ph_prologue(F); SEAM(0); }
    for (int L = 0; L < DEPTH; ++L) {
        const int pb = 1 + L * NPH;
        F.wofs = WOVL ? (size_t)(L & 1) * WS_WSET : 0;
        if (PHON(0) && IN(pb + 0) && (!WOVL || L == 0)) for (int rep = 0; rep < NREP(0); ++rep) { LAUNDER(); if (rep) xcd_barrier(bar);
            { const bool df_ = WOVL && DEFER0 && F.G == 256 && NSA_V2 == 1; const int n0_ = df_ ? WC_NALL - WC_DEF_N : WC_NALL;
              const int per = (n0_ + F.G - 1) / F.G, lo_ = F.bid * per, hi_ = (lo_ + per < n0_) ? lo_ + per : n0_; ph_wconv(F, L, F.wofs, lo_, hi_, df_ ? WC_DEF_LO : (1 << 30), WC_DEF_N); }
            __syncthreads(); SEAM(pb + 0); }
        if (PHON(1) && IN(pb + 1)) for (int rep = 0; rep < NREP(1); ++rep) { LAUNDER(); if (rep) xcd_barrier(bar);
            { pg8::Gemm g{WSP(pg8::bf16_t, WS_A0), WSL(pg8::bf16_t, WS_WIN), T, NIN, KS * D}; pg8::StaticOrder S; S.init(T, NIN, F.G, F.bid);
              pg8::rs_table_fill(glds, S, WSP(float, WS_SSQA), T, 1.0f / D, EPS, F.wave);
              pg8::EpiScaleF32 E{WSP(float, WS_Z), NIN, WSL(float, WS_BPERM), WSP(float, WS_SSQA), 32, glds, 1.0f / D, EPS};
              pg8::gemm_phase<pg8::EpiScaleF32, pg8::StaticOrder, PG8_ALIGN, PG8_SP2>(glds, g, S, E, F.wave); }
            { pg8::Gemm g{WSP(pg8::bf16_t, WS_MEMB), WSL(pg8::bf16_t, WS_WKV), MEM, 2 * D, KS * D}; pg8::StaticOrder S; S.init(MEM, 2 * D, F.G, (F.bid + F.G - (F.G > 116 ? 100 : 0)) % F.G);
              pg8::EpiScaleF32 E{WSP(float, WS_KVX), 2 * D, nullptr, WSP(float, WS_SSQM), 1, glds, 1.0f / D, EPS};
              pg8::gemm_phase<pg8::EpiScaleF32, pg8::StaticOrder, PG8_ALIGN, PG8_SP2>(glds, g, S, E, F.wave); }
#if WOVL
            if (L + 1 < DEPTH && F.G == 256 && F.bid >= 116) { LAUNDER(); const int lo_ = (F.bid - 116) * K1_PER, hi_ = lo_ + K1_PER; ph_wconv(F, L + 1, (size_t)((L + 1) & 1) * WS_WSET, lo_, hi_); __syncthreads(); }
#endif
            SEAM(pb + 1); }
#if ORACLE_MIX
        if (PHON(2) && IN(pb + 2)) { LAUNDER(); ph_prep(F, L, 0); __syncthreads(); SEAM(pb + 2); }
#endif
        if (PHON(3) && IN(pb + 3)) for (int rep = 0; rep < NREP(3); ++rep) { LAUNDER(); if (rep) xcd_barrier(bar);
#if ORACLE_MIX
            for (int it = F.bid; it < 512; it += F.G) hg_summary_item(F, L, it >> 2, it & 3);
            for (int it = F.bid; it < 512; it += F.G) ml_summary_item(F, it >> 2, it & 3);
            for (int it = F.bid; it < 256; it += F.G) cmp_item(F, L, it);
#else
            { const bool g256 = (F.G == 256), cmpwg = g256 && F.bid >= 192;
              const int c_lo = g256 ? (cmpwg ? F.bid - 192 : 64) : F.G - 1 - F.bid, c_st = g256 ? 64 : F.G;
              const int s_lo = g256 ? (cmpwg ? 960 + F.bid - 192 : 5 * F.bid) : F.bid, s_hi = g256 ? s_lo + (cmpwg ? 1 : 5) : 1024, s_st = g256 ? 1 : F.G;
#pragma unroll 1
              for (int it = c_lo; it < 64; it += c_st) cmp_item_mfma(F, L, it);
              LAUNDER();
#pragma unroll 1
              for (int it = s_lo; it < s_hi; it += s_st) { if (it < 512) hg_summary_mfma(F, L, it >> 2, it & 3); else ml_summary_mfma(F, L, (it - 512) >> 2, it & 3); } }
#if SPLITB
            __syncthreads(); LAUNDER(); ph_prep(F, L, 0); __syncthreads();
#endif
#endif
            SEAM(pb + 3); }
        if (PHON(4) && IN(pb + 4)) for (int rep = 0; rep < NREP(4); ++rep) { LAUNDER(); if (rep) xcd_barrier(bar);
#if ORACLE_MIX
            ph_scan(F);
#else
#if SPLITB
            if (F.G == 256) { ph_scan_v2(F, 2 * K5SQ, (K5SQ == 32) ? 8 : 4);
#if WOVL
                if (K4_PER > 0 && L + 1 < DEPTH && F.bid < 128) { LAUNDER(); const int lo_ = K1_CONV + F.bid * K4_PER; ph_wconv(F, L + 1, (size_t)((L + 1) & 1) * WS_WSET, lo_, lo_ + K4_PER, 1 << 30, 0, 5); }
#endif
                xcd_barrier_arrive(bar); }
            else { ph_scan_v2(F, F.G, 2); __syncthreads(); xcd_barrier(bar); }
#else
            ph_scan_v2(F, F.G, 2); LAUNDER(); ph_prep(F, L, 3);
#endif
#endif
#if !SPLITB
            __syncthreads(); SEAM(pb + 4);
#endif
            }
        if (PHON(5) && IN(pb + 5)) for (int rep = 0; rep < NREP(5); ++rep) { LAUNDER(); if (rep) xcd_barrier(bar);
#if ORACLE_MIX
#define HG_OUT hg_output_item
#define ML_OUT ml_output_item
#else
#define HG_OUT hg_output_mfma
#define ML_OUT ml_output_mfma
#endif
#ifndef P5MASK
#define P5MASK 7
#endif
#ifndef P5DBL
#define P5DBL 0
#endif
            const bool g256_ = (F.G == 256) && (NSA_V2 == 1); const int q5_ = F.bid >> 1, r5_ = F.bid & 1;
#ifndef K5A
#define K5A 265
#endif
#ifndef K5A0
#define K5A0 265
#endif
#ifndef K5CUT
#define K5CUT 120
#endif
#ifndef K5S
#define K5S 100
#endif
            long cwa_ = 0, K5TOT = 0;
            const int k5a_ = (DEFER0 && L == 0) ? K5A0 : K5A;
#pragma unroll 1
            for (int qq = 0; qq < 128; ++qq) { const int wr_ = k5a_ - 2 * qq - ((SPLITB && qq < K5SQ) ? K5S : 0), wq_ = (qq >= K5CUT || wr_ < 0) ? 0 : wr_; if (qq < q5_) cwa_ += 2 * wq_; else if (qq == q5_) cwa_ += r5_ * wq_; K5TOT += 2 * wq_; }
            const int wm_ = k5a_ - 2 * q5_ - ((SPLITB && q5_ < K5SQ) ? K5S : 0); const long cwb_ = cwa_ + ((q5_ >= K5CUT || wm_ < 0) ? 0 : wm_);
#if !SPLITB
            { const int o_lo = g256_ ? ((SPLITB && K5TAB) ? (int)K5DEAL.o[(DEFER0 && L == 0) ? 0 : 1][F.bid] : (int)(1024L * cwa_ / K5TOT)) : F.bid, o_hi = g256_ ? ((SPLITB && K5TAB) ? (int)K5DEAL.o[(DEFER0 && L == 0) ? 0 : 1][F.bid + 1] : (int)(1024L * cwb_ / K5TOT)) : 1024, o_st = g256_ ? 1 : F.G;
#pragma unroll 1
              for (int r5 = 0; r5 < 1 + (P5DBL & 1); ++r5)
#pragma unroll 1
                for (int it = o_lo; it < o_hi; it += o_st) { LAUNDER(); if (it < 512) { if (P5MASK & 1) HG_OUT(F, L, it >> 2, it & 3); } else { if (P5MASK & 2) ML_OUT(F, L, (it - 512) >> 2, it & 3); } } }
#endif
#if ORACLE_ATTN
            if (P5MASK & 4) { ph_nsa(F, L); __syncthreads(); }
#else
            LAUNDER();
            if (P5MASK & 4) for (int r5 = 0; r5 < 1 + ((P5DBL >> 2) & 1); ++r5) {
#if NSA_V2 == 2
                ph_nsa3(F, L);
#elif NSA_V2
                ph_nsa_block(F, L);
#else
                ph_nsa_mfma(F, L);
#endif
                __syncthreads(); }
#if SPLITB
            LAUNDER(); if (F.G == 256) xcd_barrier_wait(bar);
            LAUNDER();
            { const int o_lo = g256_ ? ((SPLITB && K5TAB) ? (int)K5DEAL.o[(DEFER0 && L == 0) ? 0 : 1][F.bid] : (int)(1024L * cwa_ / K5TOT)) : F.bid, o_hi = g256_ ? ((SPLITB && K5TAB) ? (int)K5DEAL.o[(DEFER0 && L == 0) ? 0 : 1][F.bid + 1] : (int)(1024L * cwb_ / K5TOT)) : 1024, o_st = g256_ ? 1 : F.G;
#pragma unroll 1
              for (int r5 = 0; r5 < 1 + (P5DBL & 1); ++r5)
#pragma unroll 1
                for (int it = o_lo; it < o_hi; it += o_st) { LAUNDER(); if (it < 512) { if (P5MASK & 1) HG_OUT(F, L, it >> 2, it & 3); } else { if (P5MASK & 2) ML_OUT(F, L, (it - 512) >> 2, it & 3); } } }
            __syncthreads();
#endif
#if WOVL
            if (g256_) {
#pragma unroll 1
                for (int s5 = (DEFER0 && L == 0) ? 0 : 1; s5 < 2 && L + s5 < DEPTH; ++s5) { LAUNDER();
                    const int c0_ = s5 ? K1_CONV + (SPLITB ? K4_CONV : 0) : WC_DEF_LO, n5_ = s5 ? WC_NALL - K1_CONV - (SPLITB ? K4_CONV : 0) : WC_DEF_N; const int cl_ = (DEFER0 && L == 0) ? 0 : 1; const int lo_ = c0_ + ((SPLITB && K5TAB) ? (int)(((long)n5_ * K5DEAL.cf[cl_][F.bid]) >> 20) : (int)((long)n5_ * cwa_ / K5TOT)), hi_ = c0_ + ((SPLITB && K5TAB) ? (int)(((long)n5_ * K5DEAL.cf[cl_][F.bid + 1]) >> 20) : (int)((long)n5_ * cwb_ / K5TOT));
                    ph_wconv(F, L + s5, (size_t)((L + s5) & 1) * WS_WSET, lo_, hi_); __syncthreads(); } }
            else if (L + 1 < DEPTH) { LAUNDER(); const int per = (WC_NALL + F.G - 1) / F.G, lo_ = F.bid * per, hi_ = (lo_ + per < WC_NALL) ? lo_ + per : WC_NALL; ph_wconv(F, L + 1, (size_t)((L + 1) & 1) * WS_WSET, lo_, hi_); __syncthreads(); }
#endif
#endif
            SEAM(pb + 5); }
        if (PHON(6) && IN(pb + 6)) { LAUNDER(); pg8::Gemm g{WSP(pg8::bf16_t, WS_A1), WSL(pg8::bf16_t, WS_WOUT), T, D, KS * D}; pg8::StaticOrder S; S.init(T, D, F.G, F.bid);
            pg8::EpiResid E{L == 0 ? INP(0) : OUTP, OUTP, WSP(pg8::bf16_t, WS_A0), WSP(float, WS_SSQB), D, T};
            pg8::gemm_phase<pg8::EpiResid, pg8::StaticOrder, PG8_ALIGN, PG8_SP2>(glds, g, S, E, F.wave); SEAM(pb + 6); }
        if (PHON(7) && IN(pb + 7)) for (int rep = 0; rep < NREP(7); ++rep) { LAUNDER(); if (rep) xcd_barrier(bar); pg8::Gemm g{WSP(pg8::bf16_t, WS_A0), WSL(pg8::bf16_t, WS_WQ), T, D, KS * D}; pg8::StaticOrder S; S.init(T, D, F.G, F.bid);
#if ORACLE_ATTN
            pg8::rs_table_fill(glds, S, WSP(float, WS_SSQB), T, 1.0f / D, EPS, F.wave);
            pg8::EpiScaleF32 E{WSP(float, WS_XQ), D, nullptr, WSP(float, WS_SSQB), 32, glds, 1.0f / D, EPS};
            pg8::gemm_phase<pg8::EpiScaleF32, pg8::StaticOrder, PG8_ALIGN, PG8_SP2>(glds, g, S, E, F.wave);
#else
            pg8::rs_table_fill(glds, S, WSP(float, WS_SSQB), T, 1.0f / D, EPS, F.wave);
            pg8::EpiScaleBf16 E{WSP(pg8::bf16_t, WS_XQB), T, WSP(float, WS_SSQB), 32, glds, 1.0f / D, EPS, WSP(float, WS_QSS)};
            pg8::gemm_phase<pg8::EpiScaleBf16, pg8::StaticOrder, PG8_ALIGN, PG8_SP2>(glds, g, S, E, F.wave);
#endif
            SEAM(pb + 7); }
        if (PHON(8) && IN(pb + 8)) for (int rep = 0; rep < NREP(8); ++rep) { LAUNDER(); if (rep) xcd_barrier(bar);
#if ORACLE_ATTN
            ph_xattn(F, L);
            __syncthreads(); SEAM(pb + 8);
#else
#if XFUSE
            { const float* qg_ = INP(20) + L * 512; const float* kg_ = INP(21) + L * 512; float gq_ = 0.f, gk_ = 0.f;
#pragma unroll
              for (int i = 0; i < 8; ++i) { gq_ = fmaxf(gq_, fabsf(qg_[F.lane + 64 * i])); gk_ = fmaxf(gk_, fabsf(kg_[F.lane + 64 * i])); }
              const float bound_ = 22.627416997969522f * 1.4426950408889634f * 1.02f * wave_max(gq_) * wave_max(gk_);
#pragma unroll 1
              for (int h = 0; h < 4; ++h) { pg8::Gemm g{WSP(pg8::bf16_t, WS_XQB) + (size_t)h * T * 512, WSP(pg8::bf16_t, WS_KXF) + (size_t)h * MEM * 512, T, MEM, 512};
                  pg8::StaticOrder S; S.init(T, MEM, F.G, (F.bid + 64 * h) % F.G);
                  pg8::rs_table_fill(glds, S, WSP(float, WS_QSS), T, 1.0f / 512.0f, EPS, F.wave, 8 * h, 8, false);
                  pg8::EpiExpPN E{WSP(pg8::bf16_t, WS_PH), 1024, 256 * h, glds, bound_};
                  pg8::gemm_phase<pg8::EpiExpPN, pg8::StaticOrder, true, PG8_SP2>(glds, g, S, E, F.wave); __syncthreads(); }
#pragma unroll 1
              for (int h = 0; h < 4; ++h) { pg8::Gemm g{WSL(pg8::bf16_t, WS_WO) + (size_t)h * D * 512, WSP(pg8::bf16_t, WS_VXF) + (size_t)h * MEM * 512, D, MEM, 512};
                  pg8::StaticOrder S; S.init(D, MEM, F.G, (F.bid + 64 * h + 224) % F.G);
                  pg8::EpiPlainBf16 E{WSP(pg8::bf16_t, WS_BTC), 1024, 256 * h};
                  pg8::gemm_phase<pg8::EpiPlainBf16, pg8::StaticOrder, PG8_ALIGN, PG8_SP2>(glds, g, S, E, F.wave); __syncthreads(); } }
#else
            { const float* qg_ = INP(20) + L * 512; const float* kg_ = INP(21) + L * 512; float gq_ = 0.f, gk_ = 0.f;
#pragma unroll
              for (int i = 0; i < 8; ++i) { gq_ = fmaxf(gq_, fabsf(qg_[F.lane + 64 * i])); gk_ = fmaxf(gk_, fabsf(kg_[F.lane + 64 * i])); }
              const float bound_ = 22.627416997969522f * 1.4426950408889634f * 1.02f * wave_max(gq_) * wave_max(gk_);
#pragma unroll 1
              for (int h = 0; h < 4; ++h) { pg8::Gemm g{WSP(pg8::bf16_t, WS_XQB) + (size_t)h * T * 512, WSP(pg8::bf16_t, WS_KXF) + (size_t)h * MEM * 512, T, MEM, 512};
                  pg8::StaticOrder S; S.init(T, MEM, F.G, (F.bid + 64 * h) % F.G);
                  pg8::rs_table_fill(glds, S, WSP(float, WS_QSS), T, 1.0f / 512.0f, EPS, F.wave, 8 * h, 8, false);
                  pg8::EpiExpP E{WSP(pg8::bf16_t, WS_PH) + (size_t)h * T * MEM, WSP(float, WS_LPX) + (size_t)h * 4 * T, T, glds, bound_};
                  pg8::gemm_phase<pg8::EpiExpP, pg8::StaticOrder, PG8_ALIGN, PG8_SP2>(glds, g, S, E, F.wave); __syncthreads(); } }
            xcd_barrier(bar); LAUNDER();
#pragma unroll 1
            for (int h = 0; h < 4; ++h) { pg8::Gemm g{WSP(pg8::bf16_t, WS_PH) + (size_t)h * T * MEM, WSP(pg8::bf16_t, WS_VXF) + (size_t)h * 512 * MEM, T, 512, MEM};
                pg8::StaticOrder S; S.init(T, 512, F.G, (F.bid + 64 * h) % F.G);
                pg8::rs_table_fill(glds, S, WSP(float, WS_LPX) + (size_t)h * 4 * T, T, 1.0f, 0.f, F.wave, 0, 4, true);
                pg8::EpiRowScaleA E{WSP(pg8::bf16_t, WS_A1), D, 512 * h, glds};
                pg8::gemm_phase<pg8::EpiRowScaleA, pg8::StaticOrder, PG8_ALIGN, PG8_SP2>(glds, g, S, E, F.wave); __syncthreads(); }
#endif
            SEAM(pb + 8);
#endif
            }
        if (PHON(9) && IN(pb + 9)) { LAUNDER();
#if XFUSE
            pg8::Gemm g{WSP(pg8::bf16_t, WS_PH), WSP(pg8::bf16_t, WS_BTC), T, D, 1024};
#else
            pg8::Gemm g{WSP(pg8::bf16_t, WS_A1), WSL(pg8::bf16_t, WS_WO), T, D, KS * D};
#endif
            pg8::StaticOrder S; S.init(T, D, F.G, F.bid);
            pg8::EpiResid E{OUTP, OUTP, WSP(pg8::bf16_t, WS_A0), WSP(float, WS_SSQC), D, T};
            pg8::gemm_phase<pg8::EpiResid, pg8::StaticOrder, PG8_ALIGN, PG8_SP2>(glds, g, S, E, F.wave); SEAM(pb + 9); }
        if (PHON(10) && IN(pb + 10)) for (int rep = 0; rep < NREP(10); ++rep) { LAUNDER(); if (rep) xcd_barrier(bar); pg8::Gemm g{WSP(pg8::bf16_t, WS_A0), WSL(pg8::bf16_t, WS_W1), T, DFF, KS * D}; pg8::StaticOrder S; S.init(T, DFF, F.G, F.bid);
            pg8::rs_table_fill(glds, S, WSP(float, WS_SSQC), T, 1.0f / D, EPS, F.wave);
            pg8::EpiRelu2 E{WSP(pg8::bf16_t, WS_HM), DFF, WSP(float, WS_SSQC), 32, glds, 1.0f / D, EPS};
            pg8::gemm_phase<pg8::EpiRelu2, pg8::StaticOrder, PG8_ALIGN, PG8_SP2>(glds, g, S, E, F.wave); SEAM(pb + 10); }
        if (PHON(11) && IN(pb + 11)) { LAUNDER(); pg8::Gemm g{WSP(pg8::bf16_t, WS_HM), WSL(pg8::bf16_t, WS_W2), T, D, KS * DFF}; pg8::StaticOrder S; S.init(T, D, F.G, F.bid);
            pg8::EpiResid E{OUTP, OUTP, WSP(pg8::bf16_t, WS_A0), WSP(float, WS_SSQA), D, T};
            pg8::gemm_phase<pg8::EpiResid, pg8::StaticOrder, PG8_ALIGN, PG8_SP2>(glds, g, S, E, F.wave); SEAM(pb + 11); }
    }
    LAUNDER();
    if (hi - lo > 1 && hi == NPHASES) { __syncthreads(); if (xb_ld(&bar.bar[XB_TMO]) != 0u) { const float q = __builtin_nanf(""); for (int i = F.bid * 512 + F.tid; i < T * D; i += F.G * 512 * 64) OUTP[i] = q; } }
#undef IN
#undef SEAM
}

#ifndef MK_PER_PHASE
#define MK_PER_PHASE 0
#endif
extern "C" void kernel_launch(void* const* d_in, const int* in_sizes, int n_in, void* d_out, int out_size, void* d_ws, size_t ws_size, hipStream_t stream) {
    static int grid = 0;
    if (grid == 0) {
        if (n_in != 25 || out_size != T * D || ws_size < WS_END) { fprintf(stderr, "kernel_launch: unexpected sizes (n_in %d, out %d, ws %zu, need %zu); nothing launched\n", n_in, out_size, ws_size, (size_t)WS_END); grid = -1; return; }
        int dev = 0, cus = 0, per_cu = 0;
        if (hipGetDevice(&dev) != hipSuccess || hipDeviceGetAttribute(&cus, hipDeviceAttributeMultiprocessorCount, dev) != hipSuccess) { grid = -1; return; }
        if (hipFuncSetAttribute((const void*)fwd, hipFuncAttributeMaxDynamicSharedMemorySize, LDS_BYTES) != hipSuccess) { fprintf(stderr, "kernel_launch: hipFuncSetAttribute failed\n"); grid = -1; return; }
        if (hipOccupancyMaxActiveBlocksPerMultiprocessor(&per_cu, (const void*)fwd, 512, LDS_BYTES) != hipSuccess || per_cu < 1) { fprintf(stderr, "kernel_launch: occupancy query says %d\n", per_cu); }
        (void)hipGetLastError();
        grid = cus;
    }
    if (grid < 0) return;
    if (hipMemsetAsync((char*)d_ws + WS_CTL, 0, CTL_ZERO_BYTES, stream) != hipSuccess) return;
    Args a{};
    for (int i = 0; i < 25; ++i) a.in[i] = (const float*)d_in[i];
    a.out = (float*)d_out; a.ws = (unsigned char*)d_ws; a.pad = 0;
#if MK_PER_PHASE
    for (int p = 0; p < NPHASES; ++p) { a.ph_lo = p; a.ph_hi = p + 1; a.li = 0; hipLaunchKernelGGL(fwd, dim3(grid), dim3(512), LDS_BYTES, stream, a); }
#else
    a.ph_lo = 0; a.ph_hi = NPHASES; a.li = 0;
    hipLaunchKernelGGL(fwd, dim3(grid), dim3(512), LDS_BYTES, stream, a);
#endif
}
```

```cpp
#include <hip/hip_runtime.h>
#include <cstdio>
#include <cstdint>
#define MK_PER_PHASE 0
#ifndef ORACLE_MIX
#define ORACLE_MIX 0
#endif
#ifndef ORACLE_ATTN
#define ORACLE_ATTN 0
#endif
#ifndef NSA_V2
#define NSA_V2 1
#endif
#ifndef KS
#define KS 1
#endif
__device__ __forceinline__ void swap32(unsigned& a, unsigned& b) { asm volatile("s_nop 1\n\tv_permlane32_swap_b32 %0, %1\n\ts_nop 1" : "+v"(a), "+v"(b)); }
template <int M> __device__ __forceinline__ float sxor(float v) { static_assert(M < 32, "use half_sum / half_max for the two lane halves");
    return __builtin_bit_cast(float, __builtin_amdgcn_ds_swizzle(__builtin_bit_cast(int, v), (M << 10) | 0x1f)); }
template <int M> __device__ __forceinline__ int sxori(int v) { static_assert(M < 32, "");
    return __builtin_amdgcn_ds_swizzle(v, (M << 10) | 0x1f); }
__device__ __forceinline__ float half_sum(float v) { unsigned a = __builtin_bit_cast(unsigned, v), b = a; swap32(a, b); return __builtin_bit_cast(float, a) + __builtin_bit_cast(float, b); }
__device__ __forceinline__ float half_max(float v) { unsigned a = __builtin_bit_cast(unsigned, v), b = a; swap32(a, b); return fmaxf(__builtin_bit_cast(float, a), __builtin_bit_cast(float, b)); }
namespace pg8 {
#define PG8_LAS __attribute__((address_space(3)))
typedef unsigned short bf16_t;
typedef short bf16x8 __attribute__((ext_vector_type(8)));
typedef float f32x4 __attribute__((ext_vector_type(4)));
typedef unsigned u32x4 __attribute__((ext_vector_type(4)));
constexpr int BM = 256, BK = 64, HALF = 128, HTB = HALF * BK * 2  , STAGE_BYTES = 8 * HTB, NXCD = 8, WGM = 8;

__host__ __device__ __forceinline__ int lds_byte(int r, int c) { const int st = (r >> 4) * 2 + (c >> 5), rr = r & 15, cc = c & 31, ob = rr * 64 + cc * 2; return st * 1024 + (ob ^ (((ob >> 9) & 1) << 5)); }
__host__ __device__ __forceinline__ void stage_rc(int b, int& R, int& C) { const int st = b / 1024, sb = b % 1024, swz = sb ^ (((sb >> 9) & 1) << 5); R = (st >> 1) * 16 + swz / 64; C = (st & 1) * 32 + (swz % 64) / 2; }
__host__ __device__ __forceinline__ int perm32(int rho) { const int n = rho >> 4, i = rho & 15; return 8 * (i >> 2) + 4 * n + (i & 3); }

struct Unit { int pm, pn; };
struct Gemm { const bf16_t* A; const bf16_t* Bt; int M, N, K; };

struct StaticOrder {
    int nM, nN, nwg, G, c;
    __host__ __device__ void init(int M, int N, int G_, int c_) { nM = M / BM; nN = N / BM; nwg = nM * nN; G = G_; c = c_; }
    __host__ __device__ bool next(int i, Unit& u) const {
        const long L = (long)i * G + c; if (L >= nwg) return false;
        int wgid = (int)L; { const int q = nwg / NXCD, r = nwg % NXCD, xcd = wgid % NXCD, off = wgid / NXCD; wgid = (xcd < r ? xcd * (q + 1) : r * (q + 1) + (xcd - r) * q) + off; }
        const int nig = WGM * nN, gid = wgid / nig, fm = gid * WGM, gsz = (nM - fm) < WGM ? (nM - fm) : WGM;
        u.pm = fm + ((wgid % nig) % gsz); u.pn = (wgid % nig) / gsz; return true;
    }
    __device__ __forceinline__ void a_ready(const Unit&) const {}
    __device__ __forceinline__ void done(const Unit&) const {}
};

__device__ __forceinline__ unsigned cvt_pk_bf16(float lo, float hi) { unsigned r; asm volatile("v_cvt_pk_bf16_f32 %0, %1, %2" : "=v"(r) : "v"(lo), "v"(hi)); return r; }
__device__ __forceinline__ float bf_hi_f(unsigned pk) { return __builtin_bit_cast(float, pk << 16); }
__device__ __forceinline__ float bf_lo_of(float v) { unsigned h; { unsigned u = __builtin_bit_cast(unsigned, v); h = (u + 0x7fffu + ((u >> 16) & 1u)) & 0xffff0000u; } return v - __builtin_bit_cast(float, h); }
__device__ __forceinline__ void store_a8(bf16_t* rowp, int Kreal, int col, const f32x4& v0, const f32x4& v1) {
    u32x4 w; w.x = cvt_pk_bf16(v0[0], v0[1]); w.y = cvt_pk_bf16(v0[2], v0[3]); w.z = cvt_pk_bf16(v1[0], v1[1]); w.w = cvt_pk_bf16(v1[2], v1[3]);
    *(u32x4*)(rowp + col) = w;
#if KS == 3
    *(u32x4*)(rowp + Kreal + col) = w;
    u32x4 l; l.x = cvt_pk_bf16(bf_lo_of(v0[0]), bf_lo_of(v0[1])); l.y = cvt_pk_bf16(bf_lo_of(v0[2]), bf_lo_of(v0[3])); l.z = cvt_pk_bf16(bf_lo_of(v1[0]), bf_lo_of(v1[1])); l.w = cvt_pk_bf16(bf_lo_of(v1[2]), bf_lo_of(v1[3]));
    *(u32x4*)(rowp + 2 * Kreal + col) = l;
#endif
}

constexpr int RS_OFF = 131072, RS_TAG_OFF = RS_OFF + 4 * 256 * 4;
template <class Sched>
__device__ __forceinline__ void rs_table_fill(PG8_LAS unsigned char* lds, const Sched& S, const float* ssq, int ldp, float inv_n, float eps, int wid_, int p0 = 0, int npart = 32, bool recip = false) {
    int tid = 0;
    PG8_LAS float* rs = (PG8_LAS float*)(lds + RS_OFF); PG8_LAS int* tag = (PG8_LAS int*)(lds + RS_TAG_OFF);
    { int z_ = 0; asm volatile("" : "+s"(z_)); tid = (tid >> 6) * 0 + (int)__builtin_amdgcn_mbcnt_hi(~0u, __builtin_amdgcn_mbcnt_lo(~0u, (unsigned)z_)) + 64 * wid_; }
#pragma unroll 1
    for (int pass = 0; pass < 2; ++pass) { const int i = 2 * pass + (tid >> 8); Unit u; const bool ok = S.next(i, u);
        if (ok) { const int r = u.pm * BM + (tid & 255); float s = 0.f;
#pragma unroll 8
            for (int p = 0; p < npart; ++p) s += ssq[(size_t)(p0 + p) * ldp + r];
            rs[i * 256 + (tid & 255)] = recip ? ((s > 0.f) ? 1.0f / s : 0.f) : 1.0f / sqrtf(s * inv_n + eps); }
        if ((tid & 255) == 0) tag[i] = ok ? u.pm : -1; }
    __syncthreads();
}
__device__ __forceinline__ int rs_slot(PG8_LAS unsigned char* lds, const Unit& u) { const PG8_LAS int* tag = (const PG8_LAS int*)(lds + RS_TAG_OFF);
    const int t0 = __builtin_amdgcn_readfirstlane(tag[0]), t1 = __builtin_amdgcn_readfirstlane(tag[1]), t2 = __builtin_amdgcn_readfirstlane(tag[2]);
    return (t0 == u.pm) ? 0 : (t1 == u.pm) ? 1 : (t2 == u.pm) ? 2 : 3; }
__device__ __forceinline__ float row_rs(const float* ssq, int np, PG8_LAS unsigned char* lds, int slot, int r, float inv_n, float eps) {
    if (np == 1) return 1.0f / sqrtf(ssq[r] * inv_n + eps);
    return ((const PG8_LAS float*)(lds + RS_OFF))[slot * 256 + (r & 255)];
}

struct EpiScaleF32 {
    static constexpr bool PERM = false, AFTER_DRAIN = false;
    float* C; int ldc; const float* bias; const float* ssq; int np; PG8_LAS unsigned char* lds; float inv_n, eps;
    __device__ __forceinline__ void operator()(const f32x4 (&acc)[2][2][4][2], const Unit& u, int wr, int wc, int fr, int fq) const {
        const int row0 = u.pm * BM + wr * 64 + fr, col0 = u.pn * BM + wc * 32 + 4 * fq;
        const int slot = (np == 1) ? 0 : rs_slot(lds, u);
        f32x4 bv[2][2];
#pragma unroll
        for (int bj = 0; bj < 2; ++bj)
#pragma unroll
            for (int n = 0; n < 2; ++n) bv[bj][n] = bias ? *(const f32x4*)(bias + col0 + bj * HALF + n * 16) : (f32x4){0.f, 0.f, 0.f, 0.f};
#pragma unroll
        for (int ai = 0; ai < 2; ++ai)
#pragma unroll
            for (int m = 0; m < 4; ++m) { const int r = row0 + ai * HALF + m * 16; float* rowp = C + (size_t)r * ldc + col0;
                const float rs = row_rs(ssq, np, lds, slot, r, inv_n, eps);
#pragma unroll
                for (int bj = 0; bj < 2; ++bj)
#pragma unroll
                    for (int n = 0; n < 2; ++n) *(f32x4*)(rowp + bj * HALF + n * 16) = acc[ai][bj][m][n] * rs + bv[bj][n]; }
    }
};

struct EpiResid {
    static constexpr bool PERM = true, AFTER_DRAIN = false;
    const float* xres; float* xout; bf16_t* xb; float* ssq; int ld, ldp;
    __device__ __forceinline__ void operator()(const f32x4 (&acc)[2][2][4][2], const Unit& u, int wr, int wc, int fr, int fq) const {
        const int row0 = u.pm * BM + wr * 64 + fr, col0 = u.pn * BM + wc * 32 + 8 * fq;
#pragma unroll
        for (int ai = 0; ai < 2; ++ai)
#pragma unroll
            for (int m = 0; m < 4; ++m) { const int r = row0 + ai * HALF + m * 16; float s = 0.f;
#pragma unroll
                for (int bj = 0; bj < 2; ++bj) { const int c = col0 + bj * HALF; const float* xr = xres + (size_t)r * ld + c; float* xo = xout + (size_t)r * ld + c;
                    const f32x4 v0 = acc[ai][bj][m][0] + *(const f32x4*)xr, v1 = acc[ai][bj][m][1] + *(const f32x4*)(xr + 4);
                    *(f32x4*)xo = v0; *(f32x4*)(xo + 4) = v1;
                    s += (v0[0] * v0[0] + v0[1] * v0[1]) + (v0[2] * v0[2] + v0[3] * v0[3]) + (v1[0] * v1[0] + v1[1] * v1[1]) + (v1[2] * v1[2] + v1[3] * v1[3]);
                    store_a8(xb + (size_t)r * (KS * ld), ld, c, v0, v1); }
                s += sxor<16>(s); s = half_sum(s);
                if (fq == 0) ssq[(size_t)(u.pn * 4 + wc) * ldp + r] = s;
                if (m & 1) asm volatile("" ::: "memory"); }
    }
};

struct EpiRelu2 {
    static constexpr bool PERM = true, AFTER_DRAIN = false;
    bf16_t* H; int ld; const float* ssq; int np; PG8_LAS unsigned char* lds; float inv_n, eps;
    __device__ __forceinline__ void operator()(const f32x4 (&acc)[2][2][4][2], const Unit& u, int wr, int wc, int fr, int fq) const {
        const int row0 = u.pm * BM + wr * 64 + fr, col0 = u.pn * BM + wc * 32 + 8 * fq; const int slot = (np == 1) ? 0 : rs_slot(lds, u);
#pragma unroll
        for (int ai = 0; ai < 2; ++ai)
#pragma unroll
            for (int m = 0; m < 4; ++m) { const int r = row0 + ai * HALF + m * 16; const float rs = row_rs(ssq, np, lds, slot, r, inv_n, eps);
#pragma unroll
                for (int bj = 0; bj < 2; ++bj) { f32x4 v0 = acc[ai][bj][m][0] * rs, v1 = acc[ai][bj][m][1] * rs;
#pragma unroll
                    for (int j = 0; j < 4; ++j) { const float a = fmaxf(v0[j], 0.f), b = fmaxf(v1[j], 0.f); v0[j] = a * a; v1[j] = b * b; }
                    store_a8(H + (size_t)r * (KS * ld), ld, col0 + bj * HALF, v0, v1); } }
    }
};

struct EpiScaleBf16 {
    static constexpr bool PERM = true, AFTER_DRAIN = false;
    bf16_t* O; int M_; const float* ssq; int np; PG8_LAS unsigned char* lds; float inv_n, eps; float* qss;
    __device__ __forceinline__ void operator()(const f32x4 (&acc)[2][2][4][2], const Unit& u, int wr, int wc, int fr, int fq) const {
        const int row0 = u.pm * BM + wr * 64 + fr, col0 = (u.pn & 1) * BM + wc * 32 + 8 * fq; const int slot = (np == 1) ? 0 : rs_slot(lds, u);
        bf16_t* Oh = O + (size_t)(u.pn >> 1) * M_ * 512;
#pragma unroll
        for (int ai = 0; ai < 2; ++ai)
#pragma unroll
            for (int m = 0; m < 4; ++m) { const int r = row0 + ai * HALF + m * 16; const float rs = row_rs(ssq, np, lds, slot, r, inv_n, eps); float s = 0.f;
#pragma unroll
                for (int bj = 0; bj < 2; ++bj) { const f32x4 v0 = acc[ai][bj][m][0] * rs, v1 = acc[ai][bj][m][1] * rs;
                    s += (v0[0] * v0[0] + v0[1] * v0[1]) + (v0[2] * v0[2] + v0[3] * v0[3]) + (v1[0] * v1[0] + v1[1] * v1[1]) + (v1[2] * v1[2] + v1[3] * v1[3]);
                    u32x4 w; w.x = cvt_pk_bf16(v0[0], v0[1]); w.y = cvt_pk_bf16(v0[2], v0[3]); w.z = cvt_pk_bf16(v1[0], v1[1]); w.w = cvt_pk_bf16(v1[2], v1[3]);
                    *(u32x4*)(Oh + (size_t)r * 512 + col0 + bj * HALF) = w; }
                s += sxor<16>(s); s = half_sum(s);
                if (fq == 0) qss[(size_t)(u.pn * 4 + wc) * M_ + r] = s;
                asm volatile("" ::: "memory"); }
    }
};
#define EPI_FRESH_LANE() { int z_ = 0; asm volatile("" : "+s"(z_)); const int l_ = (int)__builtin_amdgcn_mbcnt_hi(~0u, __builtin_amdgcn_mbcnt_lo(~0u, (unsigned)z_)); fr = l_ & 15; fq = l_ >> 4; }
struct EpiExpP {
    static constexpr bool PERM = true, AFTER_DRAIN = false;
    bf16_t* P; float* lp; int M_; PG8_LAS unsigned char* lds; float bound;
    __device__ __forceinline__ void operator()(const f32x4 (&acc)[2][2][4][2], const Unit& u, int wr, int wc, int fr, int fq) const {
        EPI_FRESH_LANE();
        const int row0 = u.pm * BM + wr * 64 + fr, col0 = wc * 32 + 8 * fq; const int slot = rs_slot(lds, u);
#pragma unroll
        for (int ai = 0; ai < 2; ++ai)
#pragma unroll
            for (int m = 0; m < 4; ++m) { const int r = row0 + ai * HALF + m * 16; const float rs = ((const PG8_LAS float*)(lds + RS_OFF))[slot * 256 + (r & 255)]; float s = 0.f;
#pragma unroll
                for (int bj = 0; bj < 2; ++bj) { f32x4 v0, v1;
#pragma unroll
                    for (int j = 0; j < 4; ++j) { v0[j] = __builtin_amdgcn_exp2f(acc[ai][bj][m][0][j] * rs - bound); v1[j] = __builtin_amdgcn_exp2f(acc[ai][bj][m][1][j] * rs - bound); }
                    s += ((v0[0] + v0[1]) + (v0[2] + v0[3])) + ((v1[0] + v1[1]) + (v1[2] + v1[3]));
                    u32x4 w; w.x = cvt_pk_bf16(v0[0], v0[1]); w.y = cvt_pk_bf16(v0[2], v0[3]); w.z = cvt_pk_bf16(v1[0], v1[1]); w.w = cvt_pk_bf16(v1[2], v1[3]);
                    *(u32x4*)(P + (size_t)r * 256 + col0 + bj * HALF) = w; }
                s += sxor<16>(s); s = half_sum(s);
                if (fq == 0) lp[(size_t)wc * M_ + r] = s;
                asm volatile("" ::: "memory"); }
    }
};
struct EpiRowScaleA {
    static constexpr bool PERM = true, AFTER_DRAIN = false;
    bf16_t* Y; int ld, colbase; PG8_LAS unsigned char* lds;
    __device__ __forceinline__ void operator()(const f32x4 (&acc)[2][2][4][2], const Unit& u, int wr, int wc, int fr, int fq) const {
        EPI_FRESH_LANE();
        const int row0 = u.pm * BM + wr * 64 + fr, col0 = colbase + u.pn * BM + wc * 32 + 8 * fq; const int slot = rs_slot(lds, u);
#pragma unroll
        for (int ai = 0; ai < 2; ++ai)
#pragma unroll
            for (int m = 0; m < 4; ++m) { const int r = row0 + ai * HALF + m * 16; const float il = ((const PG8_LAS float*)(lds + RS_OFF))[slot * 256 + (r & 255)];
#pragma unroll
                for (int bj = 0; bj < 2; ++bj) store_a8(Y + (size_t)r * (KS * ld), ld, col0 + bj * HALF, acc[ai][bj][m][0] * il, acc[ai][bj][m][1] * il);
                asm volatile("" ::: "memory"); }
    }
};

struct EpiExpPN {
    static constexpr bool PERM = true, AFTER_DRAIN = false;
    bf16_t* P; int ldc, colbase; PG8_LAS unsigned char* lds; float bound;
    __device__ __forceinline__ void operator()(const f32x4 (&acc)[2][2][4][2], const Unit& u, int wr, int wc, int fr, int fq) const {
        EPI_FRESH_LANE();
        const int rin0 = wr * 64 + fr, col0 = colbase + wc * 32 + 8 * fq; const int slot = rs_slot(lds, u);
        const PG8_LAS float* rst = (const PG8_LAS float*)(lds + RS_OFF) + slot * 256; PG8_LAS float* part = (PG8_LAS float*)(lds + RS_OFF + 8192);
#pragma unroll
        for (int ai = 0; ai < 2; ++ai)
#pragma unroll
            for (int m = 0; m < 4; ++m) { const int rin = rin0 + ai * HALF + m * 16; const float rs = rst[rin]; float s = 0.f;
#pragma unroll
                for (int bj = 0; bj < 2; ++bj)
#pragma unroll
                    for (int j = 0; j < 4; ++j) s += __builtin_amdgcn_exp2f(acc[ai][bj][m][0][j] * rs - bound) + __builtin_amdgcn_exp2f(acc[ai][bj][m][1][j] * rs - bound);
                s += sxor<16>(s); s = half_sum(s);
                if (fq == 0) part[rin * 4 + wc] = s; }
        asm volatile("s_waitcnt lgkmcnt(0)" ::: "memory"); __builtin_amdgcn_s_barrier(); asm volatile("" ::: "memory");
#pragma unroll
        for (int ai = 0; ai < 2; ++ai)
#pragma unroll
            for (int m = 0; m < 4; ++m) { const int rin = rin0 + ai * HALF + m * 16; const float rs = rst[rin]; const f32x4 p4 = *(const PG8_LAS f32x4*)(part + rin * 4);
                const float inv = 1.0f / ((p4[0] + p4[1]) + (p4[2] + p4[3])); bf16_t* prow = P + (size_t)(u.pm * BM + rin) * ldc + col0;
#pragma unroll
                for (int bj = 0; bj < 2; ++bj) { f32x4 v0, v1;
#pragma unroll
                    for (int j = 0; j < 4; ++j) { v0[j] = __builtin_amdgcn_exp2f(acc[ai][bj][m][0][j] * rs - bound) * inv; v1[j] = __builtin_amdgcn_exp2f(acc[ai][bj][m][1][j] * rs - bound) * inv; }
                    u32x4 w; w.x = cvt_pk_bf16(v0[0], v0[1]); w.y = cvt_pk_bf16(v0[2], v0[3]); w.z = cvt_pk_bf16(v1[0], v1[1]); w.w = cvt_pk_bf16(v1[2], v1[3]);
                    *(u32x4*)(prow + bj * HALF) = w; }
                asm volatile("" ::: "memory"); }
    }
};
struct EpiPlainBf16 {
    static constexpr bool PERM = true, AFTER_DRAIN = false;
    bf16_t* O; int ldc, colbase;
    __device__ __forceinline__ void operator()(const f32x4 (&acc)[2][2][4][2], const Unit& u, int wr, int wc, int fr, int fq) const {
        EPI_FRESH_LANE();
        const int row0 = u.pm * BM + wr * 64 + fr, col0 = colbase + u.pn * BM + wc * 32 + 8 * fq;
#pragma unroll
        for (int ai = 0; ai < 2; ++ai)
#pragma unroll
            for (int m = 0; m < 4; ++m) { bf16_t* orow = O + (size_t)(row0 + ai * HALF + m * 16) * ldc + col0;
#pragma unroll
                for (int bj = 0; bj < 2; ++bj) { const f32x4 v0 = acc[ai][bj][m][0], v1 = acc[ai][bj][m][1];
                    u32x4 w; w.x = cvt_pk_bf16(v0[0], v0[1]); w.y = cvt_pk_bf16(v0[2], v0[3]); w.z = cvt_pk_bf16(v1[0], v1[1]); w.w = cvt_pk_bf16(v1[2], v1[3]);
                    *(u32x4*)(orow + bj * HALF) = w; }
                asm volatile("" ::: "memory"); }
    }
};
template <class Epi, class Sched, bool ALIGN_EPI = false, bool SP2 = false>
__device__ __forceinline__ void gemm_phase(PG8_LAS unsigned char* lds, const Gemm g, const Sched& S, const Epi& E, int wid_in) {
    int zero_ = 0; asm volatile("" : "+s"(zero_));
    const int lane = (int)__builtin_amdgcn_mbcnt_hi(~0u, __builtin_amdgcn_mbcnt_lo(~0u, (unsigned)zero_));
    const int wid = wid_in, tid = wid * 64 + lane, wr = wid >> 2, wc = wid & 3, fr = lane & 15, fq = lane >> 4;
    const int K = g.K, nt = K / BK;
    unsigned voffA[2], voffB[2];
#pragma unroll
    for (int i = 0; i < 2; ++i) { int R, C; stage_rc(tid * 16 + i * 8192, R, C); const int Rb = Epi::PERM ? ((R & ~31) + perm32(R & 31)) : R;
        voffA[i] = (unsigned)(R * K + C) * 2u; voffB[i] = (unsigned)(Rb * K + C) * 2u; }
    const size_t kstep = (size_t)(BK * 2);
    const size_t hstep = (size_t)HALF * K * 2;
    const size_t tstep = 2 * hstep;
    const unsigned ldsw = (unsigned)wid * 1024u;
    const int aoff = lds_byte(wr * 64 + fr, fq * 8), boff = lds_byte(wc * 32 + fr, fq * 8);
#define PG8_SA(b, h) (((b) * 2 + (h)) * HTB)
#define PG8_SB(b, h) ((4 + (b) * 2 + (h)) * HTB)
#define PG8_STAGE(bufoff, gbase, voff) do { _Pragma("unroll") for (int _i = 0; _i < 2; ++_i) \
        __builtin_amdgcn_global_load_lds((const unsigned*)((const char*)(gbase) + (voff)[_i]), (PG8_LAS unsigned*)(lds + (bufoff) + ldsw + _i * 8192), 16, 0, 0); } while (0)
#define PG8_LDA(dst, b, h) do { _Pragma("unroll") for (int m = 0; m < 4; ++m) _Pragma("unroll") for (int k = 0; k < 2; ++k) dst[m][k] = *(const PG8_LAS bf16x8*)(lds + PG8_SA(b, h) + aoff + m * 2048 + k * 1024); } while (0)
#define PG8_LDB(dst, b, h) do { _Pragma("unroll") for (int n = 0; n < 2; ++n) _Pragma("unroll") for (int k = 0; k < 2; ++k) dst[n][k] = *(const PG8_LAS bf16x8*)(lds + PG8_SB(b, h) + boff + n * 2048 + k * 1024); } while (0)
#define PG8_MMA(ai, bj, At, Bt) do { __builtin_amdgcn_s_setprio(1); _Pragma("unroll") for (int m = 0; m < 4; ++m) _Pragma("unroll") for (int n = 0; n < 2; ++n) _Pragma("unroll") for (int k = 0; k < 2; ++k) \
        acc[ai][bj][m][n] = __builtin_amdgcn_mfma_f32_16x16x32_bf16(Bt[n][k], At[m][k], acc[ai][bj][m][n], 0, 0, 0); __builtin_amdgcn_s_setprio(0); } while (0)
#define PG8_WAIT_V(n) asm volatile("s_waitcnt vmcnt(" #n ")" ::: "memory")
#define PG8_WAIT_L(n) asm volatile("s_waitcnt lgkmcnt(" #n ")" ::: "memory")
#define PG8_BAR __builtin_amdgcn_s_barrier()
#define PG8_SCHED __builtin_amdgcn_sched_barrier(0)
    Unit cur, nxt; int ui = 0;
    if (!S.next(0, cur)) return;
    f32x4 acc[2][2][4][2];
#pragma unroll
    for (int a = 0; a < 2; ++a)
#pragma unroll
        for (int b = 0; b < 2; ++b)
#pragma unroll
            for (int m = 0; m < 4; ++m)
#pragma unroll
                for (int n = 0; n < 2; ++n) acc[a][b][m][n] = (f32x4){0.f, 0.f, 0.f, 0.f};
    bf16x8 At[4][2], B0[2][2], B1[2][2];
    const char* cA = (const char*)g.A + (size_t)cur.pm * tstep; const char* cB = (const char*)g.Bt + (size_t)cur.pn * tstep;
    S.a_ready(cur);
    if constexpr (SP2) {
        PG8_STAGE(PG8_SB(0, 0), cB, voffB); PG8_STAGE(PG8_SB(0, 1), cB + hstep, voffB); PG8_STAGE(PG8_SA(0, 0), cA, voffA); PG8_STAGE(PG8_SA(0, 1), cA + hstep, voffA);
        if (wr == 1) PG8_BAR;
        PG8_WAIT_V(2); PG8_BAR;
        PG8_STAGE(PG8_SB(1, 0), cB + kstep, voffB); PG8_STAGE(PG8_SA(1, 0), cA + kstep, voffA); PG8_STAGE(PG8_SB(1, 1), cB + hstep + kstep, voffB);
        PG8_WAIT_V(6); PG8_BAR;
    } else {
        PG8_STAGE(PG8_SB(0, 0), cB, voffB); PG8_STAGE(PG8_SA(0, 0), cA, voffA); PG8_STAGE(PG8_SB(0, 1), cB + hstep, voffB); PG8_STAGE(PG8_SA(0, 1), cA + hstep, voffA);
        if (wr == 1) PG8_BAR;
        PG8_WAIT_V(4); PG8_BAR;
        PG8_STAGE(PG8_SB(1, 0), cB + kstep, voffB); PG8_STAGE(PG8_SA(1, 0), cA + kstep, voffA); PG8_STAGE(PG8_SB(1, 1), cB + hstep + kstep, voffB);
        PG8_WAIT_V(6); PG8_BAR;
    }
    for (;;) {
        const bool has_next = S.next(ui + 1, nxt);
        const char* nA = has_next ? (const char*)g.A + (size_t)nxt.pm * tstep : cA; const char* nB = has_next ? (const char*)g.Bt + (size_t)nxt.pn * tstep : cB;
        for (int t = 0; t < nt; t += 2) {
            const bool last = (t == nt - 2);
            const char* a1 = cA + (size_t)(t + 1) * kstep;
            const char* a2 = last ? nA : cA + (size_t)(t + 2) * kstep; const char* b2 = last ? nB : cB + (size_t)(t + 2) * kstep;
            const char* a3 = a2 + kstep; const char* b3 = b2 + kstep;
            if (last && has_next) S.a_ready(nxt);
            if constexpr (SP2) {
            PG8_LDB(B0, 0, 0); PG8_LDB(B1, 0, 1); PG8_SCHED; PG8_LDA(At, 0, 0); PG8_STAGE(PG8_SA(1, 1), a1 + hstep, voffA);
            PG8_WAIT_V(8); PG8_WAIT_L(0); PG8_BAR; PG8_MMA(0, 0, At, B0); PG8_MMA(0, 1, At, B1); PG8_BAR; PG8_SCHED;
            PG8_LDA(At, 0, 1); PG8_STAGE(PG8_SB(0, 0), b2, voffB); PG8_STAGE(PG8_SB(0, 1), b2 + hstep, voffB); PG8_STAGE(PG8_SA(0, 0), a2, voffA);
            PG8_WAIT_V(8); PG8_WAIT_L(0); PG8_BAR; PG8_MMA(1, 0, At, B0); PG8_MMA(1, 1, At, B1); PG8_BAR; PG8_SCHED;
            PG8_LDB(B0, 1, 0); PG8_LDB(B1, 1, 1); PG8_SCHED; PG8_LDA(At, 1, 0); PG8_STAGE(PG8_SA(0, 1), a2 + hstep, voffA);
            PG8_WAIT_V(8); PG8_WAIT_L(0); PG8_BAR; PG8_MMA(0, 0, At, B0); PG8_MMA(0, 1, At, B1); PG8_BAR; PG8_SCHED;
            PG8_LDA(At, 1, 1); PG8_STAGE(PG8_SB(1, 0), b3, voffB); PG8_STAGE(PG8_SB(1, 1), b3 + hstep, voffB); PG8_STAGE(PG8_SA(1, 0), a3, voffA);
            PG8_WAIT_V(8); PG8_WAIT_L(0); PG8_BAR; PG8_MMA(1, 0, At, B0); PG8_MMA(1, 1, At, B1); PG8_BAR; PG8_SCHED;
            } else {
            PG8_LDB(B0, 0, 0); PG8_SCHED; PG8_LDA(At, 0, 0); PG8_STAGE(PG8_SA(1, 1), a1 + hstep, voffA);
            PG8_WAIT_L(8); PG8_BAR; PG8_WAIT_L(0); PG8_MMA(0, 0, At, B0); PG8_BAR; PG8_SCHED;
            PG8_LDB(B1, 0, 1); PG8_STAGE(PG8_SB(0, 0), b2, voffB);
            PG8_BAR; PG8_WAIT_L(0); PG8_MMA(0, 1, At, B1); PG8_BAR;
            PG8_LDA(At, 0, 1); PG8_STAGE(PG8_SA(0, 0), a2, voffA);
            PG8_BAR; PG8_WAIT_L(0); PG8_MMA(1, 0, At, B0); PG8_BAR; PG8_SCHED;
            PG8_STAGE(PG8_SB(0, 1), b2 + hstep, voffB);
            PG8_WAIT_V(6); PG8_BAR; PG8_MMA(1, 1, At, B1); PG8_BAR;
            PG8_LDB(B0, 1, 0); PG8_SCHED; PG8_LDA(At, 1, 0); PG8_STAGE(PG8_SA(0, 1), a2 + hstep, voffA);
            PG8_WAIT_L(8); PG8_BAR; PG8_WAIT_L(0); PG8_MMA(0, 0, At, B0); PG8_BAR; PG8_SCHED;
            PG8_LDB(B1, 1, 1); PG8_STAGE(PG8_SB(1, 0), b3, voffB);
            PG8_BAR; PG8_WAIT_L(0); PG8_MMA(0, 1, At, B1); PG8_BAR;
            PG8_LDA(At, 1, 1); PG8_STAGE(PG8_SA(1, 0), a3, voffA);
            PG8_BAR; PG8_WAIT_L(0); PG8_MMA(1, 0, At, B0); PG8_BAR; PG8_SCHED;
            PG8_STAGE(PG8_SB(1, 1), b3 + hstep, voffB);
            PG8_WAIT_V(6); PG8_BAR; PG8_MMA(1, 1, At, B1); PG8_BAR;
            }
        }
        if constexpr (ALIGN_EPI) { if (wr == 0) PG8_BAR; }
        if constexpr (!Epi::AFTER_DRAIN) { E(acc, cur, wr, wc, fr, fq); S.done(cur); }
        if (!has_next) break;
#pragma unroll
        for (int a = 0; a < 2; ++a)
#pragma unroll
            for (int b = 0; b < 2; ++b)
#pragma unroll
                for (int m = 0; m < 4; ++m)
#pragma unroll
                    for (int n = 0; n < 2; ++n) acc[a][b][m][n] = (f32x4){0.f, 0.f, 0.f, 0.f};
        cur = nxt; cA = nA; cB = nB; ++ui;
        if constexpr (ALIGN_EPI) { if (wr == 1) PG8_BAR; }
    }
    PG8_WAIT_V(0);
    if constexpr (!ALIGN_EPI) { if (wr == 0) PG8_BAR; }
    PG8_BAR;
    if constexpr (Epi::AFTER_DRAIN) { E.fused(acc, cur, wr, wc, fr, fq, lds, wid, lane); S.done(cur); }
#undef PG8_SA
#undef PG8_SB
#undef PG8_STAGE
#undef PG8_LDA
#undef PG8_LDB
#undef PG8_MMA
#undef PG8_WAIT_V
#undef PG8_WAIT_L
#undef PG8_BAR
#undef PG8_SCHED
}
}
#define PG8_SP2 true
#define PG8_ALIGN true
constexpr int T = 8192, D = 2048, DIN = 6688, NIN = 6912, DFF = 8192, MEM = 256, DEPTH = 4;
constexpr int NCMP = 511, NCH = 128;
constexpr float EPS = 1e-6f;
constexpr int ZC_HGQ = 0, ZC_HGF = 512, ZC_HGI = 1024, ZC_HGG = 1536, ZC_NSQ = 2048, ZC_NKC = 3072, ZC_NVC = 3328, ZC_NKS = 3584, ZC_NVS = 3840, ZC_NKW = 4096, ZC_NVW = 4352,
              ZC_MLQ = 4608, ZC_MLK = 5120, ZC_MLV = 5632, ZC_MLO = 6144, ZC_GATE = 6656, ZC_MLI = 6680, ZC_MLF = 6684;
__host__ __device__ __forceinline__ int zcol_src(int j) {
    if (j < 4608) return j; if (j < 6656) return j + 24; if (j < 6680) return j - 6656 + 4608; if (j < 6688) return j; return -1; }
#ifndef K4PER_
#define K4PER_ 24
#endif
constexpr int NPH = 12;
constexpr int NPHASES = 1 + DEPTH * NPH;

constexpr size_t MiB = 1u << 20;
constexpr size_t al256(size_t x) { return (x + 255) & ~(size_t)255; }
constexpr size_t WS_CTL = 0, CTL_ZERO_BYTES = 1 * MiB;
constexpr size_t SZ_DD = (size_t)D * D * KS * 2;
constexpr size_t WS_WIN = CTL_ZERO_BYTES;
constexpr size_t WS_WOUT = WS_WIN + (size_t)NIN * D * KS * 2;
constexpr size_t WS_WQ = WS_WOUT + SZ_DD, WS_WO = WS_WQ + SZ_DD, WS_WKV = WS_WO + SZ_DD;
constexpr size_t WS_W1 = WS_WKV + 2 * SZ_DD;
constexpr size_t WS_W2 = WS_W1 + (size_t)DFF * D * KS * 2;
constexpr size_t WS_WCF = WS_W2 + (size_t)DFF * D * KS * 2;
constexpr size_t WS_BPERM = WS_WCF + (size_t)2 * 4 * 256 * 512 * 2;
constexpr size_t WS_WSET = al256(WS_BPERM + NIN * 4) - WS_WIN;
#ifndef XFUSE
#define XFUSE (KS == 1)
#endif
#ifndef WOVL
#define WOVL (KS == 1)
#endif
constexpr size_t WS_A0 = WS_WIN + (WOVL ? 2 : 1) * WS_WSET;
constexpr size_t WS_A1 = WS_A0 + (size_t)T * D * KS * 2;
constexpr size_t WS_MEMB = WS_A1 + (size_t)T * D * KS * 2;
constexpr size_t WS_SSQA = WS_MEMB + (size_t)MEM * D * KS * 2;
constexpr size_t WS_SSQB = WS_SSQA + 32 * T * 4, WS_SSQC = WS_SSQB + 32 * T * 4, WS_SSQM = WS_SSQC + 32 * T * 4;
constexpr size_t WS_LB = WS_SSQM + MEM * 4;
constexpr size_t WS_COS = WS_LB + DEPTH * 512 * 4, WS_SIN = WS_COS + (size_t)T * 64 * 4;
constexpr size_t WS_KVX = WS_SIN + (size_t)T * 64 * 4;
constexpr size_t WS_KXN = WS_KVX + (size_t)MEM * 2 * D * 4;
constexpr size_t WS_KCN = WS_KXN + (size_t)MEM * D * 4;
constexpr size_t WS_VCN = WS_KCN + 2 * 512 * 128 * 4;
constexpr size_t WS_HGDEC = WS_VCN + 2 * 512 * 128 * 4;
constexpr size_t WS_MLNL = WS_HGDEC + NCH * 512 * 4, WS_MLN = WS_MLNL + NCH * 512 * 4;
constexpr size_t WS_MLSC = WS_MLN + NCH * 512 * 4;
constexpr size_t WS_KXF = al256(WS_MLSC + 3 * NCH * 4 * 4);
constexpr size_t WS_VXF = WS_KXF + (size_t)MEM * D * 2;
constexpr size_t WS_QSS = WS_VXF + (size_t)MEM * D * 2;
constexpr size_t WS_LPX = WS_QSS + (size_t)32 * T * 4;
constexpr size_t WS_BTC = WS_LPX + (size_t)16 * T * 4;
constexpr size_t WS_R = al256(WS_BTC + (size_t)D * 1024 * 2);
constexpr size_t WS_Z = WS_R;
constexpr size_t WS_XQ = WS_R;
constexpr size_t WS_XQB = WS_R;
constexpr size_t WS_PH = WS_R + (size_t)T * D * 2;
constexpr size_t WS_NSQ = WS_Z + (size_t)T * NIN * 4;
constexpr size_t SZ_ORA = ORACLE_ATTN ? (size_t)T * 256 * 4 : 0;
constexpr size_t WS_NKS = WS_NSQ + 4 * SZ_ORA, WS_NKW = WS_NKS + SZ_ORA;
constexpr size_t WS_MLQ = WS_NKW + SZ_ORA, WS_MLK = WS_MLQ + (size_t)T * 512 * 4;
constexpr size_t SZ_ST = (size_t)NCH * 4 * 128 * 128 * 4;
constexpr size_t SZ_STO = ORACLE_MIX ? SZ_ST : 0;
constexpr size_t WS_HGU = WS_MLK + (size_t)T * 512 * 4, WS_HGS = WS_HGU + SZ_ST, WS_MLU = WS_HGS + SZ_STO, WS_MLS = WS_MLU + SZ_ST;
constexpr size_t WS_QN = WS_MLS + SZ_STO;
constexpr size_t SZ_KF = (size_t)2 * T * 128 * 2;
constexpr size_t WS_KSF = WS_QN + (size_t)T * 1024 * 2, WS_KWF = WS_KSF + SZ_KF, WS_VSF = WS_KWF + SZ_KF, WS_VWF = WS_VSF + SZ_KF;
constexpr size_t WS_KCF = WS_VWF + SZ_KF, WS_VCF = WS_KCF + 2 * 16 * 4096 * 2;
constexpr size_t WS_OC = WS_VCF + 2 * 16 * 4096 * 2;
constexpr size_t WS_SELG = WS_OC + (size_t)T * 1024 * 4;
constexpr size_t WS_HGST = WS_SELG + (size_t)T * 2 * 16 * 4;
constexpr size_t WS_MLST = WS_HGST + SZ_ST / 2;
constexpr size_t WS_MIX_END = WS_MLST + SZ_ST / 2;
constexpr size_t WS_HM = WS_R;
constexpr size_t WS_R_END1 = WS_MIX_END, WS_R_END2 = WS_HM + (size_t)T * DFF * KS * 2;
constexpr size_t WS_END = WS_R_END1 > WS_R_END2 ? WS_R_END1 : WS_R_END2;

constexpr int CW_TMO = 0;
constexpr int CW_BAR = 4096;
constexpr int LDS_SCR = 155648;
constexpr int MISC_OFF = LDS_SCR;
constexpr int LDS_BYTES = LDS_SCR + 1024;
constexpr int WAVE_SCR = LDS_SCR / 8;

#define GAS __attribute__((address_space(1)))
#define LAS __attribute__((address_space(3)))
typedef unsigned short bf16;
typedef unsigned v4u __attribute__((ext_vector_type(4)));
typedef unsigned v2u __attribute__((ext_vector_type(2)));
typedef float f32x4 __attribute__((ext_vector_type(4)));
typedef float f32x2 __attribute__((ext_vector_type(2)));
typedef GAS unsigned gu32;
#define RLX_AGENT __ATOMIC_RELAXED, __HIP_MEMORY_SCOPE_AGENT
#define LDS_WAIT() asm volatile("s_waitcnt lgkmcnt(0)" ::: "memory")
__device__ __forceinline__ unsigned f2bf(float f) { unsigned u = __builtin_bit_cast(unsigned, f); return (u + 0x7fffu + ((u >> 16) & 1u)) >> 16; }
__device__ __forceinline__ float bf2f(unsigned b) { return __builtin_bit_cast(float, b << 16); }
__device__ __forceinline__ unsigned pk2(float lo, float hi) { return f2bf(lo) | (f2bf(hi) << 16); }
__device__ __forceinline__ float lo_of(float v) { return v - bf2f(f2bf(v)); }
__device__ __forceinline__ void storeA1(bf16* rowp, int Kreal, int col, float v) { const unsigned h = f2bf(v); rowp[col] = (bf16)h;
#if KS == 3
    rowp[Kreal + col] = (bf16)h; rowp[2 * Kreal + col] = (bf16)f2bf(v - bf2f(h));
#endif
}
__device__ __forceinline__ void storeA2(bf16* rowp, int Kreal, int col, float a, float b) { *(unsigned*)(rowp + col) = pk2(a, b);
#if KS == 3
    *(unsigned*)(rowp + Kreal + col) = pk2(a, b); *(unsigned*)(rowp + 2 * Kreal + col) = pk2(lo_of(a), lo_of(b));
#endif
}
__device__ __forceinline__ void storeA4(bf16* rowp, int Kreal, int col, f32x4 v) { v2u w; w.x = pk2(v[0], v[1]); w.y = pk2(v[2], v[3]); *(v2u*)(rowp + col) = w;
#if KS == 3
    *(v2u*)(rowp + Kreal + col) = w; v2u l; l.x = pk2(lo_of(v[0]), lo_of(v[1])); l.y = pk2(lo_of(v[2]), lo_of(v[3])); *(v2u*)(rowp + 2 * Kreal + col) = l;
#endif
}
__device__ __forceinline__ float wave_sum(float v) { v += sxor<1>(v); v += sxor<2>(v); v += sxor<4>(v); v += sxor<8>(v); v += sxor<16>(v); return half_sum(v); }
__device__ __forceinline__ float wave_max(float v) { v = fmaxf(v, sxor<1>(v)); v = fmaxf(v, sxor<2>(v)); v = fmaxf(v, sxor<4>(v)); v = fmaxf(v, sxor<8>(v)); v = fmaxf(v, sxor<16>(v)); return half_max(v); }
#define ARGMAX_STEP(M) do { const float ov_ = sxor<M>(bv); const int oi_ = sxori<M>(bi); if (ov_ > bv || (ov_ == bv && oi_ < bi)) { bv = ov_; bi = oi_; } } while (0)
__device__ __forceinline__ void wave_argmax(float& bv, int& bi) { ARGMAX_STEP(1); ARGMAX_STEP(2); ARGMAX_STEP(4); ARGMAX_STEP(8); ARGMAX_STEP(16);
    unsigned va = __builtin_bit_cast(unsigned, bv), vb = va, ia = (unsigned)bi, ib = ia; swap32(va, vb); swap32(ia, ib);
    const float v0 = __builtin_bit_cast(float, va), v1 = __builtin_bit_cast(float, vb); const int i0 = (int)ia, i1 = (int)ib;
    if (v0 > v1 || (v0 == v1 && i0 < i1)) { bv = v0; bi = i0; } else { bv = v1; bi = i1; } }
__device__ __forceinline__ float sigmoidf_(float x) { return 1.0f / (1.0f + __expf(-x)); }
#define XB_TMO      128
#define XB_XCNT(j)  (256  + 64 * (j))
#define XB_XSUB(j)  (1280 + 64 * (j))
#define XB_XGEN(j)  (2304 + 64 * (j))
#define XB_TOP      3328
#define XB_TOPGEN   3392
#define XCD_BAR_WORDS 3456
#define XB_SPIN_CAP (1u << 18)

__device__ __forceinline__ unsigned xb_ld(unsigned* p)              { return __hip_atomic_load(p, __ATOMIC_RELAXED, __HIP_MEMORY_SCOPE_AGENT); }
__device__ __forceinline__ unsigned xb_add(unsigned* p, unsigned v) { return __hip_atomic_fetch_add(p, v, __ATOMIC_RELAXED, __HIP_MEMORY_SCOPE_AGENT); }
__device__ __forceinline__ unsigned xb_xcc_id() { return (unsigned)__builtin_amdgcn_s_getreg((3 << 11) | 20) & 0xFu; }
#define XB_SPIN(cond, bar) do { unsigned _sp = 0; while (cond) { __builtin_amdgcn_s_sleep(1); \
    if ((++_sp & 255u) == 0u) { if (xb_ld(&(bar)[XB_TMO])) break; if (_sp > XB_SPIN_CAP) { atomicAdd(&(bar)[XB_TMO], 1u); break; } } } } while (0)

struct XcdBarrier {
    unsigned* bar; unsigned x;
    volatile LAS unsigned* st;
};

__device__ __forceinline__ XcdBarrier xcd_barrier_post(unsigned* bar, volatile LAS unsigned* st) {
    XcdBarrier b; b.bar = bar; b.x = xb_xcc_id(); b.st = st;
    if (threadIdx.x == 0) (void)xb_add(&bar[XB_XCNT(b.x)], 1u);
    return b;
}
__device__ __forceinline__ void xcd_barrier_complete(unsigned* bar, unsigned x, unsigned& nloc, unsigned& nx) {
    const unsigned G = gridDim.x * gridDim.y * gridDim.z;
    unsigned sum, cnt, mine, sp = 0u;
    for (;;) {
        sum = 0u; cnt = 0u; mine = 0u;
#pragma unroll
        for (unsigned j = 0; j < 16; ++j) { const unsigned c = xb_ld(&bar[XB_XCNT(j)]); sum += c; cnt += (c > 0u) ? 1u : 0u; mine = (j == x) ? c : mine; }
        if (sum == G) break;
        __builtin_amdgcn_s_sleep(1);
        if ((++sp & 255u) == 0u) { if (xb_ld(&bar[XB_TMO])) break; if (sp > XB_SPIN_CAP) { atomicAdd(&bar[XB_TMO], 1u); break; } }
    }
    nloc = mine > 0u ? mine : 1u; nx = cnt > 0u ? cnt : 1u;
}

__device__ __forceinline__ void xcd_barrier(const XcdBarrier& b) {
    asm volatile("s_waitcnt vmcnt(0)" ::: "memory");
    __syncthreads();
    if (threadIdx.x == 0) {
        unsigned* bar = b.bar;
        __builtin_amdgcn_s_waitcnt(0);
        unsigned nloc = b.st[0], nx = b.st[1];
        if (nloc == 0u) { xcd_barrier_complete(bar, b.x, nloc, nx); b.st[0] = nloc; b.st[1] = nx; }
        const unsigned old = xb_add(&bar[XB_XSUB(b.x)], 1u);
        const unsigned gen = old / nloc;
        if (old + 1u == (gen + 1u) * nloc) {
            __builtin_amdgcn_fence(__ATOMIC_RELEASE, "agent");
            asm volatile("s_waitcnt vmcnt(0)" ::: "memory");
            const unsigned og = xb_add(&bar[XB_TOP], 1u);
            const unsigned tg = og / nx;
            if (og + 1u == (tg + 1u) * nx) xb_add(&bar[XB_TOPGEN], 1u);
            else XB_SPIN(xb_ld(&bar[XB_TOPGEN]) == tg, bar);
            __builtin_amdgcn_fence(__ATOMIC_ACQUIRE, "agent");
            xb_add(&bar[XB_XGEN(b.x)], 1u);
            asm volatile("s_waitcnt vmcnt(0)" ::: "memory");
        } else {
            XB_SPIN(xb_ld(&bar[XB_XGEN(b.x)]) == gen, bar);
            __builtin_amdgcn_fence(__ATOMIC_ACQUIRE, "agent");
            asm volatile("s_waitcnt vmcnt(0)" ::: "memory");
        }
    }
    __syncthreads();
}


__device__ __forceinline__ void xcd_barrier_arrive(const XcdBarrier& b) {
    asm volatile("s_waitcnt vmcnt(0)" ::: "memory");
    __syncthreads();
    if (threadIdx.x == 0) {
        unsigned* bar = b.bar;
        __builtin_amdgcn_s_waitcnt(0);
        unsigned nloc = b.st[0], nx = b.st[1];
        if (nloc == 0u) { xcd_barrier_complete(bar, b.x, nloc, nx); b.st[0] = nloc; b.st[1] = nx; }
        const unsigned old = xb_add(&bar[XB_XSUB(b.x)], 1u);
        const unsigned gen = old / nloc;
        if (old + 1u == (gen + 1u) * nloc) {
            __builtin_amdgcn_fence(__ATOMIC_RELEASE, "agent");
            asm volatile("s_waitcnt vmcnt(0)" ::: "memory");
            const unsigned og = xb_add(&bar[XB_TOP], 1u);
            const unsigned tg = og / nx;
            if (og + 1u == (tg + 1u) * nx) xb_add(&bar[XB_TOPGEN], 1u);
            else XB_SPIN(xb_ld(&bar[XB_TOPGEN]) == tg, bar);
            __builtin_amdgcn_fence(__ATOMIC_ACQUIRE, "agent");
            xb_add(&bar[XB_XGEN(b.x)], 1u);
            asm volatile("s_waitcnt vmcnt(0)" ::: "memory");
            b.st[2] = 0xFFFFFFFFu;
        } else b.st[2] = gen;
    }
}
__device__ __forceinline__ void xcd_barrier_wait(const XcdBarrier& b) {
    if (threadIdx.x == 0) {
        const unsigned gen = b.st[2];
        if (gen != 0xFFFFFFFFu) {
            XB_SPIN(xb_ld(&b.bar[XB_XGEN(b.x)]) == gen, b.bar);
            __builtin_amdgcn_fence(__ATOMIC_ACQUIRE, "agent");
            asm volatile("s_waitcnt vmcnt(0)" ::: "memory");
        }
    }
    __syncthreads();
}
struct KArgs { const float* in[25]; float* out; unsigned char* ws; int ph_lo, ph_hi, li, pad; };
struct Frame {
    LAS unsigned char* lds;
    volatile LAS unsigned* MISC;
    gu32* ctl;
    int tid, lane, wave, G, bid;
    size_t wofs;
    unsigned char* ws;
    const KArgs __attribute__((address_space(4)))* ap;
};
#define INP(i) ((const float*)F.ap->in[i])
#define OUTP   ((float*)F.ap->out)
#define LAUNDER() do { asm volatile("" : "+s"(F.ws)); asm volatile("" : "+s"(F.ap)); int z_ = 0; asm volatile("" : "+s"(z_)); F.lane = (int)__builtin_amdgcn_mbcnt_hi(~0u, __builtin_amdgcn_mbcnt_lo(~0u, (unsigned)z_)); F.tid = F.wave * 64 + F.lane; } while (0)
#define WSP(type, off) ((type*)(F.ws + (off)))
#define WSL(type, off) ((type*)(F.ws + (off) + F.wofs))
#define WSO(type, off, wo) ((type*)(F.ws + (off) + (wo)))
#define EXPF(x) __expf(x)
#define LOGF(x) __logf(x)
__device__ __forceinline__ float sigm(float x) { return __builtin_amdgcn_rcpf(1.0f + EXPF(-x)); }
__device__ __forceinline__ float siluf_(float x) { return x * __builtin_amdgcn_rcpf(1.0f + EXPF(-x)); }

__device__ const float c_invf[64] = {1.000000000e+00f, 8.659643531e-01f, 7.498942018e-01f, 6.493816376e-01f, 5.623413324e-01f, 4.869675338e-01f, 4.216965139e-01f, 3.651741147e-01f, 3.162277639e-01f, 2.738419771e-01f, 2.371373773e-01f, 2.053525001e-01f, 1.778279394e-01f, 1.539926529e-01f, 1.333521456e-01f, 1.154781953e-01f, 1.000000015e-01f, 8.659642935e-02f, 7.498942316e-02f, 6.493816525e-02f, 5.623413250e-02f, 4.869675264e-02f, 4.216964915e-02f, 3.651741147e-02f, 3.162277490e-02f, 2.738419548e-02f, 2.371373773e-02f, 2.053525113e-02f, 1.778279431e-02f, 1.539926510e-02f, 1.333521400e-02f, 1.154781971e-02f, 9.999999776e-03f, 8.659643121e-03f, 7.498942316e-03f, 6.493816152e-03f, 5.623413250e-03f, 4.869675264e-03f, 4.216964822e-03f, 3.651741194e-03f, 3.162277630e-03f, 2.738419687e-03f, 2.371373819e-03f, 2.053525066e-03f, 1.778279431e-03f, 1.539926510e-03f, 1.333521446e-03f, 1.154782018e-03f, 1.000000047e-03f, 8.659643354e-04f, 7.498941850e-04f, 6.493816036e-04f, 5.623413017e-04f, 4.869675322e-04f, 4.216965172e-04f, 3.651741135e-04f, 3.162277571e-04f, 2.738419571e-04f, 2.371373703e-04f, 2.053525095e-04f, 1.778279402e-04f, 1.539926598e-04f, 1.333521504e-04f, 1.154782003e-04f};

__device__ __forceinline__ void sincos_acc(float ang, float& s_out, float& c_out) {
    const double x = (double)ang;
    const double k = rint(x * 0.63661977236758134308);
    double r = fma(-k, 1.57079632679489655800e+00, x); r = fma(-k, 6.12323399573676603587e-17, r);
    const double r2 = r * r;
    double sp = -1.0 / 6227020800.0; sp = fma(sp, r2, 1.0 / 39916800.0); sp = fma(sp, r2, -1.0 / 362880.0); sp = fma(sp, r2, 1.0 / 5040.0); sp = fma(sp, r2, -1.0 / 120.0); sp = fma(sp, r2, 1.0 / 6.0);
    const double sn = fma(-sp * r2, r, r);
    double cp = -1.0 / 87178291200.0; cp = fma(cp, r2, 1.0 / 479001600.0); cp = fma(cp, r2, -1.0 / 3628800.0); cp = fma(cp, r2, 1.0 / 40320.0); cp = fma(cp, r2, -1.0 / 720.0); cp = fma(cp, r2, 1.0 / 24.0); cp = fma(cp, r2, -0.5);
    const double cs = fma(cp, r2, 1.0);
    const int q = ((int)k) & 3;
    const double s = (q == 0) ? sn : (q == 1) ? cs : (q == 2) ? -sn : -cs;
    const double c = (q == 0) ? cs : (q == 1) ? -sn : (q == 2) ? -cs : sn;
    s_out = (float)s; c_out = (float)c;
}

__device__ __forceinline__ void row_to_bf16_ssq(Frame& F, const float* xrow, bf16* orow, float* ssq_out, int np, int ldp) {
    const f32x4* xr = (const f32x4*)xrow + F.lane; float s = 0.f;
#pragma unroll
    for (int j = 0; j < D / 256; ++j) { const f32x4 v = xr[64 * j]; s += (v[0] * v[0] + v[1] * v[1]) + (v[2] * v[2] + v[3] * v[3]); storeA4(orow, D, 256 * j + 4 * F.lane, v); }
    s = wave_sum(s); if (F.lane < np) ssq_out[(size_t)F.lane * ldp] = (F.lane == 0) ? s : 0.f;
}

__device__ __forceinline__ void ph_prologue(Frame& F) {
    const int gw = F.bid * 8 + F.wave, NGW = F.G * 8, gt = F.bid * 512 + F.tid, NGT = F.G * 512;
    float* cosT = WSP(float, WS_COS); float* sinT = WSP(float, WS_SIN);
    for (int i = gt; i < T * 64; i += NGT) { const int pos = i >> 6, fi = i & 63; const float ang = (float)pos * c_invf[fi]; float s, c; sincos_acc(ang, s, c); cosT[i] = c; sinT[i] = s; }
    const float* lg = INP(5); float* lb = WSP(float, WS_LB);
    for (int j = gt; j < 512; j += NGT) { const float a0 = lg[j], a1 = lg[512 + j], a2 = lg[1024 + j], a3 = lg[1536 + j]; const float mx = fmaxf(fmaxf(a0, a1), fmaxf(a2, a3));
        const float e0 = EXPF(a0 - mx), e1 = EXPF(a1 - mx), e2 = EXPF(a2 - mx), e3 = EXPF(a3 - mx), inv = 1.0f / (((e0 + e1) + e2) + e3);
        const float p0 = e0 * inv, p1 = e1 * inv, p2 = e2 * inv, p3 = e3 * inv;
        lb[j] = p0 - p0; lb[512 + j] = (p0 + p1) - p0; lb[1024 + j] = ((p0 + p1) + p2) - p0; lb[1536 + j] = (((p0 + p1) + p2) + p3) - p0; }
    for (int m = gw; m < T; m += NGW) row_to_bf16_ssq(F, INP(0) + (size_t)m * D, WSP(bf16, WS_A0) + (size_t)m * (KS * D), WSP(float, WS_SSQA) + m, 32, T);
    for (int m = gw; m < MEM; m += NGW) row_to_bf16_ssq(F, INP(1) + (size_t)m * D, WSP(bf16, WS_MEMB) + (size_t)m * (KS * D), WSP(float, WS_SSQM) + m, 1, 0);
}

template <bool ZMAP, bool HSL = false>
__device__ __forceinline__ void wconv_item(const float* W, int K, int ldw, const float* gain, bf16* WT, LAS float* scr, int item, int nblk, int lane) {
    const int kb = item / nblk, nb = item % nblk, k0 = 64 * kb, n0 = 64 * nb;
    const int c4 = 4 * (lane & 15), rr = lane >> 4;
    const int nsrc = ZMAP ? zcol_src(n0 + c4) : (n0 + c4);
    f32x4 v[16];
#pragma unroll
    for (int i = 0; i < 16; ++i) v[i] = (nsrc >= 0) ? __builtin_nontemporal_load((const f32x4*)(W + (size_t)(k0 + 4 * i + rr) * ldw + nsrc)) : (f32x4){0.f, 0.f, 0.f, 0.f};
#pragma unroll
    for (int i = 0; i < 16; ++i) { const int kk = 4 * i + rr; const float gk = gain ? gain[k0 + kk] : 1.0f; LAS float* d = scr + kk * 65 + c4; d[0] = v[i][0] * gk; d[1] = v[i][1] * gk; d[2] = v[i][2] * gk; d[3] = v[i][3] * gk; }
    LDS_WAIT(); asm volatile("" ::: "memory");
    const int c = lane & 7;
#pragma unroll
    for (int j = 0; j < 8; ++j) { const int n = (lane >> 3) + 8 * j; const LAS float* s = scr + (8 * c) * 65 + n;
        float x[8];
#pragma unroll
        for (int q = 0; q < 8; ++q) x[q] = s[q * 65];
        v4u o; o.x = pk2(x[0], x[1]); o.y = pk2(x[2], x[3]); o.z = pk2(x[4], x[5]); o.w = pk2(x[6], x[7]);
        bf16* dst = HSL ? WT + ((size_t)(k0 >> 9) * (size_t)(nblk * 64) + (n0 + n)) * 512 + (k0 & 511) + 8 * c : WT + (size_t)(n0 + n) * (KS * K) + k0 + 8 * c;
        __builtin_nontemporal_store(o, (v4u*)dst);
#if KS == 3
        v4u l; l.x = pk2(lo_of(x[0]), lo_of(x[1])); l.y = pk2(lo_of(x[2]), lo_of(x[3])); l.z = pk2(lo_of(x[4]), lo_of(x[5])); l.w = pk2(lo_of(x[6]), lo_of(x[7]));
        *(v4u*)(dst + K) = l; *(v4u*)(dst + 2 * K) = o;
#endif
    }
    LDS_WAIT(); asm volatile("" ::: "memory");
}
constexpr int WC_I_IN = (D / 64) * (NIN / 64), WC_I_DD = (D / 64) * (D / 64), WC_I_1 = (D / 64) * (DFF / 64), WC_I_2 = (DFF / 64) * (D / 64);
constexpr int WC_NT = WC_I_IN + 5 * WC_I_DD + WC_I_1 + WC_I_2, WC_NALL = WC_NT + 2048 + NIN / 256;
constexpr int K4_PER = K4PER_, K4_CONV = 128 * K4_PER;
constexpr int K1_PER = 40, K1_CONV = 140 * K1_PER;
__device__ __forceinline__ void wcf_item(Frame& F, int L, size_t wo, int item);
constexpr int WC_DEF_LO = WC_I_IN + 5 * WC_I_DD, WC_DEF_N = WC_I_1 + WC_I_2;
__device__ __forceinline__ void ph_wconv(Frame& F, int L, size_t wo, int lo, int hi, int skip_lo = 1 << 30, int skip_len = 0, int w_lo = 0) {
    LAS float* scr = (LAS float*)(F.lds + F.wave * WAVE_SCR);
    const float* w_in = INP(3) + (size_t)L * D * DIN; const float* g_mix = INP(2) + L * D;
    const float* w_out = INP(13) + (size_t)L * D * D;
    const float* wq = INP(16) + (size_t)L * D * D; const float* wk = INP(17) + (size_t)L * D * D; const float* wv = INP(18) + (size_t)L * D * D; const float* wo_ = INP(19) + (size_t)L * D * D;
    const float* g_xa = INP(14) + L * D; const float* g_mem = INP(15) + L * D; const float* g_mlp = INP(22) + L * D;
    const float* w1 = INP(23) + (size_t)L * D * DFF; const float* w2 = INP(24) + (size_t)L * DFF * D;
    if (F.wave < w_lo) return;
    for (int it = lo + (F.wave - w_lo); it < hi; it += 8 - w_lo) {
        int r = it + (it >= skip_lo ? skip_len : 0);
        if (r < WC_I_IN) { wconv_item<true>(w_in, D, DIN, g_mix, WSO(bf16, WS_WIN, wo), scr, r, NIN / 64, F.lane); continue; } r -= WC_I_IN;
        if (r < WC_I_DD) { wconv_item<false>(w_out, D, D, nullptr, WSO(bf16, WS_WOUT, wo), scr, r, D / 64, F.lane); continue; } r -= WC_I_DD;
        if (r < WC_I_DD) { wconv_item<false>(wq, D, D, g_xa, WSO(bf16, WS_WQ, wo), scr, r, D / 64, F.lane); continue; } r -= WC_I_DD;
        if (r < WC_I_DD) { wconv_item<false, XFUSE != 0>(wo_, D, D, nullptr, WSO(bf16, WS_WO, wo), scr, r, D / 64, F.lane); continue; } r -= WC_I_DD;
        if (r < WC_I_DD) { wconv_item<false>(wk, D, D, g_mem, WSO(bf16, WS_WKV, wo), scr, r, D / 64, F.lane); continue; } r -= WC_I_DD;
        if (r < WC_I_DD) { wconv_item<false>(wv, D, D, g_mem, WSO(bf16, WS_WKV, wo) + (size_t)D * (KS * D), scr, r, D / 64, F.lane); continue; } r -= WC_I_DD;
        if (r < WC_I_1) { wconv_item<false>(w1, D, DFF, g_mlp, WSO(bf16, WS_W1, wo), scr, r, DFF / 64, F.lane); continue; } r -= WC_I_1;
        if (r < WC_I_2) { wconv_item<false>(w2, DFF, D, nullptr, WSO(bf16, WS_W2, wo), scr, r, D / 64, F.lane); continue; } r -= WC_I_2;
        if (r < 2048) { wcf_item(F, L, wo, r); continue; } r -= 2048;
        { float* bp = WSO(float, WS_BPERM, wo); const float* b_in = INP(4) + (size_t)L * DIN;
          for (int j = 256 * r + F.lane; j < 256 * r + 256; j += 64) { const int s = zcol_src(j); bp[j] = (s >= 0) ? b_in[s] : 0.f; } }
    }
}

__device__ __forceinline__ void normrope_head(const float* src, const float* gain, const float* cosr, const float* sinr, float& o1, float& o2, int lane) {
    const float x1 = src[lane], x2 = src[lane + 64];
    const float ss = wave_sum(x1 * x1 + x2 * x2);
    const float rs = 1.0f / sqrtf(ss * (1.0f / 128.0f) + EPS);
    const float y1 = x1 * rs * gain[lane], y2 = x2 * rs * gain[lane + 64];
    const float c = cosr[lane], s = sinr[lane];
    o1 = y1 * c - y2 * s; o2 = y2 * c + y1 * s;
}
__device__ __forceinline__ int swap23_(int r) { return (r & ~12) | ((r & 4) << 1) | ((r & 8) >> 1); }
__device__ __forceinline__ size_t kf_index_(int g, int t, int d) { return ((size_t)(g * 256 + (t >> 5)) * 4096) + (d >> 4) * 512 + (swap23_(t & 31) + 32 * ((d >> 3) & 1)) * 8 + (d & 7); }
__device__ __forceinline__ void ph_prep(Frame& F, int L, int w_lo) {
    if (F.wave < w_lo) return;
    const int gw = F.bid * (8 - w_lo) + (F.wave - w_lo), NGW = F.G * (8 - w_lo), lane = F.lane;
    const float* z = WSP(float, WS_Z);
    const float* qg = INP(7) + L * 128; const float* kg = INP(8) + L * 3 * 128; const float* cw = INP(11) + (size_t)L * 4 * 1024;
    const float* cosT = WSP(float, WS_COS); const float* sinT = WSP(float, WS_SIN);
#if ORACLE_ATTN
    float* nsq = WSP(float, WS_NSQ); float* nks = WSP(float, WS_NKS); float* nkw = WSP(float, WS_NKW);
#endif
    float* mlq = WSP(float, WS_MLQ); float* mlk = WSP(float, WS_MLK);
    const float qscale = 0.08838834764831845f;
    bf16* qn = WSP(bf16, WS_QN); bf16* ksf = WSP(bf16, WS_KSF); bf16* kwf = WSP(bf16, WS_KWF);
    for (int t = gw; t < T; t += NGW) {
        const float* zr = z + (size_t)t * NIN; const float c = cosT[t * 64 + lane], s = sinT[t * 64 + lane];
        float x1[12], x2[12], ss[12];
#pragma unroll
        for (int i = 0; i < 12; ++i) { const int col = (i < 8) ? ZC_NSQ + i * 128 : (i < 10) ? ZC_NKS + (i - 8) * 128 : ZC_NKW + (i - 10) * 128; x1[i] = zr[col + lane]; x2[i] = zr[col + lane + 64]; ss[i] = x1[i] * x1[i] + x2[i] * x2[i]; }
#pragma unroll
        for (int i = 0; i < 12; ++i) ss[i] += sxor<1>(ss[i]);
#pragma unroll
        for (int i = 0; i < 12; ++i) ss[i] += sxor<2>(ss[i]);
#pragma unroll
        for (int i = 0; i < 12; ++i) ss[i] += sxor<4>(ss[i]);
#pragma unroll
        for (int i = 0; i < 12; ++i) ss[i] += sxor<8>(ss[i]);
#pragma unroll
        for (int i = 0; i < 12; ++i) ss[i] += sxor<16>(ss[i]);
#pragma unroll
        for (int i = 0; i < 12; ++i) ss[i] = half_sum(ss[i]);
#pragma unroll
        for (int i = 0; i < 12; ++i) { const float* gn = (i < 8) ? qg : (i < 10) ? kg + 128 : kg + 256; const float rs = 1.0f / sqrtf(ss[i] * (1.0f / 128.0f) + EPS);
            const float y1 = x1[i] * rs * gn[lane], y2 = x2[i] * rs * gn[lane + 64]; const float o1 = y1 * c - y2 * s, o2 = y2 * c + y1 * s;
            if (i < 8) { qn[(size_t)t * 1024 + i * 128 + lane] = (bf16)f2bf(o1 * (qscale * 1.4426950408889634f)); qn[(size_t)t * 1024 + i * 128 + lane + 64] = (bf16)f2bf(o2 * (qscale * 1.4426950408889634f));
#if ORACLE_ATTN
                nsq[(size_t)t * 1024 + i * 128 + lane] = o1 * qscale; nsq[(size_t)t * 1024 + i * 128 + lane + 64] = o2 * qscale;
#endif
            } else { bf16* kf = (i < 10) ? ksf : kwf; const int hh = (i - 8) & 1; kf[kf_index_(hh, t, lane)] = (bf16)f2bf(o1); kf[kf_index_(hh, t, lane + 64)] = (bf16)f2bf(o2);
#if ORACLE_ATTN
                float* kn = (i < 10) ? nks : nkw; kn[(size_t)t * 256 + hh * 128 + lane] = o1; kn[(size_t)t * 256 + hh * 128 + lane + 64] = o2;
#endif
            } }
#if ORACLE_MIX
        for (int i = 0; i < 16; ++i) { const int ch = lane + 64 * i; const int zc = (ch < 512) ? (ZC_MLQ + ch) : (ZC_MLK + ch - 512); float a = 0.f;
#pragma unroll
            for (int j = 0; j < 4; ++j) { const int tt = t - 3 + j; if (tt >= 0) a += cw[j * 1024 + ch] * z[(size_t)tt * NIN + zc]; }
            a = siluf_(a); if (ch < 512) mlq[(size_t)t * 512 + ch] = a * qscale; else mlk[(size_t)t * 512 + ch - 512] = a; }
#endif
    }
    { bf16* vsf = WSP(bf16, WS_VSF); bf16* vwf = WSP(bf16, WS_VWF);
      for (int tg8 = gw; tg8 < T / 8; tg8 += NGW) { const int t0 = 8 * tg8;
#pragma unroll
          for (int which = 0; which < 2; ++which)
#pragma unroll
              for (int g = 0; g < 2; ++g)
#pragma unroll
                  for (int dd = 0; dd < 2; ++dd) { const int d = lane + 64 * dd; const float* src = z + (size_t)t0 * NIN + (which ? ZC_NVW : ZC_NVS) + g * 128 + d; float v[8];
#pragma unroll
                      for (int j = 0; j < 8; ++j) v[j] = src[(size_t)j * NIN];
                      v4u o; o.x = pk2(v[0], v[1]); o.y = pk2(v[2], v[3]); o.z = pk2(v[4], v[5]); o.w = pk2(v[6], v[7]);
                      const size_t idx = ((size_t)(g * 256 + (t0 >> 5)) * 4096) + ((d >> 5) * 2 + ((t0 & 31) >> 4)) * 512 + ((d & 31) + 32 * ((t0 >> 3) & 1)) * 8;
                      *(v4u*)((which ? vwf : vsf) + idx) = o; } } }
    const float* kvx = WSP(float, WS_KVX); const float* xkg = INP(21) + L * 512; const float* xqg = INP(20) + L * 512; bf16* kxf = WSP(bf16, WS_KXF);
#if ORACLE_ATTN
    float* kxn = WSP(float, WS_KXN);
#endif
    for (int it = gw; it < MEM * 4; it += NGW) { const int m = it >> 2, h = it & 3; const float* src = kvx + (size_t)m * (2 * D) + h * 512; float v[8]; float ss = 0.f;
#pragma unroll
        for (int j = 0; j < 8; ++j) { v[j] = src[lane + 64 * j]; ss += v[j] * v[j]; }
        ss = wave_sum(ss); const float rs = 1.0f / sqrtf(ss * (1.0f / 512.0f) + EPS);
#pragma unroll
        for (int j = 0; j < 8; ++j) { const int d = lane + 64 * j; const float y = v[j] * rs * xkg[d]; const float yq = y * xqg[d] * (0.04419417382415922f * 1.4426950408889634f);
#if ORACLE_ATTN
            kxn[((size_t)h * MEM + m) * 512 + d] = y;
#endif
            kxf[((size_t)h * MEM + m) * 512 + d] = (bf16)f2bf(yq); } }
#if XFUSE
    { bf16* vxr = WSP(bf16, WS_VXF);
      for (int it = gw; it < MEM * 4; it += NGW) { const int m = it >> 2, h = it & 3; const float* src = kvx + (size_t)m * (2 * D) + D + h * 512 + 8 * lane;
          const f32x4 a = *(const f32x4*)src, b2 = *(const f32x4*)(src + 4);
          v4u o; o.x = pk2(a[0], a[1]); o.y = pk2(a[2], a[3]); o.z = pk2(b2[0], b2[1]); o.w = pk2(b2[2], b2[3]);
          *(v4u*)(vxr + ((size_t)h * MEM + m) * 512 + 8 * lane) = o; } }
#else
    { bf16* vxf = WSP(bf16, WS_VXF);
      for (int it = gw; it < (MEM / 8) * 4; it += NGW) { const int m0 = 8 * (it >> 2), h = it & 3;
#pragma unroll
          for (int dd = 0; dd < 8; ++dd) { const int d = lane + 64 * dd; const float* src = kvx + (size_t)m0 * (2 * D) + D + h * 512 + d; float v[8];
#pragma unroll
              for (int j = 0; j < 8; ++j) v[j] = src[(size_t)j * (2 * D)];
              v4u o; o.x = pk2(v[0], v[1]); o.y = pk2(v[2], v[3]); o.z = pk2(v[4], v[5]); o.w = pk2(v[6], v[7]);
              *(v4u*)(vxf + ((size_t)h * 512 + d) * MEM + m0) = o; } } }
#endif
}
constexpr int HP = 129;
__device__ __forceinline__ void hg_gates(Frame& F, int L, int c, int h, LAS float* B, LAS float* KY) {
    const float* z = WSP(float, WS_Z); const float* lb = WSP(float, WS_LB) + L * 512 + h * 128;
    for (int i = F.tid; i < 64 * 128; i += 512) { const int s = i >> 7, d = i & 127; const float zf = z[(size_t)(64 * c + s) * NIN + ZC_HGF + h * 128 + d]; const float l = lb[d];
        const float e = EXPF(-fabsf(zf)); const float sp = (zf >= 0.f) ? 1.0f / (1.0f + e) : e / (1.0f + e);
        const float sn = (zf >= 0.f) ? e / (1.0f + e) : 1.0f / (1.0f + e);
        const float forget = l + (1.0f - l) * sp;
        B[s * HP + d] = LOGF(fmaxf(forget, 1e-20f)); KY[s * HP + d] = (1.0f - l) * sn; }
    __syncthreads();
    float offs[2];
    for (int k = 0; k < 2; ++k) { const int i = F.tid + 512 * k, d = i & 127, s0 = (i >> 7) * 8; float a = 0.f;
#pragma unroll
        for (int j = 0; j < 8; ++j) { a += B[(s0 + j) * HP + d]; B[(s0 + j) * HP + d] = a; } }
    __syncthreads();
    for (int k = 0; k < 2; ++k) { const int i = F.tid + 512 * k, d = i & 127, ch = i >> 7; float off = 0.f;
        for (int c2 = 0; c2 < ch; ++c2) off += B[(8 * c2 + 7) * HP + d];
        offs[k] = off; }
    __syncthreads();
    for (int k = 0; k < 2; ++k) { const int i = F.tid + 512 * k, d = i & 127, s0 = (i >> 7) * 8;
#pragma unroll
        for (int j = 0; j < 8; ++j) B[(s0 + j) * HP + d] += offs[k]; }
    __syncthreads();
}
__device__ __forceinline__ void hg_summary_item(Frame& F, int L, int c, int h) {
    LAS float* B = (LAS float*)F.lds; LAS float* KY = B + 64 * HP; LAS float* V = KY + 64 * HP;
    const float* z = WSP(float, WS_Z);
    hg_gates(F, L, c, h, B, KY);
    for (int i = F.tid; i < 64 * 128; i += 512) { const int s = i >> 7, d = i & 127; KY[s * HP + d] *= EXPF(B[63 * HP + d] - B[s * HP + d]); V[s * HP + d] = z[(size_t)(64 * c + s) * NIN + ZC_HGI + h * 128 + d]; }
    if (F.tid < 128) WSP(float, WS_HGDEC)[(c * 4 + h) * 128 + F.tid] = EXPF(B[63 * HP + F.tid]);
    __syncthreads();
    const int e = F.tid & 127, dg = F.tid >> 7; float acc[32];
#pragma unroll
    for (int j = 0; j < 32; ++j) acc[j] = 0.f;
    for (int s = 0; s < 64; ++s) { const float v = V[s * HP + e];
#pragma unroll
        for (int j = 0; j < 32; ++j) acc[j] += KY[s * HP + dg * 32 + j] * v; }
    float* U = WSP(float, WS_HGU) + (size_t)(c * 4 + h) * 16384;
#pragma unroll
    for (int j = 0; j < 32; ++j) U[(dg * 32 + j) * 128 + e] = acc[j];
    __syncthreads();
}
template <bool SILU>
__device__ __forceinline__ void finish_rows(Frame& F, LAS float* O, const float* gain, const float* gate_src, int gate_col, int ycol, int c) {
    bf16* y = WSP(bf16, WS_A1);
    for (int rr = 0; rr < 8; ++rr) { const int t = F.wave * 8 + rr; const float o1 = O[t * HP + F.lane], o2 = O[t * HP + F.lane + 64];
        const float ss = wave_sum(o1 * o1 + o2 * o2); const float rs = 1.0f / sqrtf(ss * (1.0f / 128.0f) + EPS);
        const float* gr = gate_src + (size_t)(64 * c + t) * NIN + gate_col; const float g1 = gr[F.lane], g2 = gr[F.lane + 64];
        const float a1 = SILU ? siluf_(g1) : sigm(g1), a2 = SILU ? siluf_(g2) : sigm(g2);
        bf16* yr = y + (size_t)(64 * c + t) * (KS * D);
        storeA1(yr, D, ycol + F.lane, o1 * rs * gain[F.lane] * a1); storeA1(yr, D, ycol + F.lane + 64, o2 * rs * gain[F.lane + 64] * a2); }
}
__device__ __forceinline__ void hg_output_item(Frame& F, int L, int c, int h) {
    LAS float* B = (LAS float*)F.lds; LAS float* KY = B + 64 * HP; LAS float* Q = KY + 64 * HP; LAS float* SC = Q + 64 * HP;
    const float* z = WSP(float, WS_Z);
    hg_gates(F, L, c, h, B, KY);
    for (int i = F.tid; i < 64 * 128; i += 512) { const int s = i >> 7, d = i & 127; Q[s * HP + d] = z[(size_t)(64 * c + s) * NIN + ZC_HGQ + h * 128 + d]; }
    __syncthreads();
    for (int p = F.tid; p < 4096; p += 512) { const int t = p >> 6, s = p & 63; float a = 0.f;
        if (s <= t) { for (int d = 0; d < 128; ++d) a += Q[t * HP + d] * KY[s * HP + d] * EXPF(B[t * HP + d] - B[s * HP + d]); }
        SC[t * 65 + s] = a; }
    __syncthreads();
    for (int i = F.tid; i < 64 * 128; i += 512) { const int s = i >> 7, d = i & 127; Q[s * HP + d] *= EXPF(B[s * HP + d]); }
    __syncthreads();
    const int e = F.tid & 127, tg = F.tid >> 7; float acc[16];
#pragma unroll
    for (int j = 0; j < 16; ++j) acc[j] = 0.f;
    for (int s = 0; s < 64; ++s) { const float v = z[(size_t)(64 * c + s) * NIN + ZC_HGI + h * 128 + e];
#pragma unroll
        for (int j = 0; j < 16; ++j) acc[j] += SC[(tg * 16 + j) * 65 + s] * v; }
    const float* S = WSP(float, WS_HGS) + (size_t)(c * 4 + h) * 16384;
    for (int d = 0; d < 128; ++d) { const float sv = S[d * 128 + e];
#pragma unroll
        for (int j = 0; j < 16; ++j) acc[j] += Q[(tg * 16 + j) * HP + d] * sv; }
    __syncthreads();
#pragma unroll
    for (int j = 0; j < 16; ++j) KY[(tg * 16 + j) * HP + e] = acc[j];
    __syncthreads();
    finish_rows<true>(F, KY, INP(6) + L * 512 + h * 128, z, ZC_HGG + h * 128, h * 128, c);
    __syncthreads();
}

__device__ __forceinline__ void ml_gates(Frame& F, int c, int h, LAS float* BL, LAS float* LI) {
    const float* z = WSP(float, WS_Z);
    if (F.tid < 64) { const float f = z[(size_t)(64 * c + F.tid) * NIN + ZC_MLF + h]; BL[F.tid] = fminf(f, 0.f) - log1pf(EXPF(-fabsf(f))); LI[F.tid] = z[(size_t)(64 * c + F.tid) * NIN + ZC_MLI + h]; }
    __syncthreads();
    if (F.tid < 64) { float a = 0.f; for (int s = 0; s < 64; ++s) { const float v = BL[s]; a += (s <= F.tid) ? v : 0.f; } LDS_WAIT(); asm volatile("" ::: "memory"); BL[F.tid] = a; }
    __syncthreads();
}
__device__ __forceinline__ void ml_summary_item(Frame& F, int c, int h) {
    LAS float* KW = (LAS float*)F.lds; LAS float* V = KW + 64 * HP; LAS float* BL = V + 64 * HP; LAS float* LI = BL + 64; LAS float* WS_ = LI + 64;
    const float* z = WSP(float, WS_Z); const float* mlk = WSP(float, WS_MLK);
    ml_gates(F, c, h, BL, LI);
    float mloc = -3.0e38f; for (int s = 0; s < 64; ++s) mloc = fmaxf(mloc, BL[63] - BL[s] + LI[s]);
    if (F.tid < 64) WS_[F.tid] = EXPF(BL[63] - BL[F.tid] + LI[F.tid] - mloc);
    __syncthreads();
    for (int i = F.tid; i < 64 * 128; i += 512) { const int s = i >> 7, d = i & 127; KW[s * HP + d] = mlk[(size_t)(64 * c + s) * 512 + h * 128 + d] * WS_[s]; V[s * HP + d] = z[(size_t)(64 * c + s) * NIN + ZC_MLV + h * 128 + d]; }
    float* msc = WSP(float, WS_MLSC);
    if (F.tid == 0) { msc[c * 4 + h] = mloc; msc[NCH * 4 + c * 4 + h] = BL[63]; }
    __syncthreads();
    const int e = F.tid & 127, dg = F.tid >> 7; float acc[32];
#pragma unroll
    for (int j = 0; j < 32; ++j) acc[j] = 0.f;
    for (int s = 0; s < 64; ++s) { const float v = V[s * HP + e];
#pragma unroll
        for (int j = 0; j < 32; ++j) acc[j] += KW[s * HP + dg * 32 + j] * v; }
    float* U = WSP(float, WS_MLU) + (size_t)(c * 4 + h) * 16384;
#pragma unroll
    for (int j = 0; j < 32; ++j) U[(dg * 32 + j) * 128 + e] = acc[j];
    if (F.tid < 128) { float a = 0.f; for (int s = 0; s < 64; ++s) a += KW[s * HP + F.tid]; WSP(float, WS_MLNL)[(c * 4 + h) * 128 + F.tid] = a; }
    __syncthreads();
}
__device__ __forceinline__ void ml_output_item(Frame& F, int L, int c, int h) {
    LAS float* Q = (LAS float*)F.lds; LAS float* KK = Q + 64 * HP; LAS float* SC = KK + 64 * HP; LAS float* BL = SC + 64 * 65; LAS float* LI = BL + 64; LAS float* MT = LI + 64; LAS float* WI = MT + 64; LAS float* QN = WI + 64;
    const float* z = WSP(float, WS_Z); const float* mlq = WSP(float, WS_MLQ); const float* mlk = WSP(float, WS_MLK);
    ml_gates(F, c, h, BL, LI);
    const float mprev = WSP(float, WS_MLSC)[2 * NCH * 4 + c * 4 + h];
    for (int i = F.tid; i < 64 * 128; i += 512) { const int s = i >> 7, d = i & 127; Q[s * HP + d] = mlq[(size_t)(64 * c + s) * 512 + h * 128 + d]; KK[s * HP + d] = mlk[(size_t)(64 * c + s) * 512 + h * 128 + d]; }
    if (F.tid < 64) { const int t = F.tid; const float inter = BL[t] + mprev; float mt = inter; for (int s = 0; s <= t; ++s) mt = fmaxf(mt, BL[t] - BL[s] + LI[s]); MT[t] = mt; WI[t] = EXPF(inter - mt); }
    __syncthreads();
    for (int p = F.tid; p < 4096; p += 512) { const int t = p >> 6, s = p & 63; float a = 0.f;
        if (s <= t) { for (int d = 0; d < 128; ++d) a += Q[t * HP + d] * KK[s * HP + d]; a *= EXPF(BL[t] - BL[s] + LI[s] - MT[t]); }
        SC[t * 65 + s] = a; }
    __syncthreads();
    if (F.tid < 64) { const int t = F.tid; const float* nst = WSP(float, WS_MLN) + (c * 4 + h) * 128; float a = 0.f; for (int d = 0; d < 128; ++d) a += Q[t * HP + d] * nst[d]; a *= WI[t];
        float r = 0.f; for (int s = 0; s < 64; ++s) r += SC[t * 65 + s]; QN[t] = a + r; }
    const int e = F.tid & 127, tg = F.tid >> 7; float acc[16];
#pragma unroll
    for (int j = 0; j < 16; ++j) acc[j] = 0.f;
    const float* Cst = WSP(float, WS_MLS) + (size_t)(c * 4 + h) * 16384;
    for (int d = 0; d < 128; ++d) { const float sv = Cst[d * 128 + e];
#pragma unroll
        for (int j = 0; j < 16; ++j) acc[j] += Q[(tg * 16 + j) * HP + d] * sv; }
#pragma unroll
    for (int j = 0; j < 16; ++j) acc[j] *= WI[tg * 16 + j];
    for (int s = 0; s < 64; ++s) { const float v = z[(size_t)(64 * c + s) * NIN + ZC_MLV + h * 128 + e];
#pragma unroll
        for (int j = 0; j < 16; ++j) acc[j] += SC[(tg * 16 + j) * 65 + s] * v; }
    __syncthreads();
#pragma unroll
    for (int j = 0; j < 16; ++j) { const int t = tg * 16 + j; KK[t * HP + e] = acc[j] / fmaxf(fabsf(QN[t]), EXPF(-MT[t])); }
    __syncthreads();
    finish_rows<false>(F, KK, INP(12) + L * 512 + h * 128, z, ZC_MLO + h * 128, 1536 + h * 128, c);
    __syncthreads();
}

__device__ __forceinline__ void cmp_item(Frame& F, int L, int item) {
    const int which = item & 1, g = (item >> 1) & 1, c0 = (item >> 2) * 8;
    LAS float* A = (LAS float*)F.lds;
    LAS float* PE = A + 144 * HP;
    LAS float* O = PE + 32 * 128;
    const float* z = WSP(float, WS_Z); const int zc = (which ? ZC_NVC : ZC_NKC) + g * 128;
    const float* pe = INP(9) + ((size_t)(L * 2 + which) * 32) * 128; const float* w = INP(10) + ((size_t)(L * 2 + which) * 32) * 128 * 128;
    for (int i = F.tid; i < 144 * 128; i += 512) { const int r = i >> 7, d = i & 127; const int tok = 16 * c0 + r; A[r * HP + d] = (tok < T) ? z[(size_t)tok * NIN + zc + d] : 0.f; }
    for (int i = F.tid; i < 32 * 128; i += 512) PE[i] = pe[i];
    __syncthreads();
    const int e = F.tid & 127, rg = F.tid >> 7;
    float a0 = 0.f, a1 = 0.f;
    for (int l = 0; l < 32; ++l) { const LAS float* r0 = A + (16 * (2 * rg) + l) * HP; const LAS float* r1 = A + (16 * (2 * rg + 1) + l) * HP; const LAS float* pr = PE + l * 128; const float* wl = w + (size_t)l * 16384 + e;
        for (int d = 0; d < 128; ++d) { const float wv = wl[d * 128], p = pr[d]; a0 += (r0[d] + p) * wv; a1 += (r1[d] + p) * wv; } }
    O[(2 * rg) * HP + e] = a0; O[(2 * rg + 1) * HP + e] = a1;
    __syncthreads();
    if (!which) { const int c = c0 + F.wave; const float o1 = O[F.wave * HP + F.lane], o2 = O[F.wave * HP + F.lane + 64];
        const float* kg = INP(8) + L * 384; const float ss = wave_sum(o1 * o1 + o2 * o2); const float rs = 1.0f / sqrtf(ss * (1.0f / 128.0f) + EPS);
        const float y1 = o1 * rs * kg[F.lane], y2 = o2 * rs * kg[F.lane + 64]; const int pos = (c < NCMP) ? 16 * c + 31 : 0; const float cs = WSP(float, WS_COS)[pos * 64 + F.lane], sn = WSP(float, WS_SIN)[pos * 64 + F.lane];
        const float r1 = y1 * cs - y2 * sn, r2 = y2 * cs + y1 * sn;
        bf16* kcf = WSP(bf16, WS_KCF) + (size_t)g * 16 * 4096 + (size_t)(c >> 5) * 4096;
        { const int d = F.lane; kcf[(d >> 4) * 512 + (swap23_(c & 31) + 32 * ((d >> 3) & 1)) * 8 + (d & 7)] = (bf16)f2bf(r1); }
        { const int d = F.lane + 64; kcf[(d >> 4) * 512 + (swap23_(c & 31) + 32 * ((d >> 3) & 1)) * 8 + (d & 7)] = (bf16)f2bf(r2); }
#if ORACLE_ATTN
        if (c < NCMP) { float* dst = WSP(float, WS_KCN) + (size_t)g * 512 * 128; dst[c * 128 + F.lane] = r1; dst[c * 128 + F.lane + 64] = r2; }
#endif
    } else {
        if (F.tid < 128) { const int d = F.tid; float v[8];
#pragma unroll
            for (int j = 0; j < 8; ++j) v[j] = O[j * HP + d];
            v4u o; o.x = pk2(v[0], v[1]); o.y = pk2(v[2], v[3]); o.z = pk2(v[4], v[5]); o.w = pk2(v[6], v[7]);
            *(v4u*)(WSP(bf16, WS_VCF) + (size_t)g * 16 * 4096 + (size_t)(c0 >> 5) * 4096 + ((d >> 5) * 2 + ((c0 & 31) >> 4)) * 512 + ((d & 31) + 32 * ((c0 >> 3) & 1)) * 8) = o; }
#if ORACLE_ATTN
        { const int c = c0 + F.wave; if (c < NCMP) { float* dst = WSP(float, WS_VCN) + (size_t)g * 512 * 128; dst[c * 128 + F.lane] = O[F.wave * HP + F.lane]; dst[c * 128 + F.lane + 64] = O[F.wave * HP + F.lane + 64]; } }
#endif
    }
    __syncthreads();
}

__device__ __forceinline__ void ph_scan(Frame& F) {
    const int gt = F.bid * 512 + F.tid, NGT = F.G * 512;
    const float* msc = WSP(float, WS_MLSC);
    for (int id = gt; id < 131072; id += NGT) { const int i = id & 65535; const int h = i >> 14, de = i & 16383, d = de >> 7;
        if (id < 65536) { const float* U = WSP(float, WS_HGU); float* S = WSP(float, WS_HGS); const float* dec = WSP(float, WS_HGDEC); float st = 0.f;
            for (int c = 0; c < NCH; ++c) { const size_t o = (size_t)(c * 4 + h) * 16384 + de; S[o] = st; st = dec[(c * 4 + h) * 128 + d] * st + U[o]; } }
        else { const float* U = WSP(float, WS_MLU); float* S = WSP(float, WS_MLS); float st = 0.f, m = 0.f;
            for (int c = 0; c < NCH; ++c) { const size_t o = (size_t)(c * 4 + h) * 16384 + de; S[o] = st; const float mloc = msc[c * 4 + h], bend = msc[NCH * 4 + c * 4 + h]; const float mn = fmaxf(bend + m, mloc);
                st = EXPF(bend + m - mn) * st + EXPF(mloc - mn) * U[o]; m = mn; } } }
    for (int i = gt; i < 512; i += NGT) { const int h = i >> 7, d = i & 127; const float* nl = WSP(float, WS_MLNL); float* ns = WSP(float, WS_MLN); float st = 0.f, m = 0.f;
        for (int c = 0; c < NCH; ++c) { const int o = (c * 4 + h) * 128 + d; ns[o] = st; const float mloc = msc[c * 4 + h], bend = msc[NCH * 4 + c * 4 + h]; const float mn = fmaxf(bend + m, mloc);
            st = EXPF(bend + m - mn) * st + EXPF(mloc - mn) * nl[o]; m = mn; } }
    for (int i = gt; i < 4; i += NGT) { float* mp = WSP(float, WS_MLSC) + 2 * NCH * 4; float m = 0.f;
        for (int c = 0; c < NCH; ++c) { mp[c * 4 + i] = m; m = fmaxf(msc[NCH * 4 + c * 4 + i] + m, msc[c * 4 + i]); } }
}
#if ORACLE_ATTN
__device__ __forceinline__ void nsa_scores(const float* kbase, int kstride, int kfirst, int nk, LAS float* QV, LAS float* SCW, int off, int lane) {
    const int sub = lane & 3, slot = lane >> 2;
    for (int p = 0; p < nk; p += 16) { const int i = p + slot; const bool ok = i < nk; const float* row = kbase + (size_t)(kfirst + (ok ? i : 0)) * kstride + 4 * sub;
        float a0 = 0.f, a1 = 0.f, a2 = 0.f, a3 = 0.f;
#pragma unroll 2
        for (int j = 0; j < 8; ++j) { const f32x4 kv = *(const f32x4*)(row + 16 * j); const LAS float* q = QV + 16 * j + 4 * sub;
            const f32x4 q0 = *(const LAS f32x4*)q, q1 = *(const LAS f32x4*)(q + 128), q2 = *(const LAS f32x4*)(q + 256), q3 = *(const LAS f32x4*)(q + 384);
            a0 += kv[0] * q0[0] + kv[1] * q0[1] + kv[2] * q0[2] + kv[3] * q0[3]; a1 += kv[0] * q1[0] + kv[1] * q1[1] + kv[2] * q1[2] + kv[3] * q1[3];
            a2 += kv[0] * q2[0] + kv[1] * q2[1] + kv[2] * q2[2] + kv[3] * q2[3]; a3 += kv[0] * q3[0] + kv[1] * q3[1] + kv[2] * q3[2] + kv[3] * q3[3]; }
        a0 += sxor<1>(a0); a1 += sxor<1>(a1); a2 += sxor<1>(a2); a3 += sxor<1>(a3);
        a0 += sxor<2>(a0); a1 += sxor<2>(a1); a2 += sxor<2>(a2); a3 += sxor<2>(a3);
        if (ok && sub == 0) *(LAS f32x4*)(SCW + (size_t)(off + i) * 4) = (f32x4){a0, a1, a2, a3}; }
}
__device__ __forceinline__ f32x4 nsa_softmax(LAS float* SCW, int n, int lane) {
    f32x4 mx = {-3.0e38f, -3.0e38f, -3.0e38f, -3.0e38f};
    for (int i = lane; i < n; i += 64) { const f32x4 s = *(const LAS f32x4*)(SCW + i * 4); mx[0] = fmaxf(mx[0], s[0]); mx[1] = fmaxf(mx[1], s[1]); mx[2] = fmaxf(mx[2], s[2]); mx[3] = fmaxf(mx[3], s[3]); }
#pragma unroll
    for (int h = 0; h < 4; ++h) mx[h] = wave_max(mx[h]);
    f32x4 sm = {0.f, 0.f, 0.f, 0.f};
    for (int i = lane; i < n; i += 64) { f32x4 s = *(const LAS f32x4*)(SCW + i * 4);
#pragma unroll
        for (int h = 0; h < 4; ++h) { s[h] = EXPF(s[h] - mx[h]); sm[h] += s[h]; }
        *(LAS f32x4*)(SCW + i * 4) = s; }
#pragma unroll
    for (int h = 0; h < 4; ++h) { sm[h] = wave_sum(sm[h]); sm[h] = (n > 0) ? 1.0f / sm[h] : 0.f; }
    LDS_WAIT();
    return sm;
}
__device__ __forceinline__ void nsa_pv(const float* vbase, int vstride, int vfirst, int nk, const LAS float* SCW, int off, f32x2 (&acc)[4], int lane) {
    const float* vp = vbase + (size_t)vfirst * vstride + 2 * lane;
    for (int i = 0; i < nk; ++i) { const f32x4 p = *(const LAS f32x4*)(SCW + (size_t)(off + i) * 4); const f32x2 v = *(const f32x2*)(vp + (size_t)i * vstride);
#pragma unroll
        for (int h = 0; h < 4; ++h) { acc[h][0] += p[h] * v[0]; acc[h][1] += p[h] * v[1]; } }
}
__device__ __forceinline__ void ph_nsa(Frame& F, int L) {
    const int lane = F.lane; LAS float* SCW = (LAS float*)(F.lds + F.wave * WAVE_SCR);
    LAS float* QV = SCW + 4096; LAS float* IMP = QV + 512; LAS int* SEL = (LAS int*)(IMP + 128);
    const float* z = WSP(float, WS_Z); const float* nsq = WSP(float, WS_NSQ); const float* nks = WSP(float, WS_NKS); const float* nkw = WSP(float, WS_NKW);
    bf16* y = WSP(bf16, WS_A1);
    for (int it = F.bid * 8 + F.wave; it < 2 * T; it += F.G * 8) {
        const int t = it >> 1, g = it & 1, cur = t >> 6;
        { const f32x4* qs = (const f32x4*)(nsq + (size_t)t * 1024 + g * 512); *(LAS f32x4*)(QV + 4 * lane) = qs[lane]; *(LAS f32x4*)(QV + 256 + 4 * lane) = qs[64 + lane]; }
        LDS_WAIT();
        f32x4 gate[3];
#pragma unroll
        for (int h = 0; h < 4; ++h)
#pragma unroll
            for (int b = 0; b < 3; ++b) gate[b][h] = sigm(z[(size_t)t * NIN + ZC_GATE + (g * 4 + h) * 3 + b]);
        f32x2 tot[4], acc[4];
#pragma unroll
        for (int h = 0; h < 4; ++h) tot[h] = (f32x2){0.f, 0.f};
        const int ncv = (t >= 31) ? ((t - 31) >> 4) + 1 : 0;
        const float* kcn = WSP(float, WS_KCN) + (size_t)g * 512 * 128; const float* vcn = WSP(float, WS_VCN) + (size_t)g * 512 * 128;
        nsa_scores(kcn, 128, 0, ncv, QV, SCW, 0, lane); LDS_WAIT();
        f32x4 inv = nsa_softmax(SCW, ncv, lane);
#pragma unroll
        for (int h = 0; h < 4; ++h) acc[h] = (f32x2){0.f, 0.f};
        nsa_pv(vcn, 128, 0, ncv, SCW, 0, acc, lane);
#pragma unroll
        for (int h = 0; h < 4; ++h) { tot[h][0] += acc[h][0] * inv[h] * gate[0][h]; tot[h][1] += acc[h][1] * inv[h] * gate[0][h]; }
        float v0, v1;
        { float im[2];
#pragma unroll
          for (int k = 0; k < 2; ++k) { const int s = lane + 64 * k; float a = 0.f;
              for (int c = 4 * s - 1; c <= 4 * s + 3; ++c) if (c >= 0 && c < ncv) { const f32x4 p = *(const LAS f32x4*)(SCW + c * 4); a += ((p[0] * inv[0] + p[1] * inv[1]) + p[2] * inv[2]) + p[3] * inv[3]; }
              im[k] = a; }
          v0 = im[0]; v1 = im[1]; }
        int nsel;
        if (cur < 16) { nsel = cur + 1; if (lane < 16) SEL[lane] = lane; }
        else { nsel = 16;
            { const int s0 = lane, s1 = lane + 64;
              v0 = (s0 > cur) ? -3.0e38f : ((s0 == 0 || s0 == cur || s0 == cur - 1) ? 3.0e38f : v0);
              v1 = (s1 > cur) ? -3.0e38f : ((s1 == cur || s1 == cur - 1) ? 3.0e38f : v1); }
            for (int k = 0; k < 16; ++k) { float bv; int bi; if (v0 >= v1) { bv = v0; bi = lane; } else { bv = v1; bi = lane + 64; }
                wave_argmax(bv, bi);
                if (bi == lane) v0 = -3.0e38f; if (bi == lane + 64) v1 = -3.0e38f;
                if (lane == 0) SEL[k] = bi; } }
        LDS_WAIT();
        int n = 0;
        for (int k = 0; k < nsel; ++k) { const int b = SEL[k]; const int nk = (b == cur) ? (t - 64 * cur + 1) : 64; nsa_scores(nks + g * 128, 256, 64 * b, nk, QV, SCW, n, lane); n += nk; }
        LDS_WAIT();
        inv = nsa_softmax(SCW, n, lane);
#pragma unroll
        for (int h = 0; h < 4; ++h) acc[h] = (f32x2){0.f, 0.f};
        n = 0;
        for (int k = 0; k < nsel; ++k) { const int b = SEL[k]; const int nk = (b == cur) ? (t - 64 * cur + 1) : 64; nsa_pv(z + ZC_NVS + g * 128, NIN, 64 * b, nk, SCW, n, acc, lane); n += nk; }
#pragma unroll
        for (int h = 0; h < 4; ++h) { tot[h][0] += acc[h][0] * inv[h] * gate[1][h]; tot[h][1] += acc[h][1] * inv[h] * gate[1][h]; }
        const int lo = (t >= 511) ? t - 511 : 0; n = t - lo + 1;
        nsa_scores(nkw + g * 128, 256, lo, n, QV, SCW, 0, lane); LDS_WAIT();
        inv = nsa_softmax(SCW, n, lane);
#pragma unroll
        for (int h = 0; h < 4; ++h) acc[h] = (f32x2){0.f, 0.f};
        nsa_pv(z + ZC_NVW + g * 128, NIN, lo, n, SCW, 0, acc, lane);
        bf16* yr = y + (size_t)t * (KS * D);
#pragma unroll
        for (int h = 0; h < 4; ++h) { const float o0 = tot[h][0] + acc[h][0] * inv[h] * gate[2][h], o1 = tot[h][1] + acc[h][1] * inv[h] * gate[2][h];
            storeA2(yr, D, 512 + (g * 4 + h) * 128 + 2 * lane, o0, o1); }
    }
}

__device__ __forceinline__ void ph_xattn(Frame& F, int L) {
    const int lane = F.lane; LAS float* QV = (LAS float*)(F.lds + F.wave * WAVE_SCR); LAS float* SC = QV + 512;
    const float* xq = WSP(float, WS_XQ); const float* kxn = WSP(float, WS_KXN); const float* kvx = WSP(float, WS_KVX); const float* qg = INP(20) + L * 512;
    bf16* y = WSP(bf16, WS_A1); const int sub = lane & 3, slot = lane >> 2;
    for (int it = F.bid * 8 + F.wave; it < 4 * T; it += F.G * 8) {
        const int t = it >> 2, h = it & 3;
        { const float* src = xq + (size_t)t * D + h * 512; const f32x4 a = *(const f32x4*)(src + 4 * lane), b = *(const f32x4*)(src + 256 + 4 * lane);
          float ss = (a[0] * a[0] + a[1] * a[1]) + (a[2] * a[2] + a[3] * a[3]) + (b[0] * b[0] + b[1] * b[1]) + (b[2] * b[2] + b[3] * b[3]); ss = wave_sum(ss);
          const float rs = (1.0f / sqrtf(ss * (1.0f / 512.0f) + EPS)) * 0.04419417382415922f;
          const f32x4 g0 = *(const f32x4*)(qg + 4 * lane), g1 = *(const f32x4*)(qg + 256 + 4 * lane);
          *(LAS f32x4*)(QV + 4 * lane) = a * rs * g0; *(LAS f32x4*)(QV + 256 + 4 * lane) = b * rs * g1; }
        LDS_WAIT();
        const float* kb = kxn + (size_t)h * MEM * 512;
        for (int p = 0; p < MEM; p += 16) { const int i = p + slot; const float* row = kb + (size_t)i * 512 + 4 * sub; float a = 0.f;
#pragma unroll 8
            for (int j = 0; j < 32; ++j) { const f32x4 kv = *(const f32x4*)(row + 16 * j); const f32x4 q = *(const LAS f32x4*)(QV + 16 * j + 4 * sub); a += (kv[0] * q[0] + kv[1] * q[1]) + (kv[2] * q[2] + kv[3] * q[3]); }
            a += sxor<1>(a); a += sxor<2>(a);
            if (sub == 0) SC[i] = a; }
        LDS_WAIT();
        float s4[4], mx = -3.0e38f;
#pragma unroll
        for (int k = 0; k < 4; ++k) { s4[k] = SC[lane + 64 * k]; mx = fmaxf(mx, s4[k]); }
        mx = wave_max(mx); float sm = 0.f;
#pragma unroll
        for (int k = 0; k < 4; ++k) { s4[k] = EXPF(s4[k] - mx); sm += s4[k]; }
        sm = wave_sum(sm); const float inv = 1.0f / sm;
#pragma unroll
        for (int k = 0; k < 4; ++k) SC[lane + 64 * k] = s4[k] * inv;
        LDS_WAIT();
        f32x4 o0 = {0.f, 0.f, 0.f, 0.f}, o1 = {0.f, 0.f, 0.f, 0.f};
        const float* vb = kvx + D + h * 512 + 4 * lane;
        for (int m = 0; m < MEM; ++m) { const float p = SC[m]; const f32x4 a = *(const f32x4*)(vb + (size_t)m * (2 * D)), b = *(const f32x4*)(vb + (size_t)m * (2 * D) + 256); o0 += a * p; o1 += b * p; }
        bf16* yr = y + (size_t)t * (KS * D);
        storeA4(yr, D, h * 512 + 4 * lane, o0); storeA4(yr, D, h * 512 + 256 + 4 * lane, o1);
        LDS_WAIT();
    }
}
#endif
typedef short bf16x8 __attribute__((ext_vector_type(8)));
typedef float f32x16 __attribute__((ext_vector_type(16)));
typedef __bf16 bf16x2_t __attribute__((ext_vector_type(2)));
#define MFMA32(a, b, c) __builtin_amdgcn_mfma_f32_32x32x16_bf16((a), (b), (c), 0, 0, 0)
__device__ __forceinline__ unsigned cvtpk(float lo, float hi) { const f32x2 v = {lo, hi}; const bf16x2_t b = __builtin_convertvector(v, bf16x2_t); return __builtin_bit_cast(unsigned, b); }
__device__ __forceinline__ bf16x8 pack8(const f32x16& x, int s) { v4u w; w.x = cvtpk(x[8 * s], x[8 * s + 1]); w.y = cvtpk(x[8 * s + 2], x[8 * s + 3]); w.z = cvtpk(x[8 * s + 4], x[8 * s + 5]); w.w = cvtpk(x[8 * s + 6], x[8 * s + 7]); return __builtin_bit_cast(bf16x8, w); }
__device__ __forceinline__ int swap23(int r) { return (r & ~12) | ((r & 4) << 1) | ((r & 8) >> 1); }
__device__ __forceinline__ size_t kf_index(int g, int t, int d) { return ((size_t)(g * 256 + (t >> 5)) * 4096) + (d >> 4) * 512 + (swap23(t & 31) + 32 * ((d >> 3) & 1)) * 8 + (d & 7); }
__device__ __forceinline__ size_t vf_chunk(int g, int t0, int d) { return ((size_t)(g * 256 + (t0 >> 5)) * 4096) + ((d >> 5) * 2 + ((t0 & 31) >> 4)) * 512 + ((d & 31) + 32 * ((t0 >> 3) & 1)) * 8; }
__device__ __forceinline__ f32x16 zero16() { f32x16 z; for (int i = 0; i < 16; ++i) z[i] = 0.f; return z; }
__device__ __forceinline__ float gain_absmax128(const float* g, int lane) { return wave_max(fmaxf(fabsf(g[lane]), fabsf(g[lane + 64]))); }
constexpr float LOG2E = 1.4426950408889634f;

__device__ __forceinline__ f32x16 st_tile128(const bf16* ktile, const bf16x8 (&qf)[8], int lane) {
    f32x16 s = zero16(); const bf16x8* kp = (const bf16x8*)ktile + lane;
#pragma unroll
    for (int sp = 0; sp < 8; ++sp) s = MFMA32(kp[sp * 64], qf[sp], s);
    return s;
}
__device__ __forceinline__ void pv_tile128(const bf16* vtile, const bf16x8 (&pb)[2], f32x16 (&o)[4], int lane) {
    const bf16x8* vp = (const bf16x8*)vtile + lane;
#pragma unroll
    for (int dt = 0; dt < 4; ++dt)
#pragma unroll
        for (int s = 0; s < 2; ++s) o[dt] = MFMA32(vp[(dt * 2 + s) * 64], pb[s], o[dt]);
}
__device__ __forceinline__ void load_qf128(const bf16* qrow, int h, bf16x8 (&qf)[8]) {
#pragma unroll
    for (int sp = 0; sp < 8; ++sp) qf[sp] = *(const bf16x8*)(qrow + 16 * sp + 8 * h);
}

__device__ __forceinline__ void nsa_wave_item(Frame& F, int L, int tg, int g, LAS float* IMPW) {
    const int lane = F.lane, r = lane & 31, h = lane >> 5, slot = r >> 2, jh = r & 3;
    const int tq = 8 * tg + slot, head = 4 * g + jh, cur = tg >> 3;
    const float gq = gain_absmax128(INP(7) + L * 128, lane); const float* kgn = INP(8) + L * 384;
    const float bc = 11.313708498984761f * LOG2E * 1.02f;
    const float bound_c = bc * gq * gain_absmax128(kgn, lane), bound_s = bc * gq * gain_absmax128(kgn + 128, lane), bound_w = bc * gq * gain_absmax128(kgn + 256, lane);
    bf16x8 qf[8]; load_qf128(WSP(bf16, WS_QN) + (size_t)tq * 1024 + head * 128, h, qf);
    const float* zg = WSP(float, WS_Z) + (size_t)tq * NIN + ZC_GATE + head * 3;
    const float g0 = sigm(zg[0]), g1 = sigm(zg[1]), g2 = sigm(zg[2]);
    f32x16 o[4];
    float* ocr = WSP(float, WS_OC) + (size_t)tq * 1024 + head * 128;
    for (int i = lane; i < 2 * 8 * 129; i += 64) IMPW[i] = 0.f;
    LDS_WAIT();
    { const bf16* kc = WSP(bf16, WS_KCF) + (size_t)g * 16 * 4096; const bf16* vc = WSP(bf16, WS_VCF) + (size_t)g * 16 * 4096;
      const int cmaxq = (tq >= 31) ? ((tq - 31) >> 4) : -1;
      const int tmax = 8 * tg + 7; const int ntile = (tmax >= 31) ? (((tmax - 31) >> 4) >> 5) + 1 : 0;
      float lsum = 0.f;
      for (int kt = 0; kt < ntile; ++kt) { const f32x16 s = st_tile128(kc + (size_t)kt * 4096, qf, lane);
#pragma unroll
          for (int R = 0; R < 16; ++R) { const int c = 32 * kt + 16 * (R >> 3) + 8 * h + (R & 7); lsum += (c <= cmaxq) ? __builtin_amdgcn_exp2f(s[R] - bound_c) : 0.f; } }
      lsum = half_sum(lsum);
      const float inv = (lsum > 0.f) ? 1.0f / lsum : 0.f;
      o[0] = zero16(); o[1] = zero16(); o[2] = zero16(); o[3] = zero16();
      LAS float* imrow = IMPW + (h * 8 + slot) * 129;
      for (int kt = 0; kt < ntile; ++kt) { f32x16 s = st_tile128(kc + (size_t)kt * 4096, qf, lane);
#pragma unroll
          for (int R = 0; R < 16; ++R) { const int c = 32 * kt + 16 * (R >> 3) + 8 * h + (R & 7); s[R] = (c <= cmaxq) ? __builtin_amdgcn_exp2f(s[R] - bound_c) * inv : 0.f; }
#pragma unroll
          for (int s2 = 0; s2 < 2; ++s2) { const int sb = 8 * kt + 4 * s2 + 2 * h;
              float a = (s[8 * s2] + s[8 * s2 + 1]) + (s[8 * s2 + 2] + s[8 * s2 + 3]), b = ((s[8 * s2 + 4] + s[8 * s2 + 5]) + (s[8 * s2 + 6] + s[8 * s2 + 7])) + s[8 * s2 + 3], c7 = s[8 * s2 + 7];
              a += sxor<1>(a); b += sxor<1>(b); c7 += sxor<1>(c7); a += sxor<2>(a); b += sxor<2>(b); c7 += sxor<2>(c7);
              if (jh == 0) { imrow[sb] = a; imrow[sb + 1] = b; imrow[sb + 2] = c7; } }
          bf16x8 pb[2]; pb[0] = pack8(s, 0); pb[1] = pack8(s, 1);
          pv_tile128(vc + (size_t)kt * 4096, pb, o, lane); }
#pragma unroll
      for (int dt = 0; dt < 4; ++dt)
#pragma unroll
          for (int rg = 0; rg < 4; ++rg) { f32x4 v = {o[dt][4 * rg], o[dt][4 * rg + 1], o[dt][4 * rg + 2], o[dt][4 * rg + 3]}; *(f32x4*)(ocr + 32 * dt + 8 * rg + 4 * h) = v * g0; } }
    LDS_WAIT();
    unsigned my[4] = {0u, 0u, 0u, 0u}, un[4] = {0u, 0u, 0u, 0u};
    if (cur < 16) { my[0] = un[0] = (cur == 31) ? 0xffffffffu : ((1u << (cur + 1)) - 1u); }
    else {
        for (int ts = 0; ts < 8; ++ts) { const int s0 = lane, s1 = lane + 64;
            float v0 = IMPW[ts * 129 + s0] + IMPW[(8 + ts) * 129 + s0], v1 = IMPW[ts * 129 + s1] + IMPW[(8 + ts) * 129 + s1];
            v0 = (s0 > cur) ? -3.0e38f : ((s0 == 0 || s0 == cur || s0 == cur - 1) ? 3.0e38f : v0);
            v1 = (s1 > cur) ? -3.0e38f : ((s1 == cur || s1 == cur - 1) ? 3.0e38f : v1);
            for (int k = 0; k < 16; ++k) { float bv; int bi; if (v0 >= v1) { bv = v0; bi = lane; } else { bv = v1; bi = lane + 64; }
                wave_argmax(bv, bi);
                if (bi == lane) v0 = -3.0e38f; if (bi == lane + 64) v1 = -3.0e38f;
                bi = __builtin_amdgcn_readfirstlane(bi);
                const unsigned bit = 1u << (bi & 31); const int wi = bi >> 5; const bool mine = (slot == ts);
#pragma unroll
                for (int q4 = 0; q4 < 4; ++q4) { if (wi == q4) { un[q4] |= bit; if (mine) my[q4] |= bit; } } } } }
    { const bf16* ksf = WSP(bf16, WS_KSF) + (size_t)g * 256 * 4096; const bf16* vsf = WSP(bf16, WS_VSF) + (size_t)g * 256 * 4096;
      o[0] = zero16(); o[1] = zero16(); o[2] = zero16(); o[3] = zero16(); float lsum = 0.f;
#pragma unroll
      for (int q4 = 0; q4 < 4; ++q4) { unsigned um = __builtin_amdgcn_readfirstlane(un[q4]);
          while (um) { const int jb = __builtin_ctz(um); um &= um - 1; const int j = 32 * q4 + jb; const bool sel = (my[q4] >> jb) & 1u;
#pragma unroll 1
              for (int half = 0; half < 2; ++half) { const int kt = 2 * j + half; f32x16 s = st_tile128(ksf + (size_t)kt * 4096, qf, lane);
#pragma unroll
                  for (int R = 0; R < 16; ++R) { const int key = 32 * kt + 16 * (R >> 3) + 8 * h + (R & 7); const float p = (sel && key <= tq) ? __builtin_amdgcn_exp2f(s[R] - bound_s) : 0.f; s[R] = p; lsum += p; }
                  bf16x8 pb[2]; pb[0] = pack8(s, 0); pb[1] = pack8(s, 1);
                  pv_tile128(vsf + (size_t)kt * 4096, pb, o, lane); } } }
      lsum = half_sum(lsum); const float cs = (lsum > 0.f) ? g1 / lsum : 0.f;
#pragma unroll
      for (int dt = 0; dt < 4; ++dt)
#pragma unroll
          for (int rg = 0; rg < 4; ++rg) { f32x4 v = {o[dt][4 * rg], o[dt][4 * rg + 1], o[dt][4 * rg + 2], o[dt][4 * rg + 3]}; f32x4* p = (f32x4*)(ocr + 32 * dt + 8 * rg + 4 * h); *p = *p + v * cs; } }
    { const bf16* kwf = WSP(bf16, WS_KWF) + (size_t)g * 256 * 4096; const bf16* vwf = WSP(bf16, WS_VWF) + (size_t)g * 256 * 4096;
      o[0] = zero16(); o[1] = zero16(); o[2] = zero16(); o[3] = zero16(); float lsum = 0.f;
      const int tmin = 8 * tg, tmax = 8 * tg + 7; const int kt0 = (tmin >= 511) ? ((tmin - 511) >> 5) : 0, ktl = tmax >> 5;
      for (int kt = kt0; kt <= ktl; ++kt) { f32x16 s = st_tile128(kwf + (size_t)kt * 4096, qf, lane);
#pragma unroll
          for (int R = 0; R < 16; ++R) { const int key = 32 * kt + 16 * (R >> 3) + 8 * h + (R & 7); const float p = (key <= tq && tq - key < 512) ? __builtin_amdgcn_exp2f(s[R] - bound_w) : 0.f; s[R] = p; lsum += p; }
          bf16x8 pb[2]; pb[0] = pack8(s, 0); pb[1] = pack8(s, 1);
          pv_tile128(vwf + (size_t)kt * 4096, pb, o, lane); }
      lsum = half_sum(lsum); const float cw = g2 / lsum;
      bf16* yr = WSP(bf16, WS_A1) + (size_t)tq * (KS * D);
#pragma unroll
      for (int dt = 0; dt < 4; ++dt)
#pragma unroll
          for (int rg = 0; rg < 4; ++rg) { const f32x4 c4 = *(const f32x4*)(ocr + 32 * dt + 8 * rg + 4 * h); f32x4 v;
#pragma unroll
              for (int e = 0; e < 4; ++e) v[e] = c4[e] + cw * o[dt][4 * rg + e];
              storeA4(yr, D, 512 + head * 128 + 32 * dt + 8 * rg + 4 * h, v); } }
}
__device__ __forceinline__ void ph_nsa_mfma(Frame& F, int L) {
    LAS float* IMPW = (LAS float*)(F.lds + F.wave * WAVE_SCR);
    for (int v = F.bid * 8 + F.wave; v < 2048; v += F.G * 8) { const int b = v >> 3, w = v & 7, s = b * 4 + (w & 3);
        const int tg = (w < 4) ? s : 1023 - s, g = (w < 4) ? 0 : 1;
        nsa_wave_item(F, L, tg, g, IMPW); }
}

constexpr int NS_KB = 0, NS_VB = 16384, NS_IMP = 32768, NS_TL = 131072, NS_UNI = NS_TL + 4 * 640, NS_MYM = NS_UNI + 64, NS_S2K = 0, NS_S2V = 65536, NS_NT = 4;
__device__ __forceinline__ f32x16 st_tile_lds(const LAS unsigned char* kslot, const bf16x8 (&qf)[8], int lane) {
    f32x16 s = zero16(); const LAS bf16x8* kp = (const LAS bf16x8*)kslot + lane;
    const unsigned ka = (unsigned)(size_t)kp;
#pragma unroll
    for (int hf = 0; hf < 2; ++hf) { bf16x8 k0, k1, k2, k3;
        if (hf == 0) asm volatile("ds_read_b128 %0, %4\n\tds_read_b128 %1, %4 offset:1024\n\tds_read_b128 %2, %4 offset:2048\n\tds_read_b128 %3, %4 offset:3072\n\ts_waitcnt lgkmcnt(0)" : "=&v"(k0), "=&v"(k1), "=&v"(k2), "=&v"(k3) : "v"(ka) : "memory");
        else         asm volatile("ds_read_b128 %0, %4 offset:4096\n\tds_read_b128 %1, %4 offset:5120\n\tds_read_b128 %2, %4 offset:6144\n\tds_read_b128 %3, %4 offset:7168\n\ts_waitcnt lgkmcnt(0)" : "=&v"(k0), "=&v"(k1), "=&v"(k2), "=&v"(k3) : "v"(ka) : "memory");
        s = MFMA32(k0, qf[4 * hf], s); s = MFMA32(k1, qf[4 * hf + 1], s); s = MFMA32(k2, qf[4 * hf + 2], s); s = MFMA32(k3, qf[4 * hf + 3], s); }
    return s;
}
__device__ __forceinline__ void pv_tile_lds(const LAS unsigned char* vslot, const bf16x8 (&pb)[2], f32x16 (&o)[4], int lane) {
    const LAS bf16x8* vp = (const LAS bf16x8*)vslot + lane;
#pragma unroll
    for (int dt = 0; dt < 4; dt += 2) { bf16x8 v0, v1, v2, v3; const unsigned va = (unsigned)(size_t)vp;
        if (dt == 0) asm volatile("ds_read_b128 %0, %4\n\tds_read_b128 %1, %4 offset:1024\n\tds_read_b128 %2, %4 offset:2048\n\tds_read_b128 %3, %4 offset:3072\n\ts_waitcnt lgkmcnt(0)" : "=&v"(v0), "=&v"(v1), "=&v"(v2), "=&v"(v3) : "v"(va) : "memory");
        else         asm volatile("ds_read_b128 %0, %4 offset:4096\n\tds_read_b128 %1, %4 offset:5120\n\tds_read_b128 %2, %4 offset:6144\n\tds_read_b128 %3, %4 offset:7168\n\ts_waitcnt lgkmcnt(0)" : "=&v"(v0), "=&v"(v1), "=&v"(v2), "=&v"(v3) : "v"(va) : "memory");
        o[dt] = MFMA32(v0, pb[0], o[dt]); o[dt] = MFMA32(v1, pb[1], o[dt]); o[dt + 1] = MFMA32(v2, pb[0], o[dt + 1]); o[dt + 1] = MFMA32(v3, pb[1], o[dt + 1]); }
}
__device__ __forceinline__ void nsa_block_unit(Frame& F, int L, int qb, int g) {
    const int lane = F.lane, w = F.wave, r = lane & 31, h = lane >> 5, slot = r >> 2, jh = r & 3;
    const int tg = 8 * qb + w, tq = 8 * tg + slot, head = 4 * g + jh, cur = qb;
    LAS unsigned char* lds = F.lds; LAS int* TL = (LAS int*)(lds + NS_TL); LAS unsigned* UNI = (LAS unsigned*)(lds + NS_UNI); LAS float* IMPW = (LAS float*)(lds + NS_IMP) + w * (2 * 8 * 129);
    const float* kgn = INP(8) + L * 384;
    const float bc = 11.313708498984761f * LOG2E * 1.02f * gain_absmax128(INP(7) + L * 128, lane);
#define UNIF(x) __builtin_bit_cast(float, __builtin_amdgcn_readfirstlane(__builtin_bit_cast(int, (x))))
    const float bound_c = UNIF(bc * gain_absmax128(kgn, lane)), bound_s = UNIF(bc * gain_absmax128(kgn + 128, lane)), bound_w = UNIF(bc * gain_absmax128(kgn + 256, lane));
    bf16x8 qf[8]; load_qf128(WSP(bf16, WS_QN) + (size_t)tq * 1024 + head * 128, h, qf);
#define NS_GATE(b) sigm(WSP(float, WS_Z)[(size_t)tq * NIN + ZC_GATE + head * 3 + (b)])
#define NS_OCR (WSP(float, WS_OC) + (size_t)tq * 1024 + head * 128)
    const unsigned char* wsb = F.ws;
#define NS_KT(src, kt) ((const v4u*)(wsb + ((src) == 0 ? WS_KCF + (size_t)g * 16 * 8192 : (src) == 1 ? WS_KSF + (size_t)g * 256 * 8192 : WS_KWF + (size_t)g * 256 * 8192) + (size_t)(kt) * 8192) + F.tid)
#define NS_VT(src, kt) ((const v4u*)(wsb + ((src) == 0 ? WS_VCF + (size_t)g * 16 * 8192 : (src) == 1 ? WS_VSF + (size_t)g * 256 * 8192 : WS_VWF + (size_t)g * 256 * 8192) + (size_t)(kt) * 8192) + F.tid)
#define NS_COPY(src, kt, sl) do { __builtin_amdgcn_global_load_lds((const unsigned*)NS_KT(src, kt), (LAS unsigned*)(lds + NS_KB + (sl) * 8192 + w * 1024), 16, 0, 0); \
                                  __builtin_amdgcn_global_load_lds((const unsigned*)NS_VT(src, kt), (LAS unsigned*)(lds + NS_VB + (sl) * 8192 + w * 1024), 16, 0, 0); } while (0)
#define NS_COPYK(src, kt, sl) __builtin_amdgcn_global_load_lds((const unsigned*)NS_KT(src, kt), (LAS unsigned*)(lds + NS_KB + (sl) * 8192 + w * 1024), 16, 0, 0)
#define NS_LAND() asm volatile("s_waitcnt vmcnt(0)" ::: "memory")
    f32x16 o[4]; o[0] = zero16(); o[1] = zero16(); o[2] = zero16(); o[3] = zero16();
    for (int i = lane; i < 2 * 8 * 129; i += 64) IMPW[i] = 0.f;
    if (F.tid < 4) UNI[F.tid] = 0u;
    const int ntb = (((64 * qb + 63 - 31) >> 4) >> 5) + 1;
    const int cmaxq = (tq >= 31) ? ((tq - 31) >> 4) : -1;
    const int ntw = (8 * tg + 7 >= 31) ? (((8 * tg + 7 - 31) >> 4) >> 5) + 1 : 0;
    float lsum = 0.f, inv = 0.f;
    { const int n = 2 * ntb;
      NS_COPYK(0, 0, 0); NS_LAND();
      __syncthreads();
      LAS float* imrow = IMPW + (h * 8 + slot) * 129;
#pragma unroll 1
      for (int i = 0; i < n; ++i) { const int kt = (i < ntb) ? i : i - ntb; const bool pass2 = i >= ntb;
          if (i + 1 < n) { if (i + 1 < ntb) NS_COPYK(0, i + 1, (i + 1) & 1); else NS_COPY(0, i + 1 - ntb, (i + 1) & 1); }
          if (i == ntb) { lsum = half_sum(lsum); inv = (lsum > 0.f) ? 1.0f / lsum : 0.f; }
          if (kt < ntw) { const LAS unsigned char* ks = lds + NS_KB + (i & 1) * 8192; f32x16 s = st_tile_lds(ks, qf, lane);
              if (!pass2) {
#pragma unroll
                  for (int R = 0; R < 16; ++R) { const int c = 32 * kt + 16 * (R >> 3) + 8 * h + (R & 7); lsum += (c <= cmaxq) ? __builtin_amdgcn_exp2f(s[R] - bound_c) : 0.f; } }
              else {
#pragma unroll
                  for (int R = 0; R < 16; ++R) { const int c = 32 * kt + 16 * (R >> 3) + 8 * h + (R & 7); s[R] = (c <= cmaxq) ? __builtin_amdgcn_exp2f(s[R] - bound_c) * inv : 0.f; }
#pragma unroll
                  for (int s2 = 0; s2 < 2; ++s2) { const int sb = 8 * kt + 4 * s2 + 2 * h;
                      float a = (s[8 * s2] + s[8 * s2 + 1]) + (s[8 * s2 + 2] + s[8 * s2 + 3]), b = ((s[8 * s2 + 4] + s[8 * s2 + 5]) + (s[8 * s2 + 6] + s[8 * s2 + 7])) + s[8 * s2 + 3], c7 = s[8 * s2 + 7];
                      a += sxor<1>(a); b += sxor<1>(b); c7 += sxor<1>(c7); a += sxor<2>(a); b += sxor<2>(b); c7 += sxor<2>(c7);
                      if (jh == 0) { imrow[sb] = a; imrow[sb + 1] = b; imrow[sb + 2] = c7; } }
                  bf16x8 pb[2]; pb[0] = pack8(s, 0); pb[1] = pack8(s, 1);
                  pv_tile_lds(lds + NS_VB + (i & 1) * 8192, pb, o, lane); } }
          NS_LAND();
          __syncthreads(); } }
    { const float g0 = NS_GATE(0); float* ocr = NS_OCR;
#pragma unroll
    for (int dt = 0; dt < 4; ++dt)
#pragma unroll
        for (int rg = 0; rg < 4; ++rg) { f32x4 v = {o[dt][4 * rg], o[dt][4 * rg + 1], o[dt][4 * rg + 2], o[dt][4 * rg + 3]}; *(f32x4*)(ocr + 32 * dt + 8 * rg + 4 * h) = v * g0; } }
    LDS_WAIT();
    unsigned my[4] = {0u, 0u, 0u, 0u}, un[4] = {0u, 0u, 0u, 0u};
    if (cur < 16) { my[0] = un[0] = (1u << (cur + 1)) - 1u; }
    else {
        float v0[8], v1[8];
#pragma unroll
        for (int ts = 0; ts < 8; ++ts) { const int s0 = lane, s1 = lane + 64;
            const float a0 = IMPW[ts * 129 + s0] + IMPW[(8 + ts) * 129 + s0], a1 = IMPW[ts * 129 + s1] + IMPW[(8 + ts) * 129 + s1];
            v0[ts] = (s0 > cur) ? -3.0e38f : ((s0 == 0 || s0 == cur || s0 == cur - 1) ? 3.0e38f : a0);
            v1[ts] = (s1 > cur) ? -3.0e38f : ((s1 == cur || s1 == cur - 1) ? 3.0e38f : a1); }
#pragma unroll 1
        for (int k = 0; k < 16; ++k) { float bv[8]; int bi[8];
#pragma unroll
            for (int ts = 0; ts < 8; ++ts) { if (v0[ts] >= v1[ts]) { bv[ts] = v0[ts]; bi[ts] = lane; } else { bv[ts] = v1[ts]; bi[ts] = lane + 64; } }
#define AMX(M) _Pragma("unroll") for (int ts = 0; ts < 8; ++ts) { const float ov_ = sxor<M>(bv[ts]); const int oi_ = sxori<M>(bi[ts]); if (ov_ > bv[ts] || (ov_ == bv[ts] && oi_ < bi[ts])) { bv[ts] = ov_; bi[ts] = oi_; } }
            AMX(1) AMX(2) AMX(4) AMX(8) AMX(16)
#undef AMX
#pragma unroll
            for (int ts = 0; ts < 8; ++ts) { unsigned va = __builtin_bit_cast(unsigned, bv[ts]), vb = va, ia = (unsigned)bi[ts], ib = ia; swap32(va, vb); swap32(ia, ib);
                const float x0 = __builtin_bit_cast(float, va), x1 = __builtin_bit_cast(float, vb); const int i0 = (int)ia, i1 = (int)ib;
                int win = (x0 > x1 || (x0 == x1 && i0 < i1)) ? i0 : i1;
                if (win == lane) v0[ts] = -3.0e38f; if (win == lane + 64) v1[ts] = -3.0e38f;
                win = __builtin_amdgcn_readfirstlane(win);
                const unsigned bit = 1u << (win & 31); const int wi = win >> 5; const bool mine = (slot == ts);
#pragma unroll
                for (int q4 = 0; q4 < 4; ++q4) { if (wi == q4) { un[q4] |= bit; if (mine) my[q4] |= bit; } } } } }
    LAS unsigned* MYM = (LAS unsigned*)(lds + NS_MYM) + (w * 64 + lane) * 4;
    *(LAS v4u*)MYM = (v4u){my[0], my[1], my[2], my[3]};
    if (lane == 0) {
#pragma unroll
        for (int q4 = 0; q4 < 4; ++q4) (void)__hip_atomic_fetch_or(UNI + q4, un[q4], __ATOMIC_RELAXED, __HIP_MEMORY_SCOPE_WORKGROUP); }
    __syncthreads();
    unsigned u0 = UNI[0], u1 = UNI[1], u2 = UNI[2], u3 = UNI[3];
    const int nsel = 2 * (__builtin_popcount(u0) + __builtin_popcount(u1) + __builtin_popcount(u2) + __builtin_popcount(u3));
    const int ktl = 2 * qb + 1, kt0 = (ktl >= 17) ? ktl - 17 : 0, nwin = ktl - kt0 + 1, ntl = nsel + nwin;
    int jt_ = F.tid; asm volatile("" : "+v"(jt_));
    if (jt_ < 128) { const int j = jt_; const unsigned wsel = (j < 32) ? u0 : (j < 64) ? u1 : (j < 96) ? u2 : u3;
        if ((wsel >> (j & 31)) & 1u) { int pos = __builtin_popcount(wsel & ((1u << (j & 31)) - 1u)); if (j >= 32) pos += __builtin_popcount(u0); if (j >= 64) pos += __builtin_popcount(u1); if (j >= 96) pos += __builtin_popcount(u2);
            TL[2 * pos] = (2 * j) | (1 << 16); TL[2 * pos + 1] = (2 * j + 1) | (1 << 16); } }
    else if (jt_ < 128 + 32) { const int i = jt_ - 128; if (i < nwin) TL[nsel + i] = (kt0 + i) | (2 << 16); }
    __syncthreads();
    o[0] = zero16(); o[1] = zero16(); o[2] = zero16(); o[3] = zero16(); lsum = 0.f;
    {
#define NS_COPY2(src, kt, sl) do { __builtin_amdgcn_global_load_lds((const unsigned*)NS_KT(src, kt), (LAS unsigned*)(lds + NS_S2K + (sl) * 8192 + w * 1024), 16, 0, 0); \
                                   __builtin_amdgcn_global_load_lds((const unsigned*)NS_VT(src, kt), (LAS unsigned*)(lds + NS_S2V + (sl) * 8192 + w * 1024), 16, 0, 0); } while (0)
#pragma unroll 1
      for (int u2 = 0; u2 < NS_NT; ++u2) if (u2 < ntl) { const int e0 = TL[u2]; NS_COPY2(e0 >> 16, e0 & 0xffff, u2); }
      NS_LAND();
      __syncthreads();
      const int wkt0 = (8 * tg >= 511) ? ((8 * tg - 511) >> 5) : 0, wktl = (8 * tg + 7) >> 5;
      const int nst = (ntl + NS_NT - 1) / NS_NT, nss = nsel / NS_NT;
#pragma unroll 1
      for (int st = 0; st < nst; ++st) {
          if (st + 1 < nst) {
#pragma unroll 1
              for (int u2 = 0; u2 < NS_NT; ++u2) { const int ix = NS_NT * (st + 1) + u2; if (ix < ntl) { const int ea = TL[ix]; NS_COPY2(ea >> 16, ea & 0xffff, ((st + 1) & 1) * NS_NT + u2); } } }
#pragma unroll 1
          for (int u2 = 0; u2 < NS_NT; ++u2) { const int i = NS_NT * st + u2; if (i >= ntl) break;
          if (i == nsel) {
              lsum = half_sum(lsum); const float cs = (lsum > 0.f) ? NS_GATE(1) / lsum : 0.f; float* ocr = NS_OCR;
#pragma unroll
              for (int dt = 0; dt < 4; ++dt)
#pragma unroll
                  for (int rg = 0; rg < 4; ++rg) { f32x4 v = {o[dt][4 * rg], o[dt][4 * rg + 1], o[dt][4 * rg + 2], o[dt][4 * rg + 3]}; f32x4* p = (f32x4*)(ocr + 32 * dt + 8 * rg + 4 * h); *p = *p + v * cs; }
              o[0] = zero16(); o[1] = zero16(); o[2] = zero16(); o[3] = zero16(); lsum = 0.f; }
          const int en = TL[i], src = en >> 16, kt = en & 0xffff; const int sl = (st & 1) * NS_NT + u2;
          bool need, full; int lo, hi; float bnd;
          if (src == 1) { const int j = kt >> 1; const unsigned wu = (j < 32) ? un[0] : (j < 64) ? un[1] : (j < 96) ? un[2] : un[3]; const unsigned wm = MYM[j >> 5];
              need = (__builtin_amdgcn_readfirstlane(wu) >> (j & 31)) & 1u; const bool sel = (wm >> (j & 31)) & 1u; lo = 0; hi = tq; bnd = sel ? bound_s : 3.0e38f; full = (j < cur); }
          else { need = (kt >= wkt0 && kt <= wktl); lo = tq - 511; hi = tq; bnd = bound_w; full = (32 * kt + 31 <= 8 * tg) && (32 * kt >= 8 * tg + 7 - 511); }
          if (need) { f32x16 s = st_tile_lds(lds + NS_S2K + sl * 8192, qf, lane);
              if (full) {
#pragma unroll
                  for (int R = 0; R < 16; ++R) { const float p = __builtin_amdgcn_exp2f(s[R] - bnd); s[R] = p; lsum += p; } }
              else {
#pragma unroll
              for (int R = 0; R < 16; ++R) { const int key = 32 * kt + 16 * (R >> 3) + 8 * h + (R & 7); const float p = (key >= lo && key <= hi) ? __builtin_amdgcn_exp2f(s[R] - bnd) : 0.f; s[R] = p; lsum += p; } }
              bf16x8 pb[2]; pb[0] = pack8(s, 0); pb[1] = pack8(s, 1);
              pv_tile_lds(lds + NS_S2V + sl * 8192, pb, o, lane); } }
          NS_LAND();
          __syncthreads(); } }
    { lsum = half_sum(lsum); const float cw = NS_GATE(2) / lsum; const float* ocr = NS_OCR;
      bf16* yr = WSP(bf16, WS_A1) + (size_t)tq * (KS * D);
#pragma unroll
      for (int dt = 0; dt < 4; ++dt)
#pragma unroll
          for (int rg = 0; rg < 4; ++rg) { const f32x4 c4 = *(const f32x4*)(ocr + 32 * dt + 8 * rg + 4 * h); f32x4 v;
#pragma unroll
              for (int e = 0; e < 4; ++e) v[e] = c4[e] + cw * o[dt][4 * rg + e];
              storeA4(yr, D, 512 + head * 128 + 32 * dt + 8 * rg + 4 * h, v); } }
    __syncthreads();
#undef NS_KT
#undef NS_VT
#undef NS_COPY
#undef NS_LAND
#undef NS_COPY2
#undef NS_GATE
#undef NS_OCR
#undef UNIF
}
__device__ __forceinline__ void ph_nsa_block(Frame& F, int L) {
    for (int u = F.bid; u < 256; u += F.G) { const int g = u & 1, qb = u >> 1; nsa_block_unit(F, L, qb, g); }
}

__device__ __forceinline__ f32x16 st_tile_lds_q(const LAS unsigned char* kslot, const LAS unsigned char* qlds, const bf16x8 (&qh)[4], int lane) {
    f32x16 s = zero16(); const unsigned ka = (unsigned)(size_t)((const LAS bf16x8*)kslot + lane), qa = (unsigned)(size_t)((const LAS bf16x8*)qlds + lane);
    { bf16x8 k0, k1, k2, k3, q0, q1, q2, q3;
      asm volatile("ds_read_b128 %0, %8\n\tds_read_b128 %1, %8 offset:1024\n\tds_read_b128 %2, %8 offset:2048\n\tds_read_b128 %3, %8 offset:3072\n\t"
                   "ds_read_b128 %4, %9\n\tds_read_b128 %5, %9 offset:1024\n\tds_read_b128 %6, %9 offset:2048\n\tds_read_b128 %7, %9 offset:3072\n\ts_waitcnt lgkmcnt(0)"
                   : "=&v"(k0), "=&v"(k1), "=&v"(k2), "=&v"(k3), "=&v"(q0), "=&v"(q1), "=&v"(q2), "=&v"(q3) : "v"(ka), "v"(qa) : "memory");
      s = MFMA32(k0, q0, s); s = MFMA32(k1, q1, s); s = MFMA32(k2, q2, s); s = MFMA32(k3, q3, s); }
    { bf16x8 k0, k1, k2, k3;
      asm volatile("ds_read_b128 %0, %4 offset:4096\n\tds_read_b128 %1, %4 offset:5120\n\tds_read_b128 %2, %4 offset:6144\n\tds_read_b128 %3, %4 offset:7168\n\ts_waitcnt lgkmcnt(0)" : "=&v"(k0), "=&v"(k1), "=&v"(k2), "=&v"(k3) : "v"(ka) : "memory");
      s = MFMA32(k0, qh[0], s); s = MFMA32(k1, qh[1], s); s = MFMA32(k2, qh[2], s); s = MFMA32(k3, qh[3], s); }
    return s;
}
constexpr int N3_QL = 119616;
constexpr int N3_KB = 0, N3_VB = 32768, N3_TL = 65536, N3_UNI = N3_TL + 2560, N3_LX = N3_UNI + 64, N3_IMP = N3_LX + 2048, N3_MYM = N3_IMP + 4 * 2 * 8 * 129 * 4;
__device__ __forceinline__ void n3_tile(const LAS unsigned char* ks, const LAS unsigned char* vs, const LAS unsigned char* ql, const bf16x8 (&qf)[4], f32x16 (&o)[4], float& lsum, float bnd, bool full, int lo, int hi, int kt, int h, bool do_pv, int lane) {
    f32x16 s = st_tile_lds_q(ks, ql, qf, lane);
    if (full) {
#pragma unroll
        for (int R = 0; R < 16; ++R) { const float p = __builtin_amdgcn_exp2f(s[R] - bnd); s[R] = p; lsum += p; } }
    else {
#pragma unroll
        for (int R = 0; R < 16; ++R) { const int key = 32 * kt + 16 * (R >> 3) + 8 * h + (R & 7); const float p = (key >= lo && key <= hi) ? __builtin_amdgcn_exp2f(s[R] - bnd) : 0.f; s[R] = p; lsum += p; } }
    if (do_pv) { bf16x8 pb[2]; pb[0] = pack8(s, 0); pb[1] = pack8(s, 1); pv_tile_lds(vs, pb, o, lane); }
}
__device__ __forceinline__ void nsa_unit3(Frame& F, int L, int qbh, int g) {
#define OPQL() ({ int l_ = F.lane; asm volatile("" : "+v"(l_)); l_; })
    const int lane = OPQL(), w = F.wave, r = lane & 31, h = lane >> 5, slot = r >> 2, jh = r & 3, tgw = w & 3, par = w >> 2;
    const int tg = 4 * qbh + tgw, tq = 8 * tg + slot, head = 4 * g + jh, cur = qbh >> 1;
    LAS unsigned char* lds = F.lds; LAS int* TL = (LAS int*)(lds + N3_TL); LAS unsigned* UNI = (LAS unsigned*)(lds + N3_UNI); LAS float* LX = (LAS float*)(lds + N3_LX);
    LAS float* IMPG = (LAS float*)(lds + N3_IMP) + tgw * (2 * 8 * 129);
    const float* kgn = INP(8) + L * 384;
    const float bc = 11.313708498984761f * LOG2E * 1.02f * gain_absmax128(INP(7) + L * 128, lane);
#define UNIF(x) __builtin_bit_cast(float, __builtin_amdgcn_readfirstlane(__builtin_bit_cast(int, (x))))
    const float bound_c = UNIF(bc * gain_absmax128(kgn, lane)), bound_s = UNIF(bc * gain_absmax128(kgn + 128, lane)), bound_w = UNIF(bc * gain_absmax128(kgn + 256, lane));
    bf16x8 qf[4]; LAS unsigned char* ql = lds + N3_QL + w * 4096;
    { const bf16* qrow = WSP(bf16, WS_QN) + (size_t)tq * 1024 + head * 128 + 8 * h;
#pragma unroll
      for (int sp = 0; sp < 4; ++sp) { *((LAS bf16x8*)ql + sp * 64 + lane) = *(const bf16x8*)(qrow + 16 * sp); qf[sp] = *(const bf16x8*)(qrow + 16 * (sp + 4)); } }
#define N3_GATE(b) sigm(*(const float*)(F.ws + WS_Z + (size_t)(32 * qbh) * NIN * 4 + (unsigned)((((tq - 32 * qbh) * NIN) + ZC_GATE + head * 3 + (b)) * 4)))
#define N3_OCR ({ const int l2_ = OPQL(); const int r2_ = l2_ & 31; (float*)(F.ws + WS_OC + (unsigned)((((8 * tg + (r2_ >> 2)) * 1024 + (4 * g + (r2_ & 3)) * 128) + 4 * (l2_ >> 5)) * 4)); })
    const unsigned char* wsb = F.ws;
    const unsigned dmaoff = (unsigned)(w * 1024 + lane * 16);
#define N3_KT(src, kt) ((const unsigned*)((wsb + ((src) == 0 ? WS_KCF + (size_t)g * 16 * 8192 : (src) == 1 ? WS_KSF + (size_t)g * 256 * 8192 : WS_KWF + (size_t)g * 256 * 8192) + (size_t)(kt) * 8192) + dmaoff))
#define N3_VT(src, kt) ((const unsigned*)((wsb + ((src) == 0 ? WS_VCF + (size_t)g * 16 * 8192 : (src) == 1 ? WS_VSF + (size_t)g * 256 * 8192 : WS_VWF + (size_t)g * 256 * 8192) + (size_t)(kt) * 8192) + dmaoff))
#define N3_COPY(src, kt, sl) do { __builtin_amdgcn_global_load_lds(N3_KT(src, kt), (LAS unsigned*)(lds + N3_KB + (sl) * 8192 + w * 1024), 16, 0, 0); \
                                  __builtin_amdgcn_global_load_lds(N3_VT(src, kt), (LAS unsigned*)(lds + N3_VB + (sl) * 8192 + w * 1024), 16, 0, 0); } while (0)
#define N3_LAND() asm volatile("s_waitcnt vmcnt(0)" ::: "memory")
#define N3_FOLD(COEF, FIRST) do { const float cf_ = (COEF); float* ocr_ = N3_OCR; \
        for (int pp_ = 0; pp_ < 2; ++pp_) { if (pp_ == par) { _Pragma("unroll") for (int dt = 0; dt < 4; ++dt) _Pragma("unroll") for (int rg = 0; rg < 4; ++rg) { \
            f32x4 v_ = {o[dt][4 * rg], o[dt][4 * rg + 1], o[dt][4 * rg + 2], o[dt][4 * rg + 3]}; f32x4* p_ = (f32x4*)(ocr_ + 32 * dt + 8 * rg); if ((FIRST) && pp_ == 0) *p_ = v_ * cf_; else *p_ = *p_ + v_ * cf_; } \
            asm volatile("s_waitcnt vmcnt(0)" ::: "memory"); } __syncthreads(); } } while (0)
#define N3_LTOT(dst) do { const int l3_ = OPQL(); lsum = half_sum(lsum); LX[w * 64 + l3_] = lsum; __syncthreads(); dst = LX[tgw * 64 + l3_] + LX[(tgw + 4) * 64 + l3_]; __syncthreads(); } while (0)
    f32x16 o[4]; o[0] = zero16(); o[1] = zero16(); o[2] = zero16(); o[3] = zero16();
    for (int i = OPQL() + 64 * par; i < 2 * 8 * 129; i += 128) IMPG[i] = 0.f;
    if (F.tid < 4) UNI[F.tid] = 0u;
    const int tlast = 32 * qbh + 31; const int ntb = (tlast >= 31) ? (((tlast - 31) >> 4) >> 5) + 1 : 0;
    const int cmaxq = (tq >= 31) ? ((tq - 31) >> 4) : -1;
    const int cmin_w = (8 * tg >= 31) ? ((8 * tg - 31) >> 4) : -1;
    const int ntw = (8 * tg + 7 >= 31) ? (((8 * tg + 7 - 31) >> 4) >> 5) + 1 : 0;
    float lsum = 0.f; float bnd2 = 3.0e38f;
    { const int s1 = (ntb + 1) >> 1, n = 2 * s1;
      if (n > 0) { if (0 < ntb) N3_COPY(0, 0, 0); if (1 < ntb) N3_COPY(0, 1, 1); }
      N3_LAND(); __syncthreads();
      LAS float* imrow = IMPG + (h * 8 + slot) * 129;
#pragma unroll 1
      for (int i = 0; i < n; ++i) { const int ii = (i < s1) ? i : i - s1, kt = 2 * ii + par; const bool pass2 = i >= s1;
          if (i + 1 < n) { const int in = (i + 1 < s1) ? i + 1 : i + 1 - s1; if (2 * in < ntb) N3_COPY(0, 2 * in, ((i + 1) & 1) * 2); if (2 * in + 1 < ntb) N3_COPY(0, 2 * in + 1, ((i + 1) & 1) * 2 + 1); }
          if (i == s1) { float lt; N3_LTOT(lt); bnd2 = (lt > 0.f) ? bound_c + __builtin_amdgcn_logf(lt) : 3.0e38f; lsum = 0.f; }
          if (kt < ntb && kt < ntw) { const LAS unsigned char* ks = lds + N3_KB + ((i & 1) * 2 + par) * 8192; const LAS unsigned char* vs = lds + N3_VB + ((i & 1) * 2 + par) * 8192;
              const bool full = (32 * kt + 31 <= cmin_w);
              if (!pass2) n3_tile(ks, vs, ql, qf, o, lsum, bound_c, full, 0, cmaxq, kt, h, false, lane);
              else { f32x16 s = st_tile_lds_q(ks, ql, qf, lane);
#pragma unroll
                  for (int R = 0; R < 16; ++R) { const int c = 32 * kt + 16 * (R >> 3) + 8 * h + (R & 7); s[R] = (full || c <= cmaxq) ? __builtin_amdgcn_exp2f(s[R] - bnd2) : 0.f; }
#pragma unroll
                  for (int s2 = 0; s2 < 2; ++s2) { const int sb = 8 * kt + 4 * s2 + 2 * h;
                      float a = (s[8 * s2] + s[8 * s2 + 1]) + (s[8 * s2 + 2] + s[8 * s2 + 3]), b = ((s[8 * s2 + 4] + s[8 * s2 + 5]) + (s[8 * s2 + 6] + s[8 * s2 + 7])) + s[8 * s2 + 3], c7 = s[8 * s2 + 7];
                      a += sxor<1>(a); b += sxor<1>(b); c7 += sxor<1>(c7); a += sxor<2>(a); b += sxor<2>(b); c7 += sxor<2>(c7);
                      if (jh == 0) { imrow[sb] = a; imrow[sb + 1] = b; imrow[sb + 2] = c7; } }
                  bf16x8 pb[2]; pb[0] = pack8(s, 0); pb[1] = pack8(s, 1);
                  pv_tile_lds(vs, pb, o, lane); } }
          N3_LAND(); __syncthreads(); } }
    N3_FOLD(N3_GATE(0), true);
    unsigned my[4] = {0u, 0u, 0u, 0u}, un[4] = {0u, 0u, 0u, 0u};
    if (cur < 16) { my[0] = un[0] = (1u << (cur + 1)) - 1u; }
    else {
        const int lk_ = OPQL();
#pragma unroll 1
        for (int ts = 0; ts < 8; ++ts) { const int s0 = lk_, s1 = lk_ + 64;
            float v0 = IMPG[ts * 129 + s0] + IMPG[(8 + ts) * 129 + s0], v1 = IMPG[ts * 129 + s1] + IMPG[(8 + ts) * 129 + s1];
            v0 = (s0 > cur) ? -3.0e38f : ((s0 == 0 || s0 == cur || s0 == cur - 1) ? 3.0e38f : v0);
            v1 = (s1 > cur) ? -3.0e38f : ((s1 == cur || s1 == cur - 1) ? 3.0e38f : v1);
#pragma unroll 1
            for (int k = 0; k < 16; ++k) { float bv; int bi; if (v0 >= v1) { bv = v0; bi = lk_; } else { bv = v1; bi = lk_ + 64; }
                wave_argmax(bv, bi);
                if (bi == lk_) v0 = -3.0e38f; if (bi == lk_ + 64) v1 = -3.0e38f;
                bi = __builtin_amdgcn_readfirstlane(bi);
                const unsigned bit = 1u << (bi & 31); const int wi = bi >> 5; const bool mine = (slot == ts);
#pragma unroll
                for (int q4 = 0; q4 < 4; ++q4) { if (wi == q4) { un[q4] |= bit; if (mine) my[q4] |= bit; } } } } }
    LAS unsigned* MYM = (LAS unsigned*)(lds + N3_MYM) + (w * 64 + OPQL()) * 4;
    *(LAS v4u*)MYM = (v4u){my[0], my[1], my[2], my[3]};
    if (lane == 0) {
#pragma unroll
        for (int q4 = 0; q4 < 4; ++q4) (void)__hip_atomic_fetch_or(UNI + q4, un[q4], __ATOMIC_RELAXED, __HIP_MEMORY_SCOPE_WORKGROUP); }
    __syncthreads();
    const unsigned u0 = UNI[0], u1 = UNI[1], u2 = UNI[2], u3 = UNI[3];
    const int nsel = 2 * (__builtin_popcount(u0) + __builtin_popcount(u1) + __builtin_popcount(u2) + __builtin_popcount(u3));
    const int ktl = qbh, kt0 = (ktl >= 16) ? ktl - 16 : 0, nwin = ktl - kt0 + 1, ntl = nsel + nwin;
    { int jt_ = F.tid; asm volatile("" : "+v"(jt_));
      if (jt_ < 128) { const int j = jt_; const unsigned wsel = (j < 32) ? u0 : (j < 64) ? u1 : (j < 96) ? u2 : u3;
          if ((wsel >> (j & 31)) & 1u) { int pos = __builtin_popcount(wsel & ((1u << (j & 31)) - 1u)); if (j >= 32) pos += __builtin_popcount(u0); if (j >= 64) pos += __builtin_popcount(u1); if (j >= 96) pos += __builtin_popcount(u2);
              TL[2 * pos] = (2 * j) | (1 << 16); TL[2 * pos + 1] = (2 * j + 1) | (1 << 16); } }
      else if (jt_ < 128 + 32) { const int i = jt_ - 128; if (i < nwin) TL[nsel + i] = (kt0 + i) | (2 << 16); } }
    __syncthreads();
    o[0] = zero16(); o[1] = zero16(); o[2] = zero16(); o[3] = zero16(); lsum = 0.f;
    { const int nst = (ntl + 1) >> 1, nss = nsel >> 1;
      { const int e0 = TL[0]; N3_COPY(e0 >> 16, e0 & 0xffff, 0); if (1 < ntl) { const int e1 = TL[1]; N3_COPY(e1 >> 16, e1 & 0xffff, 1); } }
      N3_LAND(); __syncthreads();
      const int wkt0 = (8 * tg >= 511) ? ((8 * tg - 511) >> 5) : 0, wktl = (8 * tg + 7) >> 5;
#pragma unroll 1
      for (int i = 0; i < nst; ++i) {
          if (i + 1 < nst) { const int ea = TL[2 * i + 2]; N3_COPY(ea >> 16, ea & 0xffff, ((i + 1) & 1) * 2); if (2 * i + 3 < ntl) { const int eb = TL[2 * i + 3]; N3_COPY(eb >> 16, eb & 0xffff, ((i + 1) & 1) * 2 + 1); } }
          if (i == nss) { float lt; N3_LTOT(lt); N3_FOLD((lt > 0.f) ? N3_GATE(1) / lt : 0.f, false); o[0] = zero16(); o[1] = zero16(); o[2] = zero16(); o[3] = zero16(); lsum = 0.f; }
          const int ei = 2 * i + par;
          if (ei < ntl) { const int en = TL[ei], src = en >> 16, kt = en & 0xffff; bool need, full; int lo, hi; float bnd;
              if (src == 1) { const int j = kt >> 1; const unsigned wu = (j < 32) ? un[0] : (j < 64) ? un[1] : (j < 96) ? un[2] : un[3];
                  need = (__builtin_amdgcn_readfirstlane(wu) >> (j & 31)) & 1u; const bool sel = (MYM[j >> 5] >> (j & 31)) & 1u; bnd = sel ? bound_s : 3.0e38f; lo = 0; hi = tq; full = (j < cur); }
              else { need = (kt >= wkt0 && kt <= wktl); lo = tq - 511; hi = tq; bnd = bound_w; full = (32 * kt + 31 <= 8 * tg) && (32 * kt >= 8 * tg + 7 - 511); }
              if (need) n3_tile(lds + N3_KB + ((i & 1) * 2 + par) * 8192, lds + N3_VB + ((i & 1) * 2 + par) * 8192, ql, qf, o, lsum, bnd, full, lo, hi, kt, h, true, lane); }
          N3_LAND(); __syncthreads(); } }
    { float lt; N3_LTOT(lt); const float cw = N3_GATE(2) / lt; float* ocr = N3_OCR;
      if (par == 0) {
#pragma unroll
          for (int dt = 0; dt < 4; ++dt)
#pragma unroll
              for (int rg = 0; rg < 4; ++rg) { f32x4 v = {o[dt][4 * rg], o[dt][4 * rg + 1], o[dt][4 * rg + 2], o[dt][4 * rg + 3]}; f32x4* p = (f32x4*)(ocr + 32 * dt + 8 * rg); *p = *p + v * cw; }
          asm volatile("s_waitcnt vmcnt(0)" ::: "memory"); }
      __syncthreads();
      if (par == 1) { const int l4_ = OPQL(); const int hh_ = l4_ >> 5; bf16* yr = (bf16*)(F.ws + WS_A1 + (size_t)(32 * qbh) * (KS * D) * 2 + (unsigned)(((8 * tgw + ((l4_ & 31) >> 2)) * (KS * D)) * 2));
#pragma unroll
          for (int dt = 0; dt < 4; ++dt)
#pragma unroll
              for (int rg = 0; rg < 4; ++rg) { const f32x4 c4 = *(const f32x4*)(ocr + 32 * dt + 8 * rg); f32x4 v;
#pragma unroll
                  for (int e = 0; e < 4; ++e) v[e] = c4[e] + cw * o[dt][4 * rg + e];
                  storeA4(yr, D, 512 + head * 128 + 32 * dt + 8 * rg + 4 * hh_, v); } } }
    __syncthreads();
#undef OPQL
#undef UNIF
#undef N3_GATE
#undef N3_OCR
#undef N3_KT
#undef N3_VT
#undef N3_COPY
#undef N3_LAND
#undef N3_FOLD
#undef N3_LTOT
}
__device__ __forceinline__ void ph_nsa3(Frame& F, int L) {
    for (int b = F.bid; b < 256; b += F.G) {
#pragma unroll 1
        for (int k = 0; k < 2; ++k) { const int u = k ? 511 - b : b; nsa_unit3(F, L, u >> 1, u & 1); } }
}

__device__ __forceinline__ void ph_xattn_mfma(Frame& F, int L) {
    const int lane = F.lane, q = lane & 31, h = lane >> 5;
    const float* qg = INP(20) + L * 512; const float* kg = INP(21) + L * 512;
    float gm_q = 0.f, gm_k = 0.f;
#pragma unroll
    for (int i = 0; i < 8; ++i) { gm_q = fmaxf(gm_q, fabsf(qg[lane + 64 * i])); gm_k = fmaxf(gm_k, fabsf(kg[lane + 64 * i])); }
    const float bound = 22.627416997969522f * LOG2E * 1.02f * wave_max(gm_q) * wave_max(gm_k);
    const bf16* xqb = WSP(bf16, WS_XQB);
    for (int it = F.bid * 8 + F.wave; it < (T / 32) * 4; it += F.G * 8) {
        const int tg = it >> 2, hd = it & 3, t = 32 * tg + q;
        const bf16x8* qp = (const bf16x8*)(xqb + (size_t)t * D + hd * 512 + 8 * h);
        float ss = 0.f;
#pragma unroll 8
        for (int sp = 0; sp < 32; ++sp) { const v4u wv = __builtin_bit_cast(v4u, qp[2 * sp]);
#pragma unroll
            for (int e = 0; e < 4; ++e) { const float lo = bf2f(wv[e] & 0xffffu), hi = bf2f(wv[e] >> 16); ss += lo * lo + hi * hi; } }
        ss = half_sum(ss);
        const float rs = 1.0f / sqrtf(ss * (1.0f / 512.0f) + EPS);
        const bf16x8* kx = (const bf16x8*)(WSP(bf16, WS_KXF) + (size_t)hd * 8 * 16384) + lane;
        bf16x8 pb[16]; float lsum = 0.f;
#pragma unroll
        for (int kt = 0; kt < 8; ++kt) { f32x16 s = zero16();
#pragma unroll 4
            for (int sp = 0; sp < 32; ++sp) s = MFMA32(kx[(kt * 32 + sp) * 64], qp[2 * sp], s);
#pragma unroll
            for (int R = 0; R < 16; ++R) { const float p = __builtin_amdgcn_exp2f(s[R] * rs - bound); s[R] = p; lsum += p; }
            pb[2 * kt] = pack8(s, 0); pb[2 * kt + 1] = pack8(s, 1); }
        lsum = half_sum(lsum); const float inv = 1.0f / lsum;
        const bf16x8* vx = (const bf16x8*)(WSP(bf16, WS_VXF) + (size_t)hd * 8 * 16384) + lane;
        bf16* yr = WSP(bf16, WS_A1) + (size_t)t * (KS * D);
#pragma unroll 1
        for (int dt = 0; dt < 16; ++dt) { f32x16 o = zero16();
#pragma unroll
            for (int kt = 0; kt < 8; ++kt)
#pragma unroll
                for (int s = 0; s < 2; ++s) o = MFMA32(vx[((kt * 16 + dt) * 2 + s) * 64], pb[2 * kt + s], o);
#pragma unroll
            for (int rg = 0; rg < 4; ++rg) { f32x4 v = {o[4 * rg] * inv, o[4 * rg + 1] * inv, o[4 * rg + 2] * inv, o[4 * rg + 3] * inv}; storeA4(yr, D, hd * 512 + 32 * dt + 8 * rg + 4 * h, v); } }
    }
}
__device__ __forceinline__ bf16x8 ldsfrag(const LAS bf16* p) { return *(const LAS bf16x8*)p; }
__device__ __forceinline__ v4u pack8f(const float (&v)[8]) { v4u o; o.x = cvtpk(v[0], v[1]); o.y = cvtpk(v[2], v[3]); o.z = cvtpk(v[4], v[5]); o.w = cvtpk(v[6], v[7]); return o; }
constexpr int PQ = 136, PV = 72;
__device__ __forceinline__ size_t st_chunk(int c, int h, int e, int doct) { return ((((size_t)(c * 4 + h) * 4 + (e >> 5)) * 8 + (doct >> 1)) * 512) + ((e & 31) + 32 * (doct & 1)) * 8; }

__device__ __forceinline__ void summary_mma(Frame& F, const LAS bf16* AT, const LAS bf16* VT, float* U) {
    const int lane = F.lane, r = lane & 31, h = lane >> 5;
#pragma unroll
    for (int i = 0; i < 2; ++i) { const int tile = F.wave * 2 + i, dt = tile >> 2, et = tile & 3; f32x16 c = zero16();
#pragma unroll
        for (int ks = 0; ks < 4; ++ks) c = MFMA32(ldsfrag(AT + (32 * dt + r) * PV + 16 * ks + 8 * h), ldsfrag(VT + (32 * et + r) * PV + 16 * ks + 8 * h), c);
#pragma unroll
        for (int R = 0; R < 16; ++R) U[(size_t)(32 * dt + (R & 3) + 8 * (R >> 2) + 4 * h) * 128 + 32 * et + r] = c[R]; }
}
__device__ __forceinline__ void fill_vt(Frame& F, const float* vsrc  , LAS bf16* VT) {
    for (int i = F.tid; i < 1024; i += 512) { const int e = i & 127, s0 = (i >> 7) * 8; float v[8];
#pragma unroll
        for (int j = 0; j < 8; ++j) v[j] = vsrc[(size_t)(s0 + j) * NIN + e];
        *(LAS v4u*)(VT + e * PV + s0) = pack8f(v); }
}
__device__ __forceinline__ void hg_summary_mfma(Frame& F, int L, int c, int h) {
    LAS float* B = (LAS float*)F.lds; LAS float* KY = B + 64 * HP; LAS bf16* AT = (LAS bf16*)(KY + 64 * HP); LAS bf16* VT = AT + 128 * PV;
    const float* z = WSP(float, WS_Z);
    hg_gates(F, L, c, h, B, KY);
    for (int i = F.tid; i < 1024; i += 512) { const int d = i & 127, s0 = (i >> 7) * 8; const float be = B[63 * HP + d]; float v[8];
#pragma unroll
        for (int j = 0; j < 8; ++j) v[j] = KY[(s0 + j) * HP + d] * EXPF(be - B[(s0 + j) * HP + d]);
        *(LAS v4u*)(AT + d * PV + s0) = pack8f(v); }
    fill_vt(F, z + (size_t)(64 * c) * NIN + ZC_HGI + h * 128, VT);
    if (F.tid < 128) WSP(float, WS_HGDEC)[(c * 4 + h) * 128 + F.tid] = EXPF(B[63 * HP + F.tid]);
    __syncthreads();
    summary_mma(F, AT, VT, WSP(float, WS_HGU) + (size_t)(c * 4 + h) * 16384);
    __syncthreads();
}
__device__ __forceinline__ void ml_summary_mfma(Frame& F, int L, int c, int h) {
    LAS float* BL = (LAS float*)F.lds; LAS float* LI = BL + 64; LAS float* WS_ = LI + 64; LAS bf16* AT = (LAS bf16*)(WS_ + 64); LAS bf16* VT = AT + 128 * PV; LAS float* KC = (LAS float*)(VT + 128 * PV);
    const float* z = WSP(float, WS_Z); float* mlq = WSP(float, WS_MLQ); float* mlk = WSP(float, WS_MLK); const float* cw = INP(11) + (size_t)L * 4 * 1024;
    ml_gates(F, c, h, BL, LI);
    if (F.tid < 64) { const float a = BL[63] - BL[F.tid] + LI[F.tid]; const float mloc = wave_max(a); WS_[F.tid] = EXPF(a - mloc); if (F.tid == 0) { float* msc = WSP(float, WS_MLSC); msc[c * 4 + h] = mloc; msc[NCH * 4 + c * 4 + h] = BL[63]; } }
    { const int d = F.tid & 127; const float wq0 = cw[h * 128 + d], wq1 = cw[1024 + h * 128 + d], wq2 = cw[2048 + h * 128 + d], wq3 = cw[3072 + h * 128 + d];
      const float wk0 = cw[512 + h * 128 + d], wk1 = cw[1536 + h * 128 + d], wk2 = cw[2560 + h * 128 + d], wk3 = cw[3584 + h * 128 + d];
#pragma unroll 1
      for (int s = F.tid >> 7; s < 64; s += 4) { const int t = 64 * c + s; const float* zq = z + (size_t)t * NIN + ZC_MLQ + h * 128 + d; const float* zk = z + (size_t)t * NIN + ZC_MLK + h * 128 + d;
          const long b1 = (t >= 1) ? -(long)NIN : 0, b2 = (t >= 2) ? -2L * NIN : 0, b3 = (t >= 3) ? -3L * NIN : 0;
          const float f1 = (t >= 1) ? 1.f : 0.f, f2 = (t >= 2) ? 1.f : 0.f, f3 = (t >= 3) ? 1.f : 0.f;
          const float q0 = zq[0], q1 = zq[b1], q2 = zq[b2], q3 = zq[b3], k0_ = zk[0], k1_ = zk[b1], k2_ = zk[b2], k3_ = zk[b3];
          float aq = wq3 * q0 + f1 * wq2 * q1 + f2 * wq1 * q2 + f3 * wq0 * q3, ak = wk3 * k0_ + f1 * wk2 * k1_ + f2 * wk1 * k2_ + f3 * wk0 * k3_;
          aq = siluf_(aq) * 0.08838834764831845f; ak = siluf_(ak);
          mlq[(size_t)t * 512 + h * 128 + d] = aq; mlk[(size_t)t * 512 + h * 128 + d] = ak; KC[s * HP + d] = ak; } }
    __syncthreads();
    for (int i = F.tid; i < 1024; i += 512) { const int d = i & 127, s0 = (i >> 7) * 8; float v[8];
#pragma unroll
        for (int j = 0; j < 8; ++j) v[j] = KC[(s0 + j) * HP + d] * WS_[s0 + j];
        *(LAS v4u*)(AT + d * PV + s0) = pack8f(v); }
    fill_vt(F, z + (size_t)(64 * c) * NIN + ZC_MLV + h * 128, VT);
    if (F.tid < 128) { float a = 0.f; for (int s = 0; s < 64; ++s) a += KC[s * HP + F.tid] * WS_[s]; WSP(float, WS_MLNL)[(c * 4 + h) * 128 + F.tid] = a; }
    __syncthreads();
    summary_mma(F, AT, VT, WSP(float, WS_MLU) + (size_t)(c * 4 + h) * 16384);
    __syncthreads();
}


__device__ __forceinline__ void ph_scan_v2(Frame& F, int nblk, int nw) {
    const float* msc = WSP(float, WS_MLSC);
    const bool main_ = F.bid < nblk;
    const bool nst_ = (nw < 8) ? (main_ && F.wave == nw) : (F.bid >= nblk && F.bid < nblk + 8 && F.wave == 0); const int nsb_ = (nw < 8) ? F.bid : F.bid - nblk;
    if (main_ && F.wave < nw) for (int id = (F.bid * nw + F.wave) * 64 + F.lane; id < 32768; id += nblk * nw * 64) { const bool ml = id >= 16384; const int i = id & 16383, h = i >> 12, dq = (i >> 7) & 31, e = i & 127;
        const float* U = WSP(float, ml ? WS_MLU : WS_HGU) + (size_t)h * 16384 + (size_t)(4 * dq) * 128 + e; bf16* ST = WSP(bf16, ml ? WS_MLST : WS_HGST);
        const float* dec = WSP(float, WS_HGDEC) + h * 128 + 4 * dq;
        float st[4] = {0.f, 0.f, 0.f, 0.f}; float m = 0.f;
#pragma unroll 1
        for (int c0 = 0; c0 < NCH; c0 += 8) { float u[8][4], dk[8][4];
#pragma unroll
            for (int cc = 0; cc < 8; ++cc)
#pragma unroll
                for (int j = 0; j < 4; ++j) { u[cc][j] = U[(size_t)(c0 + cc) * 65536 + j * 128]; dk[cc][j] = ml ? 0.f : dec[(c0 + cc) * 512 + j]; }
#pragma unroll
            for (int cc = 0; cc < 8; ++cc) { const int c = c0 + cc;
                { v2u pk; pk.x = cvtpk(st[0], st[1]); pk.y = cvtpk(st[2], st[3]); *(v2u*)(ST + st_chunk(c, h, e, dq >> 1) + 4 * (dq & 1)) = pk; }
                if (ml) { const float mloc = msc[c * 4 + h], bend = msc[NCH * 4 + c * 4 + h]; const float mn = fmaxf(bend + m, mloc); const float fa = EXPF(bend + m - mn), fb = EXPF(mloc - mn); m = mn;
#pragma unroll
                    for (int j = 0; j < 4; ++j) st[j] = fa * st[j] + fb * u[cc][j]; }
                else {
#pragma unroll
                    for (int j = 0; j < 4; ++j) st[j] = dk[cc][j] * st[j] + u[cc][j]; } } } }
    const int gt = F.bid * 512 + F.tid, NGT = nblk * 512;
    if (nst_) for (int i = nsb_ * 64 + F.lane; i < 512; i += 512) { const int h = i >> 7, d = i & 127; const float* nl = WSP(float, WS_MLNL); float* ns = WSP(float, WS_MLN); float st = 0.f, m = 0.f;
        for (int c = 0; c < NCH; ++c) { const int o = (c * 4 + h) * 128 + d; ns[o] = st; const float mloc = msc[c * 4 + h], bend = msc[NCH * 4 + c * 4 + h]; const float mn = fmaxf(bend + m, mloc);
            st = EXPF(bend + m - mn) * st + EXPF(mloc - mn) * nl[o]; m = mn; } }
    if (main_) for (int i = gt; i < 4; i += NGT) { float* mp = WSP(float, WS_MLSC) + 2 * NCH * 4; float m = 0.f;
        for (int c = 0; c < NCH; ++c) { mp[c * 4 + i] = m; m = fmaxf(msc[NCH * 4 + c * 4 + i] + m, msc[c * 4 + i]); } }
}

template <bool SILU>
__device__ __forceinline__ void finish_tile(Frame& F, const f32x16& o, LAS float* PART, const float* gain, const float* gate_base  , int ycol, int c) {
    const int lane = F.lane, r = lane & 31, h = lane >> 5, et = F.wave & 3, tt = F.wave >> 2, t = 32 * tt + r;
    float ss = 0.f;
#pragma unroll
    for (int R = 0; R < 16; ++R) ss += o[R] * o[R];
    ss = half_sum(ss);
    if (h == 0) PART[t * 4 + et] = ss;
    __syncthreads();
    const f32x4 p4 = *(const LAS f32x4*)(PART + t * 4); const float rs = 1.0f / sqrtf(((p4[0] + p4[1]) + (p4[2] + p4[3])) * (1.0f / 128.0f) + EPS);
    bf16* yr = WSP(bf16, WS_A1) + (size_t)(64 * c + t) * (KS * D); const float* gr = gate_base + (size_t)t * NIN;
#pragma unroll
    for (int rg = 0; rg < 4; ++rg) { const int e = 32 * et + 8 * rg + 4 * h; const f32x4 gv = *(const f32x4*)(gr + e), gn = *(const f32x4*)(gain + e); f32x4 v;
#pragma unroll
        for (int q = 0; q < 4; ++q) v[q] = o[4 * rg + q] * rs * gn[q] * (SILU ? siluf_(gv[q]) : sigm(gv[q]));
        storeA4(yr, D, ycol + e, v); }
}
__device__ __forceinline__ void hg_output_mfma(Frame& F, int L, int c, int h) {
    LAS float* B = (LAS float*)F.lds; LAS float* KY = B + 64 * HP; LAS bf16* QA = (LAS bf16*)(KY + 64 * HP); LAS bf16* KA = QA + 64 * PQ; LAS bf16* QE = KA + 64 * PQ; LAS bf16* VT = QE + 64 * PQ; LAS float* PART = (LAS float*)(VT + 128 * PV);
    const float* z = WSP(float, WS_Z);
    hg_gates(F, L, c, h, B, KY);
    for (int i = F.tid; i < 1024; i += 512) { const int t = i >> 4, d0 = (i & 15) * 8; const float* qs = z + (size_t)(64 * c + t) * NIN + ZC_HGQ + h * 128 + d0; const f32x4 qa = *(const f32x4*)qs, qb = *(const f32x4*)(qs + 4);
        float vq[8], vk[8], ve[8];
#pragma unroll
        for (int j = 0; j < 8; ++j) { const float b = B[t * HP + d0 + j], br = B[31 * HP + d0 + j], qv = (j < 4) ? qa[j & 3] : qb[j & 3];
            vq[j] = qv * EXPF(fminf(fmaxf(b - br, -80.f), 80.f)); vk[j] = KY[t * HP + d0 + j] * EXPF(fminf(fmaxf(br - b, -80.f), 80.f)); ve[j] = qv * EXPF(b); }
        *(LAS v4u*)(QA + t * PQ + d0) = pack8f(vq); *(LAS v4u*)(KA + t * PQ + d0) = pack8f(vk); *(LAS v4u*)(QE + t * PQ + d0) = pack8f(ve); }
    fill_vt(F, z + (size_t)(64 * c) * NIN + ZC_HGI + h * 128, VT);
    __syncthreads();
    const int lane = F.lane, r = lane & 31, hh = lane >> 5, et = F.wave & 3, tt = F.wave >> 2, t = 32 * tt + r;
    f32x16 o = zero16();
#pragma unroll
    for (int st = 0; st <= 1; ++st) { if (st <= tt) { f32x16 sc = zero16();
#pragma unroll
        for (int kd = 0; kd < 8; ++kd) sc = MFMA32(ldsfrag(KA + (32 * st + swap23(r)) * PQ + 16 * kd + 8 * hh), ldsfrag(QA + t * PQ + 16 * kd + 8 * hh), sc);
#pragma unroll
        for (int R = 0; R < 16; ++R) { const int s = 32 * st + 16 * (R >> 3) + 8 * hh + (R & 7); sc[R] = (s <= t) ? sc[R] : 0.f; }
        bf16x8 pb[2]; pb[0] = pack8(sc, 0); pb[1] = pack8(sc, 1);
#pragma unroll
        for (int ks = 0; ks < 2; ++ks) o = MFMA32(ldsfrag(VT + (32 * et + r) * PV + 32 * st + 16 * ks + 8 * hh), pb[ks], o); } }
    { const bf16x8* sp = (const bf16x8*)(WSP(bf16, WS_HGST) + (((size_t)(c * 4 + h) * 4 + et) * 8) * 512) + lane;
#pragma unroll
      for (int kd = 0; kd < 8; ++kd) o = MFMA32(sp[kd * 64], ldsfrag(QE + t * PQ + 16 * kd + 8 * hh), o); }
    finish_tile<true>(F, o, PART, INP(6) + L * 512 + h * 128, z + (size_t)(64 * c) * NIN + ZC_HGG + h * 128, h * 128, c);
    __syncthreads();
}
__device__ __forceinline__ void ml_output_mfma(Frame& F, int L, int c, int h) {
    LAS float* BL = (LAS float*)F.lds; LAS float* LI = BL + 64; LAS float* MT = LI + 64; LAS float* WI = MT + 64; LAS float* QNN = WI + 64; LAS float* PART = QNN + 64;
    LAS bf16* QA = (LAS bf16*)(PART + 256); LAS bf16* KA = QA + 64 * PQ; LAS bf16* VT = KA + 64 * PQ;
    const float* z = WSP(float, WS_Z); const float* mlq = WSP(float, WS_MLQ); const float* mlk = WSP(float, WS_MLK);
    ml_gates(F, c, h, BL, LI);
    const float mprev = WSP(float, WS_MLSC)[2 * NCH * 4 + c * 4 + h];
    for (int i = F.tid; i < 1024; i += 512) { const int t = i >> 4, d0 = (i & 15) * 8; const float* qs = mlq + (size_t)(64 * c + t) * 512 + h * 128 + d0; const float* ks = mlk + (size_t)(64 * c + t) * 512 + h * 128 + d0;
        const f32x4 qa = *(const f32x4*)qs, qb = *(const f32x4*)(qs + 4), ka = *(const f32x4*)ks, kb = *(const f32x4*)(ks + 4);
        float vq[8] = {qa[0], qa[1], qa[2], qa[3], qb[0], qb[1], qb[2], qb[3]}, vk[8] = {ka[0], ka[1], ka[2], ka[3], kb[0], kb[1], kb[2], kb[3]};
        *(LAS v4u*)(QA + t * PQ + d0) = pack8f(vq); *(LAS v4u*)(KA + t * PQ + d0) = pack8f(vk); }
    fill_vt(F, z + (size_t)(64 * c) * NIN + ZC_MLV + h * 128, VT);
    if (F.tid < 64) { const int t = F.tid; const float inter = BL[t] + mprev; float mt = inter; for (int s = 0; s <= t; ++s) mt = fmaxf(mt, BL[t] - BL[s] + LI[s]); MT[t] = mt; WI[t] = EXPF(inter - mt);
    }
    { const int t = F.tid >> 3, p = F.tid & 7; const float* nst = WSP(float, WS_MLN) + (c * 4 + h) * 128 + 16 * p; const float* qs = mlq + (size_t)(64 * c + t) * 512 + h * 128 + 16 * p; float a = 0.f;
#pragma unroll
      for (int d = 0; d < 16; ++d) a += qs[d] * nst[d];
      a += sxor<1>(a); a += sxor<2>(a); a += sxor<4>(a); if (p == 0) QNN[t] = a; }
    __syncthreads();
    const int lane = F.lane, r = lane & 31, hh = lane >> 5, et = F.wave & 3, tt = F.wave >> 2, t = 32 * tt + r;
    const float mt = MT[t], wi = WI[t], blt = BL[t];
    f32x16 o = zero16(); float rsum = 0.f;
#pragma unroll
    for (int st = 0; st <= 1; ++st) { if (st <= tt) { f32x16 sc = zero16();
#pragma unroll
        for (int kd = 0; kd < 8; ++kd) sc = MFMA32(ldsfrag(KA + (32 * st + swap23(r)) * PQ + 16 * kd + 8 * hh), ldsfrag(QA + t * PQ + 16 * kd + 8 * hh), sc);
#pragma unroll
        for (int R = 0; R < 16; ++R) { const int s = 32 * st + 16 * (R >> 3) + 8 * hh + (R & 7); const float wgt = (s <= t) ? EXPF(blt - BL[s] + LI[s] - mt) : 0.f; sc[R] = sc[R] * wgt; rsum += sc[R]; }
        bf16x8 pb[2]; pb[0] = pack8(sc, 0); pb[1] = pack8(sc, 1);
#pragma unroll
        for (int ks = 0; ks < 2; ++ks) o = MFMA32(ldsfrag(VT + (32 * et + r) * PV + 32 * st + 16 * ks + 8 * hh), pb[ks], o); } }
    rsum = half_sum(rsum);
    f32x16 oi = zero16();
    { const bf16x8* sp = (const bf16x8*)(WSP(bf16, WS_MLST) + (((size_t)(c * 4 + h) * 4 + et) * 8) * 512) + lane;
#pragma unroll
      for (int kd = 0; kd < 8; ++kd) oi = MFMA32(sp[kd * 64], ldsfrag(QA + t * PQ + 16 * kd + 8 * hh), oi); }
    const float qn = wi * QNN[t] + rsum; const float den = 1.0f / fmaxf(fabsf(qn), EXPF(-mt));
#pragma unroll
    for (int R = 0; R < 16; ++R) o[R] = (o[R] + wi * oi[R]) * den;
    finish_tile<false>(F, o, PART, INP(12) + L * 512 + h * 128, z + (size_t)(64 * c) * NIN + ZC_MLO + h * 128, 1536 + h * 128, c);
    __syncthreads();
}

__device__ __forceinline__ void cmp_item_mfma(Frame& F, int L, int item) {
    const int which = item & 1, g = (item >> 1) & 1, rt = item >> 2, c0 = 32 * rt;
    const int lane = F.lane, r = lane & 31, hh = lane >> 5, ct = F.wave & 3, kh = F.wave >> 2;
    LAS float* PARTC = (LAS float*)F.lds;
    LAS float* O = PARTC + 4096;
    const float* z = WSP(float, WS_Z); const int zc = (which ? ZC_NVC : ZC_NKC) + g * 128;
    const float* pe = INP(9) + ((size_t)(L * 2 + which) * 32) * 128;
    const bf16x8* wf = (const bf16x8*)(WSL(bf16, WS_WCF) + ((size_t)(which * 4 + ct) * 256) * 512) + lane;
    f32x16 acc = zero16();
    for (int l = 16 * kh; l < 16 * kh + 16; ++l) { int tok = 16 * (c0 + r) + l; const bool ok = tok < T; if (!ok) tok = T - 1; const float* zr = z + (size_t)tok * NIN + zc + 8 * hh; const float* pr = pe + l * 128 + 8 * hh;
#pragma unroll
        for (int sp = 0; sp < 8; ++sp) { const f32x4 a = *(const f32x4*)(zr + 16 * sp), b = *(const f32x4*)(zr + 16 * sp + 4), pa = *(const f32x4*)(pr + 16 * sp), pb = *(const f32x4*)(pr + 16 * sp + 4);
            float v[8];
#pragma unroll
            for (int j = 0; j < 4; ++j) { v[j] = ok ? a[j] + pa[j] : 0.f; v[4 + j] = ok ? b[j] + pb[j] : 0.f; }
            acc = MFMA32(__builtin_bit_cast(bf16x8, pack8f(v)), wf[(8 * l + sp) * 64], acc); } }
    if (kh == 1) {
#pragma unroll
        for (int R = 0; R < 16; ++R) PARTC[(ct * 16 + R) * 64 + lane] = acc[R]; }
    __syncthreads();
    if (kh == 0) {
#pragma unroll
        for (int R = 0; R < 16; ++R) O[((R & 3) + 8 * (R >> 2) + 4 * hh) * HP + 32 * ct + r] = acc[R] + PARTC[(ct * 16 + R) * 64 + lane]; }
    __syncthreads();
    if (!which) { const float* kg = INP(8) + L * 384;
        for (int rr = 0; rr < 4; ++rr) { const int cl = 4 * F.wave + rr, c = c0 + cl; const float o1 = O[cl * HP + lane], o2 = O[cl * HP + lane + 64];
            const float ss = wave_sum(o1 * o1 + o2 * o2); const float rs = 1.0f / sqrtf(ss * (1.0f / 128.0f) + EPS);
            const float y1 = o1 * rs * kg[lane], y2 = o2 * rs * kg[lane + 64]; const int pos = (c < NCMP) ? 16 * c + 31 : 0; const float cs = WSP(float, WS_COS)[pos * 64 + lane], sn = WSP(float, WS_SIN)[pos * 64 + lane];
            const float r1 = y1 * cs - y2 * sn, r2 = y2 * cs + y1 * sn;
            bf16* kcf = WSP(bf16, WS_KCF) + (size_t)g * 16 * 4096 + (size_t)rt * 4096;
            { const int d = lane; kcf[(d >> 4) * 512 + (swap23(cl) + 32 * ((d >> 3) & 1)) * 8 + (d & 7)] = (bf16)f2bf(r1); }
            { const int d = lane + 64; kcf[(d >> 4) * 512 + (swap23(cl) + 32 * ((d >> 3) & 1)) * 8 + (d & 7)] = (bf16)f2bf(r2); } } }
    else { const int d = F.tid & 127, cg = F.tid >> 7; float v[8];
#pragma unroll
        for (int j = 0; j < 8; ++j) v[j] = O[(8 * cg + j) * HP + d];
        *(v4u*)(WSP(bf16, WS_VCF) + (size_t)g * 16 * 4096 + (size_t)rt * 4096 + ((d >> 5) * 2 + (cg >> 1)) * 512 + ((d & 31) + 32 * (cg & 1)) * 8) = pack8f(v); }
    __syncthreads();
}
__device__ __forceinline__ void wcf_item(Frame& F, int L, size_t wo, int item) {
    const int which = item >> 10, ct = (item >> 8) & 3, ks = item & 255, l = ks >> 3, sp = ks & 7, lane = F.lane, r = lane & 31, hh = lane >> 5;
    const float* w = INP(10) + (((size_t)(L * 2 + which) * 32 + l) * 128 + 16 * sp + 8 * hh) * 128 + 32 * ct + r; float v[8];
#pragma unroll
    for (int j = 0; j < 8; ++j) v[j] = w[j * 128];
    *(v4u*)(WSO(bf16, WS_WCF, wo) + ((size_t)((which * 4 + ct) * 256 + ks)) * 512 + lane * 8) = pack8f(v);
}
#ifndef SPLITB
#define SPLITB 1
#endif
#ifndef K5SQ
#define K5SQ 64
#endif
#ifndef K5A
#define K5A 265
#endif
#ifndef K5CUT
#define K5CUT 120
#endif
#ifndef K5S
#define K5S 100
#endif
#ifndef K5TO
#define K5TO 19
#endif
#ifndef K5TAB
#define K5TAB 1
#endif
#ifndef K5A0T
#define K5A0T 278
#endif
#ifndef K5CUT0
#define K5CUT0 128
#endif
struct K5Deal { unsigned short o[2][257]; unsigned cf[2][257]; };
constexpr K5Deal make_k5deal() {
    K5Deal d{};
    for (int cls = 0; cls < 2; ++cls) {
        long s[256] = {}; long tot = 0;
        for (int j = 0; j < 256; ++j) { const int q = j >> 1; long w = (cls ? K5A : K5A0T) - 2 * q - ((q < K5SQ) ? K5S : 0); if (q >= (cls ? K5CUT : K5CUT0) || w < 0) w = 0; s[j] = w; tot += w; }
        long cw = 0;
        for (int j = 0; j < 256; ++j) { d.o[cls][j] = (unsigned short)(1024 * cw / tot); cw += s[j]; }
        d.o[cls][256] = 1024;
        const long NC = (WC_NALL - K1_CONV - K4_CONV) + (cls == 0 ? WC_DEF_N : 0), W = 1024L * K5TO + NC;
        long r[256] = {}; long rtot = 0;
        for (int j = 0; j < 256; ++j) { const long outs = d.o[cls][j + 1] - d.o[cls][j]; long v = (s[j] * W * 16) / tot - outs * K5TO * 16; if (v < 0) v = 0; r[j] = v; rtot += v; }
        long cum = 0;
        for (int j = 0; j < 256; ++j) { d.cf[cls][j] = (unsigned)((cum << 20) / rtot); cum += r[j]; }
        d.cf[cls][256] = 1u << 20;
    }
    return d;
}
__device__ const K5Deal K5DEAL = make_k5deal();

typedef KArgs Args;
__global__ void __launch_bounds__(512, 2) fwd(Args args) {
    extern __shared__ __attribute__((aligned(16))) unsigned char lds[];
    Frame F;
    F.lds = (LAS unsigned char*)lds; F.MISC = (volatile LAS unsigned*)(F.lds + MISC_OFF);
    F.tid = threadIdx.x; F.lane = F.tid & 63; F.wave = __builtin_amdgcn_readfirstlane(F.tid >> 6); F.G = gridDim.x; F.bid = blockIdx.x;
    F.ap = (const KArgs __attribute__((address_space(4)))*)__builtin_amdgcn_kernarg_segment_ptr();
    F.ws = args.ws; F.ctl = (gu32*)(args.ws + WS_CTL);
    for (int u = F.tid; u < (LDS_BYTES - MISC_OFF) / 4; u += 512) ((LAS unsigned*)(F.lds + MISC_OFF))[u] = 0u;
    __syncthreads();
    const int lo = args.ph_lo, hi = args.ph_hi;
    XcdBarrier bar; bar.bar = (unsigned*)(F.ctl + CW_BAR) + args.li * XCD_BAR_WORDS; bar.x = 0; bar.st = nullptr;
    if (hi - lo > 1) bar = xcd_barrier_post((unsigned*)(F.ctl + CW_BAR) + args.li * XCD_BAR_WORDS, F.MISC + 8);
#if 1
#define IN(k) (lo <= (k) && (k) < hi)
#define SEAM(k) do { if (IN((k) + 1)) xcd_barrier(bar); } while (0)
#else
#define IN(k) 1
#define SEAM(k) do { if ((k) + 1 < NPHASES) xcd_barrier(bar); } while (0)
#endif
    LAS unsigned char* glds = F.lds;

#ifndef PHMASK
#define PHMASK 0x1fff
#endif
#define PHON(kk) (((PHMASK) >> (kk)) & 1)
#ifndef SPLITB
#define SPLITB 1
#endif
#ifndef K5SQ
#define K5SQ 64
#endif
#ifndef DEFER0
#define DEFER0 1
#endif
#ifndef DBLMASK
#define DBLMASK 0
#endif
#define NREP(kk) (1 + (((DBLMASK) >> (kk)) & 1))
    if (PHON(12) && IN(0)) { LAUNDER(); ph_prologue(F); SEAM(0); }
    for (int L = 0; L < DEPTH; ++L) {
        const int pb = 1 + L * NPH;
        F.wofs = WOVL ? (size_t)(L & 1) * WS_WSET : 0;
        if (PHON(0) && IN(pb + 0) && (!WOVL || L == 0)) for (int rep = 0; rep < NREP(0); ++rep) { LAUNDER(); if (rep) xcd_barrier(bar);
            { const bool df_ = WOVL && DEFER0 && F.G == 256 && NSA_V2 == 1; const int n0_ = df_ ? WC_NALL - WC_DEF_N : WC_NALL;
              const int per = (n0_ + F.G - 1) / F.G, lo_ = F.bid * per, hi_ = (lo_ + per < n0_) ? lo_ + per : n0_; ph_wconv(F, L, F.wofs, lo_, hi_, df_ ? WC_DEF_LO : (1 << 30), WC_DEF_N); }
            __syncthreads(); SEAM(pb + 0); }
        if (PHON(1) && IN(pb + 1)) for (int rep = 0; rep < NREP(1); ++rep) { LAUNDER(); if (rep) xcd_barrier(bar);
            { pg8::Gemm g{WSP(pg8::bf16_t, WS_A0), WSL(pg8::bf16_t, WS_WIN), T, NIN, KS * D}; pg8::StaticOrder S; S.init(T, NIN, F.G, F.bid);
              pg8::rs_table_fill(glds, S, WSP(float, WS_SSQA), T, 1.0f / D, EPS, F.wave);
              pg8::EpiScaleF32 E{WSP(float, WS_Z), NIN, WSL(float, WS_BPERM), WSP(float, WS_SSQA), 32, glds, 1.0f / D, EPS};
              pg8::gemm_phase<pg8::EpiScaleF32, pg8::StaticOrder, PG8_ALIGN, PG8_SP2>(glds, g, S, E, F.wave); }
            { pg8::Gemm g{WSP(pg8::bf16_t, WS_MEMB), WSL(pg8::bf16_t, WS_WKV), MEM, 2 * D, KS * D}; pg8::StaticOrder S; S.init(MEM, 2 * D, F.G, (F.bid + F.G - (F.G > 116 ? 100 : 0)) % F.G);
              pg8::EpiScaleF32 E{WSP(float, WS_KVX), 2 * D, nullptr, WSP(float, WS_SSQM), 1, glds, 1.0f / D, EPS};
              pg8::gemm_phase<pg8::EpiScaleF32, pg8::StaticOrder, PG8_ALIGN, PG8_SP2>(glds, g, S, E, F.wave); }
#if WOVL
            if (L + 1 < DEPTH && F.G == 256 && F.bid >= 116) { LAUNDER(); const int lo_ = (F.bid - 116) * K1_PER, hi_ = lo_ + K1_PER; ph_wconv(F, L + 1, (size_t)((L + 1) & 1) * WS_WSET, lo_, hi_); __syncthreads(); }
#endif
            SEAM(pb + 1); }
#if ORACLE_MIX
        if (PHON(2) && IN(pb + 2)) { LAUNDER(); ph_prep(F, L, 0); __syncthreads(); SEAM(pb + 2); }
#endif
        if (PHON(3) && IN(pb + 3)) for (int rep = 0; rep < NREP(3); ++rep) { LAUNDER(); if (rep) xcd_barrier(bar);
#if ORACLE_MIX
            for (int it = F.bid; it < 512; it += F.G) hg_summary_item(F, L, it >> 2, it & 3);
            for (int it = F.bid; it < 512; it += F.G) ml_summary_item(F, it >> 2, it & 3);
            for (int it = F.bid; it < 256; it += F.G) cmp_item(F, L, it);
#else
            { const bool g256 = (F.G == 256), cmpwg = g256 && F.bid >= 192;
              const int c_lo = g256 ? (cmpwg ? F.bid - 192 : 64) : F.G - 1 - F.bid, c_st = g256 ? 64 : F.G;
              const int s_lo = g256 ? (cmpwg ? 960 + F.bid - 192 : 5 * F.bid) : F.bid, s_hi = g256 ? s_lo + (cmpwg ? 1 : 5) : 1024, s_st = g256 ? 1 : F.G;
#pragma unroll 1
              for (int it = c_lo; it < 64; it += c_st) cmp_item_mfma(F, L, it);
              LAUNDER();
#pragma unroll 1
              for (int it = s_lo; it < s_hi; it += s_st) { if (it < 512) hg_summary_mfma(F, L, it >> 2, it & 3); else ml_summary_mfma(F, L, (it - 512) >> 2, it & 3); } }
#if SPLITB
            __syncthreads(); LAUNDER(); ph_prep(F, L, 0); __syncthreads();
#endif
#endif
            SEAM(pb + 3); }
        if (PHON(4) && IN(pb + 4)) for (int rep = 0; rep < NREP(4); ++rep) { LAUNDER(); if (rep) xcd_barrier(bar);
#if ORACLE_MIX
            ph_scan(F);
#else
#if SPLITB
            if (F.G == 256) { ph_scan_v2(F, 2 * K5SQ, (K5SQ == 32) ? 8 : 4);
#if WOVL
                if (K4_PER > 0 && L + 1 < DEPTH && F.bid < 128) { LAUNDER(); const int lo_ = K1_CONV + F.bid * K4_PER; ph_wconv(F, L + 1, (size_t)((L + 1) & 1) * WS_WSET, lo_, lo_ + K4_PER, 1 << 30, 0, 5); }
#endif
                xcd_barrier_arrive(bar); }
            else { ph_scan_v2(F, F.G, 2); __syncthreads(); xcd_barrier(bar); }
#else
            ph_scan_v2(F, F.G, 2); LAUNDER(); ph_prep(F, L, 3);
#endif
#endif
#if !SPLITB
            __syncthreads(); SEAM(pb + 4);
#endif
            }
        if (PHON(5) && IN(pb + 5)) for (int rep = 0; rep < NREP(5); ++rep) { LAUNDER(); if (rep) xcd_barrier(bar);
#if ORACLE_MIX
#define HG_OUT hg_output_item
#define ML_OUT ml_output_item
#else
#define HG_OUT hg_output_mfma
#define ML_OUT ml_output_mfma
#endif
#ifndef P5MASK
#define P5MASK 7
#endif
#ifndef P5DBL
#define P5DBL 0
#endif
            const bool g256_ = (F.G == 256) && (NSA_V2 == 1); const int q5_ = F.bid >> 1, r5_ = F.bid & 1;
#ifndef K5A
#define K5A 265
#endif
#ifndef K5A0
#define K5A0 265
#endif
#ifndef K5CUT
#define K5CUT 120
#endif
#ifndef K5S
#define K5S 100
#endif
            long cwa_ = 0, K5TOT = 0;
            const int k5a_ = (DEFER0 && L == 0) ? K5A0 : K5A;
#pragma unroll 1
            for (int qq = 0; qq < 128; ++qq) { const int wr_ = k5a_ - 2 * qq - ((SPLITB && qq < K5SQ) ? K5S : 0), wq_ = (qq >= K5CUT || wr_ < 0) ? 0 : wr_; if (qq < q5_) cwa_ += 2 * wq_; else if (qq == q5_) cwa_ += r5_ * wq_; K5TOT += 2 * wq_; }
            const int wm_ = k5a_ - 2 * q5_ - ((SPLITB && q5_ < K5SQ) ? K5S : 0); const long cwb_ = cwa_ + ((q5_ >= K5CUT || wm_ < 0) ? 0 : wm_);
#if !SPLITB
            { const int o_lo = g256_ ? ((SPLITB && K5TAB) ? (int)K5DEAL.o[(DEFER0 && L == 0) ? 0 : 1][F.bid] : (int)(1024L * cwa_ / K5TOT)) : F.bid, o_hi = g256_ ? ((SPLITB && K5TAB) ? (int)K5DEAL.o[(DEFER0 && L == 0) ? 0 : 1][F.bid + 1] : (int)(1024L * cwb_ / K5TOT)) : 1024, o_st = g256_ ? 1 : F.G;
#pragma unroll 1
              for (int r5 = 0; r5 < 1 + (P5DBL & 1); ++r5)
#pragma unroll 1
                for (int it = o_lo; it < o_hi; it += o_st) { LAUNDER(); if (it < 512) { if (P5MASK & 1) HG_OUT(F, L, it >> 2, it & 3); } else { if (P5MASK & 2) ML_OUT(F, L, (it - 512) >> 2, it & 3); } } }
#endif
#if ORACLE_ATTN
            if (P5MASK & 4) { ph_nsa(F, L); __syncthreads(); }
#else
            LAUNDER();
            if (P5MASK & 4) for (int r5 = 0; r5 < 1 + ((P5DBL >> 2) & 1); ++r5) {
#if NSA_V2 == 2
                ph_nsa3(F, L);
#elif NSA_V2
                ph_nsa_block(F, L);
#else
                ph_nsa_mfma(F, L);
#endif
                __syncthreads(); }
#if SPLITB
            LAUNDER(); if (F.G == 256) xcd_barrier_wait(bar);
            LAUNDER();
            { const int o_lo = g256_ ? ((SPLITB && K5TAB) ? (int)K5DEAL.o[(DEFER0 && L == 0) ? 0 : 1][F.bid] : (int)(1024L * cwa_ / K5TOT)) : F.bid, o_hi = g256_ ? ((SPLITB && K5TAB) ? (int)K5DEAL.o[(DEFER0 && L == 0) ? 0 : 1][F.bid + 1] : (int)(1024L * cwb_ / K5TOT)) : 1024, o_st = g256_ ? 1 : F.G;
#pragma unroll 1
              for (int r5 = 0; r5 < 1 + (P5DBL & 1); ++r5)
#pragma unroll 1
                for (int it = o_lo; it < o_hi; it += o_st) { LAUNDER(); if (it < 512) { if (P5MASK & 1) HG_OUT(F, L, it >> 2, it & 3); } else { if (P5MASK & 2) ML_OUT(F, L, (it - 512) >> 2, it & 3); } } }
            __syncthreads();
#endif
#if WOVL
            if (g256_) {
#pragma unroll 1
                for (int s5 = (DEFER0 && L == 0) ? 0 : 1; s5 < 2 && L + s5 < DEPTH; ++s5) { LAUNDER();
                    const int c0_ = s5 ? K1_CONV + (SPLITB ? K4_CONV : 0) : WC_DEF_LO, n5_ = s5 ? WC_NALL - K1_CONV - (SPLITB ? K4_CONV : 0) : WC_DEF_N; const int cl_ = (DEFER0 && L == 0) ? 0 : 1; const int lo_ = c0_ + ((SPLITB && K5TAB) ? (int)(((long)n5_ * K5DEAL.cf[cl_][F.bid]) >> 20) : (int)((long)n5_ * cwa_ / K5TOT)), hi_ = c0_ + ((SPLITB && K5TAB) ? (int)(((long)n5_ * K5DEAL.cf[cl_][F.bid + 1]) >> 20) : (int)((long)n5_ * cwb_ / K5TOT));
                    ph_wconv(F, L + s5, (size_t)((L + s5) & 1) * WS_WSET, lo_, hi_); __syncthreads(); } }
            else if (L + 1 < DEPTH) { LAUNDER(); const int per = (WC_NALL + F.G - 1) / F.G, lo_ = F.bid * per, hi_ = (lo_ + per < WC_NALL) ? lo_ + per : WC_NALL; ph_wconv(F, L + 1, (size_t)((L + 1) & 1) * WS_WSET, lo_, hi_); __syncthreads(); }
#endif
#endif
            SEAM(pb + 5); }
        if (PHON(6) && IN(pb + 6)) { LAUNDER(); pg8::Gemm g{WSP(pg8::bf16_t, WS_A1), WSL(pg8::bf16_t, WS_WOUT), T, D, KS * D}; pg8::StaticOrder S; S.init(T, D, F.G, F.bid);
            pg8::EpiResid E{L == 0 ? INP(0) : OUTP, OUTP, WSP(pg8::bf16_t, WS_A0), WSP(float, WS_SSQB), D, T};
            pg8::gemm_phase<pg8::EpiResid, pg8::StaticOrder, PG8_ALIGN, PG8_SP2>(glds, g, S, E, F.wave); SEAM(pb + 6); }
        if (PHON(7) && IN(pb + 7)) for (int rep = 0; rep < NREP(7); ++rep) { LAUNDER(); if (rep) xcd_barrier(bar); pg8::Gemm g{WSP(pg8::bf16_t, WS_A0), WSL(pg8::bf16_t, WS_WQ), T, D, KS * D}; pg8::StaticOrder S; S.init(T, D, F.G, F.bid);
#if ORACLE_ATTN
            pg8::rs_table_fill(glds, S, WSP(float, WS_SSQB), T, 1.0f / D, EPS, F.wave);
            pg8::EpiScaleF32 E{WSP(float, WS_XQ), D, nullptr, WSP(float, WS_SSQB), 32, glds, 1.0f / D, EPS};
            pg8::gemm_phase<pg8::EpiScaleF32, pg8::StaticOrder, PG8_ALIGN, PG8_SP2>(glds, g, S, E, F.wave);
#else
            pg8::rs_table_fill(glds, S, WSP(float, WS_SSQB), T, 1.0f / D, EPS, F.wave);
            pg8::EpiScaleBf16 E{WSP(pg8::bf16_t, WS_XQB), T, WSP(float, WS_SSQB), 32, glds, 1.0f / D, EPS, WSP(float, WS_QSS)};
            pg8::gemm_phase<pg8::EpiScaleBf16, pg8::StaticOrder, PG8_ALIGN, PG8_SP2>(glds, g, S, E, F.wave);
#endif
            SEAM(pb + 7); }
        if (PHON(8) && IN(pb + 8)) for (int rep = 0; rep < NREP(8); ++rep) { LAUNDER(); if (rep) xcd_barrier(bar);
#if ORACLE_ATTN
            ph_xattn(F, L);
            __syncthreads(); SEAM(pb + 8);
#else
#if XFUSE
            { const float* qg_ = INP(20) + L * 512; const float* kg_ = INP(21) + L * 512; float gq_ = 0.f, gk_ = 0.f;
#pragma unroll
              for (int i = 0; i < 8; ++i) { gq_ = fmaxf(gq_, fabsf(qg_[F.lane + 64 * i])); gk_ = fmaxf(gk_, fabsf(kg_[F.lane + 64 * i])); }
              const float bound_ = 22.627416997969522f * 1.4426950408889634f * 1.02f * wave_max(gq_) * wave_max(gk_);
#pragma unroll 1
              for (int h = 0; h < 4; ++h) { pg8::Gemm g{WSP(pg8::bf16_t, WS_XQB) + (size_t)h * T * 512, WSP(pg8::bf16_t, WS_KXF) + (size_t)h * MEM * 512, T, MEM, 512};
                  pg8::StaticOrder S; S.init(T, MEM, F.G, (F.bid + 64 * h) % F.G);
                  pg8::rs_table_fill(glds, S, WSP(float, WS_QSS), T, 1.0f / 512.0f, EPS, F.wave, 8 * h, 8, false);
                  pg8::EpiExpPN E{WSP(pg8::bf16_t, WS_PH), 1024, 256 * h, glds, bound_};
                  pg8::gemm_phase<pg8::EpiExpPN, pg8::StaticOrder, true, PG8_SP2>(glds, g, S, E, F.wave); __syncthreads(); }
#pragma unroll 1
              for (int h = 0; h < 4; ++h) { pg8::Gemm g{WSL(pg8::bf16_t, WS_WO) + (size_t)h * D * 512, WSP(pg8::bf16_t, WS_VXF) + (size_t)h * MEM * 512, D, MEM, 512};
                  pg8::StaticOrder S; S.init(D, MEM, F.G, (F.bid + 64 * h + 224) % F.G);
                  pg8::EpiPlainBf16 E{WSP(pg8::bf16_t, WS_BTC), 1024, 256 * h};
                  pg8::gemm_phase<pg8::EpiPlainBf16, pg8::StaticOrder, PG8_ALIGN, PG8_SP2>(glds, g, S, E, F.wave); __syncthreads(); } }
#else
            { const float* qg_ = INP(20) + L * 512; const float* kg_ = INP(21) + L * 512; float gq_ = 0.f, gk_ = 0.f;
#pragma unroll
              for (int i = 0; i < 8; ++i) { gq_ = fmaxf(gq_, fabsf(qg_[F.lane + 64 * i])); gk_ = fmaxf(gk_, fabsf(kg_[F.lane + 64 * i])); }
              const float bound_ = 22.627416997969522f * 1.4426950408889634f * 1.02f * wave_max(gq_) * wave_max(gk_);
#pragma unroll 1
              for (int h = 0; h < 4; ++h) { pg8::Gemm g{WSP(pg8::bf16_t, WS_XQB) + (size_t)h * T * 512, WSP(pg8::bf16_t, WS_KXF) + (size_t)h * MEM * 512, T, MEM, 512};
                  pg8::StaticOrder S; S.init(T, MEM, F.G, (F.bid + 64 * h) % F.G);
                  pg8::rs_table_fill(glds, S, WSP(float, WS_QSS), T, 1.0f / 512.0f, EPS, F.wave, 8 * h, 8, false);
                  pg8::EpiExpP E{WSP(pg8::bf16_t, WS_PH) + (size_t)h * T * MEM, WSP(float, WS_LPX) + (size_t)h * 4 * T, T, glds, bound_};
                  pg8::gemm_phase<pg8::EpiExpP, pg8::StaticOrder, PG8_ALIGN, PG8_SP2>(glds, g, S, E, F.wave); __syncthreads(); } }
            xcd_barrier(bar); LAUNDER();
#pragma unroll 1
            for (int h = 0; h < 4; ++h) { pg8::Gemm g{WSP(pg8::bf16_t, WS_PH) + (size_t)h * T * MEM, WSP(pg8::bf16_t, WS_VXF) + (size_t)h * 512 * MEM, T, 512, MEM};
                pg8::StaticOrder S; S.init(T, 512, F.G, (F.bid + 64 * h) % F.G);
                pg8::rs_table_fill(glds, S, WSP(float, WS_LPX) + (size_t)h * 4 * T, T, 1.0f, 0.f, F.wave, 0, 4, true);
                pg8::EpiRowScaleA E{WSP(pg8::bf16_t, WS_A1), D, 512 * h, glds};
                pg8::gemm_phase<pg8::EpiRowScaleA, pg8::StaticOrder, PG8_ALIGN, PG8_SP2>(glds, g, S, E, F.wave); __syncthreads(); }
#endif
            SEAM(pb + 8);
#endif
            }
        if (PHON(9) && IN(pb + 9)) { LAUNDER();
#if XFUSE
            pg8::Gemm g{WSP(pg8::bf16_t, WS_PH), WSP(pg8::bf16_t, WS_BTC), T, D, 1024};
#else
            pg8::Gemm g{WSP(pg8::bf16_t, WS_A1), WSL(pg8::bf16_t, WS_WO), T, D, KS * D};
#endif
            pg8::StaticOrder S; S.init(T, D, F.G, F.bid);
            pg8::EpiResid E{OUTP, OUTP, WSP(pg8::bf16_t, WS_A0), WSP(float, WS_SSQC), D, T};
            pg8::gemm_phase<pg8::EpiResid, pg8::StaticOrder, PG8_ALIGN, PG8_SP2>(glds, g, S, E, F.wave); SEAM(pb + 9); }
        if (PHON(10) && IN(pb + 10)) for (int rep = 0; rep < NREP(10); ++rep) { LAUNDER(); if (rep) xcd_barrier(bar); pg8::Gemm g{WSP(pg8::bf16_t, WS_A0), WSL(pg8::bf16_t, WS_W1), T, DFF, KS * D}; pg8::StaticOrder S; S.init(T, DFF, F.G, F.bid);
            pg8::rs_table_fill(glds, S, WSP(float, WS_SSQC), T, 1.0f / D, EPS, F.wave);
            pg8::EpiRelu2 E{WSP(pg8::bf16_t, WS_HM), DFF, WSP(float, WS_SSQC), 32, glds, 1.0f / D, EPS};
            pg8::gemm_phase<pg8::EpiRelu2, pg8::StaticOrder, PG8_ALIGN, PG8_SP2>(glds, g, S, E, F.wave); SEAM(pb + 10); }
        if (PHON(11) && IN(pb + 11)) { LAUNDER(); pg8::Gemm g{WSP(pg8::bf16_t, WS_HM), WSL(pg8::bf16_t, WS_W2), T, D, KS * DFF}; pg8::StaticOrder S; S.init(T, D, F.G, F.bid);
            pg8::EpiResid E{OUTP, OUTP, WSP(pg8::bf16_t, WS_A0), WSP(float, WS_SSQA), D, T};
            pg8::gemm_phase<pg8::EpiResid, pg8::StaticOrder, PG8_ALIGN, PG8_SP2>(glds, g, S, E, F.wave); SEAM(pb + 11); }
    }
    LAUNDER();
    if (hi - lo > 1 && hi == NPHASES) { __syncthreads(); if (xb_ld(&bar.bar[XB_TMO]) != 0u) { const float q = __builtin_nanf(""); for (int i = F.bid * 512 + F.tid; i < T * D; i += F.G * 512 * 64) OUTP[i] = q; } }
#undef IN
#undef SEAM
}

#ifndef MK_PER_PHASE
#define MK_PER_PHASE 0
#endif
extern "C" void kernel_launch(void* const* d_in, const int* in_sizes, int n_in, void* d_out, int out_size, void* d_ws, size_t ws_size, hipStream_t stream) {
    static int grid = 0;
    if (grid == 0) {
        if (n_in != 25 || out_size != T * D || ws_size < WS_END) { fprintf(stderr, "kernel_launch: unexpected sizes (n_in %d, out %d, ws %zu, need %zu); nothing launched\n", n_in, out_size, ws_size, (size_t)WS_END); grid = -1; return; }
        int dev = 0, cus = 0, per_cu = 0;
        if (hipGetDevice(&dev) != hipSuccess || hipDeviceGetAttribute(&cus, hipDeviceAttributeMultiprocessorCount, dev) != hipSuccess) { grid = -1; return; }
        if (hipFuncSetAttribute((const void*)fwd, hipFuncAttributeMaxDynamicSharedMemorySize, LDS_BYTES) != hipSuccess) { fprintf(stderr, "kernel_launch: hipFuncSetAttribute failed\n"); grid = -1; return; }
        if (hipOccupancyMaxActiveBlocksPerMultiprocessor(&per_cu, (const void*)fwd, 512, LDS_BYTES) != hipSuccess || per_cu < 1) { fprintf(stderr, "kernel_launch: occupancy query says %d\n", per_cu); }
        (void)hipGetLastError();
        grid = cus;
    }
    if (grid < 0) return;
    if (hipMemsetAsync((char*)d_ws + WS_CTL, 0, CTL_ZERO_BYTES, stream) != hipSuccess) return;
    Args a{};
    for (int i = 0; i < 25; ++i) a.in[i] = (const float*)d_in[i];
    a.out = (float*)d_out; a.ws = (unsigned char*)d_ws; a.pad = 0;
#if MK_PER_PHASE
    for (int p = 0; p < NPHASES; ++p) { a.ph_lo = p; a.ph_hi = p + 1; a.li = 0; hipLaunchKernelGGL(fwd, dim3(grid), dim3(512), LDS_BYTES, stream, a); }
#else
    a.ph_lo = 0; a.ph_hi = NPHASES; a.li = 0;
    hipLaunchKernelGGL(fwd, dim3(grid), dim3(512), LDS_BYTES, stream, a);
#endif
}
```
